# Optimizing an MI355X kernel written in HIP

```python
import math
import jax, jax.numpy as jnp
from jax import lax
import numpy as np

D_MODEL = 2048
BATCH = 2
SEQ = 16384
DEPTH = 2

N_A_LAYERS = DEPTH // 2
N_B_LAYERS = DEPTH - N_A_LAYERS
RMS_EPS = 1e-6
GLA_HEADS = 4
GLA_DK = D_MODEL // (2 * GLA_HEADS)
GLA_DV = D_MODEL // GLA_HEADS
GLA_GATE_RANK = 16
GLA_GATE_NORMALIZER = 16.0
GLA_LOG_GATE_MIN = -1.0
GLA_CHUNK = 64
GLA_PROJ = 2 * GLA_HEADS * GLA_DK + 2 * GLA_HEADS * GLA_DV + GLA_GATE_RANK
SWA_HEAD_DIM = 64
SWA_Q_HEADS = D_MODEL // SWA_HEAD_DIM
SWA_KV_HEADS = SWA_Q_HEADS // 8
SWA_GROUPS = SWA_Q_HEADS // SWA_KV_HEADS
WINDOW = 128
NUM_BUCKETS = 32
REL_MAX_DISTANCE = 128
MOE_GROUPS = 4
MOE_EXPERTS_PER_GROUP = 8
MOE_N_EXPERTS = MOE_GROUPS * MOE_EXPERTS_PER_GROUP
MOE_TOP_K = 2
MOE_D_FF = 512
MOE_TOKEN_BLOCK = 1024

kernel_name = 'yoco_gla_swa_sink_hmoe'


def rms_norm(x, g):
    x32 = x.astype(jnp.float32)
    y = x32 * lax.rsqrt(jnp.mean(x32 * x32, axis=-1, keepdims=True) + RMS_EPS)
    return (y * g.astype(jnp.float32)).astype(x.dtype)


def gla_mixer(x, norm_g, w_in, w_gate_up, b_gate, head_g, w_out):
    bsz, seq, _ = x.shape
    n_chunks = seq // GLA_CHUNK
    h = rms_norm(x, norm_g)
    proj = h @ w_in
    qk = GLA_HEADS * GLA_DK
    vd = GLA_HEADS * GLA_DV
    q, k, v, r, g_lr = jnp.split(proj, [qk, 2 * qk, 2 * qk + vd, 2 * qk + 2 * vd], axis=-1)
    log_a = jax.nn.log_sigmoid((g_lr @ w_gate_up + b_gate).astype(jnp.float32)) / GLA_GATE_NORMALIZER
    log_a = jnp.maximum(log_a, GLA_LOG_GATE_MIN)

    def chunks(t, dh):
        t = t.astype(jnp.float32).reshape(bsz, n_chunks, GLA_CHUNK, GLA_HEADS, dh)
        return t.transpose(0, 3, 1, 2, 4)

    q = chunks(q, GLA_DK) * (GLA_DK ** -0.5)
    k = chunks(k, GLA_DK)
    v = chunks(v, GLA_DV)
    b = jnp.cumsum(chunks(log_a, GLA_DK), axis=3)
    b_last = b[:, :, :, -1:, :]
    q_e = q * jnp.exp(b)
    k_e = k * jnp.exp(-b)
    k_last = k * jnp.exp(b_last - b)
    causal = jnp.tril(jnp.ones((GLA_CHUNK, GLA_CHUNK), dtype=bool))
    att = jnp.where(causal, jnp.einsum('bhnid,bhnjd->bhnij', q_e, k_e), 0.0)
    o_intra = jnp.einsum('bhnij,bhnjv->bhniv', att, v)

    def step(state, inp):
        qe_n, kl_n, v_n, dec_n = inp
        o_n = jnp.einsum('bhcd,bhdv->bhcv', qe_n, state)
        state = dec_n[..., None] * state + jnp.einsum('bhcd,bhcv->bhdv', kl_n, v_n)
        return state, o_n

    xs = (jnp.moveaxis(q_e, 2, 0), jnp.moveaxis(k_last, 2, 0), jnp.moveaxis(v, 2, 0),
          jnp.moveaxis(jnp.exp(b_last[:, :, :, 0, :]), 2, 0))
    s0 = jnp.zeros((bsz, GLA_HEADS, GLA_DK, GLA_DV), jnp.float32)
    _, o_inter = lax.scan(step, s0, xs)
    o = o_intra + jnp.moveaxis(o_inter, 0, 2)
    o = o.transpose(0, 2, 3, 1, 4).reshape(bsz, seq, GLA_HEADS, GLA_DV)
    o = rms_norm(o, head_g) * jax.nn.silu(r.astype(jnp.float32)).reshape(bsz, seq, GLA_HEADS, GLA_DV)
    return o.reshape(bsz, seq, vd).astype(x.dtype) @ w_out


def shared_kv(x, kv_norm, w_kv, k_norm):
    bsz, seq, _ = x.shape
    n_blk = seq // WINDOW
    kv = rms_norm(x, kv_norm) @ w_kv
    k, v = jnp.split(kv, 2, axis=-1)
    k = rms_norm(k.reshape(bsz, seq, SWA_KV_HEADS, SWA_HEAD_DIM), k_norm)
    v = v.reshape(bsz, seq, SWA_KV_HEADS, SWA_HEAD_DIM)

    def banded(t):
        tb = t.reshape(bsz, n_blk, WINDOW, SWA_KV_HEADS, SWA_HEAD_DIM)
        prev = jnp.concatenate([jnp.zeros_like(tb[:, :1]), tb[:, :-1]], axis=1)
        return jnp.moveaxis(jnp.concatenate([prev, tb], axis=2), 1, 0)

    return banded(k), banded(v)


def t5_bucket(dist):
    max_exact = NUM_BUCKETS // 2
    n = np.maximum(dist, 0)
    large = max_exact + (np.log(np.maximum(n, max_exact) / max_exact) / math.log(REL_MAX_DISTANCE / max_exact)
                         * (NUM_BUCKETS - max_exact)).astype(np.int32)
    return np.where(n < max_exact, n, np.minimum(large, NUM_BUCKETS - 1)).astype(np.int32)


def swa_mixer(x, k_blocks, v_blocks, rel_bias, norm_g, w_q, q_norm, sinks, w_out):
    bsz, seq, _ = x.shape
    n_blk = seq // WINDOW
    q = (rms_norm(x, norm_g) @ w_q).reshape(bsz, seq, SWA_Q_HEADS, SWA_HEAD_DIM)
    q = rms_norm(q, q_norm) * (SWA_HEAD_DIM ** -0.5)
    q = jnp.moveaxis(q.reshape(bsz, n_blk, WINDOW, SWA_KV_HEADS, SWA_GROUPS, SWA_HEAD_DIM), 1, 0)
    row = np.arange(WINDOW)[:, None]
    col = np.arange(2 * WINDOW)[None, :]
    dist = WINDOW + row - col
    band = jnp.asarray((dist >= 0) & (dist < WINDOW))
    first_ok = jnp.asarray(np.broadcast_to(col >= WINDOW, dist.shape))
    bias = rel_bias.astype(jnp.float32)[t5_bucket(dist)]
    bias = jnp.transpose(bias, (2, 0, 1)).reshape(SWA_KV_HEADS, SWA_GROUPS, WINDOW, 2 * WINDOW)
    sink = sinks.astype(jnp.float32).reshape(SWA_KV_HEADS, SWA_GROUPS)[None, :, :, None]

    def block(inp):
        q_n, k_n, v_n, n = inp
        s = jnp.einsum('bqhgd,bkhd->bhgqk', q_n.astype(jnp.float32), k_n.astype(jnp.float32)) + bias
        valid = band & (first_ok | (n > 0))
        s = jnp.where(valid, s, -jnp.inf)
        m = jnp.maximum(jnp.max(s, axis=-1), sink)
        p = jnp.exp(s - m[..., None])
        denom = jnp.sum(p, axis=-1) + jnp.exp(sink - m)
        o = jnp.einsum('bhgqk,bkhd->bqhgd', p, v_n.astype(jnp.float32))
        return o / jnp.transpose(denom, (0, 3, 1, 2))[..., None]

    o = lax.map(block, (q, k_blocks, v_blocks, jnp.arange(n_blk)))
    o = jnp.moveaxis(o, 0, 1).reshape(bsz, seq, SWA_Q_HEADS * SWA_HEAD_DIM).astype(x.dtype)
    return o @ w_out


def hier_moe(x, norm_g, w_group, b_group, w_router, b_router, w_gate, w_up, w_down):
    bsz, seq, d = x.shape
    t = bsz * seq
    h = rms_norm(x, norm_g).reshape(t, d)
    g_logits = (h @ w_group).astype(jnp.float32) + b_group.astype(jnp.float32)
    g_probs = jax.nn.softmax(g_logits, axis=-1)
    g_idx = jnp.argmax(g_logits, axis=-1)
    p_group = jnp.take_along_axis(g_probs, g_idx[:, None], axis=-1)
    e_logits = ((h @ w_router).astype(jnp.float32) + b_router.astype(jnp.float32)).reshape(t, MOE_GROUPS, MOE_EXPERTS_PER_GROUP)
    e_in = jnp.take_along_axis(e_logits, g_idx[:, None, None], axis=1)[:, 0]
    top_v, top_i = lax.top_k(e_in, MOE_TOP_K)
    top_w = jax.nn.softmax(top_v, axis=-1) * p_group
    flat = g_idx[:, None] * MOE_EXPERTS_PER_GROUP + top_i
    combine = jnp.sum(jax.nn.one_hot(flat, MOE_N_EXPERTS, dtype=jnp.float32) * top_w[..., None], axis=1)
    blk = math.gcd(t, MOE_TOKEN_BLOCK)

    def block(inp):
        h_b, c_b = inp
        a = jax.nn.silu(jnp.einsum('td,edf->tef', h_b, w_gate)) * jnp.einsum('td,edf->tef', h_b, w_up)
        return jnp.einsum('tef,efd->td', a * c_b[..., None].astype(a.dtype), w_down)

    y = lax.map(block, (h.reshape(t // blk, blk, d), combine.reshape(t // blk, blk, MOE_N_EXPERTS)))
    return y.reshape(bsz, seq, d)


def setup_inputs(seed: int = 0) -> dict:
    key = jax.random.key(seed)
    ks = jax.random.split(key, 24)
    f32 = jnp.float32

    def nrm(k, shape, scale):
        return jax.random.normal(k, shape, f32) * scale

    def gain(k, shape):
        return 1.0 + 0.02 * jax.random.normal(k, shape, f32)

    d = D_MODEL
    hq = SWA_Q_HEADS
    hd = SWA_HEAD_DIM
    ne = MOE_N_EXPERTS
    return {
        'x': nrm(ks[0], (BATCH, SEQ, d), 1.0),
        'gla_norm': gain(ks[1], (N_A_LAYERS, d)),
        'gla_w_in': nrm(ks[2], (N_A_LAYERS, d, GLA_PROJ), d ** -0.5),
        'gla_w_gate_up': nrm(ks[3], (N_A_LAYERS, GLA_GATE_RANK, GLA_HEADS * GLA_DK), GLA_GATE_RANK ** -0.5),
        'gla_b_gate': nrm(ks[4], (N_A_LAYERS, GLA_HEADS * GLA_DK), 0.1),
        'gla_head_norm': gain(ks[5], (N_A_LAYERS, GLA_DV)),
        'gla_w_out': nrm(ks[6], (N_A_LAYERS, GLA_HEADS * GLA_DV, d), (GLA_HEADS * GLA_DV) ** -0.5),
        'kv_norm': gain(ks[7], (d,)),
        'w_kv': nrm(ks[8], (d, 2 * SWA_KV_HEADS * hd), d ** -0.5),
        'k_norm': gain(ks[9], (hd,)),
        'rel_bias': nrm(ks[10], (NUM_BUCKETS, hq), 0.5),
        'swa_norm': gain(ks[11], (N_B_LAYERS, d)),
        'swa_w_q': nrm(ks[12], (N_B_LAYERS, d, hq * hd), d ** -0.5),
        'swa_q_norm': gain(ks[13], (N_B_LAYERS, hd)),
        'swa_sinks': nrm(ks[14], (N_B_LAYERS, hq), 1.0),
        'swa_w_out': nrm(ks[15], (N_B_LAYERS, hq * hd, d), (hq * hd) ** -0.5),
        'moe_norm': gain(ks[16], (DEPTH, d)),
        'moe_w_group': nrm(ks[17], (DEPTH, d, MOE_GROUPS), d ** -0.5),
        'moe_b_group': nrm(ks[18], (DEPTH, MOE_GROUPS), 0.01),
        'moe_w_router': nrm(ks[19], (DEPTH, d, ne), d ** -0.5),
        'moe_b_router': nrm(ks[20], (DEPTH, ne), 0.01),
        'moe_w_gate': nrm(ks[21], (DEPTH, ne, d, MOE_D_FF), d ** -0.5),
        'moe_w_up': nrm(ks[22], (DEPTH, ne, d, MOE_D_FF), d ** -0.5),
        'moe_w_down': nrm(ks[23], (DEPTH, ne, MOE_D_FF, d), MOE_D_FF ** -0.5),
    }


def reference(x, gla_norm, gla_w_in, gla_w_gate_up, gla_b_gate, gla_head_norm, gla_w_out,
              kv_norm, w_kv, k_norm, rel_bias, swa_norm, swa_w_q, swa_q_norm, swa_sinks, swa_w_out,
              moe_norm, moe_w_group, moe_b_group, moe_w_router, moe_b_router, moe_w_gate, moe_w_up, moe_w_down):
    h = x
    k_blocks = None
    v_blocks = None
    for layer in range(DEPTH):
        if layer < N_A_LAYERS:
            a = layer
            h = h + gla_mixer(h, gla_norm[a], gla_w_in[a], gla_w_gate_up[a], gla_b_gate[a],
                              gla_head_norm[a], gla_w_out[a])
        else:
            if layer == N_A_LAYERS:
                k_blocks, v_blocks = shared_kv(h, kv_norm, w_kv, k_norm)
            b = layer - N_A_LAYERS
            h = h + swa_mixer(h, k_blocks, v_blocks, rel_bias, swa_norm[b], swa_w_q[b], swa_q_norm[b],
                              swa_sinks[b], swa_w_out[b])
        h = h + hier_moe(h, moe_norm[layer], moe_w_group[layer], moe_b_group[layer], moe_w_router[layer],
                         moe_b_router[layer], moe_w_gate[layer], moe_w_up[layer], moe_w_down[layer])
    return h
```

```cpp
#include <hip/hip_runtime.h>
#include <cstdio>
#include <cstdint>

#ifndef MK_PER_PHASE
#define MK_PER_PHASE 1
#endif
#ifndef MK_LAST_PHASE
#define MK_LAST_PHASE 23
#endif

#ifndef MK_PHASE_MASK
#define MK_PHASE_MASK 0x7fffff
#endif

namespace pg8 {
#define PG8_LAS __attribute__((address_space(3)))
typedef unsigned short bf16_t;
typedef short bf16x8 __attribute__((ext_vector_type(8)));
typedef float f32x4 __attribute__((ext_vector_type(4)));
typedef unsigned u32x4 __attribute__((ext_vector_type(4)));
constexpr int BM = 256, BK = 64, HALF = 128, HTB = HALF * BK * 2  , STAGE_BYTES = 8 * HTB, NXCD = 8, WGM = 8;

__host__ __device__ __forceinline__ int lds_byte(int r, int c) { const int st = (r >> 4) * 2 + (c >> 5), rr = r & 15, cc = c & 31, ob = rr * 64 + cc * 2; return st * 1024 + (ob ^ (((ob >> 9) & 1) << 5)); }
__host__ __device__ __forceinline__ void stage_rc(int b, int& R, int& C) { const int st = b / 1024, sb = b % 1024, swz = sb ^ (((sb >> 9) & 1) << 5); R = (st >> 1) * 16 + swz / 64; C = (st & 1) * 32 + (swz % 64) / 2; }
__host__ __device__ __forceinline__ int perm32(int rho) { const int n = rho >> 4, i = rho & 15; return 8 * (i >> 2) + 4 * n + (i & 3); }

struct Unit { int pm, pn, pc; };
struct Gemm { const bf16_t* A; const bf16_t* Bt; int M, N, K; };


struct StaticOrder {
    int nM, nN, nwg, G, c;
    __host__ __device__ void init(int M, int N, int G_, int c_) { nM = M / BM; nN = N / BM; nwg = nM * nN; G = G_; c = c_; }
    __host__ __device__ bool next(int i, Unit& u) const {
        const long L = (long)i * G + c; if (L >= nwg) return false;
        int wgid = (int)L; { const int q = nwg / NXCD, r = nwg % NXCD, xcd = wgid % NXCD, off = wgid / NXCD; wgid = (xcd < r ? xcd * (q + 1) : r * (q + 1) + (xcd - r) * q) + off; }
        const int nig = WGM * nN, gid = wgid / nig, fm = gid * WGM, gsz = (nM - fm) < WGM ? (nM - fm) : WGM;
        u.pm = fm + ((wgid % nig) % gsz); u.pn = (wgid % nig) / gsz; u.pc = u.pn; return true;
    }
    __device__ __forceinline__ void a_ready(const Unit&) const {}
    __device__ __forceinline__ void done(const Unit&) const {}
};
struct GroupedOrder {
    const PG8_LAS unsigned char* texp; int MT, npn, G, c;
    __device__ __forceinline__ bool next(int i, Unit& u) const {
        const long L = (long)i * G + c; if (L >= (long)MT * npn) return false;
        const int pm = (int)(L / npn), pc = (int)(L % npn);
        const int e = __builtin_amdgcn_readfirstlane((int)texp[pm]);
        u.pm = pm; u.pn = e * npn + pc; u.pc = pc; return true;
    }
    __device__ __forceinline__ void a_ready(const Unit&) const {}
    __device__ __forceinline__ void done(const Unit&) const {}
};

__device__ __forceinline__ unsigned cvt_pk_bf16(float lo, float hi) { unsigned r; asm volatile("v_cvt_pk_bf16_f32 %0, %1, %2" : "=v"(r) : "v"(lo), "v"(hi)); return r; }

struct EpiBf16 {
    static constexpr bool PERM = true, AFTER_DRAIN = false;
    bf16_t* O; int ldc;
    __device__ __forceinline__ void operator()(const f32x4 (&acc)[2][2][4][2], const Unit& u, int wr, int wc, int fr, int fq) const {
        const int row0 = u.pm * BM + wr * 64 + fr, col0 = u.pc * BM + wc * 32 + 8 * fq;
#pragma unroll
        for (int ai = 0; ai < 2; ++ai)
#pragma unroll
            for (int m = 0; m < 4; ++m) { bf16_t* rowp = O + (size_t)(row0 + ai * HALF + m * 16) * ldc + col0;
#pragma unroll
                for (int bj = 0; bj < 2; ++bj) { const f32x4 v0 = acc[ai][bj][m][0], v1 = acc[ai][bj][m][1];
                    u32x4 w; w.x = cvt_pk_bf16(v0[0], v0[1]); w.y = cvt_pk_bf16(v0[2], v0[3]); w.z = cvt_pk_bf16(v1[0], v1[1]); w.w = cvt_pk_bf16(v1[2], v1[3]);
                    *(u32x4*)(rowp + bj * HALF) = w; } }
    }
};
struct EpiGlaProj {
    static constexpr bool PERM = true, AFTER_DRAIN = false;
    bf16_t *QK, *V, *R, *GL;
    __device__ __forceinline__ void operator()(const f32x4 (&acc)[2][2][4][2], const Unit& u, int wr, int wc, int fr, int fq) const {
        bf16_t* base; int ldc, ct;
        if (u.pc < 8) { base = QK; ldc = 2048; ct = u.pc; } else if (u.pc < 16) { base = V; ldc = 2048; ct = u.pc - 8; } else if (u.pc < 24) { base = R; ldc = 2048; ct = u.pc - 16; } else { base = GL; ldc = 256; ct = 0; }
        const int row0 = u.pm * BM + wr * 64 + fr, col0 = ct * BM + wc * 32 + 8 * fq;
#pragma unroll
        for (int ai = 0; ai < 2; ++ai)
#pragma unroll
            for (int m = 0; m < 4; ++m) { bf16_t* rowp = base + (size_t)(row0 + ai * HALF + m * 16) * ldc + col0;
#pragma unroll
                for (int bj = 0; bj < 2; ++bj) { const f32x4 v0 = acc[ai][bj][m][0], v1 = acc[ai][bj][m][1];
                    u32x4 w; w.x = cvt_pk_bf16(v0[0], v0[1]); w.y = cvt_pk_bf16(v0[2], v0[3]); w.z = cvt_pk_bf16(v1[0], v1[1]); w.w = cvt_pk_bf16(v1[2], v1[3]);
                    *(u32x4*)(rowp + bj * HALF) = w; } }
    }
};
struct EpiResF32 {
    static constexpr bool PERM = false, AFTER_DRAIN = false;
    float* C; const float* RES; int ldc;
    __device__ __forceinline__ void operator()(const f32x4 (&acc)[2][2][4][2], const Unit& u, int wr, int wc, int fr, int fq) const {
        const int row0 = u.pm * BM + wr * 64 + fr, col0 = u.pc * BM + wc * 32 + 4 * fq;
#pragma unroll
        for (int ai = 0; ai < 2; ++ai)
#pragma unroll
            for (int m = 0; m < 4; ++m) { const size_t off = (size_t)(row0 + ai * HALF + m * 16) * ldc + col0;
                f32x4 rv[2][2];
#pragma unroll
                for (int bj = 0; bj < 2; ++bj)
#pragma unroll
                    for (int n = 0; n < 2; ++n) rv[bj][n] = *(const f32x4*)(RES + off + bj * HALF + n * 16);
#pragma unroll
                for (int bj = 0; bj < 2; ++bj)
#pragma unroll
                    for (int n = 0; n < 2; ++n) *(f32x4*)(C + off + bj * HALF + n * 16) = acc[ai][bj][m][n] + rv[bj][n]; }
    }
};
struct EpiRouter {
    static constexpr bool PERM = false, AFTER_DRAIN = false;
    float* RL;
    __device__ __forceinline__ void operator()(const f32x4 (&acc)[2][2][4][2], const Unit& u, int wr, int wc, int fr, int fq) const {
        if (wc >= 2) return;
        const int row0 = u.pm * BM + wr * 64 + fr, col0 = wc * 32 + 4 * fq;
#pragma unroll
        for (int ai = 0; ai < 2; ++ai)
#pragma unroll
            for (int m = 0; m < 4; ++m) { float* rowp = RL + (size_t)(row0 + ai * HALF + m * 16) * 64 + col0;
#pragma unroll
                for (int n = 0; n < 2; ++n) *(f32x4*)(rowp + n * 16) = acc[ai][0][m][n]; }
    }
};
__device__ __forceinline__ float silu_f(float x) { return x * __builtin_amdgcn_rcpf(1.0f + __expf(-x)); }
struct EpiSwiGLU {
    static constexpr bool PERM = true, AFTER_DRAIN = false;
    bf16_t* ACT;
    __device__ __forceinline__ void operator()(const f32x4 (&acc)[2][2][4][2], const Unit& u, int wr, int wc, int fr, int fq) const {
        const int row0 = u.pm * BM + wr * 64 + fr, col0 = u.pc * HALF + wc * 32 + 8 * fq;
#pragma unroll
        for (int ai = 0; ai < 2; ++ai)
#pragma unroll
            for (int m = 0; m < 4; ++m) { bf16_t* rowp = ACT + (size_t)(row0 + ai * HALF + m * 16) * 512 + col0;
                const f32x4 g0 = acc[ai][0][m][0], g1 = acc[ai][0][m][1], u0 = acc[ai][1][m][0], u1 = acc[ai][1][m][1];
                u32x4 w;
                w.x = cvt_pk_bf16(silu_f(g0[0]) * u0[0], silu_f(g0[1]) * u0[1]); w.y = cvt_pk_bf16(silu_f(g0[2]) * u0[2], silu_f(g0[3]) * u0[3]);
                w.z = cvt_pk_bf16(silu_f(g1[0]) * u1[0], silu_f(g1[1]) * u1[1]); w.w = cvt_pk_bf16(silu_f(g1[2]) * u1[2], silu_f(g1[3]) * u1[3]);
                *(u32x4*)rowp = w; }
    }
};

template <class Epi, class Sched, bool ALIGN_EPI = false, bool SP2 = false>
__device__ __forceinline__ void gemm_phase(PG8_LAS unsigned char* lds, const Gemm g, const Sched& S, const Epi& E) {
    const int tid = threadIdx.x, wid = __builtin_amdgcn_readfirstlane(tid >> 6), lane = tid & 63, wr = wid >> 2, wc = wid & 3, fr = lane & 15, fq = lane >> 4;
    const int K = g.K, nt = K / BK;
    unsigned voffA[2], voffB[2];
#pragma unroll
    for (int i = 0; i < 2; ++i) { int R, C; stage_rc(tid * 16 + i * 8192, R, C); const int Rb = Epi::PERM ? ((R & ~31) + perm32(R & 31)) : R;
        voffA[i] = (unsigned)(R * K + C) * 2u; voffB[i] = (unsigned)(Rb * K + C) * 2u; }
    const size_t kstep = (size_t)(BK * 2);
    const size_t hstep = (size_t)HALF * K * 2;
    const size_t tstep = 2 * hstep;
    const unsigned ldsw = (unsigned)wid * 1024u;
    const int aoff = lds_byte(wr * 64 + fr, fq * 8), boff = lds_byte(wc * 32 + fr, fq * 8);
#define PG8_SA(b, h) (((b) * 2 + (h)) * HTB)
#define PG8_SB(b, h) ((4 + (b) * 2 + (h)) * HTB)
#define PG8_STAGE(bufoff, gbase, voff) do { _Pragma("unroll") for (int _i = 0; _i < 2; ++_i) \
        __builtin_amdgcn_global_load_lds((const unsigned*)((const char*)(gbase) + (voff)[_i]), (PG8_LAS unsigned*)(lds + (bufoff) + ldsw + _i * 8192), 16, 0, 0); } while (0)
#define PG8_LDA(dst, b, h) do { _Pragma("unroll") for (int m = 0; m < 4; ++m) _Pragma("unroll") for (int k = 0; k < 2; ++k) dst[m][k] = *(const PG8_LAS bf16x8*)(lds + PG8_SA(b, h) + aoff + m * 2048 + k * 1024); } while (0)
#define PG8_LDB(dst, b, h) do { _Pragma("unroll") for (int n = 0; n < 2; ++n) _Pragma("unroll") for (int k = 0; k < 2; ++k) dst[n][k] = *(const PG8_LAS bf16x8*)(lds + PG8_SB(b, h) + boff + n * 2048 + k * 1024); } while (0)
#define PG8_MMA(ai, bj, At, Bt) do { __builtin_amdgcn_s_setprio(1); _Pragma("unroll") for (int m = 0; m < 4; ++m) _Pragma("unroll") for (int n = 0; n < 2; ++n) _Pragma("unroll") for (int k = 0; k < 2; ++k) \
        acc[ai][bj][m][n] = __builtin_amdgcn_mfma_f32_16x16x32_bf16(Bt[n][k], At[m][k], acc[ai][bj][m][n], 0, 0, 0); __builtin_amdgcn_s_setprio(0); } while (0)
#define PG8_WAIT_V(n) asm volatile("s_waitcnt vmcnt(" #n ")" ::: "memory")
#define PG8_WAIT_L(n) asm volatile("s_waitcnt lgkmcnt(" #n ")" ::: "memory")
#define PG8_BAR __builtin_amdgcn_s_barrier()
#define PG8_SCHED __builtin_amdgcn_sched_barrier(0)
    Unit cur, nxt; int ui = 0;
    if (!S.next(0, cur)) return;
    f32x4 acc[2][2][4][2];
#pragma unroll
    for (int a = 0; a < 2; ++a)
#pragma unroll
        for (int b = 0; b < 2; ++b)
#pragma unroll
            for (int m = 0; m < 4; ++m)
#pragma unroll
                for (int n = 0; n < 2; ++n) acc[a][b][m][n] = (f32x4){0.f, 0.f, 0.f, 0.f};
    bf16x8 At[4][2], B0[2][2], B1[2][2];
    const char* cA = (const char*)g.A + (size_t)cur.pm * tstep; const char* cB = (const char*)g.Bt + (size_t)cur.pn * tstep;
    S.a_ready(cur);
    if constexpr (SP2) {
        PG8_STAGE(PG8_SB(0, 0), cB, voffB); PG8_STAGE(PG8_SB(0, 1), cB + hstep, voffB); PG8_STAGE(PG8_SA(0, 0), cA, voffA); PG8_STAGE(PG8_SA(0, 1), cA + hstep, voffA);
        if (wr == 1) PG8_BAR;
        PG8_WAIT_V(2); PG8_BAR;
        PG8_STAGE(PG8_SB(1, 0), cB + kstep, voffB); PG8_STAGE(PG8_SA(1, 0), cA + kstep, voffA); PG8_STAGE(PG8_SB(1, 1), cB + hstep + kstep, voffB);
        PG8_WAIT_V(6); PG8_BAR;
    } else {
        PG8_STAGE(PG8_SB(0, 0), cB, voffB); PG8_STAGE(PG8_SA(0, 0), cA, voffA); PG8_STAGE(PG8_SB(0, 1), cB + hstep, voffB); PG8_STAGE(PG8_SA(0, 1), cA + hstep, voffA);
        if (wr == 1) PG8_BAR;
        PG8_WAIT_V(4); PG8_BAR;
        PG8_STAGE(PG8_SB(1, 0), cB + kstep, voffB); PG8_STAGE(PG8_SA(1, 0), cA + kstep, voffA); PG8_STAGE(PG8_SB(1, 1), cB + hstep + kstep, voffB);
        PG8_WAIT_V(6); PG8_BAR;
    }
    for (;;) {
        const bool has_next = S.next(ui + 1, nxt);
        const char* nA = has_next ? (const char*)g.A + (size_t)nxt.pm * tstep : cA; const char* nB = has_next ? (const char*)g.Bt + (size_t)nxt.pn * tstep : cB;
        for (int t = 0; t < nt; t += 2) {
            const bool last = (t == nt - 2);
            const char* a1 = cA + (size_t)(t + 1) * kstep;
            const char* a2 = last ? nA : cA + (size_t)(t + 2) * kstep; const char* b2 = last ? nB : cB + (size_t)(t + 2) * kstep;
            const char* a3 = a2 + kstep; const char* b3 = b2 + kstep;
            if (last && has_next) S.a_ready(nxt);
            if constexpr (SP2) {
            PG8_LDB(B0, 0, 0); PG8_LDB(B1, 0, 1); PG8_SCHED; PG8_LDA(At, 0, 0); PG8_STAGE(PG8_SA(1, 1), a1 + hstep, voffA);
            PG8_WAIT_V(8); PG8_WAIT_L(0); PG8_BAR; PG8_MMA(0, 0, At, B0); PG8_MMA(0, 1, At, B1); PG8_BAR; PG8_SCHED;
            PG8_LDA(At, 0, 1); PG8_STAGE(PG8_SB(0, 0), b2, voffB); PG8_STAGE(PG8_SB(0, 1), b2 + hstep, voffB); PG8_STAGE(PG8_SA(0, 0), a2, voffA);
            PG8_WAIT_V(8); PG8_WAIT_L(0); PG8_BAR; PG8_MMA(1, 0, At, B0); PG8_MMA(1, 1, At, B1); PG8_BAR; PG8_SCHED;
            PG8_LDB(B0, 1, 0); PG8_LDB(B1, 1, 1); PG8_SCHED; PG8_LDA(At, 1, 0); PG8_STAGE(PG8_SA(0, 1), a2 + hstep, voffA);
            PG8_WAIT_V(8); PG8_WAIT_L(0); PG8_BAR; PG8_MMA(0, 0, At, B0); PG8_MMA(0, 1, At, B1); PG8_BAR; PG8_SCHED;
            PG8_LDA(At, 1, 1); PG8_STAGE(PG8_SB(1, 0), b3, voffB); PG8_STAGE(PG8_SB(1, 1), b3 + hstep, voffB); PG8_STAGE(PG8_SA(1, 0), a3, voffA);
            PG8_WAIT_V(8); PG8_WAIT_L(0); PG8_BAR; PG8_MMA(1, 0, At, B0); PG8_MMA(1, 1, At, B1); PG8_BAR; PG8_SCHED;
            } else {
            PG8_LDB(B0, 0, 0); PG8_SCHED; PG8_LDA(At, 0, 0); PG8_STAGE(PG8_SA(1, 1), a1 + hstep, voffA);
            PG8_WAIT_L(8); PG8_BAR; PG8_WAIT_L(0); PG8_MMA(0, 0, At, B0); PG8_BAR; PG8_SCHED;
            PG8_LDB(B1, 0, 1); PG8_STAGE(PG8_SB(0, 0), b2, voffB);
            PG8_BAR; PG8_WAIT_L(0); PG8_MMA(0, 1, At, B1); PG8_BAR;
            PG8_LDA(At, 0, 1); PG8_STAGE(PG8_SA(0, 0), a2, voffA);
            PG8_BAR; PG8_WAIT_L(0); PG8_MMA(1, 0, At, B0); PG8_BAR; PG8_SCHED;
            PG8_STAGE(PG8_SB(0, 1), b2 + hstep, voffB);
            PG8_WAIT_V(6); PG8_BAR; PG8_MMA(1, 1, At, B1); PG8_BAR;
            PG8_LDB(B0, 1, 0); PG8_SCHED; PG8_LDA(At, 1, 0); PG8_STAGE(PG8_SA(0, 1), a2 + hstep, voffA);
            PG8_WAIT_L(8); PG8_BAR; PG8_WAIT_L(0); PG8_MMA(0, 0, At, B0); PG8_BAR; PG8_SCHED;
            PG8_LDB(B1, 1, 1); PG8_STAGE(PG8_SB(1, 0), b3, voffB);
            PG8_BAR; PG8_WAIT_L(0); PG8_MMA(0, 1, At, B1); PG8_BAR;
            PG8_LDA(At, 1, 1); PG8_STAGE(PG8_SA(1, 0), a3, voffA);
            PG8_BAR; PG8_WAIT_L(0); PG8_MMA(1, 0, At, B0); PG8_BAR; PG8_SCHED;
            PG8_STAGE(PG8_SB(1, 1), b3 + hstep, voffB);
            PG8_WAIT_V(6); PG8_BAR; PG8_MMA(1, 1, At, B1); PG8_BAR;
            }
        }
        if constexpr (ALIGN_EPI) { if (wr == 0) PG8_BAR; }
        if constexpr (!Epi::AFTER_DRAIN) { E(acc, cur, wr, wc, fr, fq); S.done(cur); }
        if (!has_next) break;
#pragma unroll
        for (int a = 0; a < 2; ++a)
#pragma unroll
            for (int b = 0; b < 2; ++b)
#pragma unroll
                for (int m = 0; m < 4; ++m)
#pragma unroll
                    for (int n = 0; n < 2; ++n) acc[a][b][m][n] = (f32x4){0.f, 0.f, 0.f, 0.f};
        cur = nxt; cA = nA; cB = nB; ++ui;
        if constexpr (ALIGN_EPI) { if (wr == 1) PG8_BAR; }
    }
    PG8_WAIT_V(0);
    if constexpr (!ALIGN_EPI) { if (wr == 0) PG8_BAR; }
    PG8_BAR;
    if constexpr (Epi::AFTER_DRAIN) { E.fused(acc, cur, wr, wc, fr, fq, lds, wid, lane); S.done(cur); }
#undef PG8_SA
#undef PG8_SB
#undef PG8_STAGE
#undef PG8_LDA
#undef PG8_LDB
#undef PG8_MMA
#undef PG8_WAIT_V
#undef PG8_WAIT_L
#undef PG8_BAR
#undef PG8_SCHED
}
}

constexpr int NWAVES = 8;
constexpr int T = 32768, D = 2048, SEQ = 16384;
constexpr float RMS_EPS = 1e-6f;
constexpr int GLA_H = 4, GLA_DK = 256, GLA_DV = 512, GLA_C = 64, GLA_NCH = SEQ / GLA_C  , GLA_PROJ_N = 6160, GLA_PROJ_NP = 6400;
constexpr int NITEM_GLA = 2 * GLA_H * GLA_NCH;
constexpr int SWA_HQ = 32, SWA_HKV = 4, SWA_HD = 64, SWA_W = 128, KVQ_N = 2560;
constexpr int NE = 32, FF = 512, MOE_MAXROWS = 2 * T + NE * 256;

constexpr size_t MiB = 1u << 20;
constexpr size_t WS_CTL = 0, CTL_ZERO_BYTES = 1 * MiB;
constexpr size_t WS_W_GLA_IN = 1 * MiB;
constexpr size_t WS_W_GLA_OUT = 26 * MiB;
constexpr size_t WS_W_KVQ = 34 * MiB;
constexpr size_t WS_W_SWA_OUT = 44 * MiB;
constexpr size_t WS_W_ROUTER = 52 * MiB;
constexpr size_t WS_TOK = 54 * MiB;
constexpr size_t WS_RL = 56 * MiB;
constexpr size_t WS_W_GU = 64 * MiB;
constexpr size_t WS_W_DN = 192 * MiB;
constexpr size_t WS_HN = 256 * MiB;
constexpr size_t WS_BIG = 384 * MiB;
constexpr size_t WS_QK = WS_BIG;
constexpr size_t WS_V = WS_BIG + 128 * MiB;
constexpr size_t WS_R = WS_BIG + 256 * MiB;
constexpr size_t WS_GL = WS_BIG + 384 * MiB;
constexpr size_t WS_QEF = WS_BIG + 400 * MiB;
constexpr size_t WS_KLTF = WS_BIG + 464 * MiB;
constexpr size_t WS_ATTF = WS_BIG + 528 * MiB;
constexpr size_t WS_VTF = WS_BIG + 544 * MiB;
constexpr size_t WS_DEC = WS_BIG + 672 * MiB;
constexpr size_t WS_GLA_END = WS_BIG + 674 * MiB;
constexpr size_t WS_XS = WS_BIG;
constexpr size_t WS_ACT = WS_BIG + 288 * MiB;
constexpr size_t WS_Y = WS_BIG + 360 * MiB;
constexpr size_t WS_KVQ = WS_BIG;
constexpr size_t WS_AO = WS_BIG + 160 * MiB;
constexpr size_t WS_END = WS_GLA_END;
static_assert(WS_Y + (size_t)MOE_MAXROWS * 2048 * 2 <= WS_END && WS_ACT + (size_t)MOE_MAXROWS * 512 * 2 <= WS_Y, "MoE map");
constexpr int CW_BAR = 4096;
constexpr int CW_CNT = 16384;

constexpr int RING_OFF = 0, RING_BYTES = 131072;
constexpr int LDSCTL_OFF = RING_BYTES;
constexpr int MISC_OFF = LDSCTL_OFF + 64;
constexpr int MOE_OFF_OFF = LDSCTL_OFF + 256;
constexpr int MOE_TEXP_OFF = LDSCTL_OFF + 512;
constexpr int LDS_BYTES = 147456;

#define GAS __attribute__((address_space(1)))
#define LAS __attribute__((address_space(3)))
typedef unsigned short bf16;
typedef unsigned v4u __attribute__((ext_vector_type(4)));
typedef unsigned v2u __attribute__((ext_vector_type(2)));
typedef float f32x4 __attribute__((ext_vector_type(4)));
typedef short bf16x8 __attribute__((ext_vector_type(8)));
typedef GAS unsigned gu32;
#define RLX_AGENT __ATOMIC_RELAXED, __HIP_MEMORY_SCOPE_AGENT
#define LDS_WAIT() asm volatile("s_waitcnt lgkmcnt(0)" ::: "memory")
#define VM_WAIT() asm volatile("s_waitcnt vmcnt(0)" ::: "memory")
__device__ __forceinline__ unsigned f2bf(float f) { unsigned u = __builtin_bit_cast(unsigned, f); return (u + 0x7fffu + ((u >> 16) & 1u)) >> 16; }
__device__ __forceinline__ unsigned pk2(float lo, float hi) { return pg8::cvt_pk_bf16(lo, hi); }
__device__ __forceinline__ float bf_lo(unsigned w) { return __builtin_bit_cast(float, w << 16); }
__device__ __forceinline__ float bf_hi(unsigned w) { return __builtin_bit_cast(float, w & 0xffff0000u); }
__device__ __forceinline__ float bf2f(bf16 b) { return __builtin_bit_cast(float, ((unsigned)b) << 16); }
__device__ __forceinline__ float wave_sum(float v) {
#pragma unroll
    for (int o = 1; o < 64; o <<= 1) v += __shfl_xor(v, o);
    return v;
}

#define XB_TMO      128
#define XB_XCNT(j)  (256  + 64 * (j))
#define XB_XSUB(j)  (1280 + 64 * (j))
#define XB_XGEN(j)  (2304 + 64 * (j))
#define XB_TOP      3328
#define XB_TOPGEN   3392
#define XCD_BAR_WORDS 3456
#define XB_SPIN_CAP (1u << 18)

__device__ __forceinline__ unsigned xb_ld(unsigned* p)              { return __hip_atomic_load(p, __ATOMIC_RELAXED, __HIP_MEMORY_SCOPE_AGENT); }
__device__ __forceinline__ unsigned xb_add(unsigned* p, unsigned v) { return __hip_atomic_fetch_add(p, v, __ATOMIC_RELAXED, __HIP_MEMORY_SCOPE_AGENT); }
__device__ __forceinline__ unsigned xb_xcc_id() { return (unsigned)__builtin_amdgcn_s_getreg((3 << 11) | 20) & 0xFu; }
#define XB_SPIN(cond, bar) do { unsigned _sp = 0; while (cond) { __builtin_amdgcn_s_sleep(1); \
    if ((++_sp & 255u) == 0u) { if (xb_ld(&(bar)[XB_TMO])) break; if (_sp > XB_SPIN_CAP) { atomicAdd(&(bar)[XB_TMO], 1u); break; } } } } while (0)

struct XcdBarrier {
    unsigned* bar; unsigned x;
    volatile LAS unsigned* st;
};

__device__ __forceinline__ XcdBarrier xcd_barrier_post(unsigned* bar, volatile LAS unsigned* st) {
    XcdBarrier b; b.bar = bar; b.x = xb_xcc_id(); b.st = st;
    if (threadIdx.x == 0) (void)xb_add(&bar[XB_XCNT(b.x)], 1u);
    return b;
}
__device__ __forceinline__ void xcd_barrier_complete(unsigned* bar, unsigned x, unsigned& nloc, unsigned& nx) {
    const unsigned G = gridDim.x * gridDim.y * gridDim.z;
    unsigned sum, cnt, mine, sp = 0u;
    for (;;) {
        sum = 0u; cnt = 0u; mine = 0u;
#pragma unroll
        for (unsigned j = 0; j < 16; ++j) { const unsigned c = xb_ld(&bar[XB_XCNT(j)]); sum += c; cnt += (c > 0u) ? 1u : 0u; mine = (j == x) ? c : mine; }
        if (sum == G) break;
        __builtin_amdgcn_s_sleep(1);
        if ((++sp & 255u) == 0u) { if (xb_ld(&bar[XB_TMO])) break; if (sp > XB_SPIN_CAP) { atomicAdd(&bar[XB_TMO], 1u); break; } }
    }
    nloc = mine > 0u ? mine : 1u; nx = cnt > 0u ? cnt : 1u;
}

__device__ __forceinline__ void xcd_barrier(const XcdBarrier& b) {
    asm volatile("s_waitcnt vmcnt(0)" ::: "memory");
    __syncthreads();
    if (threadIdx.x == 0) {
        unsigned* bar = b.bar;
        __builtin_amdgcn_s_waitcnt(0);
        unsigned nloc = b.st[0], nx = b.st[1];
        if (nloc == 0u) { xcd_barrier_complete(bar, b.x, nloc, nx); b.st[0] = nloc; b.st[1] = nx; }
        const unsigned old = xb_add(&bar[XB_XSUB(b.x)], 1u);
        const unsigned gen = old / nloc;
        if (old + 1u == (gen + 1u) * nloc) {
            __builtin_amdgcn_fence(__ATOMIC_RELEASE, "agent");
            asm volatile("s_waitcnt vmcnt(0)" ::: "memory");
            const unsigned og = xb_add(&bar[XB_TOP], 1u);
            const unsigned tg = og / nx;
            if (og + 1u == (tg + 1u) * nx) xb_add(&bar[XB_TOPGEN], 1u);
            else XB_SPIN(xb_ld(&bar[XB_TOPGEN]) == tg, bar);
            __builtin_amdgcn_fence(__ATOMIC_ACQUIRE, "agent");
            xb_add(&bar[XB_XGEN(b.x)], 1u);
            asm volatile("s_waitcnt vmcnt(0)" ::: "memory");
        } else {
            XB_SPIN(xb_ld(&bar[XB_XGEN(b.x)]) == gen, bar);
            __builtin_amdgcn_fence(__ATOMIC_ACQUIRE, "agent");
            asm volatile("s_waitcnt vmcnt(0)" ::: "memory");
        }
    }
    __syncthreads();
}


__device__ __forceinline__ void cvt_item(const float* W, int N, const float* gain, bf16* WT, int K, int k0, int n0, int nvalid, size_t dst_row0, LAS float* scr, int lane) {
    const int nn = lane & 31;
#pragma unroll 8
    for (int i = 0; i < 32; ++i) { const int kk = 2 * i + (lane >> 5);
        float v = (nn < nvalid) ? W[(size_t)(k0 + kk) * N + n0 + nn] : 0.f;
        if (gain) v *= gain[k0 + kk];
        scr[kk * 33 + nn] = v; }
    LDS_WAIT(); asm volatile("" ::: "memory");
    const int c = lane & 7;
#pragma unroll
    for (int j = 0; j < 4; ++j) { const int n = (lane >> 3) + 8 * j; const LAS float* s = scr + (8 * c) * 33 + n;
        v4u o; o.x = pk2(s[0 * 33], s[1 * 33]); o.y = pk2(s[2 * 33], s[3 * 33]); o.z = pk2(s[4 * 33], s[5 * 33]); o.w = pk2(s[6 * 33], s[7 * 33]);
        if (n < nvalid) *(GAS v4u*)(WT + (dst_row0 + n) * (size_t)K + k0 + 8 * c) = o; }
    LDS_WAIT(); asm volatile("" ::: "memory");
}
__device__ __forceinline__ void cvt_matrix(const float* W, int K, int N, const float* gain, bf16* WT, int rowbase, LAS float* scr, int gw, int NGW, int lane) {
    const int nblk = (N + 31) / 32, nitems = (K / 64) * nblk;
    for (int it = gw; it < nitems; it += NGW) { const int kb = it / nblk, nb = it - kb * nblk, n0 = nb * 32; const int nv = (N - n0) < 32 ? (N - n0) : 32;
        cvt_item(W, N, gain, WT, K, kb * 64, n0, nv, (size_t)(rowbase + n0), scr, lane); }
}
__device__ __forceinline__ void cvt_moe(const float* wg, const float* wu, const float* wd, const float* gain, bf16* WGU, bf16* WDN, LAS float* scr, int gw, int NGW, int lane) {
    for (int it = gw; it < 2 * 16384; it += NGW) { const int which = it >> 14, r = it & 16383, e = r >> 9, q = r & 511, kb = q >> 4, nb = q & 15, n0 = nb * 32;
        const float* W = (which ? wu : wg) + (size_t)e * 2048 * 512;
        const size_t dst = (size_t)e * 1024 + 256 * (n0 >> 7) + (n0 & 127) + (which ? 128 : 0);
        cvt_item(W, 512, gain, WGU, 2048, kb * 64, n0, 32, dst, scr, lane); }
    for (int it = gw; it < 16384; it += NGW) { const int e = it >> 9, q = it & 511, kb = q >> 6, nb = q & 63;
        cvt_item(wd + (size_t)e * 512 * 2048, 2048, nullptr, WDN + (size_t)e * 2048 * 512, 512, kb * 64, nb * 32, 32, (size_t)(nb * 32), scr, lane); }
}
__device__ __forceinline__ void norm_rows(const float* src, bf16* dst, int gw, int NGW, int lane) {
    for (int m = gw; m < T; m += NGW) {
        const GAS f32x4* xr = (const GAS f32x4*)(src + (size_t)m * D) + lane;
        f32x4 v[8]; float s = 0.f;
#pragma unroll
        for (int j = 0; j < 8; ++j) { v[j] = xr[64 * j]; s += (v[j].x * v[j].x + v[j].y * v[j].y) + (v[j].z * v[j].z + v[j].w * v[j].w); }
        const float rstd = rsqrtf(wave_sum(s) * (1.f / D) + RMS_EPS);
        GAS v2u* o8 = (GAS v2u*)(dst + (size_t)m * D) + lane;
#pragma unroll
        for (int j = 0; j < 8; ++j) { v2u o; o.x = pk2(v[j].x * rstd, v[j].y * rstd); o.y = pk2(v[j].z * rstd, v[j].w * rstd); o8[64 * j] = o; }
    }
}

__device__ __forceinline__ float logsig(float z) { return fminf(z, 0.f) - __logf(1.f + __expf(-fabsf(z))); }
constexpr int GP_QE = 0, GP_KE = 33792, GP_ATT = 67584, GP_GLF = 76800, GP_TOT = 81152;
__device__ __forceinline__ void gla_prepass(LAS unsigned char* lds, const bf16* QK, const bf16* V, const bf16* GL, const float* Wgu, const float* bgate,
                                            bf16* QEF, bf16* KLTF, bf16* ATTF, bf16* VTF, float* DEC) {
    const int tid = threadIdx.x, lane = tid & 63, wave = __builtin_amdgcn_readfirstlane(tid >> 6), d = tid & 255, half = tid >> 8;
    LAS bf16* QEl = (LAS bf16*)(lds + GP_QE); LAS bf16* KEl = (LAS bf16*)(lds + GP_KE); LAS bf16* ATl = (LAS bf16*)(lds + GP_ATT);
    LAS float* glf = (LAS float*)(lds + GP_GLF); LAS float* tot = (LAS float*)(lds + GP_TOT);
    for (int it = blockIdx.x; it < NITEM_GLA; it += gridDim.x) {
        const int bh = it >> 8, n = it & 255, h = bh & 3, b = bh >> 2; const int t0 = b * SEQ + n * GLA_C;
        __syncthreads();
        { const int c = tid >> 3, j2 = (tid & 7) * 2; const unsigned w = *(const GAS unsigned*)(GL + (size_t)(t0 + c) * 256 + j2); glf[c * 17 + j2] = bf_lo(w); glf[c * 17 + j2 + 1] = bf_hi(w); }
        float wg[16];
#pragma unroll
        for (int j = 0; j < 16; ++j) wg[j] = Wgu[j * 1024 + h * 256 + d];
        const float bg = bgate[h * 256 + d];
        __syncthreads();
        float la[32]; float run = 0.f;
#pragma unroll
        for (int i = 0; i < 32; ++i) { const int c = half * 32 + i; float z = bg;
#pragma unroll
            for (int j = 0; j < 16; ++j) z += glf[c * 17 + j] * wg[j];
            run += fmaxf(logsig(z) * 0.0625f, -1.0f); la[i] = run; }
        tot[half * 256 + d] = run;
        __syncthreads();
        const float other = tot[(1 - half) * 256 + d]; const float blast = run + other, offs = half ? other : 0.f;
        const bf16* qp = QK + (size_t)t0 * 2048 + h * 256 + d;
#pragma unroll
        for (int g = 0; g < 4; ++g) { float klv[8];
#pragma unroll
            for (int jj = 0; jj < 8; ++jj) { const int i = 8 * g + jj, c = half * 32 + i; const float bb = la[i] + offs;
                const float qv = bf2f(qp[(size_t)c * 2048]), kv = bf2f(qp[(size_t)c * 2048 + 1024]);
                QEl[c * 264 + d] = (bf16)f2bf(qv * 0.0625f * __expf(bb)); KEl[c * 264 + d] = (bf16)f2bf(kv * __expf(-bb)); klv[jj] = kv * __expf(blast - bb); }
            v4u o; o.x = pk2(klv[0], klv[1]); o.y = pk2(klv[2], klv[3]); o.z = pk2(klv[4], klv[5]); o.w = pk2(klv[6], klv[7]);
            const size_t fi = ((((size_t)it * 8 + (d >> 5)) * 2 + ((d >> 4) & 1)) * 2 + half) * 64 + g * 16 + (d & 15);
            *(GAS v4u*)(KLTF + fi * 8) = o; }
        if (half == 0) DEC[(size_t)it * 256 + d] = __expf(blast);
        { const bf16* vp = V + (size_t)t0 * 2048 + h * 512 + tid;
#pragma unroll
          for (int ks = 0; ks < 2; ++ks)
#pragma unroll
            for (int q = 0; q < 4; ++q) { unsigned short e[8];
#pragma unroll
                for (int jj = 0; jj < 8; ++jj) e[jj] = vp[(size_t)(32 * ks + 8 * q + jj) * 2048];
                v4u o; o.x = e[0] | ((unsigned)e[1] << 16); o.y = e[2] | ((unsigned)e[3] << 16); o.z = e[4] | ((unsigned)e[5] << 16); o.w = e[6] | ((unsigned)e[7] << 16);
                const size_t fi = (((size_t)it * 32 + (tid >> 4)) * 2 + ks) * 64 + q * 16 + (tid & 15);
                *(GAS v4u*)(VTF + fi * 8) = o; } }
        __syncthreads();
        { const int mt = wave >> 1, i = lane & 15, q = lane >> 4;
#pragma unroll
          for (int nn = 0; nn < 2; ++nn) { const int nt = 2 * (wave & 1) + nn; f32x4 acc = {0.f, 0.f, 0.f, 0.f};
            if (nt <= mt) {
#pragma unroll
                for (int ks = 0; ks < 8; ++ks) { const bf16x8 a = *(const LAS bf16x8*)(QEl + (16 * mt + i) * 264 + 32 * ks + 8 * q); const bf16x8 bb = *(const LAS bf16x8*)(KEl + (16 * nt + i) * 264 + 32 * ks + 8 * q);
                    acc = __builtin_amdgcn_mfma_f32_16x16x32_bf16(a, bb, acc, 0, 0, 0); } }
#pragma unroll
            for (int r = 0; r < 4; ++r) { const int c = 16 * mt + 4 * q + r, cp = 16 * nt + i; ATl[c * 72 + cp] = (bf16)f2bf(cp <= c ? acc[r] : 0.f); } } }
        __syncthreads();
        { const int f = tid, mt = f >> 7, ks = (f >> 6) & 1, l2 = f & 63, i2 = l2 & 15, q2 = l2 >> 4;
          const v4u o = *(const LAS v4u*)(ATl + (16 * mt + i2) * 72 + 32 * ks + 8 * q2);
          *(GAS v4u*)(ATTF + ((size_t)it * 512 + f) * 8) = o; }
#pragma unroll
        for (int k = 0; k < 4; ++k) { const int f = tid + 512 * k, w = f >> 8, mt = (f >> 6) & 3, l2 = f & 63, i2 = l2 & 15, q2 = l2 >> 4;
            const v2u lo = *(const LAS v2u*)(QEl + (16 * mt + i2) * 264 + 32 * w + 4 * q2), hi = *(const LAS v2u*)(QEl + (16 * mt + i2) * 264 + 32 * w + 16 + 4 * q2);
            v4u o; o.x = lo.x; o.y = lo.y; o.z = hi.x; o.w = hi.y;
            *(GAS v4u*)(QEF + ((((size_t)it * 8 + w) * 4 + mt) * 64 + l2) * 8) = o; }
    }
}
struct GStep { bf16x8 qa[4], ka[2][2], vb[2], at; f32x4 dc[2]; };
__device__ __forceinline__ void gla_load(GStep& s, int it, int vs, int w, int lane, const bf16* QEF, const bf16* KLTF, const bf16* ATTF, const bf16* VTF, const float* DEC) {
    const GAS bf16x8* q16 = (const GAS bf16x8*)QEF + (((size_t)it * 8 + w) * 4) * 64 + lane;
#pragma unroll
    for (int mt = 0; mt < 4; ++mt) s.qa[mt] = q16[mt * 64];
    const GAS bf16x8* k16 = (const GAS bf16x8*)KLTF + (((size_t)it * 8 + w) * 4) * 64 + lane;
#pragma unroll
    for (int m = 0; m < 2; ++m)
#pragma unroll
        for (int ks = 0; ks < 2; ++ks) s.ka[m][ks] = k16[(m * 2 + ks) * 64];
    const GAS bf16x8* v16 = (const GAS bf16x8*)VTF + (((size_t)it * 32 + vs) * 2) * 64 + lane;
    s.vb[0] = v16[0]; s.vb[1] = v16[64];
    s.at = ((const GAS bf16x8*)ATTF)[(size_t)it * 512 + w * 64 + lane];
    const GAS f32x4* d4 = (const GAS f32x4*)(DEC + (size_t)it * 256 + 32 * w + 4 * (lane >> 4));
    s.dc[0] = d4[0]; s.dc[1] = d4[4];
}
__device__ __forceinline__ void gla_seq(LAS unsigned char* lds, const bf16* QEF, const bf16* KLTF, const bf16* ATTF, const bf16* VTF, const float* DEC, bf16* O) {
    const int tid = threadIdx.x, lane = tid & 63, w = __builtin_amdgcn_readfirstlane(tid >> 6), q = lane >> 4;
    LAS float* part = (LAS float*)lds;
    for (int wi = blockIdx.x; wi < 256; wi += gridDim.x) {
        const int bh = wi & 7, vs = wi >> 3, h = bh & 3, b = bh >> 2;
        f32x4 S0 = {0.f, 0.f, 0.f, 0.f}, S1 = {0.f, 0.f, 0.f, 0.f};
        GStep cur, nxt;
        gla_load(cur, bh * 256, vs, w, lane, QEF, KLTF, ATTF, VTF, DEC);
        __syncthreads();
        for (int n = 0; n < GLA_NCH; ++n) {
            const int it = bh * 256 + n;
            gla_load(nxt, (n + 1 < GLA_NCH) ? it + 1 : it, vs, w, lane, QEF, KLTF, ATTF, VTF, DEC);
            v4u sbw; sbw.x = pk2(S0[0], S0[1]); sbw.y = pk2(S0[2], S0[3]); sbw.z = pk2(S1[0], S1[1]); sbw.w = pk2(S1[2], S1[3]);
            const bf16x8 sb = __builtin_bit_cast(bf16x8, sbw);
            f32x4 po[4];
#pragma unroll
            for (int mt = 0; mt < 4; ++mt) po[mt] = __builtin_amdgcn_mfma_f32_16x16x32_bf16(cur.qa[mt], sb, (f32x4){0.f, 0.f, 0.f, 0.f}, 0, 0, 0);
            const bf16x8 vsel = (w & 1) ? cur.vb[1] : cur.vb[0];
#pragma unroll
            for (int mt = 0; mt < 4; ++mt) if (mt == (w >> 1)) po[mt] = __builtin_amdgcn_mfma_f32_16x16x32_bf16(cur.at, vsel, po[mt], 0, 0, 0);
            S0 = S0 * cur.dc[0]; S1 = S1 * cur.dc[1];
            S0 = __builtin_amdgcn_mfma_f32_16x16x32_bf16(cur.ka[0][0], cur.vb[0], S0, 0, 0, 0); S0 = __builtin_amdgcn_mfma_f32_16x16x32_bf16(cur.ka[0][1], cur.vb[1], S0, 0, 0, 0);
            S1 = __builtin_amdgcn_mfma_f32_16x16x32_bf16(cur.ka[1][0], cur.vb[0], S1, 0, 0, 0); S1 = __builtin_amdgcn_mfma_f32_16x16x32_bf16(cur.ka[1][1], cur.vb[1], S1, 0, 0, 0);
            LAS float* pb = part + (size_t)((n & 1) * 8 + w) * 1024;
#pragma unroll
            for (int mt = 0; mt < 4; ++mt)
#pragma unroll
                for (int r = 0; r < 4; ++r) pb[(16 * mt + 4 * q + r) * 16 + (lane & 15)] = po[mt][r];
            __syncthreads();
            { const int c = tid >> 3, v2 = (tid & 7) * 2; const LAS float* pr = part + (size_t)((n & 1) * 8) * 1024 + c * 16 + v2; float s0 = 0.f, s1 = 0.f;
#pragma unroll
              for (int ww = 0; ww < 8; ++ww) { s0 += pr[ww * 1024]; s1 += pr[ww * 1024 + 1]; }
              *(GAS unsigned*)(O + (size_t)(b * SEQ + n * GLA_C + c) * 2048 + h * 512 + vs * 16 + v2) = pk2(s0, s1); }
            cur = nxt;
        }
        __syncthreads();
    }
}
__device__ __forceinline__ void gla_gate(const bf16* O, const bf16* R, const float* head_g, bf16* OG, int gw, int NGW, int lane) {
    float hg[8];
#pragma unroll
    for (int j = 0; j < 8; ++j) hg[j] = head_g[8 * lane + j];
    for (int m = gw; m < T; m += NGW) {
#pragma unroll
        for (int h = 0; h < 4; ++h) {
            const v4u ov = *(const GAS v4u*)(O + (size_t)m * 2048 + h * 512 + 8 * lane), rv = *(const GAS v4u*)(R + (size_t)m * 2048 + h * 512 + 8 * lane);
            float o[8] = {bf_lo(ov.x), bf_hi(ov.x), bf_lo(ov.y), bf_hi(ov.y), bf_lo(ov.z), bf_hi(ov.z), bf_lo(ov.w), bf_hi(ov.w)};
            float r[8] = {bf_lo(rv.x), bf_hi(rv.x), bf_lo(rv.y), bf_hi(rv.y), bf_lo(rv.z), bf_hi(rv.z), bf_lo(rv.w), bf_hi(rv.w)};
            float ss = 0.f;
#pragma unroll
            for (int j = 0; j < 8; ++j) ss += o[j] * o[j];
            const float rstd = rsqrtf(wave_sum(ss) * (1.f / 512.f) + RMS_EPS);
            float y[8];
#pragma unroll
            for (int j = 0; j < 8; ++j) y[j] = o[j] * rstd * hg[j] * pg8::silu_f(r[j]);
            v4u w; w.x = pk2(y[0], y[1]); w.y = pk2(y[2], y[3]); w.z = pk2(y[4], y[5]); w.w = pk2(y[6], y[7]);
            *(GAS v4u*)(OG + (size_t)m * 2048 + h * 512 + 8 * lane) = w;
        }
    }
}

__device__ __forceinline__ void moe_route(LAS unsigned char* lds, const float* RL, const float* bgroup, const float* brouter, unsigned* gcnt, unsigned* EP0, unsigned* EP1, float* W0, float* W1) {
    const int tid = threadIdx.x; LAS int* lcnt = (LAS int*)lds; LAS int* lbase = lcnt + 32;
    for (int base = blockIdx.x * 128; base < T; base += gridDim.x * 128) {
        if (tid < 32) lcnt[tid] = 0;
        __syncthreads();
        int e0 = 0, e1 = 0, r0 = 0, r1 = 0; float w0 = 0.f, w1 = 0.f;
        if (tid < 128) { const int t = base + tid; const float* rl = RL + (size_t)t * 64;
            const f32x4 g4 = *(const GAS f32x4*)rl; float gl[4] = {g4.x + bgroup[0], g4.y + bgroup[1], g4.z + bgroup[2], g4.w + bgroup[3]};
            int g = 0; float best = gl[0];
#pragma unroll
            for (int j = 1; j < 4; ++j) if (gl[j] > best) { best = gl[j]; g = j; }
            float se = 0.f;
#pragma unroll
            for (int j = 0; j < 4; ++j) se += __expf(gl[j] - best);
            const float pg = 1.0f / se;
            const f32x4 a4 = *(const GAS f32x4*)(rl + 4 + 8 * g), b4 = *(const GAS f32x4*)(rl + 8 + 8 * g);
            float el[8] = {a4.x, a4.y, a4.z, a4.w, b4.x, b4.y, b4.z, b4.w};
#pragma unroll
            for (int j = 0; j < 8; ++j) el[j] += brouter[8 * g + j];
            int i0 = 0; float v0 = el[0];
#pragma unroll
            for (int j = 1; j < 8; ++j) if (el[j] > v0) { v0 = el[j]; i0 = j; }
            int i1 = -1; float v1 = -3.0e38f;
#pragma unroll
            for (int j = 0; j < 8; ++j) if (j != i0 && el[j] > v1) { v1 = el[j]; i1 = j; }
            w0 = pg / (1.0f + __expf(v1 - v0)); w1 = pg - w0;
            e0 = 8 * g + i0; e1 = 8 * g + i1;
            r0 = __hip_atomic_fetch_add(&lcnt[e0], 1, __ATOMIC_RELAXED, __HIP_MEMORY_SCOPE_WORKGROUP); r1 = __hip_atomic_fetch_add(&lcnt[e1], 1, __ATOMIC_RELAXED, __HIP_MEMORY_SCOPE_WORKGROUP); }
        __syncthreads();
        if (tid < 32) lbase[tid] = (int)__hip_atomic_fetch_add(gcnt + tid, (unsigned)lcnt[tid], RLX_AGENT);
        __syncthreads();
        if (tid < 128) { const int t = base + tid;
            EP0[t] = ((unsigned)e0 << 24) | (unsigned)(lbase[e0] + r0); EP1[t] = ((unsigned)e1 << 24) | (unsigned)(lbase[e1] + r1); W0[t] = w0; W1[t] = w1; }
        __syncthreads();
    }
}
__device__ __forceinline__ void moe_build_table(LAS unsigned char* ldsbase, unsigned* gcnt) {
    LAS int* off = (LAS int*)(ldsbase + MOE_OFF_OFF); LAS unsigned char* texp = ldsbase + MOE_TEXP_OFF;
    __syncthreads();
    if (threadIdx.x == 0) { int acc = 0, ti = 0;
        for (int e = 0; e < NE; ++e) { const int c = (int)__hip_atomic_load(gcnt + e, RLX_AGENT); off[e] = acc; const int nt = (c + 255) >> 8;
            for (int k = 0; k < nt && ti < 288; ++k) texp[ti++] = (unsigned char)e;
            acc += nt * 256; }
        off[32] = acc; }
    __syncthreads();
}
__device__ __forceinline__ void moe_gather(LAS unsigned char* ldsbase, const bf16* HN, bf16* XS, const unsigned* EP0, const unsigned* EP1, unsigned* SL0, unsigned* SL1, int gw, int NGW, int lane) {
    const LAS int* off = (const LAS int*)(ldsbase + MOE_OFF_OFF);
    for (int t = gw; t < T; t += NGW) {
        const unsigned p0 = EP0[t], p1 = EP1[t];
        const unsigned s0 = (unsigned)off[p0 >> 24] + (p0 & 0xffffffu), s1 = (unsigned)off[p1 >> 24] + (p1 & 0xffffffu);
        const GAS v4u* src = (const GAS v4u*)(HN + (size_t)t * 2048) + lane; GAS v4u* d0 = (GAS v4u*)(XS + (size_t)s0 * 2048) + lane; GAS v4u* d1 = (GAS v4u*)(XS + (size_t)s1 * 2048) + lane;
        v4u v[4];
#pragma unroll
        for (int j = 0; j < 4; ++j) v[j] = src[64 * j];
#pragma unroll
        for (int j = 0; j < 4; ++j) { d0[64 * j] = v[j]; d1[64 * j] = v[j]; }
        if (lane == 0) { SL0[t] = s0; SL1[t] = s1; }
    }
}
__device__ __forceinline__ void moe_combine(float* out, const bf16* Y, const unsigned* SL0, const unsigned* SL1, const float* W0, const float* W1, bf16* HN, bool do_norm, int gw, int NGW, int lane) {
    for (int t = gw; t < T; t += NGW) {
        const unsigned s0 = SL0[t], s1 = SL1[t]; const float w0 = W0[t], w1 = W1[t];
        GAS f32x4* xr = (GAS f32x4*)(out + (size_t)t * D) + lane;
        const GAS v2u* y0 = (const GAS v2u*)(Y + (size_t)s0 * 2048) + lane; const GAS v2u* y1 = (const GAS v2u*)(Y + (size_t)s1 * 2048) + lane;
        f32x4 v[8]; float s = 0.f;
#pragma unroll
        for (int j = 0; j < 8; ++j) { const v2u a = y0[64 * j], b = y1[64 * j]; f32x4 x = xr[64 * j];
            x.x += w0 * bf_lo(a.x) + w1 * bf_lo(b.x); x.y += w0 * bf_hi(a.x) + w1 * bf_hi(b.x); x.z += w0 * bf_lo(a.y) + w1 * bf_lo(b.y); x.w += w0 * bf_hi(a.y) + w1 * bf_hi(b.y);
            v[j] = x; xr[64 * j] = x; s += (x.x * x.x + x.y * x.y) + (x.z * x.z + x.w * x.w); }
        if (do_norm) { const float rstd = rsqrtf(wave_sum(s) * (1.f / D) + RMS_EPS);
            GAS v2u* o8 = (GAS v2u*)(HN + (size_t)t * D) + lane;
#pragma unroll
            for (int j = 0; j < 8; ++j) { v2u o; o.x = pk2(v[j].x * rstd, v[j].y * rstd); o.y = pk2(v[j].z * rstd, v[j].w * rstd); o8[64 * j] = o; } }
    }
}

__device__ const unsigned char T5_BUCKET[128] = {0,1,2,3,4,5,6,7,8,9,10,11,12,13,14,15,16,16,16,17,17,18,18,18,19,19,19,20,20,20,20,21,21,21,21,22,22,22,22,22,23,23,23,23,23,23,24,24,24,24,24,24,25,25,25,25,25,25,25,26,26,26,26,26,26,26,26,27,27,27,27,27,27,27,27,27,27,28,28,28,28,28,28,28,28,28,28,29,29,29,29,29,29,29,29,29,29,29,29,30,30,30,30,30,30,30,30,30,30,30,30,30,30,31,31,31,31,31,31,31,31,31,31,31,31,31,31,31};
constexpr int AT_K = 0, AT_VT = 36864, AT_BIAS = 70656;
__device__ __forceinline__ void swa_attention(LAS unsigned char* lds, const bf16* KVQ, const float* knorm, const float* qnorm, const float* relb, const float* sinks, bf16* AO) {
    const int tid = threadIdx.x, lane = tid & 63, g = __builtin_amdgcn_readfirstlane(tid >> 6), li = lane & 15, q = lane >> 4;
    LAS bf16* KL = (LAS bf16*)(lds + AT_K); LAS bf16* VTL = (LAS bf16*)(lds + AT_VT); LAS float* BL = (LAS float*)(lds + AT_BIAS);
    float qn[2][8];
#pragma unroll
    for (int ks = 0; ks < 2; ++ks)
#pragma unroll
        for (int j = 0; j < 8; ++j) qn[ks][j] = qnorm[32 * ks + 8 * q + j] * 0.125f;
    for (int wi = blockIdx.x; wi < 1024; wi += gridDim.x) {
        const int hk = wi & 3, n = (wi >> 2) & 127, b = wi >> 9;
        __syncthreads();
        { const int key = tid >> 1, hf = tid & 1; const bool live = (n > 0) || (key >= 128);
          const size_t tk = (size_t)b * SEQ + (size_t)(n - 1) * 128 + key;
          const bf16* kp = KVQ + tk * KVQ_N + hk * 64 + 32 * hf;
          v4u kw[4], vw[4];
#pragma unroll
          for (int j = 0; j < 4; ++j) { kw[j] = live ? *(const GAS v4u*)(kp + 8 * j) : (v4u){0u, 0u, 0u, 0u}; vw[j] = live ? *(const GAS v4u*)(kp + 256 + 8 * j) : (v4u){0u, 0u, 0u, 0u}; }
          float ss = 0.f;
#pragma unroll
          for (int j = 0; j < 4; ++j) { const float a0 = bf_lo(kw[j].x), a1 = bf_hi(kw[j].x), a2 = bf_lo(kw[j].y), a3 = bf_hi(kw[j].y), a4 = bf_lo(kw[j].z), a5 = bf_hi(kw[j].z), a6 = bf_lo(kw[j].w), a7 = bf_hi(kw[j].w);
              ss += (a0 * a0 + a1 * a1) + (a2 * a2 + a3 * a3) + (a4 * a4 + a5 * a5) + (a6 * a6 + a7 * a7); }
          ss += __shfl_xor(ss, 1);
          const float rstd = rsqrtf(ss * (1.f / 64.f) + RMS_EPS);
#pragma unroll
          for (int j = 0; j < 4; ++j) { const float* kn = knorm + 32 * hf + 8 * j; v4u o;
              o.x = pk2(bf_lo(kw[j].x) * rstd * kn[0], bf_hi(kw[j].x) * rstd * kn[1]); o.y = pk2(bf_lo(kw[j].y) * rstd * kn[2], bf_hi(kw[j].y) * rstd * kn[3]);
              o.z = pk2(bf_lo(kw[j].z) * rstd * kn[4], bf_hi(kw[j].z) * rstd * kn[5]); o.w = pk2(bf_lo(kw[j].w) * rstd * kn[6], bf_hi(kw[j].w) * rstd * kn[7]);
              *(LAS v4u*)(KL + key * 72 + 32 * hf + 8 * j) = o; }
#pragma unroll
          for (int j = 0; j < 4; ++j) { const int d0 = 32 * hf + 8 * j;
              VTL[(d0 + 0) * 264 + key] = (bf16)(vw[j].x & 0xffffu); VTL[(d0 + 1) * 264 + key] = (bf16)(vw[j].x >> 16); VTL[(d0 + 2) * 264 + key] = (bf16)(vw[j].y & 0xffffu); VTL[(d0 + 3) * 264 + key] = (bf16)(vw[j].y >> 16);
              VTL[(d0 + 4) * 264 + key] = (bf16)(vw[j].z & 0xffffu); VTL[(d0 + 5) * 264 + key] = (bf16)(vw[j].z >> 16); VTL[(d0 + 6) * 264 + key] = (bf16)(vw[j].w & 0xffffu); VTL[(d0 + 7) * 264 + key] = (bf16)(vw[j].w >> 16); }
#pragma unroll
          for (int k = 0; k < 2; ++k) { const int e = tid + 512 * k, gg = e >> 7, dist = e & 127; BL[e] = relb[(int)T5_BUCKET[dist] * 32 + hk * 8 + gg]; }
        }
        __syncthreads();
        const int head = hk * 8 + g; const float sink = sinks[head];
        for (int mt = 0; mt < 8; ++mt) {
            const size_t tq = (size_t)b * SEQ + (size_t)n * 128 + 16 * mt + li;
            bf16x8 qf[2];
            { const bf16* qp = KVQ + tq * KVQ_N + 512 + head * 64 + 8 * q; const v4u q0 = *(const GAS v4u*)qp, q1 = *(const GAS v4u*)(qp + 32);
              float a[16] = {bf_lo(q0.x), bf_hi(q0.x), bf_lo(q0.y), bf_hi(q0.y), bf_lo(q0.z), bf_hi(q0.z), bf_lo(q0.w), bf_hi(q0.w), bf_lo(q1.x), bf_hi(q1.x), bf_lo(q1.y), bf_hi(q1.y), bf_lo(q1.z), bf_hi(q1.z), bf_lo(q1.w), bf_hi(q1.w)};
              float ss = 0.f;
#pragma unroll
              for (int j = 0; j < 16; ++j) ss += a[j] * a[j];
              ss += __shfl_xor(ss, 16); ss += __shfl_xor(ss, 32);
              const float rstd = rsqrtf(ss * (1.f / 64.f) + RMS_EPS);
              v4u w0, w1;
              w0.x = pk2(a[0] * rstd * qn[0][0], a[1] * rstd * qn[0][1]); w0.y = pk2(a[2] * rstd * qn[0][2], a[3] * rstd * qn[0][3]); w0.z = pk2(a[4] * rstd * qn[0][4], a[5] * rstd * qn[0][5]); w0.w = pk2(a[6] * rstd * qn[0][6], a[7] * rstd * qn[0][7]);
              w1.x = pk2(a[8] * rstd * qn[1][0], a[9] * rstd * qn[1][1]); w1.y = pk2(a[10] * rstd * qn[1][2], a[11] * rstd * qn[1][3]); w1.z = pk2(a[12] * rstd * qn[1][4], a[13] * rstd * qn[1][5]); w1.w = pk2(a[14] * rstd * qn[1][6], a[15] * rstd * qn[1][7]);
              qf[0] = __builtin_bit_cast(bf16x8, w0); qf[1] = __builtin_bit_cast(bf16x8, w1); }
            f32x4 st[9]; float mx = sink;
#pragma unroll
            for (int tt = 0; tt < 9; ++tt) { const int nt = mt + tt; f32x4 acc = {0.f, 0.f, 0.f, 0.f};
#pragma unroll
                for (int ks = 0; ks < 2; ++ks) { const bf16x8 a = *(const LAS bf16x8*)(KL + (16 * nt + li) * 72 + 32 * ks + 8 * q); acc = __builtin_amdgcn_mfma_f32_16x16x32_bf16(a, qf[ks], acc, 0, 0, 0); }
#pragma unroll
                for (int r = 0; r < 4; ++r) { const int col = 16 * nt + 4 * q + r, row = 16 * mt + li, dist = 128 + row - col;
                    const bool valid = (dist >= 0) && (dist < 128) && ((col >= 128) || (n > 0));
                    const float s = valid ? acc[r] + BL[g * 128 + (dist & 127)] : -__builtin_inff();
                    acc[r] = s; mx = fmaxf(mx, s); }
                st[tt] = acc; }
            mx = fmaxf(mx, __shfl_xor(mx, 16)); mx = fmaxf(mx, __shfl_xor(mx, 32));
            float lsum = 0.f;
#pragma unroll
            for (int tt = 0; tt < 9; ++tt)
#pragma unroll
                for (int r = 0; r < 4; ++r) { const float p = __expf(st[tt][r] - mx); st[tt][r] = p; lsum += p; }
            lsum += __shfl_xor(lsum, 16); lsum += __shfl_xor(lsum, 32);
            const float inv = 1.0f / (lsum + __expf(sink - mx));
            f32x4 oacc[4];
#pragma unroll
            for (int dt = 0; dt < 4; ++dt) oacc[dt] = (f32x4){0.f, 0.f, 0.f, 0.f};
#pragma unroll
            for (int s = 0; s < 5; ++s) {
                v4u pw; pw.x = pk2(st[2 * s][0], st[2 * s][1]); pw.y = pk2(st[2 * s][2], st[2 * s][3]);
                if (s < 4) { pw.z = pk2(st[2 * s + 1][0], st[2 * s + 1][1]); pw.w = pk2(st[2 * s + 1][2], st[2 * s + 1][3]); } else { pw.z = 0u; pw.w = 0u; }
                const bf16x8 pb = __builtin_bit_cast(bf16x8, pw);
                const int k0 = 16 * (mt + 2 * s) + 4 * q; int k1 = 16 * (mt + 2 * s + 1) + 4 * q; if (k1 > 252) k1 = 240 + 4 * q;
#pragma unroll
                for (int dt = 0; dt < 4; ++dt) { const v2u lo = *(const LAS v2u*)(VTL + (16 * dt + li) * 264 + k0), hi = *(const LAS v2u*)(VTL + (16 * dt + li) * 264 + k1);
                    v4u aw; aw.x = lo.x; aw.y = lo.y; aw.z = hi.x; aw.w = hi.y;
                    oacc[dt] = __builtin_amdgcn_mfma_f32_16x16x32_bf16(__builtin_bit_cast(bf16x8, aw), pb, oacc[dt], 0, 0, 0); } }
#pragma unroll
            for (int dt = 0; dt < 4; ++dt) { v2u o; o.x = pk2(oacc[dt][0] * inv, oacc[dt][1] * inv); o.y = pk2(oacc[dt][2] * inv, oacc[dt][3] * inv);
                *(GAS v2u*)(AO + tq * 2048 + head * 64 + 16 * dt + 4 * q) = o; }
        }
    }
}

struct Args { const float* in[24]; float* out; unsigned char* ws; int ph_lo, ph_hi; };
constexpr int N_PHASES = 23;
__global__ void __launch_bounds__(NWAVES * 64, 2) fwd(Args args) {
    extern __shared__ __attribute__((aligned(16))) unsigned char lds_raw[];
    LAS unsigned char* lds = (LAS unsigned char*)lds_raw;
    const int tid = threadIdx.x, lane = tid & 63, wave = __builtin_amdgcn_readfirstlane(tid >> 6);
    const int G = gridDim.x, gw = blockIdx.x * NWAVES + wave, NGW = G * NWAVES;
    unsigned char* ws = args.ws;
    gu32* ctl = (gu32*)(ws + WS_CTL);
    for (int u = tid; u < (LDS_BYTES - LDSCTL_OFF) / 4; u += NWAVES * 64) ((LAS unsigned*)(lds + LDSCTL_OFF))[u] = 0u;
    __syncthreads();
    XcdBarrier bar = xcd_barrier_post((unsigned*)(ctl + CW_BAR), (volatile LAS unsigned*)(lds + MISC_OFF));
    const int lo = args.ph_lo, hi = args.ph_hi;
#define IN(k) ((((MK_PHASE_MASK) >> (k)) & 1) && lo <= (k) && (k) < hi)
#define SEAM(k) do { if (IN(k) && IN((k) + 1)) xcd_barrier(bar); } while (0)

    const float* x = args.in[0]; float* out = args.out;
    bf16* W_GLA_IN = (bf16*)(ws + WS_W_GLA_IN); bf16* W_GLA_OUT = (bf16*)(ws + WS_W_GLA_OUT); bf16* W_KVQ = (bf16*)(ws + WS_W_KVQ); bf16* W_SWA_OUT = (bf16*)(ws + WS_W_SWA_OUT);
    bf16* W_ROUTER = (bf16*)(ws + WS_W_ROUTER); bf16* W_GU = (bf16*)(ws + WS_W_GU); bf16* W_DN = (bf16*)(ws + WS_W_DN);
    bf16* HN = (bf16*)(ws + WS_HN);
    unsigned* EP0 = (unsigned*)(ws + WS_TOK); unsigned* EP1 = EP0 + T; unsigned* SL0 = EP1 + T; unsigned* SL1 = SL0 + T; float* TW0 = (float*)(SL1 + T); float* TW1 = TW0 + T;
    float* RL = (float*)(ws + WS_RL);
    LAS float* scr = (LAS float*)(lds + RING_OFF + wave * 16384);

    if (IN(0)) {
        cvt_matrix(args.in[2], 2048, GLA_PROJ_N, args.in[1], W_GLA_IN, 0, scr, gw, NGW, lane);
        cvt_matrix(args.in[6], 2048, 2048, nullptr, W_GLA_OUT, 0, scr, gw, NGW, lane);
        cvt_matrix(args.in[8], 2048, 512, args.in[7], W_KVQ, 0, scr, gw, NGW, lane);
        cvt_matrix(args.in[12], 2048, 2048, args.in[11], W_KVQ, 512, scr, gw, NGW, lane);
        cvt_matrix(args.in[15], 2048, 2048, nullptr, W_SWA_OUT, 0, scr, gw, NGW, lane);
        for (int l = 0; l < 2; ++l) {
            cvt_matrix(args.in[17] + (size_t)l * 2048 * 4, 2048, 4, args.in[16] + l * 2048, W_ROUTER + (size_t)l * 256 * 2048, 0, scr, gw, NGW, lane);
            cvt_matrix(args.in[19] + (size_t)l * 2048 * 32, 2048, 32, args.in[16] + l * 2048, W_ROUTER + (size_t)l * 256 * 2048, 4, scr, gw, NGW, lane);
        }
        cvt_moe(args.in[21], args.in[22], args.in[23], args.in[16], W_GU, W_DN, scr, gw, NGW, lane);
        norm_rows(x, HN, gw, NGW, lane);
    }
    SEAM(0);
    if (IN(1)) {
        pg8::Gemm g{HN, W_GLA_IN, T, GLA_PROJ_NP, 2048}; pg8::StaticOrder S; S.init(T, GLA_PROJ_NP, G, (int)blockIdx.x);
        pg8::EpiGlaProj E{(bf16*)(ws + WS_QK), (bf16*)(ws + WS_V), (bf16*)(ws + WS_R), (bf16*)(ws + WS_GL)};
        pg8::gemm_phase<pg8::EpiGlaProj, pg8::StaticOrder, true, true>(lds + RING_OFF, g, S, E);
    }
    SEAM(1);
    if (IN(2)) gla_prepass(lds + RING_OFF, (const bf16*)(ws + WS_QK), (const bf16*)(ws + WS_V), (const bf16*)(ws + WS_GL), args.in[3], args.in[4],
                           (bf16*)(ws + WS_QEF), (bf16*)(ws + WS_KLTF), (bf16*)(ws + WS_ATTF), (bf16*)(ws + WS_VTF), (float*)(ws + WS_DEC));
    SEAM(2);
    if (IN(3)) gla_seq(lds + RING_OFF, (const bf16*)(ws + WS_QEF), (const bf16*)(ws + WS_KLTF), (const bf16*)(ws + WS_ATTF), (const bf16*)(ws + WS_VTF), (const float*)(ws + WS_DEC), (bf16*)(ws + WS_QK));
    SEAM(3);
    if (IN(4)) gla_gate((const bf16*)(ws + WS_QK), (const bf16*)(ws + WS_R), args.in[5], HN, gw, NGW, lane);
    SEAM(4);
    if (IN(5)) {
        pg8::Gemm g{HN, W_GLA_OUT, T, 2048, 2048}; pg8::StaticOrder S; S.init(T, 2048, G, (int)blockIdx.x);
        pg8::EpiResF32 E{out, x, 2048};
        pg8::gemm_phase<pg8::EpiResF32, pg8::StaticOrder, true, true>(lds + RING_OFF, g, S, E);
    }
    SEAM(5);

    { constexpr int layer = 0; constexpr int pb = 6 + 10 * layer;
    unsigned* gcnt = (unsigned*)(ctl + CW_CNT + layer * 64);
    if (IN(pb + 0)) norm_rows(out, HN, gw, NGW, lane);
    SEAM(pb + 0);
    if (IN(pb + 1)) {
        pg8::Gemm g{HN, W_ROUTER + (size_t)layer * 256 * 2048, T, 256, 2048}; pg8::StaticOrder S; S.init(T, 256, G, (int)blockIdx.x);
        pg8::EpiRouter E{RL};
        pg8::gemm_phase<pg8::EpiRouter, pg8::StaticOrder, true, true>(lds + RING_OFF, g, S, E);
    }
    SEAM(pb + 1);
    if (IN(pb + 2)) moe_route(lds + RING_OFF, RL, args.in[18] + layer * 4, args.in[20] + layer * 32, gcnt, EP0, EP1, TW0, TW1);
    SEAM(pb + 2);
    if (IN(pb + 3)) { moe_build_table(lds, gcnt); moe_gather(lds, HN, (bf16*)(ws + WS_XS), EP0, EP1, SL0, SL1, gw, NGW, lane); }
    SEAM(pb + 3);
    if (IN(pb + 4)) {
        moe_build_table(lds, gcnt);
        const int rows = __builtin_amdgcn_readfirstlane(((const LAS int*)(lds + MOE_OFF_OFF))[32]);
        pg8::Gemm g{(const bf16*)(ws + WS_XS), W_GU, rows, 1024, 2048};
        pg8::GroupedOrder S{(const LAS unsigned char*)(lds + MOE_TEXP_OFF), rows >> 8, 4, G, (int)blockIdx.x};
        pg8::EpiSwiGLU E{(bf16*)(ws + WS_ACT)};
        pg8::gemm_phase<pg8::EpiSwiGLU, pg8::GroupedOrder, true, true>(lds + RING_OFF, g, S, E);
    }
    SEAM(pb + 4);
    if (IN(pb + 5)) {
        moe_build_table(lds, gcnt);
        const int rows = __builtin_amdgcn_readfirstlane(((const LAS int*)(lds + MOE_OFF_OFF))[32]);
        pg8::Gemm g{(const bf16*)(ws + WS_ACT), W_DN, rows, 2048, 512};
        pg8::GroupedOrder S{(const LAS unsigned char*)(lds + MOE_TEXP_OFF), rows >> 8, 8, G, (int)blockIdx.x};
        pg8::EpiBf16 E{(bf16*)(ws + WS_Y), 2048};
        pg8::gemm_phase<pg8::EpiBf16, pg8::GroupedOrder, true, true>(lds + RING_OFF, g, S, E);
    }
    SEAM(pb + 5);
    if (IN(pb + 6)) {
        moe_combine(out, (const bf16*)(ws + WS_Y), SL0, SL1, TW0, TW1, HN, layer == 0, gw, NGW, lane);
        if (layer == 0) cvt_moe(args.in[21] + (size_t)NE * 2048 * 512, args.in[22] + (size_t)NE * 2048 * 512, args.in[23] + (size_t)NE * 512 * 2048, args.in[16] + 2048, W_GU, W_DN, scr, gw, NGW, lane);
    }
    if (layer == 0) SEAM(pb + 6);
    }
    if (IN(13)) {
        pg8::Gemm g{HN, W_KVQ, T, KVQ_N, 2048}; pg8::StaticOrder S; S.init(T, KVQ_N, G, (int)blockIdx.x);
        pg8::EpiBf16 E{(bf16*)(ws + WS_KVQ), KVQ_N};
        pg8::gemm_phase<pg8::EpiBf16, pg8::StaticOrder, true, true>(lds + RING_OFF, g, S, E);
    }
    SEAM(13);
    if (IN(14)) swa_attention(lds + RING_OFF, (const bf16*)(ws + WS_KVQ), args.in[9], args.in[13], args.in[10], args.in[14], (bf16*)(ws + WS_AO));
    SEAM(14);
    if (IN(15)) {
        pg8::Gemm g{(const bf16*)(ws + WS_AO), W_SWA_OUT, T, 2048, 2048}; pg8::StaticOrder S; S.init(T, 2048, G, (int)blockIdx.x);
        pg8::EpiResF32 E{out, out, 2048};
        pg8::gemm_phase<pg8::EpiResF32, pg8::StaticOrder, true, true>(lds + RING_OFF, g, S, E);
    }
    SEAM(15);
    { constexpr int layer = 1; constexpr int pb = 6 + 10 * layer;
    unsigned* gcnt = (unsigned*)(ctl + CW_CNT + layer * 64);
    if (IN(pb + 0)) norm_rows(out, HN, gw, NGW, lane);
    SEAM(pb + 0);
    if (IN(pb + 1)) {
        pg8::Gemm g{HN, W_ROUTER + (size_t)layer * 256 * 2048, T, 256, 2048}; pg8::StaticOrder S; S.init(T, 256, G, (int)blockIdx.x);
        pg8::EpiRouter E{RL};
        pg8::gemm_phase<pg8::EpiRouter, pg8::StaticOrder, true, true>(lds + RING_OFF, g, S, E);
    }
    SEAM(pb + 1);
    if (IN(pb + 2)) moe_route(lds + RING_OFF, RL, args.in[18] + layer * 4, args.in[20] + layer * 32, gcnt, EP0, EP1, TW0, TW1);
    SEAM(pb + 2);
    if (IN(pb + 3)) { moe_build_table(lds, gcnt); moe_gather(lds, HN, (bf16*)(ws + WS_XS), EP0, EP1, SL0, SL1, gw, NGW, lane); }
    SEAM(pb + 3);
    if (IN(pb + 4)) {
        moe_build_table(lds, gcnt);
        const int rows = __builtin_amdgcn_readfirstlane(((const LAS int*)(lds + MOE_OFF_OFF))[32]);
        pg8::Gemm g{(const bf16*)(ws + WS_XS), W_GU, rows, 1024, 2048};
        pg8::GroupedOrder S{(const LAS unsigned char*)(lds + MOE_TEXP_OFF), rows >> 8, 4, G, (int)blockIdx.x};
        pg8::EpiSwiGLU E{(bf16*)(ws + WS_ACT)};
        pg8::gemm_phase<pg8::EpiSwiGLU, pg8::GroupedOrder, true, true>(lds + RING_OFF, g, S, E);
    }
    SEAM(pb + 4);
    if (IN(pb + 5)) {
        moe_build_table(lds, gcnt);
        const int rows = __builtin_amdgcn_readfirstlane(((const LAS int*)(lds + MOE_OFF_OFF))[32]);
        pg8::Gemm g{(const bf16*)(ws + WS_ACT), W_DN, rows, 2048, 512};
        pg8::GroupedOrder S{(const LAS unsigned char*)(lds + MOE_TEXP_OFF), rows >> 8, 8, G, (int)blockIdx.x};
        pg8::EpiBf16 E{(bf16*)(ws + WS_Y), 2048};
        pg8::gemm_phase<pg8::EpiBf16, pg8::GroupedOrder, true, true>(lds + RING_OFF, g, S, E);
    }
    SEAM(pb + 5);
    if (IN(pb + 6)) {
        moe_combine(out, (const bf16*)(ws + WS_Y), SL0, SL1, TW0, TW1, HN, layer == 0, gw, NGW, lane);
        if (layer == 0) cvt_moe(args.in[21] + (size_t)NE * 2048 * 512, args.in[22] + (size_t)NE * 2048 * 512, args.in[23] + (size_t)NE * 512 * 2048, args.in[16] + 2048, W_GU, W_DN, scr, gw, NGW, lane);
    }
    if (layer == 0) SEAM(pb + 6);
    }
#undef IN
#undef SEAM
}

extern "C" void kernel_launch(void* const* d_in, const int* in_sizes, int n_in, void* d_out, int out_size, void* d_ws, size_t ws_size, hipStream_t stream) {
    static int grid = 0;
    if (grid == 0) {
        if (n_in != 24 || in_sizes[0] != T * D || out_size != T * D || ws_size < WS_END) { fprintf(stderr, "kernel_launch: unexpected shapes / workspace (n_in %d, in0 %d, out %d, ws %zu < %zu)\n", n_in, n_in > 0 ? in_sizes[0] : -1, out_size, ws_size, (size_t)WS_END); grid = -1; return; }
        int dev = 0, cus = 0, per_cu = 0;
        if (hipGetDevice(&dev) != hipSuccess || hipDeviceGetAttribute(&cus, hipDeviceAttributeMultiprocessorCount, dev) != hipSuccess) { grid = -1; return; }
        if (hipFuncSetAttribute((const void*)fwd, hipFuncAttributeMaxDynamicSharedMemorySize, LDS_BYTES) != hipSuccess) { fprintf(stderr, "kernel_launch: hipFuncSetAttribute failed\n"); grid = -1; return; }
        if (hipOccupancyMaxActiveBlocksPerMultiprocessor(&per_cu, (const void*)fwd, NWAVES * 64, LDS_BYTES) != hipSuccess || per_cu < 1) { fprintf(stderr, "kernel_launch: occupancy query says %d\n", per_cu); }
        (void)hipGetLastError();
        grid = cus;
    }
    if (grid < 0) return;
    if (hipMemsetAsync((char*)d_ws + WS_CTL, 0, CTL_ZERO_BYTES, stream) != hipSuccess) return;
    Args a{};
    for (int i = 0; i < 24; ++i) a.in[i] = (const float*)d_in[i];
    a.out = (float*)d_out; a.ws = (unsigned char*)d_ws;
#if MK_PER_PHASE
    for (int p = 0; p < MK_LAST_PHASE; ++p) { a.ph_lo = p; a.ph_hi = p + 1; hipLaunchKernelGGL(fwd, dim3(grid), dim3(NWAVES * 64), LDS_BYTES, stream, a); }
#else
    a.ph_lo = 0; a.ph_hi = MK_LAST_PHASE;
    hipLaunchKernelGGL(fwd, dim3(grid), dim3(NWAVES * 64), LDS_BYTES, stream, a);
#endif
    const hipError_t le = hipPeekAtLastError();
    if (le != hipSuccess) fprintf(stderr, "kernel_launch: launch failed: %s\n", hipGetErrorName(le));
}
```

```cpp
#include <hip/hip_runtime.h>
#include <cstdio>
#include <cstdint>

#ifndef MK_PER_PHASE
#define MK_PER_PHASE 0
#endif
#ifndef MK_LAST_PHASE
#define MK_LAST_PHASE 23
#endif

#ifndef MK_PHASE_MASK
#define MK_PHASE_MASK 0x7fffff
#endif

namespace pg8 {
#define PG8_LAS __attribute__((address_space(3)))
typedef unsigned short bf16_t;
typedef short bf16x8 __attribute__((ext_vector_type(8)));
typedef float f32x4 __attribute__((ext_vector_type(4)));
typedef unsigned u32x4 __attribute__((ext_vector_type(4)));
constexpr int BM = 256, BK = 64, HALF = 128, HTB = HALF * BK * 2  , STAGE_BYTES = 8 * HTB, NXCD = 8, WGM = 8;

__host__ __device__ __forceinline__ int lds_byte(int r, int c) { const int st = (r >> 4) * 2 + (c >> 5), rr = r & 15, cc = c & 31, ob = rr * 64 + cc * 2; return st * 1024 + (ob ^ (((ob >> 9) & 1) << 5)); }
__host__ __device__ __forceinline__ void stage_rc(int b, int& R, int& C) { const int st = b / 1024, sb = b % 1024, swz = sb ^ (((sb >> 9) & 1) << 5); R = (st >> 1) * 16 + swz / 64; C = (st & 1) * 32 + (swz % 64) / 2; }
__host__ __device__ __forceinline__ int perm32(int rho) { const int n = rho >> 4, i = rho & 15; return 8 * (i >> 2) + 4 * n + (i & 3); }

struct Unit { int pm, pn, pc; };
struct Gemm { const bf16_t* A; const bf16_t* Bt; int M, N, K; };


struct StaticOrder {
    int nM, nN, nwg, G, c;
    __host__ __device__ void init(int M, int N, int G_, int c_) { nM = M / BM; nN = N / BM; nwg = nM * nN; G = G_; c = c_; }
    __host__ __device__ bool next(int i, Unit& u) const {
        const long L = (long)i * G + c; if (L >= nwg) return false;
        int wgid = (int)L; { const int q = nwg / NXCD, r = nwg % NXCD, xcd = wgid % NXCD, off = wgid / NXCD; wgid = (xcd < r ? xcd * (q + 1) : r * (q + 1) + (xcd - r) * q) + off; }
        const int nig = WGM * nN, gid = wgid / nig, fm = gid * WGM, gsz = (nM - fm) < WGM ? (nM - fm) : WGM;
        u.pm = fm + ((wgid % nig) % gsz); u.pn = (wgid % nig) / gsz; u.pc = u.pn; return true;
    }
    __device__ __forceinline__ void a_ready(const Unit&) const {}
    __device__ __forceinline__ void done(const Unit&) const {}
};
struct GroupedOrder {
    const PG8_LAS unsigned char* texp; int MT, npn, G, c;
    __device__ __forceinline__ bool next(int i, Unit& u) const {
        const long L = (long)i * G + c; if (L >= (long)MT * npn) return false;
        const int pm = (int)(L / npn), pc = (int)(L % npn);
        const int e = __builtin_amdgcn_readfirstlane((int)texp[pm]);
        u.pm = pm; u.pn = e * npn + pc; u.pc = pc; return true;
    }
    __device__ __forceinline__ void a_ready(const Unit&) const {}
    __device__ __forceinline__ void done(const Unit&) const {}
};

__device__ __forceinline__ unsigned cvt_pk_bf16(float lo, float hi) { unsigned r; asm volatile("v_cvt_pk_bf16_f32 %0, %1, %2" : "=v"(r) : "v"(lo), "v"(hi)); return r; }

struct EpiBf16 {
    static constexpr bool PERM = true, AFTER_DRAIN = false;
    bf16_t* O; int ldc;
    __device__ __forceinline__ void operator()(const f32x4 (&acc)[2][2][4][2], const Unit& u, int wr, int wc, int fr, int fq) const {
        const int row0 = u.pm * BM + wr * 64 + fr, col0 = u.pc * BM + wc * 32 + 8 * fq;
#pragma unroll
        for (int ai = 0; ai < 2; ++ai)
#pragma unroll
            for (int m = 0; m < 4; ++m) { bf16_t* rowp = O + (size_t)(row0 + ai * HALF + m * 16) * ldc + col0;
#pragma unroll
                for (int bj = 0; bj < 2; ++bj) { const f32x4 v0 = acc[ai][bj][m][0], v1 = acc[ai][bj][m][1];
                    u32x4 w; w.x = cvt_pk_bf16(v0[0], v0[1]); w.y = cvt_pk_bf16(v0[2], v0[3]); w.z = cvt_pk_bf16(v1[0], v1[1]); w.w = cvt_pk_bf16(v1[2], v1[3]);
                    *(u32x4*)(rowp + bj * HALF) = w; } }
    }
};
struct EpiGlaProj {
    static constexpr bool PERM = true, AFTER_DRAIN = false;
    bf16_t *QK, *V, *R, *GL;
    __device__ __forceinline__ void operator()(const f32x4 (&acc)[2][2][4][2], const Unit& u, int wr, int wc, int fr, int fq) const {
        bf16_t* base; int ldc, ct;
        if (u.pc < 8) { base = QK; ldc = 2048; ct = u.pc; } else if (u.pc < 16) { base = V; ldc = 2048; ct = u.pc - 8; } else if (u.pc < 24) { base = R; ldc = 2048; ct = u.pc - 16; } else { base = GL; ldc = 256; ct = 0; }
        const int row0 = u.pm * BM + wr * 64 + fr, col0 = ct * BM + wc * 32 + 8 * fq;
#pragma unroll
        for (int ai = 0; ai < 2; ++ai)
#pragma unroll
            for (int m = 0; m < 4; ++m) { bf16_t* rowp = base + (size_t)(row0 + ai * HALF + m * 16) * ldc + col0;
#pragma unroll
                for (int bj = 0; bj < 2; ++bj) { const f32x4 v0 = acc[ai][bj][m][0], v1 = acc[ai][bj][m][1];
                    u32x4 w; w.x = cvt_pk_bf16(v0[0], v0[1]); w.y = cvt_pk_bf16(v0[2], v0[3]); w.z = cvt_pk_bf16(v1[0], v1[1]); w.w = cvt_pk_bf16(v1[2], v1[3]);
                    *(u32x4*)(rowp + bj * HALF) = w; } }
    }
};
struct EpiResF32 {
    static constexpr bool PERM = false, AFTER_DRAIN = false;
    float* C; const float* RES; int ldc;
    __device__ __forceinline__ void operator()(const f32x4 (&acc)[2][2][4][2], const Unit& u, int wr, int wc, int fr, int fq) const {
        const int row0 = u.pm * BM + wr * 64 + fr, col0 = u.pc * BM + wc * 32 + 4 * fq;
#pragma unroll
        for (int ai = 0; ai < 2; ++ai)
#pragma unroll
            for (int m = 0; m < 4; ++m) { const size_t off = (size_t)(row0 + ai * HALF + m * 16) * ldc + col0;
                f32x4 rv[2][2];
#pragma unroll
                for (int bj = 0; bj < 2; ++bj)
#pragma unroll
                    for (int n = 0; n < 2; ++n) rv[bj][n] = *(const f32x4*)(RES + off + bj * HALF + n * 16);
#pragma unroll
                for (int bj = 0; bj < 2; ++bj)
#pragma unroll
                    for (int n = 0; n < 2; ++n) *(f32x4*)(C + off + bj * HALF + n * 16) = acc[ai][bj][m][n] + rv[bj][n]; }
    }
};
struct EpiRouter {
    static constexpr bool PERM = false, AFTER_DRAIN = false;
    float* RL;
    __device__ __forceinline__ void operator()(const f32x4 (&acc)[2][2][4][2], const Unit& u, int wr, int wc, int fr, int fq) const {
        if (wc >= 2) return;
        const int row0 = u.pm * BM + wr * 64 + fr, col0 = wc * 32 + 4 * fq;
#pragma unroll
        for (int ai = 0; ai < 2; ++ai)
#pragma unroll
            for (int m = 0; m < 4; ++m) { float* rowp = RL + (size_t)(row0 + ai * HALF + m * 16) * 64 + col0;
#pragma unroll
                for (int n = 0; n < 2; ++n) *(f32x4*)(rowp + n * 16) = acc[ai][0][m][n]; }
    }
};
__device__ __forceinline__ float silu_f(float x) { return x * __builtin_amdgcn_rcpf(1.0f + __expf(-x)); }
struct EpiSwiGLU {
    static constexpr bool PERM = true, AFTER_DRAIN = false;
    bf16_t* ACT;
    __device__ __forceinline__ void operator()(const f32x4 (&acc)[2][2][4][2], const Unit& u, int wr, int wc, int fr, int fq) const {
        const int row0 = u.pm * BM + wr * 64 + fr, col0 = u.pc * HALF + wc * 32 + 8 * fq;
#pragma unroll
        for (int ai = 0; ai < 2; ++ai)
#pragma unroll
            for (int m = 0; m < 4; ++m) { bf16_t* rowp = ACT + (size_t)(row0 + ai * HALF + m * 16) * 512 + col0;
                const f32x4 g0 = acc[ai][0][m][0], g1 = acc[ai][0][m][1], u0 = acc[ai][1][m][0], u1 = acc[ai][1][m][1];
                u32x4 w;
                w.x = cvt_pk_bf16(silu_f(g0[0]) * u0[0], silu_f(g0[1]) * u0[1]); w.y = cvt_pk_bf16(silu_f(g0[2]) * u0[2], silu_f(g0[3]) * u0[3]);
                w.z = cvt_pk_bf16(silu_f(g1[0]) * u1[0], silu_f(g1[1]) * u1[1]); w.w = cvt_pk_bf16(silu_f(g1[2]) * u1[2], silu_f(g1[3]) * u1[3]);
                *(u32x4*)rowp = w; }
    }
};

template <class Epi, class Sched, bool ALIGN_EPI = false, bool SP2 = false>
__device__ __forceinline__ void gemm_phase(PG8_LAS unsigned char* lds, const Gemm g, const Sched& S, const Epi& E) {
    const int tid = threadIdx.x, wid = __builtin_amdgcn_readfirstlane(tid >> 6), lane = tid & 63, wr = wid >> 2, wc = wid & 3, fr = lane & 15, fq = lane >> 4;
    const int K = g.K, nt = K / BK;
    unsigned voffA[2], voffB[2];
#pragma unroll
    for (int i = 0; i < 2; ++i) { int R, C; stage_rc(tid * 16 + i * 8192, R, C); const int Rb = Epi::PERM ? ((R & ~31) + perm32(R & 31)) : R;
        voffA[i] = (unsigned)(R * K + C) * 2u; voffB[i] = (unsigned)(Rb * K + C) * 2u; }
    const size_t kstep = (size_t)(BK * 2);
    const size_t hstep = (size_t)HALF * K * 2;
    const size_t tstep = 2 * hstep;
    const unsigned ldsw = (unsigned)wid * 1024u;
    const int aoff = lds_byte(wr * 64 + fr, fq * 8), boff = lds_byte(wc * 32 + fr, fq * 8);
#define PG8_SA(b, h) (((b) * 2 + (h)) * HTB)
#define PG8_SB(b, h) ((4 + (b) * 2 + (h)) * HTB)
#define PG8_STAGE(bufoff, gbase, voff) do { _Pragma("unroll") for (int _i = 0; _i < 2; ++_i) \
        __builtin_amdgcn_global_load_lds((const unsigned*)((const char*)(gbase) + (voff)[_i]), (PG8_LAS unsigned*)(lds + (bufoff) + ldsw + _i * 8192), 16, 0, 0); } while (0)
#define PG8_LDA(dst, b, h) do { _Pragma("unroll") for (int m = 0; m < 4; ++m) _Pragma("unroll") for (int k = 0; k < 2; ++k) dst[m][k] = *(const PG8_LAS bf16x8*)(lds + PG8_SA(b, h) + aoff + m * 2048 + k * 1024); } while (0)
#define PG8_LDB(dst, b, h) do { _Pragma("unroll") for (int n = 0; n < 2; ++n) _Pragma("unroll") for (int k = 0; k < 2; ++k) dst[n][k] = *(const PG8_LAS bf16x8*)(lds + PG8_SB(b, h) + boff + n * 2048 + k * 1024); } while (0)
#define PG8_MMA(ai, bj, At, Bt) do { __builtin_amdgcn_s_setprio(1); _Pragma("unroll") for (int m = 0; m < 4; ++m) _Pragma("unroll") for (int n = 0; n < 2; ++n) _Pragma("unroll") for (int k = 0; k < 2; ++k) \
        acc[ai][bj][m][n] = __builtin_amdgcn_mfma_f32_16x16x32_bf16(Bt[n][k], At[m][k], acc[ai][bj][m][n], 0, 0, 0); __builtin_amdgcn_s_setprio(0); } while (0)
#define PG8_WAIT_V(n) asm volatile("s_waitcnt vmcnt(" #n ")" ::: "memory")
#define PG8_WAIT_L(n) asm volatile("s_waitcnt lgkmcnt(" #n ")" ::: "memory")
#define PG8_BAR __builtin_amdgcn_s_barrier()
#define PG8_SCHED __builtin_amdgcn_sched_barrier(0)
    Unit cur, nxt; int ui = 0;
    if (!S.next(0, cur)) return;
    f32x4 acc[2][2][4][2];
#pragma unroll
    for (int a = 0; a < 2; ++a)
#pragma unroll
        for (int b = 0; b < 2; ++b)
#pragma unroll
            for (int m = 0; m < 4; ++m)
#pragma unroll
                for (int n = 0; n < 2; ++n) acc[a][b][m][n] = (f32x4){0.f, 0.f, 0.f, 0.f};
    bf16x8 At[4][2], B0[2][2], B1[2][2];
    const char* cA = (const char*)g.A + (size_t)cur.pm * tstep; const char* cB = (const char*)g.Bt + (size_t)cur.pn * tstep;
    S.a_ready(cur);
    if constexpr (SP2) {
        PG8_STAGE(PG8_SB(0, 0), cB, voffB); PG8_STAGE(PG8_SB(0, 1), cB + hstep, voffB); PG8_STAGE(PG8_SA(0, 0), cA, voffA); PG8_STAGE(PG8_SA(0, 1), cA + hstep, voffA);
        if (wr == 1) PG8_BAR;
        PG8_WAIT_V(2); PG8_BAR;
        PG8_STAGE(PG8_SB(1, 0), cB + kstep, voffB); PG8_STAGE(PG8_SA(1, 0), cA + kstep, voffA); PG8_STAGE(PG8_SB(1, 1), cB + hstep + kstep, voffB);
        PG8_WAIT_V(6); PG8_BAR;
    } else {
        PG8_STAGE(PG8_SB(0, 0), cB, voffB); PG8_STAGE(PG8_SA(0, 0), cA, voffA); PG8_STAGE(PG8_SB(0, 1), cB + hstep, voffB); PG8_STAGE(PG8_SA(0, 1), cA + hstep, voffA);
        if (wr == 1) PG8_BAR;
        PG8_WAIT_V(4); PG8_BAR;
        PG8_STAGE(PG8_SB(1, 0), cB + kstep, voffB); PG8_STAGE(PG8_SA(1, 0), cA + kstep, voffA); PG8_STAGE(PG8_SB(1, 1), cB + hstep + kstep, voffB);
        PG8_WAIT_V(6); PG8_BAR;
    }
    for (;;) {
        const bool has_next = S.next(ui + 1, nxt);
        const char* nA = has_next ? (const char*)g.A + (size_t)nxt.pm * tstep : cA; const char* nB = has_next ? (const char*)g.Bt + (size_t)nxt.pn * tstep : cB;
        for (int t = 0; t < nt; t += 2) {
            const bool last = (t == nt - 2);
            const char* a1 = cA + (size_t)(t + 1) * kstep;
            const char* a2 = last ? nA : cA + (size_t)(t + 2) * kstep; const char* b2 = last ? nB : cB + (size_t)(t + 2) * kstep;
            const char* a3 = a2 + kstep; const char* b3 = b2 + kstep;
            if (last && has_next) S.a_ready(nxt);
            if constexpr (SP2) {
            PG8_LDB(B0, 0, 0); PG8_LDB(B1, 0, 1); PG8_SCHED; PG8_LDA(At, 0, 0); PG8_STAGE(PG8_SA(1, 1), a1 + hstep, voffA);
            PG8_WAIT_V(8); PG8_WAIT_L(0); PG8_BAR; PG8_MMA(0, 0, At, B0); PG8_MMA(0, 1, At, B1); PG8_BAR; PG8_SCHED;
            PG8_LDA(At, 0, 1); PG8_STAGE(PG8_SB(0, 0), b2, voffB); PG8_STAGE(PG8_SB(0, 1), b2 + hstep, voffB); PG8_STAGE(PG8_SA(0, 0), a2, voffA);
            PG8_WAIT_V(8); PG8_WAIT_L(0); PG8_BAR; PG8_MMA(1, 0, At, B0); PG8_MMA(1, 1, At, B1); PG8_BAR; PG8_SCHED;
            PG8_LDB(B0, 1, 0); PG8_LDB(B1, 1, 1); PG8_SCHED; PG8_LDA(At, 1, 0); PG8_STAGE(PG8_SA(0, 1), a2 + hstep, voffA);
            PG8_WAIT_V(8); PG8_WAIT_L(0); PG8_BAR; PG8_MMA(0, 0, At, B0); PG8_MMA(0, 1, At, B1); PG8_BAR; PG8_SCHED;
            PG8_LDA(At, 1, 1); PG8_STAGE(PG8_SB(1, 0), b3, voffB); PG8_STAGE(PG8_SB(1, 1), b3 + hstep, voffB); PG8_STAGE(PG8_SA(1, 0), a3, voffA);
            PG8_WAIT_V(8); PG8_WAIT_L(0); PG8_BAR; PG8_MMA(1, 0, At, B0); PG8_MMA(1, 1, At, B1); PG8_BAR; PG8_SCHED;
            } else {
            PG8_LDB(B0, 0, 0); PG8_SCHED; PG8_LDA(At, 0, 0); PG8_STAGE(PG8_SA(1, 1), a1 + hstep, voffA);
            PG8_WAIT_L(8); PG8_BAR; PG8_WAIT_L(0); PG8_MMA(0, 0, At, B0); PG8_BAR; PG8_SCHED;
            PG8_LDB(B1, 0, 1); PG8_STAGE(PG8_SB(0, 0), b2, voffB);
            PG8_BAR; PG8_WAIT_L(0); PG8_MMA(0, 1, At, B1); PG8_BAR;
            PG8_LDA(At, 0, 1); PG8_STAGE(PG8_SA(0, 0), a2, voffA);
            PG8_BAR; PG8_WAIT_L(0); PG8_MMA(1, 0, At, B0); PG8_BAR; PG8_SCHED;
            PG8_STAGE(PG8_SB(0, 1), b2 + hstep, voffB);
            PG8_WAIT_V(6); PG8_BAR; PG8_MMA(1, 1, At, B1); PG8_BAR;
            PG8_LDB(B0, 1, 0); PG8_SCHED; PG8_LDA(At, 1, 0); PG8_STAGE(PG8_SA(0, 1), a2 + hstep, voffA);
            PG8_WAIT_L(8); PG8_BAR; PG8_WAIT_L(0); PG8_MMA(0, 0, At, B0); PG8_BAR; PG8_SCHED;
            PG8_LDB(B1, 1, 1); PG8_STAGE(PG8_SB(1, 0), b3, voffB);
            PG8_BAR; PG8_WAIT_L(0); PG8_MMA(0, 1, At, B1); PG8_BAR;
            PG8_LDA(At, 1, 1); PG8_STAGE(PG8_SA(1, 0), a3, voffA);
            PG8_BAR; PG8_WAIT_L(0); PG8_MMA(1, 0, At, B0); PG8_BAR; PG8_SCHED;
            PG8_STAGE(PG8_SB(1, 1), b3 + hstep, voffB);
            PG8_WAIT_V(6); PG8_BAR; PG8_MMA(1, 1, At, B1); PG8_BAR;
            }
        }
        if constexpr (ALIGN_EPI) { if (wr == 0) PG8_BAR; }
        if constexpr (!Epi::AFTER_DRAIN) { E(acc, cur, wr, wc, fr, fq); S.done(cur); }
        if (!has_next) break;
#pragma unroll
        for (int a = 0; a < 2; ++a)
#pragma unroll
            for (int b = 0; b < 2; ++b)
#pragma unroll
                for (int m = 0; m < 4; ++m)
#pragma unroll
                    for (int n = 0; n < 2; ++n) acc[a][b][m][n] = (f32x4){0.f, 0.f, 0.f, 0.f};
        cur = nxt; cA = nA; cB = nB; ++ui;
        if constexpr (ALIGN_EPI) { if (wr == 1) PG8_BAR; }
    }
    PG8_WAIT_V(0);
    if constexpr (!ALIGN_EPI) { if (wr == 0) PG8_BAR; }
    PG8_BAR;
    if constexpr (Epi::AFTER_DRAIN) { E.fused(acc, cur, wr, wc, fr, fq, lds, wid, lane); S.done(cur); }
#undef PG8_SA
#undef PG8_SB
#undef PG8_STAGE
#undef PG8_LDA
#undef PG8_LDB
#undef PG8_MMA
#undef PG8_WAIT_V
#undef PG8_WAIT_L
#undef PG8_BAR
#undef PG8_SCHED
}
}

constexpr int NWAVES = 8;
constexpr int T = 32768, D = 2048, SEQ = 16384;
constexpr float RMS_EPS = 1e-6f;
constexpr int GLA_H = 4, GLA_DK = 256, GLA_DV = 512, GLA_C = 64, GLA_NCH = SEQ / GLA_C  , GLA_PROJ_N = 6160, GLA_PROJ_NP = 6400;
constexpr int NITEM_GLA = 2 * GLA_H * GLA_NCH;
constexpr int SWA_HQ = 32, SWA_HKV = 4, SWA_HD = 64, SWA_W = 128, KVQ_N = 2560;
constexpr int NE = 32, FF = 512, MOE_MAXROWS = 2 * T + NE * 256;

constexpr size_t MiB = 1u << 20;
constexpr size_t WS_CTL = 0, CTL_ZERO_BYTES = 1 * MiB;
constexpr size_t WS_W_GLA_IN = 1 * MiB;
constexpr size_t WS_W_GLA_OUT = 26 * MiB;
constexpr size_t WS_W_KVQ = 34 * MiB;
constexpr size_t WS_W_SWA_OUT = 44 * MiB;
constexpr size_t WS_W_ROUTER = 52 * MiB;
constexpr size_t WS_TOK = 54 * MiB;
constexpr size_t WS_RL = 56 * MiB;
constexpr size_t WS_W_GU = 64 * MiB;
constexpr size_t WS_W_DN = 192 * MiB;
constexpr size_t WS_HN = 256 * MiB;
constexpr size_t WS_BIG = 384 * MiB;
constexpr size_t WS_QK = WS_BIG;
constexpr size_t WS_V = WS_BIG + 128 * MiB;
constexpr size_t WS_R = WS_BIG + 256 * MiB;
constexpr size_t WS_GL = WS_BIG + 384 * MiB;
constexpr size_t WS_QEF = WS_BIG + 400 * MiB;
constexpr size_t WS_KLTF = WS_BIG + 464 * MiB;
constexpr size_t WS_ATTF = WS_BIG + 528 * MiB;
constexpr size_t WS_VTF = WS_BIG + 544 * MiB;
constexpr size_t WS_DEC = WS_BIG + 672 * MiB;
constexpr size_t WS_GLA_END = WS_BIG + 674 * MiB;
constexpr size_t WS_XS = WS_BIG;
constexpr size_t WS_ACT = WS_BIG + 288 * MiB;
constexpr size_t WS_Y = WS_BIG + 360 * MiB;
constexpr size_t WS_KVQ = WS_BIG;
constexpr size_t WS_AO = WS_BIG + 160 * MiB;
constexpr size_t WS_END = WS_GLA_END;
static_assert(WS_Y + (size_t)MOE_MAXROWS * 2048 * 2 <= WS_END && WS_ACT + (size_t)MOE_MAXROWS * 512 * 2 <= WS_Y, "MoE map");
constexpr int CW_BAR = 4096;
constexpr int CW_CNT = 16384;

constexpr int RING_OFF = 0, RING_BYTES = 131072;
constexpr int LDSCTL_OFF = RING_BYTES;
constexpr int MISC_OFF = LDSCTL_OFF + 64;
constexpr int MOE_OFF_OFF = LDSCTL_OFF + 256;
constexpr int MOE_TEXP_OFF = LDSCTL_OFF + 512;
constexpr int LDS_BYTES = 147456;

#define GAS __attribute__((address_space(1)))
#define LAS __attribute__((address_space(3)))
typedef unsigned short bf16;
typedef unsigned v4u __attribute__((ext_vector_type(4)));
typedef unsigned v2u __attribute__((ext_vector_type(2)));
typedef float f32x4 __attribute__((ext_vector_type(4)));
typedef short bf16x8 __attribute__((ext_vector_type(8)));
typedef GAS unsigned gu32;
#define RLX_AGENT __ATOMIC_RELAXED, __HIP_MEMORY_SCOPE_AGENT
#define LDS_WAIT() asm volatile("s_waitcnt lgkmcnt(0)" ::: "memory")
#define VM_WAIT() asm volatile("s_waitcnt vmcnt(0)" ::: "memory")
__device__ __forceinline__ unsigned f2bf(float f) { unsigned u = __builtin_bit_cast(unsigned, f); return (u + 0x7fffu + ((u >> 16) & 1u)) >> 16; }
__device__ __forceinline__ unsigned pk2(float lo, float hi) { return pg8::cvt_pk_bf16(lo, hi); }
__device__ __forceinline__ float bf_lo(unsigned w) { return __builtin_bit_cast(float, w << 16); }
__device__ __forceinline__ float bf_hi(unsigned w) { return __builtin_bit_cast(float, w & 0xffff0000u); }
__device__ __forceinline__ float bf2f(bf16 b) { return __builtin_bit_cast(float, ((unsigned)b) << 16); }
__device__ __forceinline__ float wave_sum(float v) {
#pragma unroll
    for (int o = 1; o < 64; o <<= 1) v += __shfl_xor(v, o);
    return v;
}

#define XB_TMO      128
#define XB_XCNT(j)  (256  + 64 * (j))
#define XB_XSUB(j)  (1280 + 64 * (j))
#define XB_XGEN(j)  (2304 + 64 * (j))
#define XB_TOP      3328
#define XB_TOPGEN   3392
#define XCD_BAR_WORDS 3456
#define XB_SPIN_CAP (1u << 18)

__device__ __forceinline__ unsigned xb_ld(unsigned* p)              { return __hip_atomic_load(p, __ATOMIC_RELAXED, __HIP_MEMORY_SCOPE_AGENT); }
__device__ __forceinline__ unsigned xb_add(unsigned* p, unsigned v) { return __hip_atomic_fetch_add(p, v, __ATOMIC_RELAXED, __HIP_MEMORY_SCOPE_AGENT); }
__device__ __forceinline__ unsigned xb_xcc_id() { return (unsigned)__builtin_amdgcn_s_getreg((3 << 11) | 20) & 0xFu; }
#define XB_SPIN(cond, bar) do { unsigned _sp = 0; while (cond) { __builtin_amdgcn_s_sleep(1); \
    if ((++_sp & 255u) == 0u) { if (xb_ld(&(bar)[XB_TMO])) break; if (_sp > XB_SPIN_CAP) { atomicAdd(&(bar)[XB_TMO], 1u); break; } } } } while (0)

struct XcdBarrier {
    unsigned* bar; unsigned x;
    volatile LAS unsigned* st;
};

__device__ __forceinline__ XcdBarrier xcd_barrier_post(unsigned* bar, volatile LAS unsigned* st) {
    XcdBarrier b; b.bar = bar; b.x = xb_xcc_id(); b.st = st;
    if (threadIdx.x == 0) (void)xb_add(&bar[XB_XCNT(b.x)], 1u);
    return b;
}
__device__ __forceinline__ void xcd_barrier_complete(unsigned* bar, unsigned x, unsigned& nloc, unsigned& nx) {
    const unsigned G = gridDim.x * gridDim.y * gridDim.z;
    unsigned sum, cnt, mine, sp = 0u;
    for (;;) {
        sum = 0u; cnt = 0u; mine = 0u;
#pragma unroll
        for (unsigned j = 0; j < 16; ++j) { const unsigned c = xb_ld(&bar[XB_XCNT(j)]); sum += c; cnt += (c > 0u) ? 1u : 0u; mine = (j == x) ? c : mine; }
        if (sum == G) break;
        __builtin_amdgcn_s_sleep(1);
        if ((++sp & 255u) == 0u) { if (xb_ld(&bar[XB_TMO])) break; if (sp > XB_SPIN_CAP) { atomicAdd(&bar[XB_TMO], 1u); break; } }
    }
    nloc = mine > 0u ? mine : 1u; nx = cnt > 0u ? cnt : 1u;
}

__device__ __forceinline__ void xcd_barrier(const XcdBarrier& b) {
    asm volatile("s_waitcnt vmcnt(0)" ::: "memory");
    __syncthreads();
    if (threadIdx.x == 0) {
        unsigned* bar = b.bar;
        __builtin_amdgcn_s_waitcnt(0);
        unsigned nloc = b.st[0], nx = b.st[1];
        if (nloc == 0u) { xcd_barrier_complete(bar, b.x, nloc, nx); b.st[0] = nloc; b.st[1] = nx; }
        const unsigned old = xb_add(&bar[XB_XSUB(b.x)], 1u);
        const unsigned gen = old / nloc;
        if (old + 1u == (gen + 1u) * nloc) {
            __builtin_amdgcn_fence(__ATOMIC_RELEASE, "agent");
            asm volatile("s_waitcnt vmcnt(0)" ::: "memory");
            const unsigned og = xb_add(&bar[XB_TOP], 1u);
            const unsigned tg = og / nx;
            if (og + 1u == (tg + 1u) * nx) xb_add(&bar[XB_TOPGEN], 1u);
            else XB_SPIN(xb_ld(&bar[XB_TOPGEN]) == tg, bar);
            __builtin_amdgcn_fence(__ATOMIC_ACQUIRE, "agent");
            xb_add(&bar[XB_XGEN(b.x)], 1u);
            asm volatile("s_waitcnt vmcnt(0)" ::: "memory");
        } else {
            XB_SPIN(xb_ld(&bar[XB_XGEN(b.x)]) == gen, bar);
            __builtin_amdgcn_fence(__ATOMIC_ACQUIRE, "agent");
            asm volatile("s_waitcnt vmcnt(0)" ::: "memory");
        }
    }
    __syncthreads();
}


__device__ __forceinline__ void cvt_item(const float* W, int N, const float* gain, bf16* WT, int K, int k0, int n0, int nvalid, size_t dst_row0, LAS float* scr, int lane) {
    const int nn = lane & 31;
#pragma unroll 8
    for (int i = 0; i < 32; ++i) { const int kk = 2 * i + (lane >> 5);
        float v = (nn < nvalid) ? W[(size_t)(k0 + kk) * N + n0 + nn] : 0.f;
        if (gain) v *= gain[k0 + kk];
        scr[kk * 33 + nn] = v; }
    LDS_WAIT(); asm volatile("" ::: "memory");
    const int c = lane & 7;
#pragma unroll
    for (int j = 0; j < 4; ++j) { const int n = (lane >> 3) + 8 * j; const LAS float* s = scr + (8 * c) * 33 + n;
        v4u o; o.x = pk2(s[0 * 33], s[1 * 33]); o.y = pk2(s[2 * 33], s[3 * 33]); o.z = pk2(s[4 * 33], s[5 * 33]); o.w = pk2(s[6 * 33], s[7 * 33]);
        if (n < nvalid) *(GAS v4u*)(WT + (dst_row0 + n) * (size_t)K + k0 + 8 * c) = o; }
    LDS_WAIT(); asm volatile("" ::: "memory");
}
__device__ __forceinline__ void cvt_matrix(const float* W, int K, int N, const float* gain, bf16* WT, int rowbase, LAS float* scr, int gw, int NGW, int lane) {
    const int nblk = (N + 31) / 32, nitems = (K / 64) * nblk;
    for (int it = gw; it < nitems; it += NGW) { const int kb = it / nblk, nb = it - kb * nblk, n0 = nb * 32; const int nv = (N - n0) < 32 ? (N - n0) : 32;
        cvt_item(W, N, gain, WT, K, kb * 64, n0, nv, (size_t)(rowbase + n0), scr, lane); }
}
__device__ __forceinline__ void cvt_moe(const float* wg, const float* wu, const float* wd, const float* gain, bf16* WGU, bf16* WDN, LAS float* scr, int gw, int NGW, int lane) {
    for (int it = gw; it < 2 * 16384; it += NGW) { const int which = it >> 14, r = it & 16383, e = r >> 9, q = r & 511, kb = q >> 4, nb = q & 15, n0 = nb * 32;
        const float* W = (which ? wu : wg) + (size_t)e * 2048 * 512;
        const size_t dst = (size_t)e * 1024 + 256 * (n0 >> 7) + (n0 & 127) + (which ? 128 : 0);
        cvt_item(W, 512, gain, WGU, 2048, kb * 64, n0, 32, dst, scr, lane); }
    for (int it = gw; it < 16384; it += NGW) { const int e = it >> 9, q = it & 511, kb = q >> 6, nb = q & 63;
        cvt_item(wd + (size_t)e * 512 * 2048, 2048, nullptr, WDN + (size_t)e * 2048 * 512, 512, kb * 64, nb * 32, 32, (size_t)(nb * 32), scr, lane); }
}
__device__ __forceinline__ void norm_rows(const float* src, bf16* dst, int gw, int NGW, int lane) {
    for (int m = gw; m < T; m += NGW) {
        const GAS f32x4* xr = (const GAS f32x4*)(src + (size_t)m * D) + lane;
        f32x4 v[8]; float s = 0.f;
#pragma unroll
        for (int j = 0; j < 8; ++j) { v[j] = xr[64 * j]; s += (v[j].x * v[j].x + v[j].y * v[j].y) + (v[j].z * v[j].z + v[j].w * v[j].w); }
        const float rstd = rsqrtf(wave_sum(s) * (1.f / D) + RMS_EPS);
        GAS v2u* o8 = (GAS v2u*)(dst + (size_t)m * D) + lane;
#pragma unroll
        for (int j = 0; j < 8; ++j) { v2u o; o.x = pk2(v[j].x * rstd, v[j].y * rstd); o.y = pk2(v[j].z * rstd, v[j].w * rstd); o8[64 * j] = o; }
    }
}

__device__ __forceinline__ float logsig(float z) { return fminf(z, 0.f) - __logf(1.f + __expf(-fabsf(z))); }
constexpr int GP_QE = 0, GP_KE = 33792, GP_ATT = 67584, GP_GLF = 76800, GP_TOT = 81152;
__device__ __forceinline__ void gla_prepass(LAS unsigned char* lds, const bf16* QK, const bf16* V, const bf16* GL, const float* Wgu, const float* bgate,
                                            bf16* QEF, bf16* KLTF, bf16* ATTF, bf16* VTF, float* DEC) {
    const int tid = threadIdx.x, lane = tid & 63, wave = __builtin_amdgcn_readfirstlane(tid >> 6), d = tid & 255, half = tid >> 8;
    LAS bf16* QEl = (LAS bf16*)(lds + GP_QE); LAS bf16* KEl = (LAS bf16*)(lds + GP_KE); LAS bf16* ATl = (LAS bf16*)(lds + GP_ATT);
    LAS float* glf = (LAS float*)(lds + GP_GLF); LAS float* tot = (LAS float*)(lds + GP_TOT);
    for (int it = blockIdx.x; it < NITEM_GLA; it += gridDim.x) {
        const int bh = it >> 8, n = it & 255, h = bh & 3, b = bh >> 2; const int t0 = b * SEQ + n * GLA_C;
        __syncthreads();
        { const int c = tid >> 3, j2 = (tid & 7) * 2; const unsigned w = *(const GAS unsigned*)(GL + (size_t)(t0 + c) * 256 + j2); glf[c * 17 + j2] = bf_lo(w); glf[c * 17 + j2 + 1] = bf_hi(w); }
        float wg[16];
#pragma unroll
        for (int j = 0; j < 16; ++j) wg[j] = Wgu[j * 1024 + h * 256 + d];
        const float bg = bgate[h * 256 + d];
        __syncthreads();
        float la[32]; float run = 0.f;
#pragma unroll
        for (int i = 0; i < 32; ++i) { const int c = half * 32 + i; float z = bg;
#pragma unroll
            for (int j = 0; j < 16; ++j) z += glf[c * 17 + j] * wg[j];
            run += fmaxf(logsig(z) * 0.0625f, -1.0f); la[i] = run; }
        tot[half * 256 + d] = run;
        __syncthreads();
        const float other = tot[(1 - half) * 256 + d]; const float blast = run + other, offs = half ? other : 0.f;
        const bf16* qp = QK + (size_t)t0 * 2048 + h * 256 + d;
#pragma unroll
        for (int g = 0; g < 4; ++g) { float klv[8];
#pragma unroll
            for (int jj = 0; jj < 8; ++jj) { const int i = 8 * g + jj, c = half * 32 + i; const float bb = la[i] + offs;
                const float qv = bf2f(qp[(size_t)c * 2048]), kv = bf2f(qp[(size_t)c * 2048 + 1024]);
                QEl[c * 264 + d] = (bf16)f2bf(qv * 0.0625f * __expf(bb)); KEl[c * 264 + d] = (bf16)f2bf(kv * __expf(-bb)); klv[jj] = kv * __expf(blast - bb); }
            v4u o; o.x = pk2(klv[0], klv[1]); o.y = pk2(klv[2], klv[3]); o.z = pk2(klv[4], klv[5]); o.w = pk2(klv[6], klv[7]);
            const size_t fi = ((((size_t)it * 8 + (d >> 5)) * 2 + ((d >> 4) & 1)) * 2 + half) * 64 + g * 16 + (d & 15);
            *(GAS v4u*)(KLTF + fi * 8) = o; }
        if (half == 0) DEC[(size_t)it * 256 + d] = __expf(blast);
        { const bf16* vp = V + (size_t)t0 * 2048 + h * 512 + tid;
#pragma unroll
          for (int ks = 0; ks < 2; ++ks)
#pragma unroll
            for (int q = 0; q < 4; ++q) { unsigned short e[8];
#pragma unroll
                for (int jj = 0; jj < 8; ++jj) e[jj] = vp[(size_t)(32 * ks + 8 * q + jj) * 2048];
                v4u o; o.x = e[0] | ((unsigned)e[1] << 16); o.y = e[2] | ((unsigned)e[3] << 16); o.z = e[4] | ((unsigned)e[5] << 16); o.w = e[6] | ((unsigned)e[7] << 16);
                const size_t fi = (((size_t)it * 32 + (tid >> 4)) * 2 + ks) * 64 + q * 16 + (tid & 15);
                *(GAS v4u*)(VTF + fi * 8) = o; } }
        __syncthreads();
        { const int mt = wave >> 1, i = lane & 15, q = lane >> 4;
#pragma unroll
          for (int nn = 0; nn < 2; ++nn) { const int nt = 2 * (wave & 1) + nn; f32x4 acc = {0.f, 0.f, 0.f, 0.f};
            if (nt <= mt) {
#pragma unroll
                for (int ks = 0; ks < 8; ++ks) { const bf16x8 a = *(const LAS bf16x8*)(QEl + (16 * mt + i) * 264 + 32 * ks + 8 * q); const bf16x8 bb = *(const LAS bf16x8*)(KEl + (16 * nt + i) * 264 + 32 * ks + 8 * q);
                    acc = __builtin_amdgcn_mfma_f32_16x16x32_bf16(a, bb, acc, 0, 0, 0); } }
#pragma unroll
            for (int r = 0; r < 4; ++r) { const int c = 16 * mt + 4 * q + r, cp = 16 * nt + i; ATl[c * 72 + cp] = (bf16)f2bf(cp <= c ? acc[r] : 0.f); } } }
        __syncthreads();
        { const int f = tid, mt = f >> 7, ks = (f >> 6) & 1, l2 = f & 63, i2 = l2 & 15, q2 = l2 >> 4;
          const v4u o = *(const LAS v4u*)(ATl + (16 * mt + i2) * 72 + 32 * ks + 8 * q2);
          *(GAS v4u*)(ATTF + ((size_t)it * 512 + f) * 8) = o; }
#pragma unroll
        for (int k = 0; k < 4; ++k) { const int f = tid + 512 * k, w = f >> 8, mt = (f >> 6) & 3, l2 = f & 63, i2 = l2 & 15, q2 = l2 >> 4;
            const v2u lo = *(const LAS v2u*)(QEl + (16 * mt + i2) * 264 + 32 * w + 4 * q2), hi = *(const LAS v2u*)(QEl + (16 * mt + i2) * 264 + 32 * w + 16 + 4 * q2);
            v4u o; o.x = lo.x; o.y = lo.y; o.z = hi.x; o.w = hi.y;
            *(GAS v4u*)(QEF + ((((size_t)it * 8 + w) * 4 + mt) * 64 + l2) * 8) = o; }
    }
}
struct GStep { bf16x8 qa[4], ka[2][2], vb[2], at; f32x4 dc[2]; };
__device__ __forceinline__ void gla_load(GStep& s, int it, int vs, int w, int lane, const bf16* QEF, const bf16* KLTF, const bf16* ATTF, const bf16* VTF, const float* DEC) {
    const GAS bf16x8* q16 = (const GAS bf16x8*)QEF + (((size_t)it * 8 + w) * 4) * 64 + lane;
#pragma unroll
    for (int mt = 0; mt < 4; ++mt) s.qa[mt] = q16[mt * 64];
    const GAS bf16x8* k16 = (const GAS bf16x8*)KLTF + (((size_t)it * 8 + w) * 4) * 64 + lane;
#pragma unroll
    for (int m = 0; m < 2; ++m)
#pragma unroll
        for (int ks = 0; ks < 2; ++ks) s.ka[m][ks] = k16[(m * 2 + ks) * 64];
    const GAS bf16x8* v16 = (const GAS bf16x8*)VTF + (((size_t)it * 32 + vs) * 2) * 64 + lane;
    s.vb[0] = v16[0]; s.vb[1] = v16[64];
    s.at = ((const GAS bf16x8*)ATTF)[(size_t)it * 512 + w * 64 + lane];
    const GAS f32x4* d4 = (const GAS f32x4*)(DEC + (size_t)it * 256 + 32 * w + 4 * (lane >> 4));
    s.dc[0] = d4[0]; s.dc[1] = d4[4];
}
__device__ __forceinline__ void gla_seq(LAS unsigned char* lds, const bf16* QEF, const bf16* KLTF, const bf16* ATTF, const bf16* VTF, const float* DEC, bf16* O) {
    const int tid = threadIdx.x, lane = tid & 63, w = __builtin_amdgcn_readfirstlane(tid >> 6), q = lane >> 4;
    LAS float* part = (LAS float*)lds;
    for (int wi = blockIdx.x; wi < 256; wi += gridDim.x) {
        const int bh = wi & 7, vs = wi >> 3, h = bh & 3, b = bh >> 2;
        f32x4 S0 = {0.f, 0.f, 0.f, 0.f}, S1 = {0.f, 0.f, 0.f, 0.f};
        GStep cur, nxt;
        gla_load(cur, bh * 256, vs, w, lane, QEF, KLTF, ATTF, VTF, DEC);
        __syncthreads();
        for (int n = 0; n < GLA_NCH; ++n) {
            const int it = bh * 256 + n;
            gla_load(nxt, (n + 1 < GLA_NCH) ? it + 1 : it, vs, w, lane, QEF, KLTF, ATTF, VTF, DEC);
            v4u sbw; sbw.x = pk2(S0[0], S0[1]); sbw.y = pk2(S0[2], S0[3]); sbw.z = pk2(S1[0], S1[1]); sbw.w = pk2(S1[2], S1[3]);
            const bf16x8 sb = __builtin_bit_cast(bf16x8, sbw);
            f32x4 po[4];
#pragma unroll
            for (int mt = 0; mt < 4; ++mt) po[mt] = __builtin_amdgcn_mfma_f32_16x16x32_bf16(cur.qa[mt], sb, (f32x4){0.f, 0.f, 0.f, 0.f}, 0, 0, 0);
            const bf16x8 vsel = (w & 1) ? cur.vb[1] : cur.vb[0];
#pragma unroll
            for (int mt = 0; mt < 4; ++mt) if (mt == (w >> 1)) po[mt] = __builtin_amdgcn_mfma_f32_16x16x32_bf16(cur.at, vsel, po[mt], 0, 0, 0);
            S0 = S0 * cur.dc[0]; S1 = S1 * cur.dc[1];
            S0 = __builtin_amdgcn_mfma_f32_16x16x32_bf16(cur.ka[0][0], cur.vb[0], S0, 0, 0, 0); S0 = __builtin_amdgcn_mfma_f32_16x16x32_bf16(cur.ka[0][1], cur.vb[1], S0, 0, 0, 0);
            S1 = __builtin_amdgcn_mfma_f32_16x16x32_bf16(cur.ka[1][0], cur.vb[0], S1, 0, 0, 0); S1 = __builtin_amdgcn_mfma_f32_16x16x32_bf16(cur.ka[1][1], cur.vb[1], S1, 0, 0, 0);
            LAS float* pb = part + (size_t)((n & 1) * 8 + w) * 1024;
#pragma unroll
            for (int mt = 0; mt < 4; ++mt)
#pragma unroll
                for (int r = 0; r < 4; ++r) pb[(16 * mt + 4 * q + r) * 16 + (lane & 15)] = po[mt][r];
            __syncthreads();
            { const int c = tid >> 3, v2 = (tid & 7) * 2; const LAS float* pr = part + (size_t)((n & 1) * 8) * 1024 + c * 16 + v2; float s0 = 0.f, s1 = 0.f;
#pragma unroll
              for (int ww = 0; ww < 8; ++ww) { s0 += pr[ww * 1024]; s1 += pr[ww * 1024 + 1]; }
              *(GAS unsigned*)(O + (size_t)(b * SEQ + n * GLA_C + c) * 2048 + h * 512 + vs * 16 + v2) = pk2(s0, s1); }
            cur = nxt;
        }
        __syncthreads();
    }
}
__device__ __forceinline__ void gla_gate(const bf16* O, const bf16* R, const float* head_g, bf16* OG, int gw, int NGW, int lane) {
    float hg[8];
#pragma unroll
    for (int j = 0; j < 8; ++j) hg[j] = head_g[8 * lane + j];
    for (int m = gw; m < T; m += NGW) {
#pragma unroll
        for (int h = 0; h < 4; ++h) {
            const v4u ov = *(const GAS v4u*)(O + (size_t)m * 2048 + h * 512 + 8 * lane), rv = *(const GAS v4u*)(R + (size_t)m * 2048 + h * 512 + 8 * lane);
            float o[8] = {bf_lo(ov.x), bf_hi(ov.x), bf_lo(ov.y), bf_hi(ov.y), bf_lo(ov.z), bf_hi(ov.z), bf_lo(ov.w), bf_hi(ov.w)};
            float r[8] = {bf_lo(rv.x), bf_hi(rv.x), bf_lo(rv.y), bf_hi(rv.y), bf_lo(rv.z), bf_hi(rv.z), bf_lo(rv.w), bf_hi(rv.w)};
            float ss = 0.f;
#pragma unroll
            for (int j = 0; j < 8; ++j) ss += o[j] * o[j];
            const float rstd = rsqrtf(wave_sum(ss) * (1.f / 512.f) + RMS_EPS);
            float y[8];
#pragma unroll
            for (int j = 0; j < 8; ++j) y[j] = o[j] * rstd * hg[j] * pg8::silu_f(r[j]);
            v4u w; w.x = pk2(y[0], y[1]); w.y = pk2(y[2], y[3]); w.z = pk2(y[4], y[5]); w.w = pk2(y[6], y[7]);
            *(GAS v4u*)(OG + (size_t)m * 2048 + h * 512 + 8 * lane) = w;
        }
    }
}

__device__ __forceinline__ void moe_route(LAS unsigned char* lds, const float* RL, const float* bgroup, const float* brouter, unsigned* gcnt, unsigned* EP0, unsigned* EP1, float* W0, float* W1) {
    const int tid = threadIdx.x; LAS int* lcnt = (LAS int*)lds; LAS int* lbase = lcnt + 32;
    for (int base = blockIdx.x * 128; base < T; base += gridDim.x * 128) {
        if (tid < 32) lcnt[tid] = 0;
        __syncthreads();
        int e0 = 0, e1 = 0, r0 = 0, r1 = 0; float w0 = 0.f, w1 = 0.f;
        if (tid < 128) { const int t = base + tid; const float* rl = RL + (size_t)t * 64;
            const f32x4 g4 = *(const GAS f32x4*)rl; float gl[4] = {g4.x + bgroup[0], g4.y + bgroup[1], g4.z + bgroup[2], g4.w + bgroup[3]};
            int g = 0; float best = gl[0];
#pragma unroll
            for (int j = 1; j < 4; ++j) if (gl[j] > best) { best = gl[j]; g = j; }
            float se = 0.f;
#pragma unroll
            for (int j = 0; j < 4; ++j) se += __expf(gl[j] - best);
            const float pg = 1.0f / se;
            const f32x4 a4 = *(const GAS f32x4*)(rl + 4 + 8 * g), b4 = *(const GAS f32x4*)(rl + 8 + 8 * g);
            float el[8] = {a4.x, a4.y, a4.z, a4.w, b4.x, b4.y, b4.z, b4.w};
#pragma unroll
            for (int j = 0; j < 8; ++j) el[j] += brouter[8 * g + j];
            int i0 = 0; float v0 = el[0];
#pragma unroll
            for (int j = 1; j < 8; ++j) if (el[j] > v0) { v0 = el[j]; i0 = j; }
            int i1 = -1; float v1 = -3.0e38f;
#pragma unroll
            for (int j = 0; j < 8; ++j) if (j != i0 && el[j] > v1) { v1 = el[j]; i1 = j; }
            w0 = pg / (1.0f + __expf(v1 - v0)); w1 = pg - w0;
            e0 = 8 * g + i0; e1 = 8 * g + i1;
            r0 = __hip_atomic_fetch_add(&lcnt[e0], 1, __ATOMIC_RELAXED, __HIP_MEMORY_SCOPE_WORKGROUP); r1 = __hip_atomic_fetch_add(&lcnt[e1], 1, __ATOMIC_RELAXED, __HIP_MEMORY_SCOPE_WORKGROUP); }
        __syncthreads();
        if (tid < 32) lbase[tid] = (int)__hip_atomic_fetch_add(gcnt + tid, (unsigned)lcnt[tid], RLX_AGENT);
        __syncthreads();
        if (tid < 128) { const int t = base + tid;
            EP0[t] = ((unsigned)e0 << 24) | (unsigned)(lbase[e0] + r0); EP1[t] = ((unsigned)e1 << 24) | (unsigned)(lbase[e1] + r1); W0[t] = w0; W1[t] = w1; }
        __syncthreads();
    }
}
__device__ __forceinline__ void moe_build_table(LAS unsigned char* ldsbase, unsigned* gcnt) {
    LAS int* off = (LAS int*)(ldsbase + MOE_OFF_OFF); LAS unsigned char* texp = ldsbase + MOE_TEXP_OFF;
    __syncthreads();
    if (threadIdx.x == 0) { int acc = 0, ti = 0;
        for (int e = 0; e < NE; ++e) { const int c = (int)__hip_atomic_load(gcnt + e, RLX_AGENT); off[e] = acc; const int nt = (c + 255) >> 8;
            for (int k = 0; k < nt && ti < 288; ++k) texp[ti++] = (unsigned char)e;
            acc += nt * 256; }
        off[32] = acc; }
    __syncthreads();
}
__device__ __forceinline__ void moe_gather(LAS unsigned char* ldsbase, const bf16* HN, bf16* XS, const unsigned* EP0, const unsigned* EP1, unsigned* SL0, unsigned* SL1, int gw, int NGW, int lane) {
    const LAS int* off = (const LAS int*)(ldsbase + MOE_OFF_OFF);
    for (int t = gw; t < T; t += NGW) {
        const unsigned p0 = EP0[t], p1 = EP1[t];
        const unsigned s0 = (unsigned)off[p0 >> 24] + (p0 & 0xffffffu), s1 = (unsigned)off[p1 >> 24] + (p1 & 0xffffffu);
        const GAS v4u* src = (const GAS v4u*)(HN + (size_t)t * 2048) + lane; GAS v4u* d0 = (GAS v4u*)(XS + (size_t)s0 * 2048) + lane; GAS v4u* d1 = (GAS v4u*)(XS + (size_t)s1 * 2048) + lane;
        v4u v[4];
#pragma unroll
        for (int j = 0; j < 4; ++j) v[j] = src[64 * j];
#pragma unroll
        for (int j = 0; j < 4; ++j) { d0[64 * j] = v[j]; d1[64 * j] = v[j]; }
        if (lane == 0) { SL0[t] = s0; SL1[t] = s1; }
    }
}
__device__ __forceinline__ void moe_combine(float* out, const bf16* Y, const unsigned* SL0, const unsigned* SL1, const float* W0, const float* W1, bf16* HN, bool do_norm, int gw, int NGW, int lane) {
    for (int t = gw; t < T; t += NGW) {
        const unsigned s0 = SL0[t], s1 = SL1[t]; const float w0 = W0[t], w1 = W1[t];
        GAS f32x4* xr = (GAS f32x4*)(out + (size_t)t * D) + lane;
        const GAS v2u* y0 = (const GAS v2u*)(Y + (size_t)s0 * 2048) + lane; const GAS v2u* y1 = (const GAS v2u*)(Y + (size_t)s1 * 2048) + lane;
        f32x4 v[8]; float s = 0.f;
#pragma unroll
        for (int j = 0; j < 8; ++j) { const v2u a = y0[64 * j], b = y1[64 * j]; f32x4 x = xr[64 * j];
            x.x += w0 * bf_lo(a.x) + w1 * bf_lo(b.x); x.y += w0 * bf_hi(a.x) + w1 * bf_hi(b.x); x.z += w0 * bf_lo(a.y) + w1 * bf_lo(b.y); x.w += w0 * bf_hi(a.y) + w1 * bf_hi(b.y);
            v[j] = x; xr[64 * j] = x; s += (x.x * x.x + x.y * x.y) + (x.z * x.z + x.w * x.w); }
        if (do_norm) { const float rstd = rsqrtf(wave_sum(s) * (1.f / D) + RMS_EPS);
            GAS v2u* o8 = (GAS v2u*)(HN + (size_t)t * D) + lane;
#pragma unroll
            for (int j = 0; j < 8; ++j) { v2u o; o.x = pk2(v[j].x * rstd, v[j].y * rstd); o.y = pk2(v[j].z * rstd, v[j].w * rstd); o8[64 * j] = o; } }
    }
}

__device__ const unsigned char T5_BUCKET[128] = {0,1,2,3,4,5,6,7,8,9,10,11,12,13,14,15,16,16,16,17,17,18,18,18,19,19,19,20,20,20,20,21,21,21,21,22,22,22,22,22,23,23,23,23,23,23,24,24,24,24,24,24,25,25,25,25,25,25,25,26,26,26,26,26,26,26,26,27,27,27,27,27,27,27,27,27,27,28,28,28,28,28,28,28,28,28,28,29,29,29,29,29,29,29,29,29,29,29,29,30,30,30,30,30,30,30,30,30,30,30,30,30,30,31,31,31,31,31,31,31,31,31,31,31,31,31,31,31};
constexpr int AT_K = 0, AT_VT = 36864, AT_BIAS = 70656;
__device__ __forceinline__ void swa_attention(LAS unsigned char* lds, const bf16* KVQ, const float* knorm, const float* qnorm, const float* relb, const float* sinks, bf16* AO) {
    const int tid = threadIdx.x, lane = tid & 63, g = __builtin_amdgcn_readfirstlane(tid >> 6), li = lane & 15, q = lane >> 4;
    LAS bf16* KL = (LAS bf16*)(lds + AT_K); LAS bf16* VTL = (LAS bf16*)(lds + AT_VT); LAS float* BL = (LAS float*)(lds + AT_BIAS);
    float qn[2][8];
#pragma unroll
    for (int ks = 0; ks < 2; ++ks)
#pragma unroll
        for (int j = 0; j < 8; ++j) qn[ks][j] = qnorm[32 * ks + 8 * q + j] * 0.125f;
    for (int wi = blockIdx.x; wi < 1024; wi += gridDim.x) {
        const int hk = wi & 3, n = (wi >> 2) & 127, b = wi >> 9;
        __syncthreads();
        { const int key = tid >> 1, hf = tid & 1; const bool live = (n > 0) || (key >= 128);
          const size_t tk = (size_t)b * SEQ + (size_t)(n - 1) * 128 + key;
          const bf16* kp = KVQ + tk * KVQ_N + hk * 64 + 32 * hf;
          v4u kw[4], vw[4];
#pragma unroll
          for (int j = 0; j < 4; ++j) { kw[j] = live ? *(const GAS v4u*)(kp + 8 * j) : (v4u){0u, 0u, 0u, 0u}; vw[j] = live ? *(const GAS v4u*)(kp + 256 + 8 * j) : (v4u){0u, 0u, 0u, 0u}; }
          float ss = 0.f;
#pragma unroll
          for (int j = 0; j < 4; ++j) { const float a0 = bf_lo(kw[j].x), a1 = bf_hi(kw[j].x), a2 = bf_lo(kw[j].y), a3 = bf_hi(kw[j].y), a4 = bf_lo(kw[j].z), a5 = bf_hi(kw[j].z), a6 = bf_lo(kw[j].w), a7 = bf_hi(kw[j].w);
              ss += (a0 * a0 + a1 * a1) + (a2 * a2 + a3 * a3) + (a4 * a4 + a5 * a5) + (a6 * a6 + a7 * a7); }
          ss += __shfl_xor(ss, 1);
          const float rstd = rsqrtf(ss * (1.f / 64.f) + RMS_EPS);
#pragma unroll
          for (int j = 0; j < 4; ++j) { const float* kn = knorm + 32 * hf + 8 * j; v4u o;
              o.x = pk2(bf_lo(kw[j].x) * rstd * kn[0], bf_hi(kw[j].x) * rstd * kn[1]); o.y = pk2(bf_lo(kw[j].y) * rstd * kn[2], bf_hi(kw[j].y) * rstd * kn[3]);
              o.z = pk2(bf_lo(kw[j].z) * rstd * kn[4], bf_hi(kw[j].z) * rstd * kn[5]); o.w = pk2(bf_lo(kw[j].w) * rstd * kn[6], bf_hi(kw[j].w) * rstd * kn[7]);
              *(LAS v4u*)(KL + key * 72 + 32 * hf + 8 * j) = o; }
#pragma unroll
          for (int j = 0; j < 4; ++j) { const int d0 = 32 * hf + 8 * j;
              VTL[(d0 + 0) * 264 + key] = (bf16)(vw[j].x & 0xffffu); VTL[(d0 + 1) * 264 + key] = (bf16)(vw[j].x >> 16); VTL[(d0 + 2) * 264 + key] = (bf16)(vw[j].y & 0xffffu); VTL[(d0 + 3) * 264 + key] = (bf16)(vw[j].y >> 16);
              VTL[(d0 + 4) * 264 + key] = (bf16)(vw[j].z & 0xffffu); VTL[(d0 + 5) * 264 + key] = (bf16)(vw[j].z >> 16); VTL[(d0 + 6) * 264 + key] = (bf16)(vw[j].w & 0xffffu); VTL[(d0 + 7) * 264 + key] = (bf16)(vw[j].w >> 16); }
#pragma unroll
          for (int k = 0; k < 2; ++k) { const int e = tid + 512 * k, gg = e >> 7, dist = e & 127; BL[e] = relb[(int)T5_BUCKET[dist] * 32 + hk * 8 + gg]; }
        }
        __syncthreads();
        const int head = hk * 8 + g; const float sink = sinks[head];
        for (int mt = 0; mt < 8; ++mt) {
            const size_t tq = (size_t)b * SEQ + (size_t)n * 128 + 16 * mt + li;
            bf16x8 qf[2];
            { const bf16* qp = KVQ + tq * KVQ_N + 512 + head * 64 + 8 * q; const v4u q0 = *(const GAS v4u*)qp, q1 = *(const GAS v4u*)(qp + 32);
              float a[16] = {bf_lo(q0.x), bf_hi(q0.x), bf_lo(q0.y), bf_hi(q0.y), bf_lo(q0.z), bf_hi(q0.z), bf_lo(q0.w), bf_hi(q0.w), bf_lo(q1.x), bf_hi(q1.x), bf_lo(q1.y), bf_hi(q1.y), bf_lo(q1.z), bf_hi(q1.z), bf_lo(q1.w), bf_hi(q1.w)};
              float ss = 0.f;
#pragma unroll
              for (int j = 0; j < 16; ++j) ss += a[j] * a[j];
              ss += __shfl_xor(ss, 16); ss += __shfl_xor(ss, 32);
              const float rstd = rsqrtf(ss * (1.f / 64.f) + RMS_EPS);
              v4u w0, w1;
              w0.x = pk2(a[0] * rstd * qn[0][0], a[1] * rstd * qn[0][1]); w0.y = pk2(a[2] * rstd * qn[0][2], a[3] * rstd * qn[0][3]); w0.z = pk2(a[4] * rstd * qn[0][4], a[5] * rstd * qn[0][5]); w0.w = pk2(a[6] * rstd * qn[0][6], a[7] * rstd * qn[0][7]);
              w1.x = pk2(a[8] * rstd * qn[1][0], a[9] * rstd * qn[1][1]); w1.y = pk2(a[10] * rstd * qn[1][2], a[11] * rstd * qn[1][3]); w1.z = pk2(a[12] * rstd * qn[1][4], a[13] * rstd * qn[1][5]); w1.w = pk2(a[14] * rstd * qn[1][6], a[15] * rstd * qn[1][7]);
              qf[0] = __builtin_bit_cast(bf16x8, w0); qf[1] = __builtin_bit_cast(bf16x8, w1); }
            f32x4 st[9]; float mx = sink;
#pragma unroll
            for (int tt = 0; tt < 9; ++tt) { const int nt = mt + tt; f32x4 acc = {0.f, 0.f, 0.f, 0.f};
#pragma unroll
                for (int ks = 0; ks < 2; ++ks) { const bf16x8 a = *(const LAS bf16x8*)(KL + (16 * nt + li) * 72 + 32 * ks + 8 * q); acc = __builtin_amdgcn_mfma_f32_16x16x32_bf16(a, qf[ks], acc, 0, 0, 0); }
#pragma unroll
                for (int r = 0; r < 4; ++r) { const int col = 16 * nt + 4 * q + r, row = 16 * mt + li, dist = 128 + row - col;
                    const bool valid = (dist >= 0) && (dist < 128) && ((col >= 128) || (n > 0));
                    const float s = valid ? acc[r] + BL[g * 128 + (dist & 127)] : -__builtin_inff();
                    acc[r] = s; mx = fmaxf(mx, s); }
                st[tt] = acc; }
            mx = fmaxf(mx, __shfl_xor(mx, 16)); mx = fmaxf(mx, __shfl_xor(mx, 32));
            float lsum = 0.f;
#pragma unroll
            for (int tt = 0; tt < 9; ++tt)
#pragma unroll
                for (int r = 0; r < 4; ++r) { const float p = __expf(st[tt][r] - mx); st[tt][r] = p; lsum += p; }
            lsum += __shfl_xor(lsum, 16); lsum += __shfl_xor(lsum, 32);
            const float inv = 1.0f / (lsum + __expf(sink - mx));
            f32x4 oacc[4];
#pragma unroll
            for (int dt = 0; dt < 4; ++dt) oacc[dt] = (f32x4){0.f, 0.f, 0.f, 0.f};
#pragma unroll
            for (int s = 0; s < 5; ++s) {
                v4u pw; pw.x = pk2(st[2 * s][0], st[2 * s][1]); pw.y = pk2(st[2 * s][2], st[2 * s][3]);
                if (s < 4) { pw.z = pk2(st[2 * s + 1][0], st[2 * s + 1][1]); pw.w = pk2(st[2 * s + 1][2], st[2 * s + 1][3]); } else { pw.z = 0u; pw.w = 0u; }
                const bf16x8 pb = __builtin_bit_cast(bf16x8, pw);
                const int k0 = 16 * (mt + 2 * s) + 4 * q; int k1 = 16 * (mt + 2 * s + 1) + 4 * q; if (k1 > 252) k1 = 240 + 4 * q;
#pragma unroll
                for (int dt = 0; dt < 4; ++dt) { const v2u lo = *(const LAS v2u*)(VTL + (16 * dt + li) * 264 + k0), hi = *(const LAS v2u*)(VTL + (16 * dt + li) * 264 + k1);
                    v4u aw; aw.x = lo.x; aw.y = lo.y; aw.z = hi.x; aw.w = hi.y;
                    oacc[dt] = __builtin_amdgcn_mfma_f32_16x16x32_bf16(__builtin_bit_cast(bf16x8, aw), pb, oacc[dt], 0, 0, 0); } }
#pragma unroll
            for (int dt = 0; dt < 4; ++dt) { v2u o; o.x = pk2(oacc[dt][0] * inv, oacc[dt][1] * inv); o.y = pk2(oacc[dt][2] * inv, oacc[dt][3] * inv);
                *(GAS v2u*)(AO + tq * 2048 + head * 64 + 16 * dt + 4 * q) = o; }
        }
    }
}

struct Args { const float* in[24]; float* out; unsigned char* ws; int ph_lo, ph_hi; };
constexpr int N_PHASES = 23;
__global__ void __launch_bounds__(NWAVES * 64, 2) fwd(Args args) {
    extern __shared__ __attribute__((aligned(16))) unsigned char lds_raw[];
    LAS unsigned char* lds = (LAS unsigned char*)lds_raw;
    const int tid = threadIdx.x, lane = tid & 63, wave = __builtin_amdgcn_readfirstlane(tid >> 6);
    const int G = gridDim.x, gw = blockIdx.x * NWAVES + wave, NGW = G * NWAVES;
    unsigned char* ws = args.ws;
    gu32* ctl = (gu32*)(ws + WS_CTL);
    for (int u = tid; u < (LDS_BYTES - LDSCTL_OFF) / 4; u += NWAVES * 64) ((LAS unsigned*)(lds + LDSCTL_OFF))[u] = 0u;
    __syncthreads();
    XcdBarrier bar = xcd_barrier_post((unsigned*)(ctl + CW_BAR), (volatile LAS unsigned*)(lds + MISC_OFF));
    const int lo = args.ph_lo, hi = args.ph_hi;
#define IN(k) ((((MK_PHASE_MASK) >> (k)) & 1) && lo <= (k) && (k) < hi)
#define SEAM(k) do { if (IN(k) && IN((k) + 1)) xcd_barrier(bar); } while (0)

    const float* x = args.in[0]; float* out = args.out;
    bf16* W_GLA_IN = (bf16*)(ws + WS_W_GLA_IN); bf16* W_GLA_OUT = (bf16*)(ws + WS_W_GLA_OUT); bf16* W_KVQ = (bf16*)(ws + WS_W_KVQ); bf16* W_SWA_OUT = (bf16*)(ws + WS_W_SWA_OUT);
    bf16* W_ROUTER = (bf16*)(ws + WS_W_ROUTER); bf16* W_GU = (bf16*)(ws + WS_W_GU); bf16* W_DN = (bf16*)(ws + WS_W_DN);
    bf16* HN = (bf16*)(ws + WS_HN);
    unsigned* EP0 = (unsigned*)(ws + WS_TOK); unsigned* EP1 = EP0 + T; unsigned* SL0 = EP1 + T; unsigned* SL1 = SL0 + T; float* TW0 = (float*)(SL1 + T); float* TW1 = TW0 + T;
    float* RL = (float*)(ws + WS_RL);
    LAS float* scr = (LAS float*)(lds + RING_OFF + wave * 16384);

    if (IN(0)) {
        cvt_matrix(args.in[2], 2048, GLA_PROJ_N, args.in[1], W_GLA_IN, 0, scr, gw, NGW, lane);
        cvt_matrix(args.in[6], 2048, 2048, nullptr, W_GLA_OUT, 0, scr, gw, NGW, lane);
        cvt_matrix(args.in[8], 2048, 512, args.in[7], W_KVQ, 0, scr, gw, NGW, lane);
        cvt_matrix(args.in[12], 2048, 2048, args.in[11], W_KVQ, 512, scr, gw, NGW, lane);
        cvt_matrix(args.in[15], 2048, 2048, nullptr, W_SWA_OUT, 0, scr, gw, NGW, lane);
        for (int l = 0; l < 2; ++l) {
            cvt_matrix(args.in[17] + (size_t)l * 2048 * 4, 2048, 4, args.in[16] + l * 2048, W_ROUTER + (size_t)l * 256 * 2048, 0, scr, gw, NGW, lane);
            cvt_matrix(args.in[19] + (size_t)l * 2048 * 32, 2048, 32, args.in[16] + l * 2048, W_ROUTER + (size_t)l * 256 * 2048, 4, scr, gw, NGW, lane);
        }
        cvt_moe(args.in[21], args.in[22], args.in[23], args.in[16], W_GU, W_DN, scr, gw, NGW, lane);
        norm_rows(x, HN, gw, NGW, lane);
    }
    SEAM(0);
    if (IN(1)) {
        pg8::Gemm g{HN, W_GLA_IN, T, GLA_PROJ_NP, 2048}; pg8::StaticOrder S; S.init(T, GLA_PROJ_NP, G, (int)blockIdx.x);
        pg8::EpiGlaProj E{(bf16*)(ws + WS_QK), (bf16*)(ws + WS_V), (bf16*)(ws + WS_R), (bf16*)(ws + WS_GL)};
        pg8::gemm_phase<pg8::EpiGlaProj, pg8::StaticOrder, true, true>(lds + RING_OFF, g, S, E);
    }
    SEAM(1);
    if (IN(2)) gla_prepass(lds + RING_OFF, (const bf16*)(ws + WS_QK), (const bf16*)(ws + WS_V), (const bf16*)(ws + WS_GL), args.in[3], args.in[4],
                           (bf16*)(ws + WS_QEF), (bf16*)(ws + WS_KLTF), (bf16*)(ws + WS_ATTF), (bf16*)(ws + WS_VTF), (float*)(ws + WS_DEC));
    SEAM(2);
    if (IN(3)) gla_seq(lds + RING_OFF, (const bf16*)(ws + WS_QEF), (const bf16*)(ws + WS_KLTF), (const bf16*)(ws + WS_ATTF), (const bf16*)(ws + WS_VTF), (const float*)(ws + WS_DEC), (bf16*)(ws + WS_QK));
    SEAM(3);
    if (IN(4)) gla_gate((const bf16*)(ws + WS_QK), (const bf16*)(ws + WS_R), args.in[5], HN, gw, NGW, lane);
    SEAM(4);
    if (IN(5)) {
        pg8::Gemm g{HN, W_GLA_OUT, T, 2048, 2048}; pg8::StaticOrder S; S.init(T, 2048, G, (int)blockIdx.x);
        pg8::EpiResF32 E{out, x, 2048};
        pg8::gemm_phase<pg8::EpiResF32, pg8::StaticOrder, true, true>(lds + RING_OFF, g, S, E);
    }
    SEAM(5);

    { constexpr int layer = 0; constexpr int pb = 6 + 10 * layer;
    unsigned* gcnt = (unsigned*)(ctl + CW_CNT + layer * 64);
    if (IN(pb + 0)) norm_rows(out, HN, gw, NGW, lane);
    SEAM(pb + 0);
    if (IN(pb + 1)) {
        pg8::Gemm g{HN, W_ROUTER + (size_t)layer * 256 * 2048, T, 256, 2048}; pg8::StaticOrder S; S.init(T, 256, G, (int)blockIdx.x);
        pg8::EpiRouter E{RL};
        pg8::gemm_phase<pg8::EpiRouter, pg8::StaticOrder, true, true>(lds + RING_OFF, g, S, E);
    }
    SEAM(pb + 1);
    if (IN(pb + 2)) moe_route(lds + RING_OFF, RL, args.in[18] + layer * 4, args.in[20] + layer * 32, gcnt, EP0, EP1, TW0, TW1);
    SEAM(pb + 2);
    if (IN(pb + 3)) { moe_build_table(lds, gcnt); moe_gather(lds, HN, (bf16*)(ws + WS_XS), EP0, EP1, SL0, SL1, gw, NGW, lane); }
    SEAM(pb + 3);
    if (IN(pb + 4)) {
        moe_build_table(lds, gcnt);
        const int rows = __builtin_amdgcn_readfirstlane(((const LAS int*)(lds + MOE_OFF_OFF))[32]);
        pg8::Gemm g{(const bf16*)(ws + WS_XS), W_GU, rows, 1024, 2048};
        pg8::GroupedOrder S{(const LAS unsigned char*)(lds + MOE_TEXP_OFF), rows >> 8, 4, G, (int)blockIdx.x};
        pg8::EpiSwiGLU E{(bf16*)(ws + WS_ACT)};
        pg8::gemm_phase<pg8::EpiSwiGLU, pg8::GroupedOrder, true, true>(lds + RING_OFF, g, S, E);
    }
    SEAM(pb + 4);
    if (IN(pb + 5)) {
        moe_build_table(lds, gcnt);
        const int rows = __builtin_amdgcn_readfirstlane(((const LAS int*)(lds + MOE_OFF_OFF))[32]);
        pg8::Gemm g{(const bf16*)(ws + WS_ACT), W_DN, rows, 2048, 512};
        pg8::GroupedOrder S{(const LAS unsigned char*)(lds + MOE_TEXP_OFF), rows >> 8, 8, G, (int)blockIdx.x};
        pg8::EpiBf16 E{(bf16*)(ws + WS_Y), 2048};
        pg8::gemm_phase<pg8::EpiBf16, pg8::GroupedOrder, true, true>(lds + RING_OFF, g, S, E);
    }
    SEAM(pb + 5);
    if (IN(pb + 6)) {
        moe_combine(out, (const bf16*)(ws + WS_Y), SL0, SL1, TW0, TW1, HN, layer == 0, gw, NGW, lane);
        if (layer == 0) cvt_moe(args.in[21] + (size_t)NE * 2048 * 512, args.in[22] + (size_t)NE * 2048 * 512, args.in[23] + (size_t)NE * 512 * 2048, args.in[16] + 2048, W_GU, W_DN, scr, gw, NGW, lane);
    }
    if (layer == 0) SEAM(pb + 6);
    }
    if (IN(13)) {
        pg8::Gemm g{HN, W_KVQ, T, KVQ_N, 2048}; pg8::StaticOrder S; S.init(T, KVQ_N, G, (int)blockIdx.x);
        pg8::EpiBf16 E{(bf16*)(ws + WS_KVQ), KVQ_N};
        pg8::gemm_phase<pg8::EpiBf16, pg8::StaticOrder, true, true>(lds + RING_OFF, g, S, E);
    }
    SEAM(13);
    if (IN(14)) swa_attention(lds + RING_OFF, (const bf16*)(ws + WS_KVQ), args.in[9], args.in[13], args.in[10], args.in[14], (bf16*)(ws + WS_AO));
    SEAM(14);
    if (IN(15)) {
        pg8::Gemm g{(const bf16*)(ws + WS_AO), W_SWA_OUT, T, 2048, 2048}; pg8::StaticOrder S; S.init(T, 2048, G, (int)blockIdx.x);
        pg8::EpiResF32 E{out, out, 2048};
        pg8::gemm_phase<pg8::EpiResF32, pg8::StaticOrder, true, true>(lds + RING_OFF, g, S, E);
    }
    SEAM(15);
    { constexpr int layer = 1; constexpr int pb = 6 + 10 * layer;
    unsigned* gcnt = (unsigned*)(ctl + CW_CNT + layer * 64);
    if (IN(pb + 0)) norm_rows(out, HN, gw, NGW, lane);
    SEAM(pb + 0);
    if (IN(pb + 1)) {
        pg8::Gemm g{HN, W_ROUTER + (size_t)layer * 256 * 2048, T, 256, 2048}; pg8::StaticOrder S; S.init(T, 256, G, (int)blockIdx.x);
        pg8::EpiRouter E{RL};
        pg8::gemm_phase<pg8::EpiRouter, pg8::StaticOrder, true, true>(lds + RING_OFF, g, S, E);
    }
    SEAM(pb + 1);
    if (IN(pb + 2)) moe_route(lds + RING_OFF, RL, args.in[18] + layer * 4, args.in[20] + layer * 32, gcnt, EP0, EP1, TW0, TW1);
    SEAM(pb + 2);
    if (IN(pb + 3)) { moe_build_table(lds, gcnt); moe_gather(lds, HN, (bf16*)(ws + WS_XS), EP0, EP1, SL0, SL1, gw, NGW, lane); }
    SEAM(pb + 3);
    if (IN(pb + 4)) {
        moe_build_table(lds, gcnt);
        const int rows = __builtin_amdgcn_readfirstlane(((const LAS int*)(lds + MOE_OFF_OFF))[32]);
        pg8::Gemm g{(const bf16*)(ws + WS_XS), W_GU, rows, 1024, 2048};
        pg8::GroupedOrder S{(const LAS unsigned char*)(lds + MOE_TEXP_OFF), rows >> 8, 4, G, (int)blockIdx.x};
        pg8::EpiSwiGLU E{(bf16*)(ws + WS_ACT)};
        pg8::gemm_phase<pg8::EpiSwiGLU, pg8::GroupedOrder, true, true>(lds + RING_OFF, g, S, E);
    }
    SEAM(pb + 4);
    if (IN(pb + 5)) {
        moe_build_table(lds, gcnt);
        const int rows = __builtin_amdgcn_readfirstlane(((const LAS int*)(lds + MOE_OFF_OFF))[32]);
        pg8::Gemm g{(const bf16*)(ws + WS_ACT), W_DN, rows, 2048, 512};
        pg8::GroupedOrder S{(const LAS unsigned char*)(lds + MOE_TEXP_OFF), rows >> 8, 8, G, (int)blockIdx.x};
        pg8::EpiBf16 E{(bf16*)(ws + WS_Y), 2048};
        pg8::gemm_phase<pg8::EpiBf16, pg8::GroupedOrder, true, true>(lds + RING_OFF, g, S, E);
    }
    SEAM(pb + 5);
    if (IN(pb + 6)) {
        moe_combine(out, (const bf16*)(ws + WS_Y), SL0, SL1, TW0, TW1, HN, layer == 0, gw, NGW, lane);
        if (layer == 0) cvt_moe(args.in[21] + (size_t)NE * 2048 * 512, args.in[22] + (size_t)NE * 2048 * 512, args.in[23] + (size_t)NE * 512 * 2048, args.in[16] + 2048, W_GU, W_DN, scr, gw, NGW, lane);
    }
    if (layer == 0) SEAM(pb + 6);
    }
#undef IN
#undef SEAM
}

extern "C" void kernel_launch(void* const* d_in, const int* in_sizes, int n_in, void* d_out, int out_size, void* d_ws, size_t ws_size, hipStream_t stream) {
    static int grid = 0;
    if (grid == 0) {
        if (n_in != 24 || in_sizes[0] != T * D || out_size != T * D || ws_size < WS_END) { fprintf(stderr, "kernel_launch: unexpected shapes / workspace (n_in %d, in0 %d, out %d, ws %zu < %zu)\n", n_in, n_in > 0 ? in_sizes[0] : -1, out_size, ws_size, (size_t)WS_END); grid = -1; return; }
        int dev = 0, cus = 0, per_cu = 0;
        if (hipGetDevice(&dev) != hipSuccess || hipDeviceGetAttribute(&cus, hipDeviceAttributeMultiprocessorCount, dev) != hipSuccess) { grid = -1; return; }
        if (hipFuncSetAttribute((const void*)fwd, hipFuncAttributeMaxDynamicSharedMemorySize, LDS_BYTES) != hipSuccess) { fprintf(stderr, "kernel_launch: hipFuncSetAttribute failed\n"); grid = -1; return; }
        if (hipOccupancyMaxActiveBlocksPerMultiprocessor(&per_cu, (const void*)fwd, NWAVES * 64, LDS_BYTES) != hipSuccess || per_cu < 1) { fprintf(stderr, "kernel_launch: occupancy query says %d\n", per_cu); }
        (void)hipGetLastError();
        grid = cus;
    }
    if (grid < 0) return;
    if (hipMemsetAsync((char*)d_ws + WS_CTL, 0, CTL_ZERO_BYTES, stream) != hipSuccess) return;
    Args a{};
    for (int i = 0; i < 24; ++i) a.in[i] = (const float*)d_in[i];
    a.out = (float*)d_out; a.ws = (unsigned char*)d_ws;
#if MK_PER_PHASE
    for (int p = 0; p < MK_LAST_PHASE; ++p) { a.ph_lo = p; a.ph_hi = p + 1; hipLaunchKernelGGL(fwd, dim3(grid), dim3(NWAVES * 64), LDS_BYTES, stream, a); }
#else
    a.ph_lo = 0; a.ph_hi = MK_LAST_PHASE;
    hipLaunchKernelGGL(fwd, dim3(grid), dim3(NWAVES * 64), LDS_BYTES, stream, a);
#endif
    const hipError_t le = hipPeekAtLastError();
    if (le != hipSuccess) fprintf(stderr, "kernel_launch: launch failed: %s\n", hipGetErrorName(le));
}
```

```cpp
#include <hip/hip_runtime.h>
#include <cstdio>
#include <cstdint>

#ifndef MK_PER_PHASE
#define MK_PER_PHASE 0
#endif
#ifndef MK_LAST_PHASE
#define MK_LAST_PHASE 23
#endif

#ifndef MK_PHASE_MASK
#define MK_PHASE_MASK 0x7fffff
#endif

#ifndef MK_DELAY_MASK
#define MK_DELAY_MASK 0
#endif

namespace pg8 {
#define PG8_LAS __attribute__((address_space(3)))
typedef unsigned short bf16_t;
typedef short bf16x8 __attribute__((ext_vector_type(8)));
typedef float f32x4 __attribute__((ext_vector_type(4)));
typedef unsigned u32x4 __attribute__((ext_vector_type(4)));
constexpr int BM = 256, BK = 64, HALF = 128, HTB = HALF * BK * 2  , STAGE_BYTES = 8 * HTB, NXCD = 8, WGM = 8;

__host__ __device__ __forceinline__ int lds_byte(int r, int c) { const int st = (r >> 4) * 2 + (c >> 5), rr = r & 15, cc = c & 31, ob = rr * 64 + cc * 2; return st * 1024 + (ob ^ (((ob >> 9) & 1) << 5)); }
__host__ __device__ __forceinline__ void stage_rc(int b, int& R, int& C) { const int st = b / 1024, sb = b % 1024, swz = sb ^ (((sb >> 9) & 1) << 5); R = (st >> 1) * 16 + swz / 64; C = (st & 1) * 32 + (swz % 64) / 2; }
__host__ __device__ __forceinline__ int perm32(int rho) { const int n = rho >> 4, i = rho & 15; return 8 * (i >> 2) + 4 * n + (i & 3); }

struct Unit { int pm, pn, pc; };
struct Gemm { const bf16_t* A; const bf16_t* Bt; int M, N, K; };


struct StaticOrder {
    int nM, nN, nwg, G, c;
    __host__ __device__ void init(int M, int N, int G_, int c_) { nM = M / BM; nN = N / BM; nwg = nM * nN; G = G_; c = c_; }
    __host__ __device__ bool next(int i, Unit& u) const {
        const long L = (long)i * G + c; if (L >= nwg) return false;
        int wgid = (int)L; { const int q = nwg / NXCD, r = nwg % NXCD, xcd = wgid % NXCD, off = wgid / NXCD; wgid = (xcd < r ? xcd * (q + 1) : r * (q + 1) + (xcd - r) * q) + off; }
        const int nig = WGM * nN, gid = wgid / nig, fm = gid * WGM, gsz = (nM - fm) < WGM ? (nM - fm) : WGM;
        u.pm = fm + ((wgid % nig) % gsz); u.pn = (wgid % nig) / gsz; u.pc = u.pn; return true;
    }
    __device__ __forceinline__ void a_ready(const Unit&) const {}
    __device__ __forceinline__ void done(const Unit&) const {}
};
struct GroupedOrder {
    const PG8_LAS unsigned char* texp; int MT, npn, G, c;
    __device__ __forceinline__ bool next(int i, Unit& u) const {
        const long L = (long)i * G + c; if (L >= (long)MT * npn) return false;
        const int pm = (int)(L / npn), pc = (int)(L % npn);
        const int e = __builtin_amdgcn_readfirstlane((int)texp[pm]);
        u.pm = pm; u.pn = e * npn + pc; u.pc = pc; return true;
    }
    __device__ __forceinline__ void a_ready(const Unit&) const {}
    __device__ __forceinline__ void done(const Unit&) const {}
};

__device__ __forceinline__ unsigned cvt_pk_bf16(float lo, float hi) { unsigned r; asm volatile("v_cvt_pk_bf16_f32 %0, %1, %2" : "=v"(r) : "v"(lo), "v"(hi)); return r; }

struct EpiBf16 {
    static constexpr bool PERM = true, AFTER_DRAIN = false;
    bf16_t* O; int ldc;
    __device__ __forceinline__ void operator()(const f32x4 (&acc)[2][2][4][2], const Unit& u, int wr, int wc, int fr, int fq) const {
        const int row0 = u.pm * BM + wr * 64 + fr, col0 = u.pc * BM + wc * 32 + 8 * fq;
#pragma unroll
        for (int ai = 0; ai < 2; ++ai)
#pragma unroll
            for (int m = 0; m < 4; ++m) { bf16_t* rowp = O + (size_t)(row0 + ai * HALF + m * 16) * ldc + col0;
#pragma unroll
                for (int bj = 0; bj < 2; ++bj) { const f32x4 v0 = acc[ai][bj][m][0], v1 = acc[ai][bj][m][1];
                    u32x4 w; w.x = cvt_pk_bf16(v0[0], v0[1]); w.y = cvt_pk_bf16(v0[2], v0[3]); w.z = cvt_pk_bf16(v1[0], v1[1]); w.w = cvt_pk_bf16(v1[2], v1[3]);
                    *(u32x4*)(rowp + bj * HALF) = w; } }
    }
};
struct EpiGlaProj {
    static constexpr bool PERM = true, AFTER_DRAIN = false;
    bf16_t *QK, *V, *R, *GL;
    __device__ __forceinline__ void operator()(const f32x4 (&acc)[2][2][4][2], const Unit& u, int wr, int wc, int fr, int fq) const {
        bf16_t* base; int ldc, ct;
        if (u.pc < 8) { base = QK; ldc = 2048; ct = u.pc; } else if (u.pc < 16) { base = V; ldc = 2048; ct = u.pc - 8; } else if (u.pc < 24) { base = R; ldc = 2048; ct = u.pc - 16; } else { base = GL; ldc = 256; ct = 0; }
        const int row0 = u.pm * BM + wr * 64 + fr, col0 = ct * BM + wc * 32 + 8 * fq;
#pragma unroll
        for (int ai = 0; ai < 2; ++ai)
#pragma unroll
            for (int m = 0; m < 4; ++m) { bf16_t* rowp = base + (size_t)(row0 + ai * HALF + m * 16) * ldc + col0;
#pragma unroll
                for (int bj = 0; bj < 2; ++bj) { const f32x4 v0 = acc[ai][bj][m][0], v1 = acc[ai][bj][m][1];
                    u32x4 w; w.x = cvt_pk_bf16(v0[0], v0[1]); w.y = cvt_pk_bf16(v0[2], v0[3]); w.z = cvt_pk_bf16(v1[0], v1[1]); w.w = cvt_pk_bf16(v1[2], v1[3]);
                    *(u32x4*)(rowp + bj * HALF) = w; } }
    }
};
struct EpiResF32 {
    static constexpr bool PERM = false, AFTER_DRAIN = false;
    float* C; const float* RES; int ldc;
    __device__ __forceinline__ void operator()(const f32x4 (&acc)[2][2][4][2], const Unit& u, int wr, int wc, int fr, int fq) const {
        const int row0 = u.pm * BM + wr * 64 + fr, col0 = u.pc * BM + wc * 32 + 4 * fq;
#pragma unroll
        for (int ai = 0; ai < 2; ++ai)
#pragma unroll
            for (int m = 0; m < 4; ++m) { const size_t off = (size_t)(row0 + ai * HALF + m * 16) * ldc + col0;
                f32x4 rv[2][2];
#pragma unroll
                for (int bj = 0; bj < 2; ++bj)
#pragma unroll
                    for (int n = 0; n < 2; ++n) rv[bj][n] = *(const f32x4*)(RES + off + bj * HALF + n * 16);
#pragma unroll
                for (int bj = 0; bj < 2; ++bj)
#pragma unroll
                    for (int n = 0; n < 2; ++n) *(f32x4*)(C + off + bj * HALF + n * 16) = acc[ai][bj][m][n] + rv[bj][n]; }
    }
};
struct EpiRouter {
    static constexpr bool PERM = false, AFTER_DRAIN = false;
    float* RL;
    __device__ __forceinline__ void operator()(const f32x4 (&acc)[2][2][4][2], const Unit& u, int wr, int wc, int fr, int fq) const {
        if (wc >= 2) return;
        const int row0 = u.pm * BM + wr * 64 + fr, col0 = wc * 32 + 4 * fq;
#pragma unroll
        for (int ai = 0; ai < 2; ++ai)
#pragma unroll
            for (int m = 0; m < 4; ++m) { float* rowp = RL + (size_t)(row0 + ai * HALF + m * 16) * 64 + col0;
#pragma unroll
                for (int n = 0; n < 2; ++n) *(f32x4*)(rowp + n * 16) = acc[ai][0][m][n]; }
    }
};
__device__ __forceinline__ float silu_f(float x) { return x * __builtin_amdgcn_rcpf(1.0f + __expf(-x)); }
struct EpiSwiGLU {
    static constexpr bool PERM = true, AFTER_DRAIN = false;
    bf16_t* ACT;
    __device__ __forceinline__ void operator()(const f32x4 (&acc)[2][2][4][2], const Unit& u, int wr, int wc, int fr, int fq) const {
        const int row0 = u.pm * BM + wr * 64 + fr, col0 = u.pc * HALF + wc * 32 + 8 * fq;
#pragma unroll
        for (int ai = 0; ai < 2; ++ai)
#pragma unroll
            for (int m = 0; m < 4; ++m) { bf16_t* rowp = ACT + (size_t)(row0 + ai * HALF + m * 16) * 512 + col0;
                const f32x4 g0 = acc[ai][0][m][0], g1 = acc[ai][0][m][1], u0 = acc[ai][1][m][0], u1 = acc[ai][1][m][1];
                u32x4 w;
                w.x = cvt_pk_bf16(silu_f(g0[0]) * u0[0], silu_f(g0[1]) * u0[1]); w.y = cvt_pk_bf16(silu_f(g0[2]) * u0[2], silu_f(g0[3]) * u0[3]);
                w.z = cvt_pk_bf16(silu_f(g1[0]) * u1[0], silu_f(g1[1]) * u1[1]); w.w = cvt_pk_bf16(silu_f(g1[2]) * u1[2], silu_f(g1[3]) * u1[3]);
                *(u32x4*)rowp = w; }
    }
};

template <class Epi, class Sched, bool ALIGN_EPI = false, bool SP2 = false>
__device__ __forceinline__ void gemm_phase(PG8_LAS unsigned char* lds, const Gemm g, const Sched& S, const Epi& E) {
    const int tid = threadIdx.x, wid = __builtin_amdgcn_readfirstlane(tid >> 6), lane = tid & 63, wr = wid >> 2, wc = wid & 3, fr = lane & 15, fq = lane >> 4;
    const int K = g.K, nt = K / BK;
    unsigned voffA[2], voffB[2];
#pragma unroll
    for (int i = 0; i < 2; ++i) { int R, C; stage_rc(tid * 16 + i * 8192, R, C); const int Rb = Epi::PERM ? ((R & ~31) + perm32(R & 31)) : R;
        voffA[i] = (unsigned)(R * K + C) * 2u; voffB[i] = (unsigned)(Rb * K + C) * 2u; }
    const size_t kstep = (size_t)(BK * 2);
    const size_t hstep = (size_t)HALF * K * 2;
    const size_t tstep = 2 * hstep;
    const unsigned ldsw = (unsigned)wid * 1024u;
    const int aoff = lds_byte(wr * 64 + fr, fq * 8), boff = lds_byte(wc * 32 + fr, fq * 8);
#define PG8_SA(b, h) (((b) * 2 + (h)) * HTB)
#define PG8_SB(b, h) ((4 + (b) * 2 + (h)) * HTB)
#define PG8_STAGE(bufoff, gbase, voff) do { _Pragma("unroll") for (int _i = 0; _i < 2; ++_i) \
        __builtin_amdgcn_global_load_lds((const unsigned*)((const char*)(gbase) + (voff)[_i]), (PG8_LAS unsigned*)(lds + (bufoff) + ldsw + _i * 8192), 16, 0, 0); } while (0)
#define PG8_LDA(dst, b, h) do { _Pragma("unroll") for (int m = 0; m < 4; ++m) _Pragma("unroll") for (int k = 0; k < 2; ++k) dst[m][k] = *(const PG8_LAS bf16x8*)(lds + PG8_SA(b, h) + aoff + m * 2048 + k * 1024); } while (0)
#define PG8_LDB(dst, b, h) do { _Pragma("unroll") for (int n = 0; n < 2; ++n) _Pragma("unroll") for (int k = 0; k < 2; ++k) dst[n][k] = *(const PG8_LAS bf16x8*)(lds + PG8_SB(b, h) + boff + n * 2048 + k * 1024); } while (0)
#define PG8_MMA(ai, bj, At, Bt) do { __builtin_amdgcn_s_setprio(1); _Pragma("unroll") for (int m = 0; m < 4; ++m) _Pragma("unroll") for (int n = 0; n < 2; ++n) _Pragma("unroll") for (int k = 0; k < 2; ++k) \
        acc[ai][bj][m][n] = __builtin_amdgcn_mfma_f32_16x16x32_bf16(Bt[n][k], At[m][k], acc[ai][bj][m][n], 0, 0, 0); __builtin_amdgcn_s_setprio(0); } while (0)
#define PG8_WAIT_V(n) asm volatile("s_waitcnt vmcnt(" #n ")" ::: "memory")
#define PG8_WAIT_L(n) asm volatile("s_waitcnt lgkmcnt(" #n ")" ::: "memory")
#define PG8_BAR __builtin_amdgcn_s_barrier()
#define PG8_SCHED __builtin_amdgcn_sched_barrier(0)
    Unit cur, nxt; int ui = 0;
    if (!S.next(0, cur)) return;
    f32x4 acc[2][2][4][2];
#pragma unroll
    for (int a = 0; a < 2; ++a)
#pragma unroll
        for (int b = 0; b < 2; ++b)
#pragma unroll
            for (int m = 0; m < 4; ++m)
#pragma unroll
                for (int n = 0; n < 2; ++n) acc[a][b][m][n] = (f32x4){0.f, 0.f, 0.f, 0.f};
    bf16x8 At[4][2], B0[2][2], B1[2][2];
    const char* cA = (const char*)g.A + (size_t)cur.pm * tstep; const char* cB = (const char*)g.Bt + (size_t)cur.pn * tstep;
    S.a_ready(cur);
    if constexpr (SP2) {
        PG8_STAGE(PG8_SB(0, 0), cB, voffB); PG8_STAGE(PG8_SB(0, 1), cB + hstep, voffB); PG8_STAGE(PG8_SA(0, 0), cA, voffA); PG8_STAGE(PG8_SA(0, 1), cA + hstep, voffA);
        if (wr == 1) PG8_BAR;
        PG8_WAIT_V(2); PG8_BAR;
        PG8_STAGE(PG8_SB(1, 0), cB + kstep, voffB); PG8_STAGE(PG8_SA(1, 0), cA + kstep, voffA); PG8_STAGE(PG8_SB(1, 1), cB + hstep + kstep, voffB);
        PG8_WAIT_V(6); PG8_BAR;
    } else {
        PG8_STAGE(PG8_SB(0, 0), cB, voffB); PG8_STAGE(PG8_SA(0, 0), cA, voffA); PG8_STAGE(PG8_SB(0, 1), cB + hstep, voffB); PG8_STAGE(PG8_SA(0, 1), cA + hstep, voffA);
        if (wr == 1) PG8_BAR;
        PG8_WAIT_V(4); PG8_BAR;
        PG8_STAGE(PG8_SB(1, 0), cB + kstep, voffB); PG8_STAGE(PG8_SA(1, 0), cA + kstep, voffA); PG8_STAGE(PG8_SB(1, 1), cB + hstep + kstep, voffB);
        PG8_WAIT_V(6); PG8_BAR;
    }
    for (;;) {
        const bool has_next = S.next(ui + 1, nxt);
        const char* nA = has_next ? (const char*)g.A + (size_t)nxt.pm * tstep : cA; const char* nB = has_next ? (const char*)g.Bt + (size_t)nxt.pn * tstep : cB;
        for (int t = 0; t < nt; t += 2) {
            const bool last = (t == nt - 2);
            const char* a1 = cA + (size_t)(t + 1) * kstep;
            const char* a2 = last ? nA : cA + (size_t)(t + 2) * kstep; const char* b2 = last ? nB : cB + (size_t)(t + 2) * kstep;
            const char* a3 = a2 + kstep; const char* b3 = b2 + kstep;
            if (last && has_next) S.a_ready(nxt);
            if constexpr (SP2) {
            PG8_LDB(B0, 0, 0); PG8_LDB(B1, 0, 1); PG8_SCHED; PG8_LDA(At, 0, 0); PG8_STAGE(PG8_SA(1, 1), a1 + hstep, voffA);
            PG8_WAIT_V(8); PG8_WAIT_L(0); PG8_BAR; PG8_MMA(0, 0, At, B0); PG8_MMA(0, 1, At, B1); PG8_BAR; PG8_SCHED;
            PG8_LDA(At, 0, 1); PG8_STAGE(PG8_SB(0, 0), b2, voffB); PG8_STAGE(PG8_SB(0, 1), b2 + hstep, voffB); PG8_STAGE(PG8_SA(0, 0), a2, voffA);
            PG8_WAIT_V(8); PG8_WAIT_L(0); PG8_BAR; PG8_MMA(1, 0, At, B0); PG8_MMA(1, 1, At, B1); PG8_BAR; PG8_SCHED;
            PG8_LDB(B0, 1, 0); PG8_LDB(B1, 1, 1); PG8_SCHED; PG8_LDA(At, 1, 0); PG8_STAGE(PG8_SA(0, 1), a2 + hstep, voffA);
            PG8_WAIT_V(8); PG8_WAIT_L(0); PG8_BAR; PG8_MMA(0, 0, At, B0); PG8_MMA(0, 1, At, B1); PG8_BAR; PG8_SCHED;
            PG8_LDA(At, 1, 1); PG8_STAGE(PG8_SB(1, 0), b3, voffB); PG8_STAGE(PG8_SB(1, 1), b3 + hstep, voffB); PG8_STAGE(PG8_SA(1, 0), a3, voffA);
            PG8_WAIT_V(8); PG8_WAIT_L(0); PG8_BAR; PG8_MMA(1, 0, At, B0); PG8_MMA(1, 1, At, B1); PG8_BAR; PG8_SCHED;
            } else {
            PG8_LDB(B0, 0, 0); PG8_SCHED; PG8_LDA(At, 0, 0); PG8_STAGE(PG8_SA(1, 1), a1 + hstep, voffA);
            PG8_WAIT_L(8); PG8_BAR; PG8_WAIT_L(0); PG8_MMA(0, 0, At, B0); PG8_BAR; PG8_SCHED;
            PG8_LDB(B1, 0, 1); PG8_STAGE(PG8_SB(0, 0), b2, voffB);
            PG8_BAR; PG8_WAIT_L(0); PG8_MMA(0, 1, At, B1); PG8_BAR;
            PG8_LDA(At, 0, 1); PG8_STAGE(PG8_SA(0, 0), a2, voffA);
            PG8_BAR; PG8_WAIT_L(0); PG8_MMA(1, 0, At, B0); PG8_BAR; PG8_SCHED;
            PG8_STAGE(PG8_SB(0, 1), b2 + hstep, voffB);
            PG8_WAIT_V(6); PG8_BAR; PG8_MMA(1, 1, At, B1); PG8_BAR;
            PG8_LDB(B0, 1, 0); PG8_SCHED; PG8_LDA(At, 1, 0); PG8_STAGE(PG8_SA(0, 1), a2 + hstep, voffA);
            PG8_WAIT_L(8); PG8_BAR; PG8_WAIT_L(0); PG8_MMA(0, 0, At, B0); PG8_BAR; PG8_SCHED;
            PG8_LDB(B1, 1, 1); PG8_STAGE(PG8_SB(1, 0), b3, voffB);
            PG8_BAR; PG8_WAIT_L(0); PG8_MMA(0, 1, At, B1); PG8_BAR;
            PG8_LDA(At, 1, 1); PG8_STAGE(PG8_SA(1, 0), a3, voffA);
            PG8_BAR; PG8_WAIT_L(0); PG8_MMA(1, 0, At, B0); PG8_BAR; PG8_SCHED;
            PG8_STAGE(PG8_SB(1, 1), b3 + hstep, voffB);
            PG8_WAIT_V(6); PG8_BAR; PG8_MMA(1, 1, At, B1); PG8_BAR;
            }
        }
        if constexpr (ALIGN_EPI) { if (wr == 0) PG8_BAR; }
        if constexpr (!Epi::AFTER_DRAIN) { E(acc, cur, wr, wc, fr, fq); S.done(cur); }
        if (!has_next) break;
#pragma unroll
        for (int a = 0; a < 2; ++a)
#pragma unroll
            for (int b = 0; b < 2; ++b)
#pragma unroll
                for (int m = 0; m < 4; ++m)
#pragma unroll
                    for (int n = 0; n < 2; ++n) acc[a][b][m][n] = (f32x4){0.f, 0.f, 0.f, 0.f};
        cur = nxt; cA = nA; cB = nB; ++ui;
        if constexpr (ALIGN_EPI) { if (wr == 1) PG8_BAR; }
    }
    PG8_WAIT_V(0);
    if constexpr (!ALIGN_EPI) { if (wr == 0) PG8_BAR; }
    PG8_BAR;
    if constexpr (Epi::AFTER_DRAIN) { E.fused(acc, cur, wr, wc, fr, fq, lds, wid, lane); S.done(cur); }
#undef PG8_SA
#undef PG8_SB
#undef PG8_STAGE
#undef PG8_LDA
#undef PG8_LDB
#undef PG8_MMA
#undef PG8_WAIT_V
#undef PG8_WAIT_L
#undef PG8_BAR
#undef PG8_SCHED
}
}

constexpr int NWAVES = 8;
constexpr int T = 32768, D = 2048, SEQ = 16384;
constexpr float RMS_EPS = 1e-6f;
constexpr int GLA_H = 4, GLA_DK = 256, GLA_DV = 512, GLA_C = 64, GLA_NCH = SEQ / GLA_C  , GLA_PROJ_N = 6160, GLA_PROJ_NP = 6400;
constexpr int NITEM_GLA = 2 * GLA_H * GLA_NCH;
constexpr int SWA_HQ = 32, SWA_HKV = 4, SWA_HD = 64, SWA_W = 128, KVQ_N = 2560;
constexpr int NE = 32, FF = 512, MOE_MAXROWS = 2 * T + NE * 256;

constexpr size_t MiB = 1u << 20;
constexpr size_t WS_CTL = 0, CTL_ZERO_BYTES = 1 * MiB;
constexpr size_t WS_W_GLA_IN = 1 * MiB;
constexpr size_t WS_W_GLA_OUT = 26 * MiB;
constexpr size_t WS_W_KVQ = 34 * MiB;
constexpr size_t WS_W_SWA_OUT = 44 * MiB;
constexpr size_t WS_W_ROUTER = 52 * MiB;
constexpr size_t WS_TOK = 54 * MiB;
constexpr size_t WS_RL = 56 * MiB;
constexpr size_t WS_W_GU = 64 * MiB;
constexpr size_t WS_W_DN = 192 * MiB;
constexpr size_t WS_HN = 256 * MiB;
constexpr size_t WS_BIG = 384 * MiB;
constexpr size_t WS_QK = WS_BIG;
constexpr size_t WS_V = WS_BIG + 128 * MiB;
constexpr size_t WS_R = WS_BIG + 256 * MiB;
constexpr size_t WS_GL = WS_BIG + 384 * MiB;
constexpr size_t WS_QEF = WS_BIG + 400 * MiB;
constexpr size_t WS_KLTF = WS_BIG + 464 * MiB;
constexpr size_t WS_ATTF = WS_BIG + 528 * MiB;
constexpr size_t WS_VTF = WS_BIG + 544 * MiB;
constexpr size_t WS_DEC = WS_BIG + 672 * MiB;
constexpr size_t WS_GLA_END = WS_BIG + 674 * MiB;
constexpr size_t WS_XS = WS_BIG;
constexpr size_t WS_ACT = WS_BIG + 288 * MiB;
constexpr size_t WS_Y = WS_BIG + 360 * MiB;
constexpr size_t WS_KVQ = WS_BIG;
constexpr size_t WS_AO = WS_BIG + 160 * MiB;
constexpr size_t WS_END = WS_GLA_END;
static_assert(WS_Y + (size_t)MOE_MAXROWS * 2048 * 2 <= WS_END && WS_ACT + (size_t)MOE_MAXROWS * 512 * 2 <= WS_Y, "MoE map");
constexpr int CW_BAR = 4096;
constexpr int CW_CNT = 16384;

constexpr int RING_OFF = 0, RING_BYTES = 131072;
constexpr int LDSCTL_OFF = RING_BYTES;
constexpr int MISC_OFF = LDSCTL_OFF + 64;
constexpr int MOE_OFF_OFF = LDSCTL_OFF + 256;
constexpr int MOE_TEXP_OFF = LDSCTL_OFF + 512;
constexpr int LDS_BYTES = 147456;

#define GAS __attribute__((address_space(1)))
#define LAS __attribute__((address_space(3)))
typedef unsigned short bf16;
typedef unsigned v4u __attribute__((ext_vector_type(4)));
typedef unsigned v2u __attribute__((ext_vector_type(2)));
typedef float f32x4 __attribute__((ext_vector_type(4)));
typedef short bf16x8 __attribute__((ext_vector_type(8)));
typedef GAS unsigned gu32;
#define RLX_AGENT __ATOMIC_RELAXED, __HIP_MEMORY_SCOPE_AGENT
#define LDS_WAIT() asm volatile("s_waitcnt lgkmcnt(0)" ::: "memory")
#define VM_WAIT() asm volatile("s_waitcnt vmcnt(0)" ::: "memory")
__device__ __forceinline__ unsigned f2bf(float f) { unsigned u = __builtin_bit_cast(unsigned, f); return (u + 0x7fffu + ((u >> 16) & 1u)) >> 16; }
__device__ __forceinline__ unsigned pk2(float lo, float hi) { return pg8::cvt_pk_bf16(lo, hi); }
__device__ __forceinline__ float bf_lo(unsigned w) { return __builtin_bit_cast(float, w << 16); }
__device__ __forceinline__ float bf_hi(unsigned w) { return __builtin_bit_cast(float, w & 0xffff0000u); }
__device__ __forceinline__ float bf2f(bf16 b) { return __builtin_bit_cast(float, ((unsigned)b) << 16); }
__device__ __forceinline__ float wave_sum(float v) {
#pragma unroll
    for (int o = 1; o < 64; o <<= 1) v += __shfl_xor(v, o);
    return v;
}

#define XB_TMO      128
#define XB_XCNT(j)  (256  + 64 * (j))
#define XB_XSUB(j)  (1280 + 64 * (j))
#define XB_XGEN(j)  (2304 + 64 * (j))
#define XB_TOP      3328
#define XB_TOPGEN   3392
#define XCD_BAR_WORDS 3456
#define XB_SPIN_CAP (1u << 18)

__device__ __forceinline__ unsigned xb_ld(unsigned* p)              { return __hip_atomic_load(p, __ATOMIC_RELAXED, __HIP_MEMORY_SCOPE_AGENT); }
__device__ __forceinline__ unsigned xb_add(unsigned* p, unsigned v) { return __hip_atomic_fetch_add(p, v, __ATOMIC_RELAXED, __HIP_MEMORY_SCOPE_AGENT); }
__device__ __forceinline__ unsigned xb_xcc_id() { return (unsigned)__builtin_amdgcn_s_getreg((3 << 11) | 20) & 0xFu; }
#define XB_SPIN(cond, bar) do { unsigned _sp = 0; while (cond) { __builtin_amdgcn_s_sleep(1); \
    if ((++_sp & 255u) == 0u) { if (xb_ld(&(bar)[XB_TMO])) break; if (_sp > XB_SPIN_CAP) { atomicAdd(&(bar)[XB_TMO], 1u); break; } } } } while (0)

struct XcdBarrier {
    unsigned* bar; unsigned x;
    volatile LAS unsigned* st;
};

__device__ __forceinline__ XcdBarrier xcd_barrier_post(unsigned* bar, volatile LAS unsigned* st) {
    XcdBarrier b; b.bar = bar; b.x = xb_xcc_id(); b.st = st;
    if (threadIdx.x == 0) (void)xb_add(&bar[XB_XCNT(b.x)], 1u);
    return b;
}
__device__ __forceinline__ void xcd_barrier_complete(unsigned* bar, unsigned x, unsigned& nloc, unsigned& nx) {
    const unsigned G = gridDim.x * gridDim.y * gridDim.z;
    unsigned sum, cnt, mine, sp = 0u;
    for (;;) {
        sum = 0u; cnt = 0u; mine = 0u;
#pragma unroll
        for (unsigned j = 0; j < 16; ++j) { const unsigned c = xb_ld(&bar[XB_XCNT(j)]); sum += c; cnt += (c > 0u) ? 1u : 0u; mine = (j == x) ? c : mine; }
        if (sum == G) break;
        __builtin_amdgcn_s_sleep(1);
        if ((++sp & 255u) == 0u) { if (xb_ld(&bar[XB_TMO])) break; if (sp > XB_SPIN_CAP) { atomicAdd(&bar[XB_TMO], 1u); break; } }
    }
    nloc = mine > 0u ? mine : 1u; nx = cnt > 0u ? cnt : 1u;
}

__device__ __forceinline__ void xcd_barrier(const XcdBarrier& b) {
    asm volatile("s_waitcnt vmcnt(0)" ::: "memory");
    __syncthreads();
    if (threadIdx.x == 0) {
        unsigned* bar = b.bar;
        __builtin_amdgcn_s_waitcnt(0);
        unsigned nloc = b.st[0], nx = b.st[1];
        if (nloc == 0u) { xcd_barrier_complete(bar, b.x, nloc, nx); b.st[0] = nloc; b.st[1] = nx; }
        const unsigned old = xb_add(&bar[XB_XSUB(b.x)], 1u);
        const unsigned gen = old / nloc;
        if (old + 1u == (gen + 1u) * nloc) {
            __builtin_amdgcn_fence(__ATOMIC_RELEASE, "agent");
            asm volatile("s_waitcnt vmcnt(0)" ::: "memory");
            const unsigned og = xb_add(&bar[XB_TOP], 1u);
            const unsigned tg = og / nx;
            if (og + 1u == (tg + 1u) * nx) xb_add(&bar[XB_TOPGEN], 1u);
            else XB_SPIN(xb_ld(&bar[XB_TOPGEN]) == tg, bar);
            __builtin_amdgcn_fence(__ATOMIC_ACQUIRE, "agent");
            xb_add(&bar[XB_XGEN(b.x)], 1u);
            asm volatile("s_waitcnt vmcnt(0)" ::: "memory");
        } else {
            XB_SPIN(xb_ld(&bar[XB_XGEN(b.x)]) == gen, bar);
            __builtin_amdgcn_fence(__ATOMIC_ACQUIRE, "agent");
            asm volatile("s_waitcnt vmcnt(0)" ::: "memory");
        }
    }
    __syncthreads();
}


__device__ __forceinline__ void cvt_item(const float* W, int N, const float* gain, bf16* WT, int K, int k0, int n0, size_t dst_row0, int lane) {
    const int q = lane >> 4, c = lane & 15;
    const bool ok = (n0 + 4 * c) < N;
    const GAS f32x4* src = (const GAS f32x4*)(W + (size_t)(k0 + 16 * q) * N + n0 + 4 * c);
    f32x4 v[16];
#pragma unroll
    for (int i = 0; i < 16; ++i) v[i] = ok ? src[(size_t)i * (N / 4)] : (f32x4){0.f, 0.f, 0.f, 0.f};
    if (gain) { const GAS f32x4* gp = (const GAS f32x4*)(gain + k0 + 16 * q);
#pragma unroll
        for (int i4 = 0; i4 < 4; ++i4) { const f32x4 g = gp[i4]; v[4 * i4 + 0] = v[4 * i4 + 0] * g.x; v[4 * i4 + 1] = v[4 * i4 + 1] * g.y; v[4 * i4 + 2] = v[4 * i4 + 2] * g.z; v[4 * i4 + 3] = v[4 * i4 + 3] * g.w; } }
    if (ok) {
#pragma unroll
        for (int e = 0; e < 4; ++e) { bf16* dst = WT + (dst_row0 + 4 * c + e) * (size_t)K + k0 + 16 * q;
            v4u o0, o1;
            o0.x = pk2(v[0][e], v[1][e]); o0.y = pk2(v[2][e], v[3][e]); o0.z = pk2(v[4][e], v[5][e]); o0.w = pk2(v[6][e], v[7][e]);
            o1.x = pk2(v[8][e], v[9][e]); o1.y = pk2(v[10][e], v[11][e]); o1.z = pk2(v[12][e], v[13][e]); o1.w = pk2(v[14][e], v[15][e]);
            *(GAS v4u*)dst = o0; *(GAS v4u*)(dst + 8) = o1; } }
}
__device__ __forceinline__ void cvt_matrix(const float* W, int K, int N, const float* gain, bf16* WT, int rowbase, int gw, int NGW, int lane) {
    const int nblk = (N + 63) / 64, nitems = (K / 64) * nblk;
    for (int it = gw; it < nitems; it += NGW) { const int kb = it / nblk, nb = it - kb * nblk;
        cvt_item(W, N, gain, WT, K, kb * 64, nb * 64, (size_t)(rowbase + nb * 64), lane); }
}
__device__ __forceinline__ void cvt_moe(const float* wg, const float* wu, const float* wd, const float* gain, bf16* WGU, bf16* WDN, int gw, int NGW, int lane) {
    for (int it = gw; it < 2 * 8192; it += NGW) { const int which = it >> 13, r = it & 8191, e = r >> 8, q = r & 255, kb = q >> 3, nb = q & 7, n0 = nb * 64;
        const float* W = (which ? wu : wg) + (size_t)e * 2048 * 512;
        const size_t dst = (size_t)e * 1024 + 256 * (n0 >> 7) + (n0 & 127) + (which ? 128 : 0);
        cvt_item(W, 512, gain, WGU, 2048, kb * 64, n0, dst, lane); }
    for (int it = gw; it < 8192; it += NGW) { const int e = it >> 8, q = it & 255, kb = q >> 5, nb = q & 31;
        cvt_item(wd + (size_t)e * 512 * 2048, 2048, nullptr, WDN + (size_t)e * 2048 * 512, 512, kb * 64, nb * 64, (size_t)(nb * 64), lane); }
}
__device__ __forceinline__ void norm_rows(const float* src, bf16* dst, int gw, int NGW, int lane) {
    for (int m = gw; m < T; m += NGW) {
        const GAS f32x4* xr = (const GAS f32x4*)(src + (size_t)m * D) + lane;
        f32x4 v[8]; float s = 0.f;
#pragma unroll
        for (int j = 0; j < 8; ++j) { v[j] = xr[64 * j]; s += (v[j].x * v[j].x + v[j].y * v[j].y) + (v[j].z * v[j].z + v[j].w * v[j].w); }
        const float rstd = rsqrtf(wave_sum(s) * (1.f / D) + RMS_EPS);
        GAS v2u* o8 = (GAS v2u*)(dst + (size_t)m * D) + lane;
#pragma unroll
        for (int j = 0; j < 8; ++j) { v2u o; o.x = pk2(v[j].x * rstd, v[j].y * rstd); o.y = pk2(v[j].z * rstd, v[j].w * rstd); o8[64 * j] = o; }
    }
}

__device__ __forceinline__ float logsig(float z) { return fminf(z, 0.f) - __logf(1.f + __expf(-fabsf(z))); }
constexpr int GP_QE = 0, GP_KE = 33792, GP_ATT = 67584, GP_GLF = 76800, GP_TOT = 81152;
__device__ __forceinline__ void gla_prepass(LAS unsigned char* lds, const bf16* QK, const bf16* V, const bf16* GL, const float* Wgu, const float* bgate,
                                            bf16* QEF, bf16* KLTF, bf16* ATTF, bf16* VTF, float* DEC) {
    const int tid = threadIdx.x, lane = tid & 63, wave = __builtin_amdgcn_readfirstlane(tid >> 6), d = tid & 255, half = tid >> 8;
    LAS bf16* QEl = (LAS bf16*)(lds + GP_QE); LAS bf16* KEl = (LAS bf16*)(lds + GP_KE); LAS bf16* ATl = (LAS bf16*)(lds + GP_ATT);
    LAS float* glf = (LAS float*)(lds + GP_GLF); LAS float* tot = (LAS float*)(lds + GP_TOT);
    for (int it = blockIdx.x; it < NITEM_GLA; it += gridDim.x) {
        const int bh = it >> 8, n = it & 255, h = bh & 3, b = bh >> 2; const int t0 = b * SEQ + n * GLA_C;
        __syncthreads();
        { const int c = tid >> 3, j2 = (tid & 7) * 2; const unsigned w = *(const GAS unsigned*)(GL + (size_t)(t0 + c) * 256 + j2); glf[c * 17 + j2] = bf_lo(w); glf[c * 17 + j2 + 1] = bf_hi(w); }
        float wg[16];
#pragma unroll
        for (int j = 0; j < 16; ++j) wg[j] = Wgu[j * 1024 + h * 256 + d];
        const float bg = bgate[h * 256 + d];
        __syncthreads();
        float la[32]; float run = 0.f;
#pragma unroll
        for (int i = 0; i < 32; ++i) { const int c = half * 32 + i; float z = bg;
#pragma unroll
            for (int j = 0; j < 16; ++j) z += glf[c * 17 + j] * wg[j];
            run += fmaxf(logsig(z) * 0.0625f, -1.0f); la[i] = run; }
        tot[half * 256 + d] = run;
        __syncthreads();
        const float other = tot[(1 - half) * 256 + d]; const float blast = run + other, offs = half ? other : 0.f;
        const bf16* qp = QK + (size_t)t0 * 2048 + h * 256 + d;
#pragma unroll
        for (int g = 0; g < 4; ++g) { float klv[8];
#pragma unroll
            for (int jj = 0; jj < 8; ++jj) { const int i = 8 * g + jj, c = half * 32 + i; const float bb = la[i] + offs;
                const float qv = bf2f(qp[(size_t)c * 2048]), kv = bf2f(qp[(size_t)c * 2048 + 1024]);
                QEl[c * 264 + d] = (bf16)f2bf(qv * 0.0625f * __expf(bb)); KEl[c * 264 + d] = (bf16)f2bf(kv * __expf(-bb)); klv[jj] = kv * __expf(blast - bb); }
            v4u o; o.x = pk2(klv[0], klv[1]); o.y = pk2(klv[2], klv[3]); o.z = pk2(klv[4], klv[5]); o.w = pk2(klv[6], klv[7]);
            const size_t fi = ((((size_t)it * 8 + (d >> 5)) * 2 + ((d >> 4) & 1)) * 2 + half) * 64 + g * 16 + (d & 15);
            *(GAS v4u*)(KLTF + fi * 8) = o; }
        if (half == 0) DEC[(size_t)it * 256 + d] = __expf(blast);
        { const bf16* vp = V + (size_t)t0 * 2048 + h * 512 + tid;
#pragma unroll
          for (int ks = 0; ks < 2; ++ks)
#pragma unroll
            for (int q = 0; q < 4; ++q) { unsigned short e[8];
#pragma unroll
                for (int jj = 0; jj < 8; ++jj) e[jj] = vp[(size_t)(32 * ks + 8 * q + jj) * 2048];
                v4u o; o.x = e[0] | ((unsigned)e[1] << 16); o.y = e[2] | ((unsigned)e[3] << 16); o.z = e[4] | ((unsigned)e[5] << 16); o.w = e[6] | ((unsigned)e[7] << 16);
                const size_t fi = (((size_t)it * 32 + (tid >> 4)) * 2 + ks) * 64 + q * 16 + (tid & 15);
                *(GAS v4u*)(VTF + fi * 8) = o; } }
        __syncthreads();
        { const int mt = wave >> 1, i = lane & 15, q = lane >> 4;
#pragma unroll
          for (int nn = 0; nn < 2; ++nn) { const int nt = 2 * (wave & 1) + nn; f32x4 acc = {0.f, 0.f, 0.f, 0.f};
            if (nt <= mt) {
#pragma unroll
                for (int ks = 0; ks < 8; ++ks) { const bf16x8 a = *(const LAS bf16x8*)(QEl + (16 * mt + i) * 264 + 32 * ks + 8 * q); const bf16x8 bb = *(const LAS bf16x8*)(KEl + (16 * nt + i) * 264 + 32 * ks + 8 * q);
                    acc = __builtin_amdgcn_mfma_f32_16x16x32_bf16(a, bb, acc, 0, 0, 0); } }
#pragma unroll
            for (int r = 0; r < 4; ++r) { const int c = 16 * mt + 4 * q + r, cp = 16 * nt + i; ATl[c * 72 + cp] = (bf16)f2bf(cp <= c ? acc[r] : 0.f); } } }
        __syncthreads();
        { const int f = tid, mt = f >> 7, ks = (f >> 6) & 1, l2 = f & 63, i2 = l2 & 15, q2 = l2 >> 4;
          const v4u o = *(const LAS v4u*)(ATl + (16 * mt + i2) * 72 + 32 * ks + 8 * q2);
          *(GAS v4u*)(ATTF + ((size_t)it * 512 + f) * 8) = o; }
#pragma unroll
        for (int k = 0; k < 4; ++k) { const int f = tid + 512 * k, w = f >> 8, mt = (f >> 6) & 3, l2 = f & 63, i2 = l2 & 15, q2 = l2 >> 4;
            const v2u lo = *(const LAS v2u*)(QEl + (16 * mt + i2) * 264 + 32 * w + 4 * q2), hi = *(const LAS v2u*)(QEl + (16 * mt + i2) * 264 + 32 * w + 16 + 4 * q2);
            v4u o; o.x = lo.x; o.y = lo.y; o.z = hi.x; o.w = hi.y;
            *(GAS v4u*)(QEF + ((((size_t)it * 8 + w) * 4 + mt) * 64 + l2) * 8) = o; }
    }
}
struct GStep { bf16x8 qa[4], ka[2][2], vb[2], at; f32x4 dc[2]; };
__device__ __forceinline__ void gla_load(GStep& s, int it, int vs, int w, int lane, const bf16* QEF, const bf16* KLTF, const bf16* ATTF, const bf16* VTF, const float* DEC) {
    const GAS bf16x8* q16 = (const GAS bf16x8*)QEF + (((size_t)it * 8 + w) * 4) * 64 + lane;
#pragma unroll
    for (int mt = 0; mt < 4; ++mt) s.qa[mt] = q16[mt * 64];
    const GAS bf16x8* k16 = (const GAS bf16x8*)KLTF + (((size_t)it * 8 + w) * 4) * 64 + lane;
#pragma unroll
    for (int m = 0; m < 2; ++m)
#pragma unroll
        for (int ks = 0; ks < 2; ++ks) s.ka[m][ks] = k16[(m * 2 + ks) * 64];
    const GAS bf16x8* v16 = (const GAS bf16x8*)VTF + (((size_t)it * 32 + vs) * 2) * 64 + lane;
    s.vb[0] = v16[0]; s.vb[1] = v16[64];
    s.at = ((const GAS bf16x8*)ATTF)[(size_t)it * 512 + w * 64 + lane];
    const GAS f32x4* d4 = (const GAS f32x4*)(DEC + (size_t)it * 256 + 32 * w + 4 * (lane >> 4));
    s.dc[0] = d4[0]; s.dc[1] = d4[4];
}
__device__ __forceinline__ void gla_seq(LAS unsigned char* lds, const bf16* QEF, const bf16* KLTF, const bf16* ATTF, const bf16* VTF, const float* DEC, bf16* O) {
    const int tid = threadIdx.x, lane = tid & 63, w = __builtin_amdgcn_readfirstlane(tid >> 6), q = lane >> 4;
    LAS float* part = (LAS float*)lds;
    for (int wi = blockIdx.x; wi < 256; wi += gridDim.x) {
        const int bh = wi & 7, vs = wi >> 3, h = bh & 3, b = bh >> 2;
        f32x4 S0 = {0.f, 0.f, 0.f, 0.f}, S1 = {0.f, 0.f, 0.f, 0.f};
        GStep cur, nxt;
        gla_load(cur, bh * 256, vs, w, lane, QEF, KLTF, ATTF, VTF, DEC);
        __syncthreads();
        for (int n = 0; n < GLA_NCH; ++n) {
            const int it = bh * 256 + n;
            gla_load(nxt, (n + 1 < GLA_NCH) ? it + 1 : it, vs, w, lane, QEF, KLTF, ATTF, VTF, DEC);
            v4u sbw; sbw.x = pk2(S0[0], S0[1]); sbw.y = pk2(S0[2], S0[3]); sbw.z = pk2(S1[0], S1[1]); sbw.w = pk2(S1[2], S1[3]);
            const bf16x8 sb = __builtin_bit_cast(bf16x8, sbw);
            f32x4 po[4];
#pragma unroll
            for (int mt = 0; mt < 4; ++mt) po[mt] = __builtin_amdgcn_mfma_f32_16x16x32_bf16(cur.qa[mt], sb, (f32x4){0.f, 0.f, 0.f, 0.f}, 0, 0, 0);
            const bf16x8 vsel = (w & 1) ? cur.vb[1] : cur.vb[0];
#pragma unroll
            for (int mt = 0; mt < 4; ++mt) if (mt == (w >> 1)) po[mt] = __builtin_amdgcn_mfma_f32_16x16x32_bf16(cur.at, vsel, po[mt], 0, 0, 0);
            S0 = S0 * cur.dc[0]; S1 = S1 * cur.dc[1];
            S0 = __builtin_amdgcn_mfma_f32_16x16x32_bf16(cur.ka[0][0], cur.vb[0], S0, 0, 0, 0); S0 = __builtin_amdgcn_mfma_f32_16x16x32_bf16(cur.ka[0][1], cur.vb[1], S0, 0, 0, 0);
            S1 = __builtin_amdgcn_mfma_f32_16x16x32_bf16(cur.ka[1][0], cur.vb[0], S1, 0, 0, 0); S1 = __builtin_amdgcn_mfma_f32_16x16x32_bf16(cur.ka[1][1], cur.vb[1], S1, 0, 0, 0);
            LAS float* pb = part + (size_t)((n & 1) * 8 + w) * 1024;
#pragma unroll
            for (int mt = 0; mt < 4; ++mt)
#pragma unroll
                for (int r = 0; r < 4; ++r) pb[(16 * mt + 4 * q + r) * 16 + (lane & 15)] = po[mt][r];
            __syncthreads();
            { const int c = tid >> 3, v2 = (tid & 7) * 2; const LAS float* pr = part + (size_t)((n & 1) * 8) * 1024 + c * 16 + v2; float s0 = 0.f, s1 = 0.f;
#pragma unroll
              for (int ww = 0; ww < 8; ++ww) { s0 += pr[ww * 1024]; s1 += pr[ww * 1024 + 1]; }
              *(GAS unsigned*)(O + (size_t)(b * SEQ + n * GLA_C + c) * 2048 + h * 512 + vs * 16 + v2) = pk2(s0, s1); }
            cur = nxt;
        }
        __syncthreads();
    }
}
__device__ __forceinline__ void gla_gate(const bf16* O, const bf16* R, const float* head_g, bf16* OG, int gw, int NGW, int lane) {
    float hg[8];
#pragma unroll
    for (int j = 0; j < 8; ++j) hg[j] = head_g[8 * lane + j];
    for (int m = gw; m < T; m += NGW) {
#pragma unroll
        for (int h = 0; h < 4; ++h) {
            const v4u ov = *(const GAS v4u*)(O + (size_t)m * 2048 + h * 512 + 8 * lane), rv = *(const GAS v4u*)(R + (size_t)m * 2048 + h * 512 + 8 * lane);
            float o[8] = {bf_lo(ov.x), bf_hi(ov.x), bf_lo(ov.y), bf_hi(ov.y), bf_lo(ov.z), bf_hi(ov.z), bf_lo(ov.w), bf_hi(ov.w)};
            float r[8] = {bf_lo(rv.x), bf_hi(rv.x), bf_lo(rv.y), bf_hi(rv.y), bf_lo(rv.z), bf_hi(rv.z), bf_lo(rv.w), bf_hi(rv.w)};
            float ss = 0.f;
#pragma unroll
            for (int j = 0; j < 8; ++j) ss += o[j] * o[j];
            const float rstd = rsqrtf(wave_sum(ss) * (1.f / 512.f) + RMS_EPS);
            float y[8];
#pragma unroll
            for (int j = 0; j < 8; ++j) y[j] = o[j] * rstd * hg[j] * pg8::silu_f(r[j]);
            v4u w; w.x = pk2(y[0], y[1]); w.y = pk2(y[2], y[3]); w.z = pk2(y[4], y[5]); w.w = pk2(y[6], y[7]);
            *(GAS v4u*)(OG + (size_t)m * 2048 + h * 512 + 8 * lane) = w;
        }
    }
}

__device__ __forceinline__ void moe_route(LAS unsigned char* lds, const float* RL, const float* bgroup, const float* brouter, unsigned* gcnt, unsigned* EP0, unsigned* EP1, float* W0, float* W1) {
    const int tid = threadIdx.x; LAS int* lcnt = (LAS int*)lds; LAS int* lbase = lcnt + 32;
    for (int base = blockIdx.x * 128; base < T; base += gridDim.x * 128) {
        if (tid < 32) lcnt[tid] = 0;
        __syncthreads();
        int e0 = 0, e1 = 0, r0 = 0, r1 = 0; float w0 = 0.f, w1 = 0.f;
        if (tid < 128) { const int t = base + tid; const float* rl = RL + (size_t)t * 64;
            const f32x4 g4 = *(const GAS f32x4*)rl; float gl[4] = {g4.x + bgroup[0], g4.y + bgroup[1], g4.z + bgroup[2], g4.w + bgroup[3]};
            int g = 0; float best = gl[0];
#pragma unroll
            for (int j = 1; j < 4; ++j) if (gl[j] > best) { best = gl[j]; g = j; }
            float se = 0.f;
#pragma unroll
            for (int j = 0; j < 4; ++j) se += __expf(gl[j] - best);
            const float pg = 1.0f / se;
            const f32x4 a4 = *(const GAS f32x4*)(rl + 4 + 8 * g), b4 = *(const GAS f32x4*)(rl + 8 + 8 * g);
            float el[8] = {a4.x, a4.y, a4.z, a4.w, b4.x, b4.y, b4.z, b4.w};
#pragma unroll
            for (int j = 0; j < 8; ++j) el[j] += brouter[8 * g + j];
            int i0 = 0; float v0 = el[0];
#pragma unroll
            for (int j = 1; j < 8; ++j) if (el[j] > v0) { v0 = el[j]; i0 = j; }
            int i1 = -1; float v1 = -3.0e38f;
#pragma unroll
            for (int j = 0; j < 8; ++j) if (j != i0 && el[j] > v1) { v1 = el[j]; i1 = j; }
            w0 = pg / (1.0f + __expf(v1 - v0)); w1 = pg - w0;
            e0 = 8 * g + i0; e1 = 8 * g + i1;
            r0 = __hip_atomic_fetch_add(&lcnt[e0], 1, __ATOMIC_RELAXED, __HIP_MEMORY_SCOPE_WORKGROUP); r1 = __hip_atomic_fetch_add(&lcnt[e1], 1, __ATOMIC_RELAXED, __HIP_MEMORY_SCOPE_WORKGROUP); }
        __syncthreads();
        if (tid < 32) lbase[tid] = (int)__hip_atomic_fetch_add(gcnt + tid, (unsigned)lcnt[tid], RLX_AGENT);
        __syncthreads();
        if (tid < 128) { const int t = base + tid;
            EP0[t] = ((unsigned)e0 << 24) | (unsigned)(lbase[e0] + r0); EP1[t] = ((unsigned)e1 << 24) | (unsigned)(lbase[e1] + r1); W0[t] = w0; W1[t] = w1; }
        __syncthreads();
    }
}
__device__ __forceinline__ void moe_build_table(LAS unsigned char* ldsbase, unsigned* gcnt) {
    LAS int* off = (LAS int*)(ldsbase + MOE_OFF_OFF); LAS unsigned char* texp = ldsbase + MOE_TEXP_OFF;
    __syncthreads();
    if (threadIdx.x == 0) { int acc = 0, ti = 0;
        for (int e = 0; e < NE; ++e) { const int c = (int)__hip_atomic_load(gcnt + e, RLX_AGENT); off[e] = acc; const int nt = (c + 255) >> 8;
            for (int k = 0; k < nt && ti < 288; ++k) texp[ti++] = (unsigned char)e;
            acc += nt * 256; }
        off[32] = acc; }
    __syncthreads();
}
__device__ __forceinline__ void moe_gather(LAS unsigned char* ldsbase, const bf16* HN, bf16* XS, const unsigned* EP0, const unsigned* EP1, unsigned* SL0, unsigned* SL1, int gw, int NGW, int lane) {
    const LAS int* off = (const LAS int*)(ldsbase + MOE_OFF_OFF);
    for (int t = gw; t < T; t += NGW) {
        const unsigned p0 = EP0[t], p1 = EP1[t];
        const unsigned s0 = (unsigned)off[p0 >> 24] + (p0 & 0xffffffu), s1 = (unsigned)off[p1 >> 24] + (p1 & 0xffffffu);
        const GAS v4u* src = (const GAS v4u*)(HN + (size_t)t * 2048) + lane; GAS v4u* d0 = (GAS v4u*)(XS + (size_t)s0 * 2048) + lane; GAS v4u* d1 = (GAS v4u*)(XS + (size_t)s1 * 2048) + lane;
        v4u v[4];
#pragma unroll
        for (int j = 0; j < 4; ++j) v[j] = src[64 * j];
#pragma unroll
        for (int j = 0; j < 4; ++j) { d0[64 * j] = v[j]; d1[64 * j] = v[j]; }
        if (lane == 0) { SL0[t] = s0; SL1[t] = s1; }
    }
}
__device__ __forceinline__ void moe_combine(float* out, const bf16* Y, const unsigned* SL0, const unsigned* SL1, const float* W0, const float* W1, bf16* HN, bool do_norm, int gw, int NGW, int lane) {
    for (int t = gw; t < T; t += NGW) {
        const unsigned s0 = SL0[t], s1 = SL1[t]; const float w0 = W0[t], w1 = W1[t];
        GAS f32x4* xr = (GAS f32x4*)(out + (size_t)t * D) + lane;
        const GAS v2u* y0 = (const GAS v2u*)(Y + (size_t)s0 * 2048) + lane; const GAS v2u* y1 = (const GAS v2u*)(Y + (size_t)s1 * 2048) + lane;
        f32x4 v[8]; float s = 0.f;
#pragma unroll
        for (int j = 0; j < 8; ++j) { const v2u a = y0[64 * j], b = y1[64 * j]; f32x4 x = xr[64 * j];
            x.x += w0 * bf_lo(a.x) + w1 * bf_lo(b.x); x.y += w0 * bf_hi(a.x) + w1 * bf_hi(b.x); x.z += w0 * bf_lo(a.y) + w1 * bf_lo(b.y); x.w += w0 * bf_hi(a.y) + w1 * bf_hi(b.y);
            v[j] = x; xr[64 * j] = x; s += (x.x * x.x + x.y * x.y) + (x.z * x.z + x.w * x.w); }
        if (do_norm) { const float rstd = rsqrtf(wave_sum(s) * (1.f / D) + RMS_EPS);
            GAS v2u* o8 = (GAS v2u*)(HN + (size_t)t * D) + lane;
#pragma unroll
            for (int j = 0; j < 8; ++j) { v2u o; o.x = pk2(v[j].x * rstd, v[j].y * rstd); o.y = pk2(v[j].z * rstd, v[j].w * rstd); o8[64 * j] = o; } }
    }
}

__device__ const unsigned char T5_BUCKET[128] = {0,1,2,3,4,5,6,7,8,9,10,11,12,13,14,15,16,16,16,17,17,18,18,18,19,19,19,20,20,20,20,21,21,21,21,22,22,22,22,22,23,23,23,23,23,23,24,24,24,24,24,24,25,25,25,25,25,25,25,26,26,26,26,26,26,26,26,27,27,27,27,27,27,27,27,27,27,28,28,28,28,28,28,28,28,28,28,29,29,29,29,29,29,29,29,29,29,29,29,30,30,30,30,30,30,30,30,30,30,30,30,30,30,31,31,31,31,31,31,31,31,31,31,31,31,31,31,31};
constexpr int AT_K = 0, AT_VT = 36864, AT_BIAS = 70656;
__device__ __forceinline__ void swa_attention(LAS unsigned char* lds, const bf16* KVQ, const float* knorm, const float* qnorm, const float* relb, const float* sinks, bf16* AO) {
    const int tid = threadIdx.x, lane = tid & 63, g = __builtin_amdgcn_readfirstlane(tid >> 6), li = lane & 15, q = lane >> 4;
    LAS bf16* KL = (LAS bf16*)(lds + AT_K); LAS bf16* VTL = (LAS bf16*)(lds + AT_VT); LAS float* BL = (LAS float*)(lds + AT_BIAS);
    float qn[2][8];
#pragma unroll
    for (int ks = 0; ks < 2; ++ks)
#pragma unroll
        for (int j = 0; j < 8; ++j) qn[ks][j] = qnorm[32 * ks + 8 * q + j] * 0.125f;
    for (int wi = blockIdx.x; wi < 1024; wi += gridDim.x) {
        const int hk = wi & 3, n = (wi >> 2) & 127, b = wi >> 9;
        __syncthreads();
        { const int key = tid >> 1, hf = tid & 1; const bool live = (n > 0) || (key >= 128);
          const size_t tk = (size_t)b * SEQ + (size_t)(n - 1) * 128 + key;
          const bf16* kp = KVQ + tk * KVQ_N + hk * 64 + 32 * hf;
          v4u kw[4], vw[4];
#pragma unroll
          for (int j = 0; j < 4; ++j) { kw[j] = live ? *(const GAS v4u*)(kp + 8 * j) : (v4u){0u, 0u, 0u, 0u}; vw[j] = live ? *(const GAS v4u*)(kp + 256 + 8 * j) : (v4u){0u, 0u, 0u, 0u}; }
          float ss = 0.f;
#pragma unroll
          for (int j = 0; j < 4; ++j) { const float a0 = bf_lo(kw[j].x), a1 = bf_hi(kw[j].x), a2 = bf_lo(kw[j].y), a3 = bf_hi(kw[j].y), a4 = bf_lo(kw[j].z), a5 = bf_hi(kw[j].z), a6 = bf_lo(kw[j].w), a7 = bf_hi(kw[j].w);
              ss += (a0 * a0 + a1 * a1) + (a2 * a2 + a3 * a3) + (a4 * a4 + a5 * a5) + (a6 * a6 + a7 * a7); }
          ss += __shfl_xor(ss, 1);
          const float rstd = rsqrtf(ss * (1.f / 64.f) + RMS_EPS);
#pragma unroll
          for (int j = 0; j < 4; ++j) { const float* kn = knorm + 32 * hf + 8 * j; v4u o;
              o.x = pk2(bf_lo(kw[j].x) * rstd * kn[0], bf_hi(kw[j].x) * rstd * kn[1]); o.y = pk2(bf_lo(kw[j].y) * rstd * kn[2], bf_hi(kw[j].y) * rstd * kn[3]);
              o.z = pk2(bf_lo(kw[j].z) * rstd * kn[4], bf_hi(kw[j].z) * rstd * kn[5]); o.w = pk2(bf_lo(kw[j].w) * rstd * kn[6], bf_hi(kw[j].w) * rstd * kn[7]);
              *(LAS v4u*)(KL + key * 72 + 32 * hf + 8 * j) = o; }
#pragma unroll
          for (int j = 0; j < 4; ++j) { const int d0 = 32 * hf + 8 * j;
              VTL[(d0 + 0) * 264 + key] = (bf16)(vw[j].x & 0xffffu); VTL[(d0 + 1) * 264 + key] = (bf16)(vw[j].x >> 16); VTL[(d0 + 2) * 264 + key] = (bf16)(vw[j].y & 0xffffu); VTL[(d0 + 3) * 264 + key] = (bf16)(vw[j].y >> 16);
              VTL[(d0 + 4) * 264 + key] = (bf16)(vw[j].z & 0xffffu); VTL[(d0 + 5) * 264 + key] = (bf16)(vw[j].z >> 16); VTL[(d0 + 6) * 264 + key] = (bf16)(vw[j].w & 0xffffu); VTL[(d0 + 7) * 264 + key] = (bf16)(vw[j].w >> 16); }
#pragma unroll
          for (int k = 0; k < 2; ++k) { const int e = tid + 512 * k, gg = e >> 7, dist = e & 127; BL[e] = relb[(int)T5_BUCKET[dist] * 32 + hk * 8 + gg]; }
        }
        __syncthreads();
        const int head = hk * 8 + g; const float sink = sinks[head];
        for (int mt = 0; mt < 8; ++mt) {
            const size_t tq = (size_t)b * SEQ + (size_t)n * 128 + 16 * mt + li;
            bf16x8 qf[2];
            { const bf16* qp = KVQ + tq * KVQ_N + 512 + head * 64 + 8 * q; const v4u q0 = *(const GAS v4u*)qp, q1 = *(const GAS v4u*)(qp + 32);
              float a[16] = {bf_lo(q0.x), bf_hi(q0.x), bf_lo(q0.y), bf_hi(q0.y), bf_lo(q0.z), bf_hi(q0.z), bf_lo(q0.w), bf_hi(q0.w), bf_lo(q1.x), bf_hi(q1.x), bf_lo(q1.y), bf_hi(q1.y), bf_lo(q1.z), bf_hi(q1.z), bf_lo(q1.w), bf_hi(q1.w)};
              float ss = 0.f;
#pragma unroll
              for (int j = 0; j < 16; ++j) ss += a[j] * a[j];
              ss += __shfl_xor(ss, 16); ss += __shfl_xor(ss, 32);
              const float rstd = rsqrtf(ss * (1.f / 64.f) + RMS_EPS);
              v4u w0, w1;
              w0.x = pk2(a[0] * rstd * qn[0][0], a[1] * rstd * qn[0][1]); w0.y = pk2(a[2] * rstd * qn[0][2], a[3] * rstd * qn[0][3]); w0.z = pk2(a[4] * rstd * qn[0][4], a[5] * rstd * qn[0][5]); w0.w = pk2(a[6] * rstd * qn[0][6], a[7] * rstd * qn[0][7]);
              w1.x = pk2(a[8] * rstd * qn[1][0], a[9] * rstd * qn[1][1]); w1.y = pk2(a[10] * rstd * qn[1][2], a[11] * rstd * qn[1][3]); w1.z = pk2(a[12] * rstd * qn[1][4], a[13] * rstd * qn[1][5]); w1.w = pk2(a[14] * rstd * qn[1][6], a[15] * rstd * qn[1][7]);
              qf[0] = __builtin_bit_cast(bf16x8, w0); qf[1] = __builtin_bit_cast(bf16x8, w1); }
            f32x4 st[9]; float mx = sink;
#pragma unroll
            for (int tt = 0; tt < 9; ++tt) { const int nt = mt + tt; f32x4 acc = {0.f, 0.f, 0.f, 0.f};
#pragma unroll
                for (int ks = 0; ks < 2; ++ks) { const bf16x8 a = *(const LAS bf16x8*)(KL + (16 * nt + li) * 72 + 32 * ks + 8 * q); acc = __builtin_amdgcn_mfma_f32_16x16x32_bf16(a, qf[ks], acc, 0, 0, 0); }
#pragma unroll
                for (int r = 0; r < 4; ++r) { const int col = 16 * nt + 4 * q + r, row = 16 * mt + li, dist = 128 + row - col;
                    const bool valid = (dist >= 0) && (dist < 128) && ((col >= 128) || (n > 0));
                    const float s = valid ? acc[r] + BL[g * 128 + (dist & 127)] : -__builtin_inff();
                    acc[r] = s; mx = fmaxf(mx, s); }
                st[tt] = acc; }
            mx = fmaxf(mx, __shfl_xor(mx, 16)); mx = fmaxf(mx, __shfl_xor(mx, 32));
            float lsum = 0.f;
#pragma unroll
            for (int tt = 0; tt < 9; ++tt)
#pragma unroll
                for (int r = 0; r < 4; ++r) { const float p = __expf(st[tt][r] - mx); st[tt][r] = p; lsum += p; }
            lsum += __shfl_xor(lsum, 16); lsum += __shfl_xor(lsum, 32);
            const float inv = 1.0f / (lsum + __expf(sink - mx));
            f32x4 oacc[4];
#pragma unroll
            for (int dt = 0; dt < 4; ++dt) oacc[dt] = (f32x4){0.f, 0.f, 0.f, 0.f};
#pragma unroll
            for (int s = 0; s < 5; ++s) {
                v4u pw; pw.x = pk2(st[2 * s][0], st[2 * s][1]); pw.y = pk2(st[2 * s][2], st[2 * s][3]);
                if (s < 4) { pw.z = pk2(st[2 * s + 1][0], st[2 * s + 1][1]); pw.w = pk2(st[2 * s + 1][2], st[2 * s + 1][3]); } else { pw.z = 0u; pw.w = 0u; }
                const bf16x8 pb = __builtin_bit_cast(bf16x8, pw);
                const int k0 = 16 * (mt + 2 * s) + 4 * q; int k1 = 16 * (mt + 2 * s + 1) + 4 * q; if (k1 > 252) k1 = 240 + 4 * q;
#pragma unroll
                for (int dt = 0; dt < 4; ++dt) { const v2u lo = *(const LAS v2u*)(VTL + (16 * dt + li) * 264 + k0), hi = *(const LAS v2u*)(VTL + (16 * dt + li) * 264 + k1);
                    v4u aw; aw.x = lo.x; aw.y = lo.y; aw.z = hi.x; aw.w = hi.y;
                    oacc[dt] = __builtin_amdgcn_mfma_f32_16x16x32_bf16(__builtin_bit_cast(bf16x8, aw), pb, oacc[dt], 0, 0, 0); } }
#pragma unroll
            for (int dt = 0; dt < 4; ++dt) { v2u o; o.x = pk2(oacc[dt][0] * inv, oacc[dt][1] * inv); o.y = pk2(oacc[dt][2] * inv, oacc[dt][3] * inv);
                *(GAS v2u*)(AO + tq * 2048 + head * 64 + 16 * dt + 4 * q) = o; }
        }
    }
}

struct Args { const float* in[24]; float* out; unsigned char* ws; int ph_lo, ph_hi; };
constexpr int N_PHASES = 23;
__global__ void __launch_bounds__(NWAVES * 64, 2) fwd(Args args) {
    extern __shared__ __attribute__((aligned(16))) unsigned char lds_raw[];
    LAS unsigned char* lds = (LAS unsigned char*)lds_raw;
    const int tid = threadIdx.x, lane = tid & 63, wave = __builtin_amdgcn_readfirstlane(tid >> 6);
    const int G = gridDim.x, gw = blockIdx.x * NWAVES + wave, NGW = G * NWAVES;
    unsigned char* ws = args.ws;
    gu32* ctl = (gu32*)(ws + WS_CTL);
    for (int u = tid; u < (LDS_BYTES - LDSCTL_OFF) / 4; u += NWAVES * 64) ((LAS unsigned*)(lds + LDSCTL_OFF))[u] = 0u;
    __syncthreads();
    XcdBarrier bar = xcd_barrier_post((unsigned*)(ctl + CW_BAR), (volatile LAS unsigned*)(lds + MISC_OFF));
    const int lo = args.ph_lo, hi = args.ph_hi;
#define IN(k) ((((MK_PHASE_MASK) >> (k)) & 1) && lo <= (k) && (k) < hi)
#define PB(k) const unsigned long long _pt0 = (((MK_DELAY_MASK) >> (k)) & 1) ? __builtin_amdgcn_s_memrealtime() : 0ull
#define PE(k) do { if (((MK_DELAY_MASK) >> (k)) & 1) { const unsigned long long _pt1 = __builtin_amdgcn_s_memrealtime(), _dt = _pt1 - _pt0; while (__builtin_amdgcn_s_memrealtime() - _pt1 < _dt) __builtin_amdgcn_s_sleep(8); } } while (0)
#define SEAM(k) do { if (IN(k) && IN((k) + 1)) xcd_barrier(bar); } while (0)

    const float* x = args.in[0]; float* out = args.out;
    bf16* W_GLA_IN = (bf16*)(ws + WS_W_GLA_IN); bf16* W_GLA_OUT = (bf16*)(ws + WS_W_GLA_OUT); bf16* W_KVQ = (bf16*)(ws + WS_W_KVQ); bf16* W_SWA_OUT = (bf16*)(ws + WS_W_SWA_OUT);
    bf16* W_ROUTER = (bf16*)(ws + WS_W_ROUTER); bf16* W_GU = (bf16*)(ws + WS_W_GU); bf16* W_DN = (bf16*)(ws + WS_W_DN);
    bf16* HN = (bf16*)(ws + WS_HN);
    unsigned* EP0 = (unsigned*)(ws + WS_TOK); unsigned* EP1 = EP0 + T; unsigned* SL0 = EP1 + T; unsigned* SL1 = SL0 + T; float* TW0 = (float*)(SL1 + T); float* TW1 = TW0 + T;
    float* RL = (float*)(ws + WS_RL);

    if (IN(0)) { PB(0);
        cvt_matrix(args.in[2], 2048, GLA_PROJ_N, args.in[1], W_GLA_IN, 0, gw, NGW, lane);
        cvt_matrix(args.in[6], 2048, 2048, nullptr, W_GLA_OUT, 0, gw, NGW, lane);
        cvt_matrix(args.in[8], 2048, 512, args.in[7], W_KVQ, 0, gw, NGW, lane);
        cvt_matrix(args.in[12], 2048, 2048, args.in[11], W_KVQ, 512, gw, NGW, lane);
        cvt_matrix(args.in[15], 2048, 2048, nullptr, W_SWA_OUT, 0, gw, NGW, lane);
        for (int l = 0; l < 2; ++l) {
            cvt_matrix(args.in[17] + (size_t)l * 2048 * 4, 2048, 4, args.in[16] + l * 2048, W_ROUTER + (size_t)l * 256 * 2048, 0, gw, NGW, lane);
            cvt_matrix(args.in[19] + (size_t)l * 2048 * 32, 2048, 32, args.in[16] + l * 2048, W_ROUTER + (size_t)l * 256 * 2048, 4, gw, NGW, lane);
        }
        cvt_moe(args.in[21], args.in[22], args.in[23], args.in[16], W_GU, W_DN, gw, NGW, lane);
        norm_rows(x, HN, gw, NGW, lane);
        PE(0);
    }
    SEAM(0);
    if (IN(1)) { PB(1);
        pg8::Gemm g{HN, W_GLA_IN, T, GLA_PROJ_NP, 2048}; pg8::StaticOrder S; S.init(T, GLA_PROJ_NP, G, (int)blockIdx.x);
        pg8::EpiGlaProj E{(bf16*)(ws + WS_QK), (bf16*)(ws + WS_V), (bf16*)(ws + WS_R), (bf16*)(ws + WS_GL)};
        pg8::gemm_phase<pg8::EpiGlaProj, pg8::StaticOrder, true, true>(lds + RING_OFF, g, S, E);
        PE(1);
    }
    SEAM(1);
    if (IN(2)) { PB(2); gla_prepass(lds + RING_OFF, (const bf16*)(ws + WS_QK), (const bf16*)(ws + WS_V), (const bf16*)(ws + WS_GL), args.in[3], args.in[4],
                           (bf16*)(ws + WS_QEF), (bf16*)(ws + WS_KLTF), (bf16*)(ws + WS_ATTF), (bf16*)(ws + WS_VTF), (float*)(ws + WS_DEC)); PE(2); }
    SEAM(2);
    if (IN(3)) { PB(3); gla_seq(lds + RING_OFF, (const bf16*)(ws + WS_QEF), (const bf16*)(ws + WS_KLTF), (const bf16*)(ws + WS_ATTF), (const bf16*)(ws + WS_VTF), (const float*)(ws + WS_DEC), (bf16*)(ws + WS_QK)); PE(3); }
    SEAM(3);
    if (IN(4)) { PB(4); gla_gate((const bf16*)(ws + WS_QK), (const bf16*)(ws + WS_R), args.in[5], HN, gw, NGW, lane); PE(4); }
    SEAM(4);
    if (IN(5)) { PB(5);
        pg8::Gemm g{HN, W_GLA_OUT, T, 2048, 2048}; pg8::StaticOrder S; S.init(T, 2048, G, (int)blockIdx.x);
        pg8::EpiResF32 E{out, x, 2048};
        pg8::gemm_phase<pg8::EpiResF32, pg8::StaticOrder, true, true>(lds + RING_OFF, g, S, E);
        PE(5);
    }
    SEAM(5);

    { constexpr int layer = 0; constexpr int pb = 6 + 10 * layer;
    unsigned* gcnt = (unsigned*)(ctl + CW_CNT + layer * 64);
    if (IN(pb + 0)) { PB(pb + 0); norm_rows(out, HN, gw, NGW, lane); PE(pb + 0); }
    SEAM(pb + 0);
    if (IN(pb + 1)) { PB(pb + 1);
        pg8::Gemm g{HN, W_ROUTER + (size_t)layer * 256 * 2048, T, 256, 2048}; pg8::StaticOrder S; S.init(T, 256, G, (int)blockIdx.x);
        pg8::EpiRouter E{RL};
        pg8::gemm_phase<pg8::EpiRouter, pg8::StaticOrder, true, true>(lds + RING_OFF, g, S, E);
        PE(pb + 1);
    }
    SEAM(pb + 1);
    if (IN(pb + 2)) { PB(pb + 2); moe_route(lds + RING_OFF, RL, args.in[18] + layer * 4, args.in[20] + layer * 32, gcnt, EP0, EP1, TW0, TW1); PE(pb + 2); }
    SEAM(pb + 2);
    if (IN(pb + 3)) { PB(pb + 3); { moe_build_table(lds, gcnt); moe_gather(lds, HN, (bf16*)(ws + WS_XS), EP0, EP1, SL0, SL1, gw, NGW, lane); } PE(pb + 3); }
    SEAM(pb + 3);
    if (IN(pb + 4)) { PB(pb + 4);
        moe_build_table(lds, gcnt);
        const int rows = __builtin_amdgcn_readfirstlane(((const LAS int*)(lds + MOE_OFF_OFF))[32]);
        pg8::Gemm g{(const bf16*)(ws + WS_XS), W_GU, rows, 1024, 2048};
        pg8::GroupedOrder S{(const LAS unsigned char*)(lds + MOE_TEXP_OFF), rows >> 8, 4, G, (int)blockIdx.x};
        pg8::EpiSwiGLU E{(bf16*)(ws + WS_ACT)};
        pg8::gemm_phase<pg8::EpiSwiGLU, pg8::GroupedOrder, true, true>(lds + RING_OFF, g, S, E);
        PE(pb + 4);
    }
    SEAM(pb + 4);
    if (IN(pb + 5)) { PB(pb + 5);
        moe_build_table(lds, gcnt);
        const int rows = __builtin_amdgcn_readfirstlane(((const LAS int*)(lds + MOE_OFF_OFF))[32]);
        pg8::Gemm g{(const bf16*)(ws + WS_ACT), W_DN, rows, 2048, 512};
        pg8::GroupedOrder S{(const LAS unsigned char*)(lds + MOE_TEXP_OFF), rows >> 8, 8, G, (int)blockIdx.x};
        pg8::EpiBf16 E{(bf16*)(ws + WS_Y), 2048};
        pg8::gemm_phase<pg8::EpiBf16, pg8::GroupedOrder, true, true>(lds + RING_OFF, g, S, E);
        PE(pb + 5);
    }
    SEAM(pb + 5);
    if (IN(pb + 6)) { PB(pb + 6);
        moe_combine(out, (const bf16*)(ws + WS_Y), SL0, SL1, TW0, TW1, HN, layer == 0, gw, NGW, lane);
        if (layer == 0) cvt_moe(args.in[21] + (size_t)NE * 2048 * 512, args.in[22] + (size_t)NE * 2048 * 512, args.in[23] + (size_t)NE * 512 * 2048, args.in[16] + 2048, W_GU, W_DN, gw, NGW, lane);
        PE(pb + 6);
    }
    if (layer == 0) SEAM(pb + 6);
    }
    if (IN(13)) { PB(13);
        pg8::Gemm g{HN, W_KVQ, T, KVQ_N, 2048}; pg8::StaticOrder S; S.init(T, KVQ_N, G, (int)blockIdx.x);
        pg8::EpiBf16 E{(bf16*)(ws + WS_KVQ), KVQ_N};
        pg8::gemm_phase<pg8::EpiBf16, pg8::StaticOrder, true, true>(lds + RING_OFF, g, S, E);
        PE(13);
    }
    SEAM(13);
    if (IN(14)) { PB(14); swa_attention(lds + RING_OFF, (const bf16*)(ws + WS_KVQ), args.in[9], args.in[13], args.in[10], args.in[14], (bf16*)(ws + WS_AO)); PE(14); }
    SEAM(14);
    if (IN(15)) { PB(15);
        pg8::Gemm g{(const bf16*)(ws + WS_AO), W_SWA_OUT, T, 2048, 2048}; pg8::StaticOrder S; S.init(T, 2048, G, (int)blockIdx.x);
        pg8::EpiResF32 E{out, out, 2048};
        pg8::gemm_phase<pg8::EpiResF32, pg8::StaticOrder, true, true>(lds + RING_OFF, g, S, E);
        PE(15);
    }
    SEAM(15);
    { constexpr int layer = 1; constexpr int pb = 6 + 10 * layer;
    unsigned* gcnt = (unsigned*)(ctl + CW_CNT + layer * 64);
    if (IN(pb + 0)) { PB(pb + 0); norm_rows(out, HN, gw, NGW, lane); PE(pb + 0); }
    SEAM(pb + 0);
    if (IN(pb + 1)) { PB(pb + 1);
        pg8::Gemm g{HN, W_ROUTER + (size_t)layer * 256 * 2048, T, 256, 2048}; pg8::StaticOrder S; S.init(T, 256, G, (int)blockIdx.x);
        pg8::EpiRouter E{RL};
        pg8::gemm_phase<pg8::EpiRouter, pg8::StaticOrder, true, true>(lds + RING_OFF, g, S, E);
        PE(pb + 1);
    }
    SEAM(pb + 1);
    if (IN(pb + 2)) { PB(pb + 2); moe_route(lds + RING_OFF, RL, args.in[18] + layer * 4, args.in[20] + layer * 32, gcnt, EP0, EP1, TW0, TW1); PE(pb + 2); }
    SEAM(pb + 2);
    if (IN(pb + 3)) { PB(pb + 3); { moe_build_table(lds, gcnt); moe_gather(lds, HN, (bf16*)(ws + WS_XS), EP0, EP1, SL0, SL1, gw, NGW, lane); } PE(pb + 3); }
    SEAM(pb + 3);
    if (IN(pb + 4)) { PB(pb + 4);
        moe_build_table(lds, gcnt);
        const int rows = __builtin_amdgcn_readfirstlane(((const LAS int*)(lds + MOE_OFF_OFF))[32]);
        pg8::Gemm g{(const bf16*)(ws + WS_XS), W_GU, rows, 1024, 2048};
        pg8::GroupedOrder S{(const LAS unsigned char*)(lds + MOE_TEXP_OFF), rows >> 8, 4, G, (int)blockIdx.x};
        pg8::EpiSwiGLU E{(bf16*)(ws + WS_ACT)};
        pg8::gemm_phase<pg8::EpiSwiGLU, pg8::GroupedOrder, true, true>(lds + RING_OFF, g, S, E);
        PE(pb + 4);
    }
    SEAM(pb + 4);
    if (IN(pb + 5)) { PB(pb + 5);
        moe_build_table(lds, gcnt);
        const int rows = __builtin_amdgcn_readfirstlane(((const LAS int*)(lds + MOE_OFF_OFF))[32]);
        pg8::Gemm g{(const bf16*)(ws + WS_ACT), W_DN, rows, 2048, 512};
        pg8::GroupedOrder S{(const LAS unsigned char*)(lds + MOE_TEXP_OFF), rows >> 8, 8, G, (int)blockIdx.x};
        pg8::EpiBf16 E{(bf16*)(ws + WS_Y), 2048};
        pg8::gemm_phase<pg8::EpiBf16, pg8::GroupedOrder, true, true>(lds + RING_OFF, g, S, E);
        PE(pb + 5);
    }
    SEAM(pb + 5);
    if (IN(pb + 6)) { PB(pb + 6);
        moe_combine(out, (const bf16*)(ws + WS_Y), SL0, SL1, TW0, TW1, HN, layer == 0, gw, NGW, lane);
        if (layer == 0) cvt_moe(args.in[21] + (size_t)NE * 2048 * 512, args.in[22] + (size_t)NE * 2048 * 512, args.in[23] + (size_t)NE * 512 * 2048, args.in[16] + 2048, W_GU, W_DN, gw, NGW, lane);
        PE(pb + 6);
    }
    if (layer == 0) SEAM(pb + 6);
    }
#undef IN
#undef SEAM
}

extern "C" void kernel_launch(void* const* d_in, const int* in_sizes, int n_in, void* d_out, int out_size, void* d_ws, size_t ws_size, hipStream_t stream) {
    static int grid = 0;
    if (grid == 0) {
        if (n_in != 24 || in_sizes[0] != T * D || out_size != T * D || ws_size < WS_END) { fprintf(stderr, "kernel_launch: unexpected shapes / workspace (n_in %d, in0 %d, out %d, ws %zu < %zu)\n", n_in, n_in > 0 ? in_sizes[0] : -1, out_size, ws_size, (size_t)WS_END); grid = -1; return; }
        int dev = 0, cus = 0, per_cu = 0;
        if (hipGetDevice(&dev) != hipSuccess || hipDeviceGetAttribute(&cus, hipDeviceAttributeMultiprocessorCount, dev) != hipSuccess) { grid = -1; return; }
        if (hipFuncSetAttribute((const void*)fwd, hipFuncAttributeMaxDynamicSharedMemorySize, LDS_BYTES) != hipSuccess) { fprintf(stderr, "kernel_launch: hipFuncSetAttribute failed\n"); grid = -1; return; }
        if (hipOccupancyMaxActiveBlocksPerMultiprocessor(&per_cu, (const void*)fwd, NWAVES * 64, LDS_BYTES) != hipSuccess || per_cu < 1) { fprintf(stderr, "kernel_launch: occupancy query says %d\n", per_cu); }
        (void)hipGetLastError();
        grid = cus;
    }
    if (grid < 0) return;
    if (hipMemsetAsync((char*)d_ws + WS_CTL, 0, CTL_ZERO_BYTES, stream) != hipSuccess) return;
    Args a{};
    for (int i = 0; i < 24; ++i) a.in[i] = (const float*)d_in[i];
    a.out = (float*)d_out; a.ws = (unsigned char*)d_ws;
#if MK_PER_PHASE
    for (int p = 0; p < MK_LAST_PHASE; ++p) { a.ph_lo = p; a.ph_hi = p + 1; hipLaunchKernelGGL(fwd, dim3(grid), dim3(NWAVES * 64), LDS_BYTES, stream, a); }
#else
    a.ph_lo = 0; a.ph_hi = MK_LAST_PHASE;
    hipLaunchKernelGGL(fwd, dim3(grid), dim3(NWAVES * 64), LDS_BYTES, stream, a);
#endif
    const hipError_t le = hipPeekAtLastError();
    if (le != hipSuccess) fprintf(stderr, "kernel_launch: launch failed: %s\n", hipGetErrorName(le));
}
```

```cpp
#include <hip/hip_runtime.h>
#include <cstdio>
#include <cstdint>

#ifndef MK_PER_PHASE
#define MK_PER_PHASE 0
#endif
#ifndef MK_LAST_PHASE
#define MK_LAST_PHASE 23
#endif

#ifndef MK_PHASE_MASK
#define MK_PHASE_MASK 0x7fffff
#endif

#ifndef MK_DELAY_MASK
#define MK_DELAY_MASK 0
#endif

namespace pg8 {
#define PG8_LAS __attribute__((address_space(3)))
typedef unsigned short bf16_t;
typedef short bf16x8 __attribute__((ext_vector_type(8)));
typedef float f32x4 __attribute__((ext_vector_type(4)));
typedef unsigned u32x4 __attribute__((ext_vector_type(4)));
constexpr int BM = 256, BK = 64, HALF = 128, HTB = HALF * BK * 2  , STAGE_BYTES = 8 * HTB, NXCD = 8, WGM = 8;

__host__ __device__ __forceinline__ int lds_byte(int r, int c) { const int st = (r >> 4) * 2 + (c >> 5), rr = r & 15, cc = c & 31, ob = rr * 64 + cc * 2; return st * 1024 + (ob ^ (((ob >> 9) & 1) << 5)); }
__host__ __device__ __forceinline__ void stage_rc(int b, int& R, int& C) { const int st = b / 1024, sb = b % 1024, swz = sb ^ (((sb >> 9) & 1) << 5); R = (st >> 1) * 16 + swz / 64; C = (st & 1) * 32 + (swz % 64) / 2; }
__host__ __device__ __forceinline__ int perm32(int rho) { const int n = rho >> 4, i = rho & 15; return 8 * (i >> 2) + 4 * n + (i & 3); }

struct Unit { int pm, pn, pc; };
struct Gemm { const bf16_t* A; const bf16_t* Bt; int M, N, K; const unsigned* rowidx; };


struct StaticOrder {
    int nM, nN, nwg, G, c;
    __host__ __device__ void init(int M, int N, int G_, int c_) { nM = M / BM; nN = N / BM; nwg = nM * nN; G = G_; c = c_; }
    __host__ __device__ bool next(int i, Unit& u) const {
        const long L = (long)i * G + c; if (L >= nwg) return false;
        int wgid = (int)L; { const int q = nwg / NXCD, r = nwg % NXCD, xcd = wgid % NXCD, off = wgid / NXCD; wgid = (xcd < r ? xcd * (q + 1) : r * (q + 1) + (xcd - r) * q) + off; }
        const int nig = WGM * nN, gid = wgid / nig, fm = gid * WGM, gsz = (nM - fm) < WGM ? (nM - fm) : WGM;
        u.pm = fm + ((wgid % nig) % gsz); u.pn = (wgid % nig) / gsz; u.pc = u.pn; return true;
    }
    __device__ __forceinline__ void a_ready(const Unit&) const {}
    __device__ __forceinline__ void done(const Unit&) const {}
};
struct GroupedOrder {
    const PG8_LAS unsigned char* texp; int MT, npn, G, c;
    __device__ __forceinline__ bool next(int i, Unit& u) const {
        const long L = (long)i * G + c; if (L >= (long)MT * npn) return false;
        const int pm = (int)(L / npn), pc = (int)(L % npn);
        const int e = __builtin_amdgcn_readfirstlane((int)texp[pm]);
        u.pm = pm; u.pn = e * npn + pc; u.pc = pc; return true;
    }
    __device__ __forceinline__ void a_ready(const Unit&) const {}
    __device__ __forceinline__ void done(const Unit&) const {}
};

__device__ __forceinline__ unsigned cvt_pk_bf16(float lo, float hi) { unsigned r; asm volatile("v_cvt_pk_bf16_f32 %0, %1, %2" : "=v"(r) : "v"(lo), "v"(hi)); return r; }

struct EpiBf16 {
    static constexpr bool PERM = true, AFTER_DRAIN = false;
    bf16_t* O; int ldc;
    __device__ __forceinline__ void operator()(const f32x4 (&acc)[2][2][4][2], const Unit& u, int wr, int wc, int fr, int fq) const {
        const int row0 = u.pm * BM + wr * 64 + fr, col0 = u.pc * BM + wc * 32 + 8 * fq;
#pragma unroll
        for (int ai = 0; ai < 2; ++ai)
#pragma unroll
            for (int m = 0; m < 4; ++m) { bf16_t* rowp = O + (size_t)(row0 + ai * HALF + m * 16) * ldc + col0;
#pragma unroll
                for (int bj = 0; bj < 2; ++bj) { const f32x4 v0 = acc[ai][bj][m][0], v1 = acc[ai][bj][m][1];
                    u32x4 w; w.x = cvt_pk_bf16(v0[0], v0[1]); w.y = cvt_pk_bf16(v0[2], v0[3]); w.z = cvt_pk_bf16(v1[0], v1[1]); w.w = cvt_pk_bf16(v1[2], v1[3]);
                    *(u32x4*)(rowp + bj * HALF) = w; } }
    }
};
struct EpiGlaProj {
    static constexpr bool PERM = true, AFTER_DRAIN = false;
    bf16_t *QK, *V, *R, *GL;
    __device__ __forceinline__ void operator()(const f32x4 (&acc)[2][2][4][2], const Unit& u, int wr, int wc, int fr, int fq) const {
        bf16_t* base; int ldc, ct;
        if (u.pc < 8) { base = QK; ldc = 2048; ct = u.pc; } else if (u.pc < 16) { base = V; ldc = 2048; ct = u.pc - 8; } else if (u.pc < 24) { base = R; ldc = 2048; ct = u.pc - 16; } else { base = GL; ldc = 256; ct = 0; }
        const int row0 = u.pm * BM + wr * 64 + fr, col0 = ct * BM + wc * 32 + 8 * fq;
#pragma unroll
        for (int ai = 0; ai < 2; ++ai)
#pragma unroll
            for (int m = 0; m < 4; ++m) { bf16_t* rowp = base + (size_t)(row0 + ai * HALF + m * 16) * ldc + col0;
#pragma unroll
                for (int bj = 0; bj < 2; ++bj) { const f32x4 v0 = acc[ai][bj][m][0], v1 = acc[ai][bj][m][1];
                    u32x4 w; w.x = cvt_pk_bf16(v0[0], v0[1]); w.y = cvt_pk_bf16(v0[2], v0[3]); w.z = cvt_pk_bf16(v1[0], v1[1]); w.w = cvt_pk_bf16(v1[2], v1[3]);
                    *(u32x4*)(rowp + bj * HALF) = w; } }
    }
};
struct EpiResF32 {
    static constexpr bool PERM = true, AFTER_DRAIN = false;
    float* C; const float* RES; int ldc; bf16_t* HB; float* SSP;
    __device__ __forceinline__ void operator()(const f32x4 (&acc)[2][2][4][2], const Unit& u, int wr, int wc, int fr, int fq) const {
        const int row0 = u.pm * BM + wr * 64 + fr, col0 = u.pc * BM + wc * 32 + 8 * fq;
#pragma unroll
        for (int ai = 0; ai < 2; ++ai)
#pragma unroll
            for (int m = 0; m < 4; ++m) { const int row = row0 + ai * HALF + m * 16; const size_t off = (size_t)row * ldc + col0;
                f32x4 rv[2][2];
#pragma unroll
                for (int bj = 0; bj < 2; ++bj)
#pragma unroll
                    for (int n = 0; n < 2; ++n) rv[bj][n] = *(const f32x4*)(RES + off + bj * HALF + n * 4);
                float ss = 0.f;
#pragma unroll
                for (int bj = 0; bj < 2; ++bj) { const f32x4 v0 = acc[ai][bj][m][0] + rv[bj][0], v1 = acc[ai][bj][m][1] + rv[bj][1];
                    *(f32x4*)(C + off + bj * HALF) = v0; *(f32x4*)(C + off + bj * HALF + 4) = v1;
                    u32x4 w; w.x = cvt_pk_bf16(v0[0], v0[1]); w.y = cvt_pk_bf16(v0[2], v0[3]); w.z = cvt_pk_bf16(v1[0], v1[1]); w.w = cvt_pk_bf16(v1[2], v1[3]);
                    *(u32x4*)(HB + off + bj * HALF) = w;
                    ss += (v0[0] * v0[0] + v0[1] * v0[1]) + (v0[2] * v0[2] + v0[3] * v0[3]) + (v1[0] * v1[0] + v1[1] * v1[1]) + (v1[2] * v1[2] + v1[3] * v1[3]); }
                ss += __shfl_xor(ss, 16); ss += __shfl_xor(ss, 32);
                if (fq == 0) SSP[(size_t)row * 32 + u.pc * 4 + wc] = ss; }
    }
};
struct EpiRouter {
    static constexpr bool PERM = false, AFTER_DRAIN = false;
    float* RL;
    __device__ __forceinline__ void operator()(const f32x4 (&acc)[2][2][4][2], const Unit& u, int wr, int wc, int fr, int fq) const {
        if (wc >= 2) return;
        const int row0 = u.pm * BM + wr * 64 + fr, col0 = wc * 32 + 4 * fq;
#pragma unroll
        for (int ai = 0; ai < 2; ++ai)
#pragma unroll
            for (int m = 0; m < 4; ++m) { float* rowp = RL + (size_t)(row0 + ai * HALF + m * 16) * 64 + col0;
#pragma unroll
                for (int n = 0; n < 2; ++n) *(f32x4*)(rowp + n * 16) = acc[ai][0][m][n]; }
    }
};
__device__ __forceinline__ float silu_f(float x) { return x * __builtin_amdgcn_rcpf(1.0f + __expf(-x)); }
struct EpiSwiGLU {
    static constexpr bool PERM = true, AFTER_DRAIN = false;
    bf16_t* ACT; const float* RS;
    __device__ __forceinline__ void operator()(const f32x4 (&acc)[2][2][4][2], const Unit& u, int wr, int wc, int fr, int fq) const {
        const int row0 = u.pm * BM + wr * 64 + fr, col0 = u.pc * HALF + wc * 32 + 8 * fq;
#pragma unroll
        for (int ai = 0; ai < 2; ++ai)
#pragma unroll
            for (int m = 0; m < 4; ++m) { const int row = row0 + ai * HALF + m * 16; bf16_t* rowp = ACT + (size_t)row * 512 + col0; const float rs = RS[row];
                const f32x4 g0 = acc[ai][0][m][0] * rs, g1 = acc[ai][0][m][1] * rs, u0 = acc[ai][1][m][0] * rs, u1 = acc[ai][1][m][1] * rs;
                u32x4 w;
                w.x = cvt_pk_bf16(silu_f(g0[0]) * u0[0], silu_f(g0[1]) * u0[1]); w.y = cvt_pk_bf16(silu_f(g0[2]) * u0[2], silu_f(g0[3]) * u0[3]);
                w.z = cvt_pk_bf16(silu_f(g1[0]) * u1[0], silu_f(g1[1]) * u1[1]); w.w = cvt_pk_bf16(silu_f(g1[2]) * u1[2], silu_f(g1[3]) * u1[3]);
                *(u32x4*)rowp = w; }
    }
};

template <class Epi, class Sched, bool ALIGN_EPI = false, bool SP2 = false, bool GATHER = false>
__device__ __forceinline__ void gemm_phase(PG8_LAS unsigned char* lds, const Gemm g, const Sched& S, const Epi& E) {
    const int tid = threadIdx.x, wid = __builtin_amdgcn_readfirstlane(tid >> 6), lane = tid & 63, wr = wid >> 2, wc = wid & 3, fr = lane & 15, fq = lane >> 4;
    const int K = g.K, nt = K / BK;
    unsigned voffA[2], voffB[2];
#pragma unroll
    for (int i = 0; i < 2; ++i) { int R, C; stage_rc(tid * 16 + i * 8192, R, C); const int Rb = Epi::PERM ? ((R & ~31) + perm32(R & 31)) : R;
        voffA[i] = (unsigned)(R * K + C) * 2u; voffB[i] = (unsigned)(Rb * K + C) * 2u; }
    unsigned vA[2][2] = {{0u, 0u}, {0u, 0u}}, vAn[2][2] = {{0u, 0u}, {0u, 0u}}; int rA[2] = {0, 0}; unsigned cbA[2] = {0u, 0u};
    if constexpr (GATHER) {
#pragma unroll
        for (int i = 0; i < 2; ++i) { int R, C; stage_rc(tid * 16 + i * 8192, R, C); rA[i] = R; cbA[i] = (unsigned)C * 2u; } }
#define PG8_GIDX(dst, pmv) do { _Pragma("unroll") for (int _h = 0; _h < 2; ++_h) _Pragma("unroll") for (int _i = 0; _i < 2; ++_i) \
        dst[_h][_i] = g.rowidx[(size_t)(pmv) * BM + _h * HALF + rA[_i]] * (unsigned)(K * 2) + cbA[_i]; } while (0)
    const size_t kstep = (size_t)(BK * 2);
    const size_t hstep = (size_t)HALF * K * 2;
    const size_t tstep = 2 * hstep;
    const unsigned ldsw = (unsigned)wid * 1024u;
    const int aoff = lds_byte(wr * 64 + fr, fq * 8), boff = lds_byte(wc * 32 + fr, fq * 8);
#define PG8_SA(b, h) (((b) * 2 + (h)) * HTB)
#define PG8_SB(b, h) ((4 + (b) * 2 + (h)) * HTB)
#define PG8_STAGE(bufoff, gbase, voff) do { _Pragma("unroll") for (int _i = 0; _i < 2; ++_i) \
        __builtin_amdgcn_global_load_lds((const unsigned*)((const char*)(gbase) + (voff)[_i]), (PG8_LAS unsigned*)(lds + (bufoff) + ldsw + _i * 8192), 16, 0, 0); } while (0)
#define PG8_STAGE_A(bufoff, nx, kb, h) do { if constexpr (GATHER) { const char* _b = (const char*)g.A + (kb); \
        _Pragma("unroll") for (int _i = 0; _i < 2; ++_i) { const unsigned _v = (nx) ? vAn[h][_i] : vA[h][_i]; \
            __builtin_amdgcn_global_load_lds((const unsigned*)(_b + _v), (PG8_LAS unsigned*)(lds + (bufoff) + ldsw + _i * 8192), 16, 0, 0); } } \
    else { const char* _b = ((nx) ? nA : cA) + (kb) + (size_t)(h) * hstep; PG8_STAGE(bufoff, _b, voffA); } } while (0)
#define PG8_LDA(dst, b, h) do { _Pragma("unroll") for (int m = 0; m < 4; ++m) _Pragma("unroll") for (int k = 0; k < 2; ++k) dst[m][k] = *(const PG8_LAS bf16x8*)(lds + PG8_SA(b, h) + aoff + m * 2048 + k * 1024); } while (0)
#define PG8_LDB(dst, b, h) do { _Pragma("unroll") for (int n = 0; n < 2; ++n) _Pragma("unroll") for (int k = 0; k < 2; ++k) dst[n][k] = *(const PG8_LAS bf16x8*)(lds + PG8_SB(b, h) + boff + n * 2048 + k * 1024); } while (0)
#define PG8_MMA(ai, bj, At, Bt) do { __builtin_amdgcn_s_setprio(1); _Pragma("unroll") for (int m = 0; m < 4; ++m) _Pragma("unroll") for (int n = 0; n < 2; ++n) _Pragma("unroll") for (int k = 0; k < 2; ++k) \
        acc[ai][bj][m][n] = __builtin_amdgcn_mfma_f32_16x16x32_bf16(Bt[n][k], At[m][k], acc[ai][bj][m][n], 0, 0, 0); __builtin_amdgcn_s_setprio(0); } while (0)
#define PG8_WAIT_V(n) asm volatile("s_waitcnt vmcnt(" #n ")" ::: "memory")
#define PG8_WAIT_L(n) asm volatile("s_waitcnt lgkmcnt(" #n ")" ::: "memory")
#define PG8_BAR __builtin_amdgcn_s_barrier()
#define PG8_SCHED __builtin_amdgcn_sched_barrier(0)
    Unit cur, nxt; int ui = 0;
    if (!S.next(0, cur)) return;
    f32x4 acc[2][2][4][2];
#pragma unroll
    for (int a = 0; a < 2; ++a)
#pragma unroll
        for (int b = 0; b < 2; ++b)
#pragma unroll
            for (int m = 0; m < 4; ++m)
#pragma unroll
                for (int n = 0; n < 2; ++n) acc[a][b][m][n] = (f32x4){0.f, 0.f, 0.f, 0.f};
    bf16x8 At[4][2], B0[2][2], B1[2][2];
    const char* cA = (const char*)g.A + (size_t)cur.pm * tstep; const char* cB = (const char*)g.Bt + (size_t)cur.pn * tstep;
    const char* nA = cA; const char* nB = cB;
    if constexpr (GATHER) { PG8_GIDX(vA, cur.pm); }
    S.a_ready(cur);
    if constexpr (SP2) {
        PG8_STAGE(PG8_SB(0, 0), cB, voffB); PG8_STAGE(PG8_SB(0, 1), cB + hstep, voffB); PG8_STAGE_A(PG8_SA(0, 0), false, 0, 0); PG8_STAGE_A(PG8_SA(0, 1), false, 0, 1);
        if (wr == 1) PG8_BAR;
        PG8_WAIT_V(2); PG8_BAR;
        PG8_STAGE(PG8_SB(1, 0), cB + kstep, voffB); PG8_STAGE_A(PG8_SA(1, 0), false, kstep, 0); PG8_STAGE(PG8_SB(1, 1), cB + hstep + kstep, voffB);
        PG8_WAIT_V(6); PG8_BAR;
    } else {
        PG8_STAGE(PG8_SB(0, 0), cB, voffB); PG8_STAGE(PG8_SA(0, 0), cA, voffA); PG8_STAGE(PG8_SB(0, 1), cB + hstep, voffB); PG8_STAGE(PG8_SA(0, 1), cA + hstep, voffA);
        if (wr == 1) PG8_BAR;
        PG8_WAIT_V(4); PG8_BAR;
        PG8_STAGE(PG8_SB(1, 0), cB + kstep, voffB); PG8_STAGE(PG8_SA(1, 0), cA + kstep, voffA); PG8_STAGE(PG8_SB(1, 1), cB + hstep + kstep, voffB);
        PG8_WAIT_V(6); PG8_BAR;
    }
    for (;;) {
        const bool has_next = S.next(ui + 1, nxt);
        nA = has_next ? (const char*)g.A + (size_t)nxt.pm * tstep : cA; nB = has_next ? (const char*)g.Bt + (size_t)nxt.pn * tstep : cB;
        if constexpr (GATHER) { if (has_next) { PG8_GIDX(vAn, nxt.pm); } else {
#pragma unroll
            for (int _h = 0; _h < 2; ++_h) { vAn[_h][0] = vA[_h][0]; vAn[_h][1] = vA[_h][1]; } } }
        for (int t = 0; t < nt; t += 2) {
            const bool last = (t == nt - 2);
            const char* a1 = cA + (size_t)(t + 1) * kstep;
            const char* a2 = last ? nA : cA + (size_t)(t + 2) * kstep; const char* b2 = last ? nB : cB + (size_t)(t + 2) * kstep;
            const char* a3 = a2 + kstep; const char* b3 = b2 + kstep;
            const size_t ka1 = (size_t)(t + 1) * kstep, ka2 = last ? (size_t)0 : (size_t)(t + 2) * kstep, ka3 = ka2 + kstep; (void)a1; (void)a3;
            if (last && has_next) S.a_ready(nxt);
            if constexpr (SP2) {
            PG8_LDB(B0, 0, 0); PG8_LDB(B1, 0, 1); PG8_SCHED; PG8_LDA(At, 0, 0); PG8_STAGE_A(PG8_SA(1, 1), false, ka1, 1);
            PG8_WAIT_V(8); PG8_WAIT_L(0); PG8_BAR; PG8_MMA(0, 0, At, B0); PG8_MMA(0, 1, At, B1); PG8_BAR; PG8_SCHED;
            PG8_LDA(At, 0, 1); PG8_STAGE(PG8_SB(0, 0), b2, voffB); PG8_STAGE(PG8_SB(0, 1), b2 + hstep, voffB); PG8_STAGE_A(PG8_SA(0, 0), last, ka2, 0);
            PG8_WAIT_V(8); PG8_WAIT_L(0); PG8_BAR; PG8_MMA(1, 0, At, B0); PG8_MMA(1, 1, At, B1); PG8_BAR; PG8_SCHED;
            PG8_LDB(B0, 1, 0); PG8_LDB(B1, 1, 1); PG8_SCHED; PG8_LDA(At, 1, 0); PG8_STAGE_A(PG8_SA(0, 1), last, ka2, 1);
            PG8_WAIT_V(8); PG8_WAIT_L(0); PG8_BAR; PG8_MMA(0, 0, At, B0); PG8_MMA(0, 1, At, B1); PG8_BAR; PG8_SCHED;
            PG8_LDA(At, 1, 1); PG8_STAGE(PG8_SB(1, 0), b3, voffB); PG8_STAGE(PG8_SB(1, 1), b3 + hstep, voffB); PG8_STAGE_A(PG8_SA(1, 0), last, ka3, 0);
            PG8_WAIT_V(8); PG8_WAIT_L(0); PG8_BAR; PG8_MMA(1, 0, At, B0); PG8_MMA(1, 1, At, B1); PG8_BAR; PG8_SCHED;
            } else {
            PG8_LDB(B0, 0, 0); PG8_SCHED; PG8_LDA(At, 0, 0); PG8_STAGE(PG8_SA(1, 1), a1 + hstep, voffA);
            PG8_WAIT_L(8); PG8_BAR; PG8_WAIT_L(0); PG8_MMA(0, 0, At, B0); PG8_BAR; PG8_SCHED;
            PG8_LDB(B1, 0, 1); PG8_STAGE(PG8_SB(0, 0), b2, voffB);
            PG8_BAR; PG8_WAIT_L(0); PG8_MMA(0, 1, At, B1); PG8_BAR;
            PG8_LDA(At, 0, 1); PG8_STAGE(PG8_SA(0, 0), a2, voffA);
            PG8_BAR; PG8_WAIT_L(0); PG8_MMA(1, 0, At, B0); PG8_BAR; PG8_SCHED;
            PG8_STAGE(PG8_SB(0, 1), b2 + hstep, voffB);
            PG8_WAIT_V(6); PG8_BAR; PG8_MMA(1, 1, At, B1); PG8_BAR;
            PG8_LDB(B0, 1, 0); PG8_SCHED; PG8_LDA(At, 1, 0); PG8_STAGE(PG8_SA(0, 1), a2 + hstep, voffA);
            PG8_WAIT_L(8); PG8_BAR; PG8_WAIT_L(0); PG8_MMA(0, 0, At, B0); PG8_BAR; PG8_SCHED;
            PG8_LDB(B1, 1, 1); PG8_STAGE(PG8_SB(1, 0), b3, voffB);
            PG8_BAR; PG8_WAIT_L(0); PG8_MMA(0, 1, At, B1); PG8_BAR;
            PG8_LDA(At, 1, 1); PG8_STAGE(PG8_SA(1, 0), a3, voffA);
            PG8_BAR; PG8_WAIT_L(0); PG8_MMA(1, 0, At, B0); PG8_BAR; PG8_SCHED;
            PG8_STAGE(PG8_SB(1, 1), b3 + hstep, voffB);
            PG8_WAIT_V(6); PG8_BAR; PG8_MMA(1, 1, At, B1); PG8_BAR;
            }
        }
        if constexpr (ALIGN_EPI) { if (wr == 0) PG8_BAR; }
        if constexpr (!Epi::AFTER_DRAIN) { E(acc, cur, wr, wc, fr, fq); S.done(cur); }
        if (!has_next) break;
#pragma unroll
        for (int a = 0; a < 2; ++a)
#pragma unroll
            for (int b = 0; b < 2; ++b)
#pragma unroll
                for (int m = 0; m < 4; ++m)
#pragma unroll
                    for (int n = 0; n < 2; ++n) acc[a][b][m][n] = (f32x4){0.f, 0.f, 0.f, 0.f};
        cur = nxt; cA = nA; cB = nB; ++ui;
        if constexpr (GATHER) {
#pragma unroll
            for (int _h = 0; _h < 2; ++_h) { vA[_h][0] = vAn[_h][0]; vA[_h][1] = vAn[_h][1]; } }
        if constexpr (ALIGN_EPI) { if (wr == 1) PG8_BAR; }
    }
    PG8_WAIT_V(0);
    if constexpr (!ALIGN_EPI) { if (wr == 0) PG8_BAR; }
    PG8_BAR;
    if constexpr (Epi::AFTER_DRAIN) { E.fused(acc, cur, wr, wc, fr, fq, lds, wid, lane); S.done(cur); }
#undef PG8_SA
#undef PG8_STAGE_A
#undef PG8_GIDX
#undef PG8_SB
#undef PG8_STAGE
#undef PG8_LDA
#undef PG8_LDB
#undef PG8_MMA
#undef PG8_WAIT_V
#undef PG8_WAIT_L
#undef PG8_BAR
#undef PG8_SCHED
}
}

constexpr int NWAVES = 8;
constexpr int T = 32768, D = 2048, SEQ = 16384;
constexpr float RMS_EPS = 1e-6f;
constexpr int GLA_H = 4, GLA_DK = 256, GLA_DV = 512, GLA_C = 64, GLA_NCH = SEQ / GLA_C  , GLA_PROJ_N = 6160, GLA_PROJ_NP = 6400;
constexpr int NITEM_GLA = 2 * GLA_H * GLA_NCH;
constexpr int SWA_HQ = 32, SWA_HKV = 4, SWA_HD = 64, SWA_W = 128, KVQ_N = 2560;
constexpr int NE = 32, FF = 512, MOE_MAXROWS = 2 * T + NE * 256;

constexpr size_t MiB = 1u << 20;
constexpr size_t WS_CTL = 0, CTL_ZERO_BYTES = 1 * MiB;
constexpr size_t WS_W_GLA_IN = 1 * MiB;
constexpr size_t WS_W_GLA_OUT = 26 * MiB;
constexpr size_t WS_W_KVQ = 34 * MiB;
constexpr size_t WS_W_SWA_OUT = 44 * MiB;
constexpr size_t WS_W_ROUTER = 52 * MiB;
constexpr size_t WS_TOK = 54 * MiB;
constexpr size_t WS_RL = 56 * MiB;
constexpr size_t WS_W_GU = 64 * MiB;
constexpr size_t WS_W_DN = 192 * MiB;
constexpr size_t WS_HN = 256 * MiB;
constexpr size_t WS_BIG = 384 * MiB;
constexpr size_t WS_QK = WS_BIG;
constexpr size_t WS_V = WS_BIG + 128 * MiB;
constexpr size_t WS_R = WS_BIG + 256 * MiB;
constexpr size_t WS_GL = WS_BIG + 384 * MiB;
constexpr size_t WS_QEF = WS_BIG + 400 * MiB;
constexpr size_t WS_KLTF = WS_BIG + 464 * MiB;
constexpr size_t WS_ATTF = WS_BIG + 528 * MiB;
constexpr size_t WS_VTF = WS_BIG + 544 * MiB;
constexpr size_t WS_DEC = WS_BIG + 672 * MiB;
constexpr size_t WS_GLA_END = WS_BIG + 674 * MiB;
constexpr size_t WS_SSP = WS_BIG;
constexpr size_t WS_TL = WS_BIG + 8 * MiB;
constexpr size_t WS_RS = WS_BIG + 9 * MiB;
constexpr size_t WS_HB = WS_BIG + 16 * MiB;
constexpr size_t WS_ACT = WS_BIG + 288 * MiB;
constexpr size_t WS_Y = WS_BIG + 360 * MiB;
constexpr size_t WS_KVQ = WS_BIG;
constexpr size_t WS_AO = WS_BIG + 160 * MiB;
constexpr size_t WS_END = WS_GLA_END;
static_assert(WS_Y + (size_t)MOE_MAXROWS * 2048 * 2 <= WS_END && WS_ACT + (size_t)MOE_MAXROWS * 512 * 2 <= WS_Y, "MoE map");
constexpr int CW_BAR = 4096;
constexpr int CW_CNT = 16384;

constexpr int RING_OFF = 0, RING_BYTES = 131072;
constexpr int LDSCTL_OFF = RING_BYTES;
constexpr int MISC_OFF = LDSCTL_OFF + 64;
constexpr int MOE_OFF_OFF = LDSCTL_OFF + 256;
constexpr int MOE_TEXP_OFF = LDSCTL_OFF + 512;
constexpr int LDS_BYTES = 147456;

#define GAS __attribute__((address_space(1)))
#define LAS __attribute__((address_space(3)))
typedef unsigned short bf16;
typedef unsigned v4u __attribute__((ext_vector_type(4)));
typedef unsigned v2u __attribute__((ext_vector_type(2)));
typedef float f32x4 __attribute__((ext_vector_type(4)));
typedef short bf16x8 __attribute__((ext_vector_type(8)));
typedef GAS unsigned gu32;
#define RLX_AGENT __ATOMIC_RELAXED, __HIP_MEMORY_SCOPE_AGENT
#define LDS_WAIT() asm volatile("s_waitcnt lgkmcnt(0)" ::: "memory")
#define VM_WAIT() asm volatile("s_waitcnt vmcnt(0)" ::: "memory")
__device__ __forceinline__ unsigned f2bf(float f) { unsigned u = __builtin_bit_cast(unsigned, f); return (u + 0x7fffu + ((u >> 16) & 1u)) >> 16; }
__device__ __forceinline__ unsigned pk2(float lo, float hi) { return pg8::cvt_pk_bf16(lo, hi); }
__device__ __forceinline__ float bf_lo(unsigned w) { return __builtin_bit_cast(float, w << 16); }
__device__ __forceinline__ float bf_hi(unsigned w) { return __builtin_bit_cast(float, w & 0xffff0000u); }
__device__ __forceinline__ float bf2f(bf16 b) { return __builtin_bit_cast(float, ((unsigned)b) << 16); }
__device__ __forceinline__ float wave_sum(float v) {
#pragma unroll
    for (int o = 1; o < 64; o <<= 1) v += __shfl_xor(v, o);
    return v;
}

#define XB_TMO      128
#define XB_XCNT(j)  (256  + 64 * (j))
#define XB_XSUB(j)  (1280 + 64 * (j))
#define XB_XGEN(j)  (2304 + 64 * (j))
#define XB_TOP      3328
#define XB_TOPGEN   3392
#define XCD_BAR_WORDS 3456
#define XB_SPIN_CAP (1u << 18)

__device__ __forceinline__ unsigned xb_ld(unsigned* p)              { return __hip_atomic_load(p, __ATOMIC_RELAXED, __HIP_MEMORY_SCOPE_AGENT); }
__device__ __forceinline__ unsigned xb_add(unsigned* p, unsigned v) { return __hip_atomic_fetch_add(p, v, __ATOMIC_RELAXED, __HIP_MEMORY_SCOPE_AGENT); }
__device__ __forceinline__ unsigned xb_xcc_id() { return (unsigned)__builtin_amdgcn_s_getreg((3 << 11) | 20) & 0xFu; }
#define XB_SPIN(cond, bar) do { unsigned _sp = 0; while (cond) { __builtin_amdgcn_s_sleep(1); \
    if ((++_sp & 255u) == 0u) { if (xb_ld(&(bar)[XB_TMO])) break; if (_sp > XB_SPIN_CAP) { atomicAdd(&(bar)[XB_TMO], 1u); break; } } } } while (0)

struct XcdBarrier {
    unsigned* bar; unsigned x;
    volatile LAS unsigned* st;
};

__device__ __forceinline__ XcdBarrier xcd_barrier_post(unsigned* bar, volatile LAS unsigned* st) {
    XcdBarrier b; b.bar = bar; b.x = xb_xcc_id(); b.st = st;
    if (threadIdx.x == 0) (void)xb_add(&bar[XB_XCNT(b.x)], 1u);
    return b;
}
__device__ __forceinline__ void xcd_barrier_complete(unsigned* bar, unsigned x, unsigned& nloc, unsigned& nx) {
    const unsigned G = gridDim.x * gridDim.y * gridDim.z;
    unsigned sum, cnt, mine, sp = 0u;
    for (;;) {
        sum = 0u; cnt = 0u; mine = 0u;
#pragma unroll
        for (unsigned j = 0; j < 16; ++j) { const unsigned c = xb_ld(&bar[XB_XCNT(j)]); sum += c; cnt += (c > 0u) ? 1u : 0u; mine = (j == x) ? c : mine; }
        if (sum == G) break;
        __builtin_amdgcn_s_sleep(1);
        if ((++sp & 255u) == 0u) { if (xb_ld(&bar[XB_TMO])) break; if (sp > XB_SPIN_CAP) { atomicAdd(&bar[XB_TMO], 1u); break; } }
    }
    nloc = mine > 0u ? mine : 1u; nx = cnt > 0u ? cnt : 1u;
}

__device__ __forceinline__ void xcd_barrier(const XcdBarrier& b) {
    asm volatile("s_waitcnt vmcnt(0)" ::: "memory");
    __syncthreads();
    if (threadIdx.x == 0) {
        unsigned* bar = b.bar;
        __builtin_amdgcn_s_waitcnt(0);
        unsigned nloc = b.st[0], nx = b.st[1];
        if (nloc == 0u) { xcd_barrier_complete(bar, b.x, nloc, nx); b.st[0] = nloc; b.st[1] = nx; }
        const unsigned old = xb_add(&bar[XB_XSUB(b.x)], 1u);
        const unsigned gen = old / nloc;
        if (old + 1u == (gen + 1u) * nloc) {
            __builtin_amdgcn_fence(__ATOMIC_RELEASE, "agent");
            asm volatile("s_waitcnt vmcnt(0)" ::: "memory");
            const unsigned og = xb_add(&bar[XB_TOP], 1u);
            const unsigned tg = og / nx;
            if (og + 1u == (tg + 1u) * nx) xb_add(&bar[XB_TOPGEN], 1u);
            else XB_SPIN(xb_ld(&bar[XB_TOPGEN]) == tg, bar);
            __builtin_amdgcn_fence(__ATOMIC_ACQUIRE, "agent");
            xb_add(&bar[XB_XGEN(b.x)], 1u);
            asm volatile("s_waitcnt vmcnt(0)" ::: "memory");
        } else {
            XB_SPIN(xb_ld(&bar[XB_XGEN(b.x)]) == gen, bar);
            __builtin_amdgcn_fence(__ATOMIC_ACQUIRE, "agent");
            asm volatile("s_waitcnt vmcnt(0)" ::: "memory");
        }
    }
    __syncthreads();
}


__device__ __forceinline__ void cvt_item(const float* W, int N, const float* gain, bf16* WT, int K, int k0, int n0, size_t dst_row0, int lane) {
    const int q = lane >> 4, c = lane & 15;
    const bool ok = (n0 + 4 * c) < N;
    const GAS f32x4* src = (const GAS f32x4*)(W + (size_t)(k0 + 16 * q) * N + n0 + 4 * c);
    f32x4 v[16];
#pragma unroll
    for (int i = 0; i < 16; ++i) v[i] = ok ? src[(size_t)i * (N / 4)] : (f32x4){0.f, 0.f, 0.f, 0.f};
    if (gain) { const GAS f32x4* gp = (const GAS f32x4*)(gain + k0 + 16 * q);
#pragma unroll
        for (int i4 = 0; i4 < 4; ++i4) { const f32x4 g = gp[i4]; v[4 * i4 + 0] = v[4 * i4 + 0] * g.x; v[4 * i4 + 1] = v[4 * i4 + 1] * g.y; v[4 * i4 + 2] = v[4 * i4 + 2] * g.z; v[4 * i4 + 3] = v[4 * i4 + 3] * g.w; } }
    if (ok) {
#pragma unroll
        for (int e = 0; e < 4; ++e) { bf16* dst = WT + (dst_row0 + 4 * c + e) * (size_t)K + k0 + 16 * q;
            v4u o0, o1;
            o0.x = pk2(v[0][e], v[1][e]); o0.y = pk2(v[2][e], v[3][e]); o0.z = pk2(v[4][e], v[5][e]); o0.w = pk2(v[6][e], v[7][e]);
            o1.x = pk2(v[8][e], v[9][e]); o1.y = pk2(v[10][e], v[11][e]); o1.z = pk2(v[12][e], v[13][e]); o1.w = pk2(v[14][e], v[15][e]);
            *(GAS v4u*)dst = o0; *(GAS v4u*)(dst + 8) = o1; } }
}
__device__ __forceinline__ void cvt_matrix(const float* W, int K, int N, const float* gain, bf16* WT, int rowbase, int gw, int NGW, int lane) {
    const int nblk = (N + 63) / 64, nitems = (K / 64) * nblk;
    for (int it = gw; it < nitems; it += NGW) { const int kb = it / nblk, nb = it - kb * nblk;
        cvt_item(W, N, gain, WT, K, kb * 64, nb * 64, (size_t)(rowbase + nb * 64), lane); }
}
__device__ __forceinline__ void cvt_moe(const float* wg, const float* wu, const float* wd, const float* gain, bf16* WGU, bf16* WDN, int gw, int NGW, int lane) {
    for (int it = gw; it < 2 * 8192; it += NGW) { const int which = it >> 13, r = it & 8191, e = r >> 8, q = r & 255, kb = q >> 3, nb = q & 7, n0 = nb * 64;
        const float* W = (which ? wu : wg) + (size_t)e * 2048 * 512;
        const size_t dst = (size_t)e * 1024 + 256 * (n0 >> 7) + (n0 & 127) + (which ? 128 : 0);
        cvt_item(W, 512, gain, WGU, 2048, kb * 64, n0, dst, lane); }
    for (int it = gw; it < 8192; it += NGW) { const int e = it >> 8, q = it & 255, kb = q >> 5, nb = q & 31;
        cvt_item(wd + (size_t)e * 512 * 2048, 2048, nullptr, WDN + (size_t)e * 2048 * 512, 512, kb * 64, nb * 64, (size_t)(nb * 64), lane); }
}
__device__ __forceinline__ void norm_rows(const float* src, bf16* dst, int gw, int NGW, int lane) {
    for (int m = gw; m < T; m += NGW) {
        const GAS f32x4* xr = (const GAS f32x4*)(src + (size_t)m * D) + lane;
        f32x4 v[8]; float s = 0.f;
#pragma unroll
        for (int j = 0; j < 8; ++j) { v[j] = xr[64 * j]; s += (v[j].x * v[j].x + v[j].y * v[j].y) + (v[j].z * v[j].z + v[j].w * v[j].w); }
        const float rstd = rsqrtf(wave_sum(s) * (1.f / D) + RMS_EPS);
        GAS v2u* o8 = (GAS v2u*)(dst + (size_t)m * D) + lane;
#pragma unroll
        for (int j = 0; j < 8; ++j) { v2u o; o.x = pk2(v[j].x * rstd, v[j].y * rstd); o.y = pk2(v[j].z * rstd, v[j].w * rstd); o8[64 * j] = o; }
    }
}

__device__ __forceinline__ float logsig(float z) { return fminf(z, 0.f) - __logf(1.f + __expf(-fabsf(z))); }
constexpr int GP_QE = 0, GP_KE = 33792, GP_ATT = 67584, GP_GLF = 76800, GP_TOT = 81152;
__device__ __forceinline__ void gla_prepass(LAS unsigned char* lds, const bf16* QK, const bf16* V, const bf16* GL, const float* Wgu, const float* bgate,
                                            bf16* QEF, bf16* KLTF, bf16* ATTF, bf16* VTF, float* DEC) {
    const int tid = threadIdx.x, lane = tid & 63, wave = __builtin_amdgcn_readfirstlane(tid >> 6), d = tid & 255, half = tid >> 8;
    LAS bf16* QEl = (LAS bf16*)(lds + GP_QE); LAS bf16* KEl = (LAS bf16*)(lds + GP_KE); LAS bf16* ATl = (LAS bf16*)(lds + GP_ATT);
    LAS float* glf = (LAS float*)(lds + GP_GLF); LAS float* tot = (LAS float*)(lds + GP_TOT);
    for (int it = blockIdx.x; it < NITEM_GLA; it += gridDim.x) {
        const int bh = it >> 8, n = it & 255, h = bh & 3, b = bh >> 2; const int t0 = b * SEQ + n * GLA_C;
        __syncthreads();
        { const int c = tid >> 3, j2 = (tid & 7) * 2; const unsigned w = *(const GAS unsigned*)(GL + (size_t)(t0 + c) * 256 + j2); glf[c * 17 + j2] = bf_lo(w); glf[c * 17 + j2 + 1] = bf_hi(w); }
        float wg[16];
#pragma unroll
        for (int j = 0; j < 16; ++j) wg[j] = Wgu[j * 1024 + h * 256 + d];
        const float bg = bgate[h * 256 + d];
        __syncthreads();
        float la[32]; float run = 0.f;
#pragma unroll
        for (int i = 0; i < 32; ++i) { const int c = half * 32 + i; float z = bg;
#pragma unroll
            for (int j = 0; j < 16; ++j) z += glf[c * 17 + j] * wg[j];
            run += fmaxf(logsig(z) * 0.0625f, -1.0f); la[i] = run; }
        tot[half * 256 + d] = run;
        __syncthreads();
        const float other = tot[(1 - half) * 256 + d]; const float blast = run + other, offs = half ? other : 0.f;
        const bf16* qp = QK + (size_t)t0 * 2048 + h * 256 + d;
#pragma unroll
        for (int g = 0; g < 4; ++g) { float klv[8];
#pragma unroll
            for (int jj = 0; jj < 8; ++jj) { const int i = 8 * g + jj, c = half * 32 + i; const float bb = la[i] + offs;
                const float qv = bf2f(qp[(size_t)c * 2048]), kv = bf2f(qp[(size_t)c * 2048 + 1024]);
                QEl[c * 264 + d] = (bf16)f2bf(qv * 0.0625f * __expf(bb)); KEl[c * 264 + d] = (bf16)f2bf(kv * __expf(-bb)); klv[jj] = kv * __expf(blast - bb); }
            v4u o; o.x = pk2(klv[0], klv[1]); o.y = pk2(klv[2], klv[3]); o.z = pk2(klv[4], klv[5]); o.w = pk2(klv[6], klv[7]);
            const size_t fi = ((((size_t)it * 8 + (d >> 5)) * 2 + ((d >> 4) & 1)) * 2 + half) * 64 + g * 16 + (d & 15);
            *(GAS v4u*)(KLTF + fi * 8) = o; }
        if (half == 0) DEC[(size_t)it * 256 + d] = __expf(blast);
        { const bf16* vp = V + (size_t)t0 * 2048 + h * 512 + tid;
#pragma unroll
          for (int ks = 0; ks < 2; ++ks)
#pragma unroll
            for (int q = 0; q < 4; ++q) { unsigned short e[8];
#pragma unroll
                for (int jj = 0; jj < 8; ++jj) e[jj] = vp[(size_t)(32 * ks + 8 * q + jj) * 2048];
                v4u o; o.x = e[0] | ((unsigned)e[1] << 16); o.y = e[2] | ((unsigned)e[3] << 16); o.z = e[4] | ((unsigned)e[5] << 16); o.w = e[6] | ((unsigned)e[7] << 16);
                const size_t fi = (((size_t)it * 32 + (tid >> 4)) * 2 + ks) * 64 + q * 16 + (tid & 15);
                *(GAS v4u*)(VTF + fi * 8) = o; } }
        __syncthreads();
        { const int mt = wave >> 1, i = lane & 15, q = lane >> 4;
#pragma unroll
          for (int nn = 0; nn < 2; ++nn) { const int nt = 2 * (wave & 1) + nn; f32x4 acc = {0.f, 0.f, 0.f, 0.f};
            if (nt <= mt) {
#pragma unroll
                for (int ks = 0; ks < 8; ++ks) { const bf16x8 a = *(const LAS bf16x8*)(QEl + (16 * mt + i) * 264 + 32 * ks + 8 * q); const bf16x8 bb = *(const LAS bf16x8*)(KEl + (16 * nt + i) * 264 + 32 * ks + 8 * q);
                    acc = __builtin_amdgcn_mfma_f32_16x16x32_bf16(a, bb, acc, 0, 0, 0); } }
#pragma unroll
            for (int r = 0; r < 4; ++r) { const int c = 16 * mt + 4 * q + r, cp = 16 * nt + i; ATl[c * 72 + cp] = (bf16)f2bf(cp <= c ? acc[r] : 0.f); } } }
        __syncthreads();
        { const int f = tid, mt = f >> 7, ks = (f >> 6) & 1, l2 = f & 63, i2 = l2 & 15, q2 = l2 >> 4;
          const v4u o = *(const LAS v4u*)(ATl + (16 * mt + i2) * 72 + 32 * ks + 8 * q2);
          *(GAS v4u*)(ATTF + ((size_t)it * 512 + f) * 8) = o; }
#pragma unroll
        for (int k = 0; k < 4; ++k) { const int f = tid + 512 * k, w = f >> 8, mt = (f >> 6) & 3, l2 = f & 63, i2 = l2 & 15, q2 = l2 >> 4;
            const v2u lo = *(const LAS v2u*)(QEl + (16 * mt + i2) * 264 + 32 * w + 4 * q2), hi = *(const LAS v2u*)(QEl + (16 * mt + i2) * 264 + 32 * w + 16 + 4 * q2);
            v4u o; o.x = lo.x; o.y = lo.y; o.z = hi.x; o.w = hi.y;
            *(GAS v4u*)(QEF + ((((size_t)it * 8 + w) * 4 + mt) * 64 + l2) * 8) = o; }
    }
}
struct GStep { bf16x8 qa[4], ka[2][2], vb[2], at; f32x4 dc[2]; };
__device__ __forceinline__ void gla_load(GStep& s, int it, int vs, int w, int lane, const bf16* QEF, const bf16* KLTF, const bf16* ATTF, const bf16* VTF, const float* DEC) {
    const GAS bf16x8* q16 = (const GAS bf16x8*)QEF + (((size_t)it * 8 + w) * 4) * 64 + lane;
#pragma unroll
    for (int mt = 0; mt < 4; ++mt) s.qa[mt] = q16[mt * 64];
    const GAS bf16x8* k16 = (const GAS bf16x8*)KLTF + (((size_t)it * 8 + w) * 4) * 64 + lane;
#pragma unroll
    for (int m = 0; m < 2; ++m)
#pragma unroll
        for (int ks = 0; ks < 2; ++ks) s.ka[m][ks] = k16[(m * 2 + ks) * 64];
    const GAS bf16x8* v16 = (const GAS bf16x8*)VTF + (((size_t)it * 32 + vs) * 2) * 64 + lane;
    s.vb[0] = v16[0]; s.vb[1] = v16[64];
    s.at = ((const GAS bf16x8*)ATTF)[(size_t)it * 512 + w * 64 + lane];
    const GAS f32x4* d4 = (const GAS f32x4*)(DEC + (size_t)it * 256 + 32 * w + 4 * (lane >> 4));
    s.dc[0] = d4[0]; s.dc[1] = d4[4];
}
__device__ __forceinline__ void gla_seq(LAS unsigned char* lds, const bf16* QEF, const bf16* KLTF, const bf16* ATTF, const bf16* VTF, const float* DEC, bf16* O) {
    const int tid = threadIdx.x, lane = tid & 63, w = __builtin_amdgcn_readfirstlane(tid >> 6), q = lane >> 4;
    LAS float* part = (LAS float*)lds;
    for (int wi = blockIdx.x; wi < 256; wi += gridDim.x) {
        const int bh = wi & 7, vs = wi >> 3, h = bh & 3, b = bh >> 2;
        f32x4 S0 = {0.f, 0.f, 0.f, 0.f}, S1 = {0.f, 0.f, 0.f, 0.f};
        GStep cur, nxt;
        gla_load(cur, bh * 256, vs, w, lane, QEF, KLTF, ATTF, VTF, DEC);
        __syncthreads();
        for (int n = 0; n < GLA_NCH; ++n) {
            const int it = bh * 256 + n;
            gla_load(nxt, (n + 1 < GLA_NCH) ? it + 1 : it, vs, w, lane, QEF, KLTF, ATTF, VTF, DEC);
            v4u sbw; sbw.x = pk2(S0[0], S0[1]); sbw.y = pk2(S0[2], S0[3]); sbw.z = pk2(S1[0], S1[1]); sbw.w = pk2(S1[2], S1[3]);
            const bf16x8 sb = __builtin_bit_cast(bf16x8, sbw);
            f32x4 po[4];
#pragma unroll
            for (int mt = 0; mt < 4; ++mt) po[mt] = __builtin_amdgcn_mfma_f32_16x16x32_bf16(cur.qa[mt], sb, (f32x4){0.f, 0.f, 0.f, 0.f}, 0, 0, 0);
            const bf16x8 vsel = (w & 1) ? cur.vb[1] : cur.vb[0];
#pragma unroll
            for (int mt = 0; mt < 4; ++mt) if (mt == (w >> 1)) po[mt] = __builtin_amdgcn_mfma_f32_16x16x32_bf16(cur.at, vsel, po[mt], 0, 0, 0);
            S0 = S0 * cur.dc[0]; S1 = S1 * cur.dc[1];
            S0 = __builtin_amdgcn_mfma_f32_16x16x32_bf16(cur.ka[0][0], cur.vb[0], S0, 0, 0, 0); S0 = __builtin_amdgcn_mfma_f32_16x16x32_bf16(cur.ka[0][1], cur.vb[1], S0, 0, 0, 0);
            S1 = __builtin_amdgcn_mfma_f32_16x16x32_bf16(cur.ka[1][0], cur.vb[0], S1, 0, 0, 0); S1 = __builtin_amdgcn_mfma_f32_16x16x32_bf16(cur.ka[1][1], cur.vb[1], S1, 0, 0, 0);
            LAS float* pb = part + (size_t)((n & 1) * 8 + w) * 1024;
#pragma unroll
            for (int mt = 0; mt < 4; ++mt)
#pragma unroll
                for (int r = 0; r < 4; ++r) pb[(16 * mt + 4 * q + r) * 16 + (lane & 15)] = po[mt][r];
            __syncthreads();
            { const int c = tid >> 3, v2 = (tid & 7) * 2; const LAS float* pr = part + (size_t)((n & 1) * 8) * 1024 + c * 16 + v2; float s0 = 0.f, s1 = 0.f;
#pragma unroll
              for (int ww = 0; ww < 8; ++ww) { s0 += pr[ww * 1024]; s1 += pr[ww * 1024 + 1]; }
              *(GAS unsigned*)(O + (size_t)(b * SEQ + n * GLA_C + c) * 2048 + h * 512 + vs * 16 + v2) = pk2(s0, s1); }
            cur = nxt;
        }
        __syncthreads();
    }
}
__device__ __forceinline__ void gla_gate(const bf16* O, const bf16* R, const float* head_g, bf16* OG, int gw, int NGW, int lane) {
    float hg[8];
#pragma unroll
    for (int j = 0; j < 8; ++j) hg[j] = head_g[8 * lane + j];
    for (int m = gw; m < T; m += NGW) {
#pragma unroll
        for (int h = 0; h < 4; ++h) {
            const v4u ov = *(const GAS v4u*)(O + (size_t)m * 2048 + h * 512 + 8 * lane), rv = *(const GAS v4u*)(R + (size_t)m * 2048 + h * 512 + 8 * lane);
            float o[8] = {bf_lo(ov.x), bf_hi(ov.x), bf_lo(ov.y), bf_hi(ov.y), bf_lo(ov.z), bf_hi(ov.z), bf_lo(ov.w), bf_hi(ov.w)};
            float r[8] = {bf_lo(rv.x), bf_hi(rv.x), bf_lo(rv.y), bf_hi(rv.y), bf_lo(rv.z), bf_hi(rv.z), bf_lo(rv.w), bf_hi(rv.w)};
            float ss = 0.f;
#pragma unroll
            for (int j = 0; j < 8; ++j) ss += o[j] * o[j];
            const float rstd = rsqrtf(wave_sum(ss) * (1.f / 512.f) + RMS_EPS);
            float y[8];
#pragma unroll
            for (int j = 0; j < 8; ++j) y[j] = o[j] * rstd * hg[j] * pg8::silu_f(r[j]);
            v4u w; w.x = pk2(y[0], y[1]); w.y = pk2(y[2], y[3]); w.z = pk2(y[4], y[5]); w.w = pk2(y[6], y[7]);
            *(GAS v4u*)(OG + (size_t)m * 2048 + h * 512 + 8 * lane) = w;
        }
    }
}

__device__ __forceinline__ void moe_route(LAS unsigned char* lds, const float* RL, const float* SSP, const float* bgroup, const float* brouter, unsigned* gcnt, unsigned* EP0, unsigned* EP1, float* W0, float* W1, float* RSTD) {
    const int tid = threadIdx.x; LAS int* lcnt = (LAS int*)lds; LAS int* lbase = lcnt + 32;
    for (int base = blockIdx.x * 128; base < T; base += gridDim.x * 128) {
        if (tid < 32) lcnt[tid] = 0;
        __syncthreads();
        int e0 = 0, e1 = 0, r0 = 0, r1 = 0; float w0 = 0.f, w1 = 0.f;
        if (tid < 128) { const int t = base + tid; const float* rl = RL + (size_t)t * 64;
            float ssq = 0.f; { const GAS f32x4* sp = (const GAS f32x4*)(SSP + (size_t)t * 32);
#pragma unroll
                for (int k = 0; k < 8; ++k) { const f32x4 v = sp[k]; ssq += (v.x + v.y) + (v.z + v.w); } }
            const float rstd = rsqrtf(ssq * (1.f / D) + RMS_EPS); RSTD[t] = rstd;
            const f32x4 g4 = *(const GAS f32x4*)rl; float gl[4] = {g4.x * rstd + bgroup[0], g4.y * rstd + bgroup[1], g4.z * rstd + bgroup[2], g4.w * rstd + bgroup[3]};
            int g = 0; float best = gl[0];
#pragma unroll
            for (int j = 1; j < 4; ++j) if (gl[j] > best) { best = gl[j]; g = j; }
            float se = 0.f;
#pragma unroll
            for (int j = 0; j < 4; ++j) se += __expf(gl[j] - best);
            const float pg = 1.0f / se;
            const f32x4 a4 = *(const GAS f32x4*)(rl + 4 + 8 * g), b4 = *(const GAS f32x4*)(rl + 8 + 8 * g);
            float el[8] = {a4.x, a4.y, a4.z, a4.w, b4.x, b4.y, b4.z, b4.w};
#pragma unroll
            for (int j = 0; j < 8; ++j) el[j] = el[j] * rstd + brouter[8 * g + j];
            int i0 = 0; float v0 = el[0];
#pragma unroll
            for (int j = 1; j < 8; ++j) if (el[j] > v0) { v0 = el[j]; i0 = j; }
            int i1 = -1; float v1 = -3.0e38f;
#pragma unroll
            for (int j = 0; j < 8; ++j) if (j != i0 && el[j] > v1) { v1 = el[j]; i1 = j; }
            w0 = pg / (1.0f + __expf(v1 - v0)); w1 = pg - w0;
            e0 = 8 * g + i0; e1 = 8 * g + i1;
            r0 = __hip_atomic_fetch_add(&lcnt[e0], 1, __ATOMIC_RELAXED, __HIP_MEMORY_SCOPE_WORKGROUP); r1 = __hip_atomic_fetch_add(&lcnt[e1], 1, __ATOMIC_RELAXED, __HIP_MEMORY_SCOPE_WORKGROUP); }
        __syncthreads();
        if (tid < 32) lbase[tid] = (int)__hip_atomic_fetch_add(gcnt + tid, (unsigned)lcnt[tid], RLX_AGENT);
        __syncthreads();
        if (tid < 128) { const int t = base + tid;
            EP0[t] = ((unsigned)e0 << 24) | (unsigned)(lbase[e0] + r0); EP1[t] = ((unsigned)e1 << 24) | (unsigned)(lbase[e1] + r1); W0[t] = w0; W1[t] = w1; }
        __syncthreads();
    }
}
__device__ __forceinline__ void moe_build_table(LAS unsigned char* ldsbase, unsigned* gcnt) {
    LAS int* off = (LAS int*)(ldsbase + MOE_OFF_OFF); LAS unsigned char* texp = ldsbase + MOE_TEXP_OFF;
    __syncthreads();
    if (threadIdx.x == 0) { int acc = 0, ti = 0;
        for (int e = 0; e < NE; ++e) { const int c = (int)__hip_atomic_load(gcnt + e, RLX_AGENT); off[e] = acc; const int nt = (c + 255) >> 8;
            for (int k = 0; k < nt && ti < 288; ++k) texp[ti++] = (unsigned char)e;
            acc += nt * 256; }
        off[32] = acc; }
    __syncthreads();
}
__device__ __forceinline__ void moe_slots(LAS unsigned char* ldsbase, unsigned* gcnt, const unsigned* EP0, const unsigned* EP1, const float* RSTD, unsigned* SL0, unsigned* SL1, unsigned* TL, float* RS) {
    const LAS int* off = (const LAS int*)(ldsbase + MOE_OFF_OFF); const int tid = threadIdx.x;
    for (int t = blockIdx.x * 512 + tid; t < T; t += gridDim.x * 512) {
        const unsigned p0 = EP0[t], p1 = EP1[t]; const float rs = RSTD[t];
        const unsigned s0 = (unsigned)off[p0 >> 24] + (p0 & 0xffffffu), s1 = (unsigned)off[p1 >> 24] + (p1 & 0xffffffu);
        TL[s0] = (unsigned)t; RS[s0] = rs; TL[s1] = (unsigned)t; RS[s1] = rs; SL0[t] = s0; SL1[t] = s1; }
    for (int e = blockIdx.x; e < NE; e += gridDim.x) { const int c = (int)__hip_atomic_load(gcnt + e, RLX_AGENT);
        for (int i = off[e] + c + tid; i < off[e + 1]; i += 512) { TL[i] = 0u; RS[i] = 0.f; } }
}
__device__ __forceinline__ void moe_combine(float* out, const bf16* Y, const unsigned* SL0, const unsigned* SL1, const float* W0, const float* W1, bf16* HN, bool do_norm, int gw, int NGW, int lane) {
    for (int t = gw; t < T; t += NGW) {
        const unsigned s0 = SL0[t], s1 = SL1[t]; const float w0 = W0[t], w1 = W1[t];
        GAS f32x4* xr = (GAS f32x4*)(out + (size_t)t * D) + lane;
        const GAS v2u* y0 = (const GAS v2u*)(Y + (size_t)s0 * 2048) + lane; const GAS v2u* y1 = (const GAS v2u*)(Y + (size_t)s1 * 2048) + lane;
        f32x4 v[8]; float s = 0.f;
#pragma unroll
        for (int j = 0; j < 8; ++j) { const v2u a = y0[64 * j], b = y1[64 * j]; f32x4 x = xr[64 * j];
            x.x += w0 * bf_lo(a.x) + w1 * bf_lo(b.x); x.y += w0 * bf_hi(a.x) + w1 * bf_hi(b.x); x.z += w0 * bf_lo(a.y) + w1 * bf_lo(b.y); x.w += w0 * bf_hi(a.y) + w1 * bf_hi(b.y);
            v[j] = x; xr[64 * j] = x; s += (x.x * x.x + x.y * x.y) + (x.z * x.z + x.w * x.w); }
        if (do_norm) { const float rstd = rsqrtf(wave_sum(s) * (1.f / D) + RMS_EPS);
            GAS v2u* o8 = (GAS v2u*)(HN + (size_t)t * D) + lane;
#pragma unroll
            for (int j = 0; j < 8; ++j) { v2u o; o.x = pk2(v[j].x * rstd, v[j].y * rstd); o.y = pk2(v[j].z * rstd, v[j].w * rstd); o8[64 * j] = o; } }
    }
}

__device__ const unsigned char T5_BUCKET[128] = {0,1,2,3,4,5,6,7,8,9,10,11,12,13,14,15,16,16,16,17,17,18,18,18,19,19,19,20,20,20,20,21,21,21,21,22,22,22,22,22,23,23,23,23,23,23,24,24,24,24,24,24,25,25,25,25,25,25,25,26,26,26,26,26,26,26,26,27,27,27,27,27,27,27,27,27,27,28,28,28,28,28,28,28,28,28,28,29,29,29,29,29,29,29,29,29,29,29,29,30,30,30,30,30,30,30,30,30,30,30,30,30,30,31,31,31,31,31,31,31,31,31,31,31,31,31,31,31};
constexpr int AT_K = 0, AT_VT = 36864, AT_BIAS = 70656;
__device__ __forceinline__ void swa_attention(LAS unsigned char* lds, const bf16* KVQ, const float* knorm, const float* qnorm, const float* relb, const float* sinks, bf16* AO) {
    const int tid = threadIdx.x, lane = tid & 63, g = __builtin_amdgcn_readfirstlane(tid >> 6), li = lane & 15, q = lane >> 4;
    LAS bf16* KL = (LAS bf16*)(lds + AT_K); LAS bf16* VTL = (LAS bf16*)(lds + AT_VT); LAS float* BL = (LAS float*)(lds + AT_BIAS);
    float qn[2][8];
#pragma unroll
    for (int ks = 0; ks < 2; ++ks)
#pragma unroll
        for (int j = 0; j < 8; ++j) qn[ks][j] = qnorm[32 * ks + 8 * q + j] * 0.125f;
    for (int wi = blockIdx.x; wi < 1024; wi += gridDim.x) {
        const int hk = wi & 3, n = (wi >> 2) & 127, b = wi >> 9;
        __syncthreads();
        { const int key = tid >> 1, hf = tid & 1; const bool live = (n > 0) || (key >= 128);
          const size_t tk = (size_t)b * SEQ + (size_t)(n - 1) * 128 + key;
          const bf16* kp = KVQ + tk * KVQ_N + hk * 64 + 32 * hf;
          v4u kw[4], vw[4];
#pragma unroll
          for (int j = 0; j < 4; ++j) { kw[j] = live ? *(const GAS v4u*)(kp + 8 * j) : (v4u){0u, 0u, 0u, 0u}; vw[j] = live ? *(const GAS v4u*)(kp + 256 + 8 * j) : (v4u){0u, 0u, 0u, 0u}; }
          float ss = 0.f;
#pragma unroll
          for (int j = 0; j < 4; ++j) { const float a0 = bf_lo(kw[j].x), a1 = bf_hi(kw[j].x), a2 = bf_lo(kw[j].y), a3 = bf_hi(kw[j].y), a4 = bf_lo(kw[j].z), a5 = bf_hi(kw[j].z), a6 = bf_lo(kw[j].w), a7 = bf_hi(kw[j].w);
              ss += (a0 * a0 + a1 * a1) + (a2 * a2 + a3 * a3) + (a4 * a4 + a5 * a5) + (a6 * a6 + a7 * a7); }
          ss += __shfl_xor(ss, 1);
          const float rstd = rsqrtf(ss * (1.f / 64.f) + RMS_EPS);
#pragma unroll
          for (int j = 0; j < 4; ++j) { const float* kn = knorm + 32 * hf + 8 * j; v4u o;
              o.x = pk2(bf_lo(kw[j].x) * rstd * kn[0], bf_hi(kw[j].x) * rstd * kn[1]); o.y = pk2(bf_lo(kw[j].y) * rstd * kn[2], bf_hi(kw[j].y) * rstd * kn[3]);
              o.z = pk2(bf_lo(kw[j].z) * rstd * kn[4], bf_hi(kw[j].z) * rstd * kn[5]); o.w = pk2(bf_lo(kw[j].w) * rstd * kn[6], bf_hi(kw[j].w) * rstd * kn[7]);
              *(LAS v4u*)(KL + key * 72 + 32 * hf + 8 * j) = o; }
#pragma unroll
          for (int j = 0; j < 4; ++j) { const int d0 = 32 * hf + 8 * j;
              VTL[(d0 + 0) * 264 + key] = (bf16)(vw[j].x & 0xffffu); VTL[(d0 + 1) * 264 + key] = (bf16)(vw[j].x >> 16); VTL[(d0 + 2) * 264 + key] = (bf16)(vw[j].y & 0xffffu); VTL[(d0 + 3) * 264 + key] = (bf16)(vw[j].y >> 16);
              VTL[(d0 + 4) * 264 + key] = (bf16)(vw[j].z & 0xffffu); VTL[(d0 + 5) * 264 + key] = (bf16)(vw[j].z >> 16); VTL[(d0 + 6) * 264 + key] = (bf16)(vw[j].w & 0xffffu); VTL[(d0 + 7) * 264 + key] = (bf16)(vw[j].w >> 16); }
#pragma unroll
          for (int k = 0; k < 2; ++k) { const int e = tid + 512 * k, gg = e >> 7, dist = e & 127; BL[e] = relb[(int)T5_BUCKET[dist] * 32 + hk * 8 + gg]; }
        }
        __syncthreads();
        const int head = hk * 8 + g; const float sink = sinks[head];
        for (int mt = 0; mt < 8; ++mt) {
            const size_t tq = (size_t)b * SEQ + (size_t)n * 128 + 16 * mt + li;
            bf16x8 qf[2];
            { const bf16* qp = KVQ + tq * KVQ_N + 512 + head * 64 + 8 * q; const v4u q0 = *(const GAS v4u*)qp, q1 = *(const GAS v4u*)(qp + 32);
              float a[16] = {bf_lo(q0.x), bf_hi(q0.x), bf_lo(q0.y), bf_hi(q0.y), bf_lo(q0.z), bf_hi(q0.z), bf_lo(q0.w), bf_hi(q0.w), bf_lo(q1.x), bf_hi(q1.x), bf_lo(q1.y), bf_hi(q1.y), bf_lo(q1.z), bf_hi(q1.z), bf_lo(q1.w), bf_hi(q1.w)};
              float ss = 0.f;
#pragma unroll
              for (int j = 0; j < 16; ++j) ss += a[j] * a[j];
              ss += __shfl_xor(ss, 16); ss += __shfl_xor(ss, 32);
              const float rstd = rsqrtf(ss * (1.f / 64.f) + RMS_EPS);
              v4u w0, w1;
              w0.x = pk2(a[0] * rstd * qn[0][0], a[1] * rstd * qn[0][1]); w0.y = pk2(a[2] * rstd * qn[0][2], a[3] * rstd * qn[0][3]); w0.z = pk2(a[4] * rstd * qn[0][4], a[5] * rstd * qn[0][5]); w0.w = pk2(a[6] * rstd * qn[0][6], a[7] * rstd * qn[0][7]);
              w1.x = pk2(a[8] * rstd * qn[1][0], a[9] * rstd * qn[1][1]); w1.y = pk2(a[10] * rstd * qn[1][2], a[11] * rstd * qn[1][3]); w1.z = pk2(a[12] * rstd * qn[1][4], a[13] * rstd * qn[1][5]); w1.w = pk2(a[14] * rstd * qn[1][6], a[15] * rstd * qn[1][7]);
              qf[0] = __builtin_bit_cast(bf16x8, w0); qf[1] = __builtin_bit_cast(bf16x8, w1); }
            f32x4 st[9]; float mx = sink;
#pragma unroll
            for (int tt = 0; tt < 9; ++tt) { const int nt = mt + tt; f32x4 acc = {0.f, 0.f, 0.f, 0.f};
#pragma unroll
                for (int ks = 0; ks < 2; ++ks) { const bf16x8 a = *(const LAS bf16x8*)(KL + (16 * nt + li) * 72 + 32 * ks + 8 * q); acc = __builtin_amdgcn_mfma_f32_16x16x32_bf16(a, qf[ks], acc, 0, 0, 0); }
#pragma unroll
                for (int r = 0; r < 4; ++r) { const int col = 16 * nt + 4 * q + r, row = 16 * mt + li, dist = 128 + row - col;
                    const bool valid = (dist >= 0) && (dist < 128) && ((col >= 128) || (n > 0));
                    const float s = valid ? acc[r] + BL[g * 128 + (dist & 127)] : -__builtin_inff();
                    acc[r] = s; mx = fmaxf(mx, s); }
                st[tt] = acc; }
            mx = fmaxf(mx, __shfl_xor(mx, 16)); mx = fmaxf(mx, __shfl_xor(mx, 32));
            float lsum = 0.f;
#pragma unroll
            for (int tt = 0; tt < 9; ++tt)
#pragma unroll
                for (int r = 0; r < 4; ++r) { const float p = __expf(st[tt][r] - mx); st[tt][r] = p; lsum += p; }
            lsum += __shfl_xor(lsum, 16); lsum += __shfl_xor(lsum, 32);
            const float inv = 1.0f / (lsum + __expf(sink - mx));
            f32x4 oacc[4];
#pragma unroll
            for (int dt = 0; dt < 4; ++dt) oacc[dt] = (f32x4){0.f, 0.f, 0.f, 0.f};
#pragma unroll
            for (int s = 0; s < 5; ++s) {
                v4u pw; pw.x = pk2(st[2 * s][0], st[2 * s][1]); pw.y = pk2(st[2 * s][2], st[2 * s][3]);
                if (s < 4) { pw.z = pk2(st[2 * s + 1][0], st[2 * s + 1][1]); pw.w = pk2(st[2 * s + 1][2], st[2 * s + 1][3]); } else { pw.z = 0u; pw.w = 0u; }
                const bf16x8 pb = __builtin_bit_cast(bf16x8, pw);
                const int k0 = 16 * (mt + 2 * s) + 4 * q; int k1 = 16 * (mt + 2 * s + 1) + 4 * q; if (k1 > 252) k1 = 240 + 4 * q;
#pragma unroll
                for (int dt = 0; dt < 4; ++dt) { const v2u lo = *(const LAS v2u*)(VTL + (16 * dt + li) * 264 + k0), hi = *(const LAS v2u*)(VTL + (16 * dt + li) * 264 + k1);
                    v4u aw; aw.x = lo.x; aw.y = lo.y; aw.z = hi.x; aw.w = hi.y;
                    oacc[dt] = __builtin_amdgcn_mfma_f32_16x16x32_bf16(__builtin_bit_cast(bf16x8, aw), pb, oacc[dt], 0, 0, 0); } }
#pragma unroll
            for (int dt = 0; dt < 4; ++dt) { v2u o; o.x = pk2(oacc[dt][0] * inv, oacc[dt][1] * inv); o.y = pk2(oacc[dt][2] * inv, oacc[dt][3] * inv);
                *(GAS v2u*)(AO + tq * 2048 + head * 64 + 16 * dt + 4 * q) = o; }
        }
    }
}

struct Args { const float* in[24]; float* out; unsigned char* ws; int ph_lo, ph_hi; };
constexpr int N_PHASES = 23;
__global__ void __launch_bounds__(NWAVES * 64, 2) fwd(Args args) {
    extern __shared__ __attribute__((aligned(16))) unsigned char lds_raw[];
    LAS unsigned char* lds = (LAS unsigned char*)lds_raw;
    const int tid = threadIdx.x, lane = tid & 63, wave = __builtin_amdgcn_readfirstlane(tid >> 6);
    const int G = gridDim.x, gw = blockIdx.x * NWAVES + wave, NGW = G * NWAVES;
    unsigned char* ws = args.ws;
    gu32* ctl = (gu32*)(ws + WS_CTL);
    for (int u = tid; u < (LDS_BYTES - LDSCTL_OFF) / 4; u += NWAVES * 64) ((LAS unsigned*)(lds + LDSCTL_OFF))[u] = 0u;
    __syncthreads();
    XcdBarrier bar = xcd_barrier_post((unsigned*)(ctl + CW_BAR), (volatile LAS unsigned*)(lds + MISC_OFF));
    const int lo = args.ph_lo, hi = args.ph_hi;
#define IN(k) ((((MK_PHASE_MASK) >> (k)) & 1) && lo <= (k) && (k) < hi)
#define PB(k) const unsigned long long _pt0 = (((MK_DELAY_MASK) >> (k)) & 1) ? __builtin_amdgcn_s_memrealtime() : 0ull
#define PE(k) do { if (((MK_DELAY_MASK) >> (k)) & 1) { const unsigned long long _pt1 = __builtin_amdgcn_s_memrealtime(), _dt = _pt1 - _pt0; while (__builtin_amdgcn_s_memrealtime() - _pt1 < _dt) __builtin_amdgcn_s_sleep(8); } } while (0)
#define SEAM(k) do { if (IN(k) && IN((k) + 1)) xcd_barrier(bar); } while (0)

    const float* x = args.in[0]; float* out = args.out;
    bf16* W_GLA_IN = (bf16*)(ws + WS_W_GLA_IN); bf16* W_GLA_OUT = (bf16*)(ws + WS_W_GLA_OUT); bf16* W_KVQ = (bf16*)(ws + WS_W_KVQ); bf16* W_SWA_OUT = (bf16*)(ws + WS_W_SWA_OUT);
    bf16* W_ROUTER = (bf16*)(ws + WS_W_ROUTER); bf16* W_GU = (bf16*)(ws + WS_W_GU); bf16* W_DN = (bf16*)(ws + WS_W_DN);
    bf16* HN = (bf16*)(ws + WS_HN);
    unsigned* EP0 = (unsigned*)(ws + WS_TOK); unsigned* EP1 = EP0 + T; unsigned* SL0 = EP1 + T; unsigned* SL1 = SL0 + T; float* TW0 = (float*)(SL1 + T); float* TW1 = TW0 + T; float* RSTD = TW1 + T;
    bf16* HB = (bf16*)(ws + WS_HB); float* SSP = (float*)(ws + WS_SSP); unsigned* TL = (unsigned*)(ws + WS_TL); float* RS = (float*)(ws + WS_RS);
    float* RL = (float*)(ws + WS_RL);

    if (IN(0)) { PB(0);
        cvt_matrix(args.in[2], 2048, GLA_PROJ_N, args.in[1], W_GLA_IN, 0, gw, NGW, lane);
        cvt_matrix(args.in[6], 2048, 2048, nullptr, W_GLA_OUT, 0, gw, NGW, lane);
        cvt_matrix(args.in[8], 2048, 512, args.in[7], W_KVQ, 0, gw, NGW, lane);
        cvt_matrix(args.in[12], 2048, 2048, args.in[11], W_KVQ, 512, gw, NGW, lane);
        cvt_matrix(args.in[15], 2048, 2048, nullptr, W_SWA_OUT, 0, gw, NGW, lane);
        for (int l = 0; l < 2; ++l) {
            cvt_matrix(args.in[17] + (size_t)l * 2048 * 4, 2048, 4, args.in[16] + l * 2048, W_ROUTER + (size_t)l * 256 * 2048, 0, gw, NGW, lane);
            cvt_matrix(args.in[19] + (size_t)l * 2048 * 32, 2048, 32, args.in[16] + l * 2048, W_ROUTER + (size_t)l * 256 * 2048, 4, gw, NGW, lane);
        }
        cvt_moe(args.in[21], args.in[22], args.in[23], args.in[16], W_GU, W_DN, gw, NGW, lane);
        norm_rows(x, HN, gw, NGW, lane);
        PE(0);
    }
    SEAM(0);
    if (IN(1)) { PB(1);
        pg8::Gemm g{HN, W_GLA_IN, T, GLA_PROJ_NP, 2048}; pg8::StaticOrder S; S.init(T, GLA_PROJ_NP, G, (int)blockIdx.x);
        pg8::EpiGlaProj E{(bf16*)(ws + WS_QK), (bf16*)(ws + WS_V), (bf16*)(ws + WS_R), (bf16*)(ws + WS_GL)};
        pg8::gemm_phase<pg8::EpiGlaProj, pg8::StaticOrder, true, true>(lds + RING_OFF, g, S, E);
        PE(1);
    }
    SEAM(1);
    if (IN(2)) { PB(2); gla_prepass(lds + RING_OFF, (const bf16*)(ws + WS_QK), (const bf16*)(ws + WS_V), (const bf16*)(ws + WS_GL), args.in[3], args.in[4],
                           (bf16*)(ws + WS_QEF), (bf16*)(ws + WS_KLTF), (bf16*)(ws + WS_ATTF), (bf16*)(ws + WS_VTF), (float*)(ws + WS_DEC)); PE(2); }
    SEAM(2);
    if (IN(3)) { PB(3); gla_seq(lds + RING_OFF, (const bf16*)(ws + WS_QEF), (const bf16*)(ws + WS_KLTF), (const bf16*)(ws + WS_ATTF), (const bf16*)(ws + WS_VTF), (const float*)(ws + WS_DEC), (bf16*)(ws + WS_QK)); PE(3); }
    SEAM(3);
    if (IN(4)) { PB(4); gla_gate((const bf16*)(ws + WS_QK), (const bf16*)(ws + WS_R), args.in[5], HN, gw, NGW, lane); PE(4); }
    SEAM(4);
    if (IN(5)) { PB(5);
        pg8::Gemm g{HN, W_GLA_OUT, T, 2048, 2048}; pg8::StaticOrder S; S.init(T, 2048, G, (int)blockIdx.x);
        pg8::EpiResF32 E{out, x, 2048, HB, SSP};
        pg8::gemm_phase<pg8::EpiResF32, pg8::StaticOrder, true, true>(lds + RING_OFF, g, S, E);
        PE(5);
    }
    SEAM(5);

    { constexpr int layer = 0; constexpr int pb = 6 + 10 * layer;
    unsigned* gcnt = (unsigned*)(ctl + CW_CNT + layer * 64);
    if (IN(pb + 1)) { PB(pb + 1);
        pg8::Gemm g{HB, W_ROUTER + (size_t)layer * 256 * 2048, T, 256, 2048}; pg8::StaticOrder S; S.init(T, 256, G, (int)blockIdx.x);
        pg8::EpiRouter E{RL};
        pg8::gemm_phase<pg8::EpiRouter, pg8::StaticOrder, true, true>(lds + RING_OFF, g, S, E);
        PE(pb + 1);
    }
    SEAM(pb + 1);
    if (IN(pb + 2)) { PB(pb + 2); moe_route(lds + RING_OFF, RL, SSP, args.in[18] + layer * 4, args.in[20] + layer * 32, gcnt, EP0, EP1, TW0, TW1, RSTD); PE(pb + 2); }
    SEAM(pb + 2);
    if (IN(pb + 3)) { PB(pb + 3); { moe_build_table(lds, gcnt); moe_slots(lds, gcnt, EP0, EP1, RSTD, SL0, SL1, TL, RS); } PE(pb + 3); }
    SEAM(pb + 3);
    if (IN(pb + 4)) { PB(pb + 4);
        moe_build_table(lds, gcnt);
        const int rows = __builtin_amdgcn_readfirstlane(((const LAS int*)(lds + MOE_OFF_OFF))[32]);
        pg8::Gemm g{HB, W_GU, rows, 1024, 2048, TL};
        pg8::GroupedOrder S{(const LAS unsigned char*)(lds + MOE_TEXP_OFF), rows >> 8, 4, G, (int)blockIdx.x};
        pg8::EpiSwiGLU E{(bf16*)(ws + WS_ACT), RS};
        pg8::gemm_phase<pg8::EpiSwiGLU, pg8::GroupedOrder, true, true, true>(lds + RING_OFF, g, S, E);
        PE(pb + 4);
    }
    SEAM(pb + 4);
    if (IN(pb + 5)) { PB(pb + 5);
        moe_build_table(lds, gcnt);
        const int rows = __builtin_amdgcn_readfirstlane(((const LAS int*)(lds + MOE_OFF_OFF))[32]);
        pg8::Gemm g{(const bf16*)(ws + WS_ACT), W_DN, rows, 2048, 512};
        pg8::GroupedOrder S{(const LAS unsigned char*)(lds + MOE_TEXP_OFF), rows >> 8, 8, G, (int)blockIdx.x};
        pg8::EpiBf16 E{(bf16*)(ws + WS_Y), 2048};
        pg8::gemm_phase<pg8::EpiBf16, pg8::GroupedOrder, true, true>(lds + RING_OFF, g, S, E);
        PE(pb + 5);
    }
    SEAM(pb + 5);
    if (IN(pb + 6)) { PB(pb + 6);
        moe_combine(out, (const bf16*)(ws + WS_Y), SL0, SL1, TW0, TW1, HN, layer == 0, gw, NGW, lane);
        if (layer == 0) cvt_moe(args.in[21] + (size_t)NE * 2048 * 512, args.in[22] + (size_t)NE * 2048 * 512, args.in[23] + (size_t)NE * 512 * 2048, args.in[16] + 2048, W_GU, W_DN, gw, NGW, lane);
        PE(pb + 6);
    }
    if (layer == 0) SEAM(pb + 6);
    }
    if (IN(13)) { PB(13);
        pg8::Gemm g{HN, W_KVQ, T, KVQ_N, 2048}; pg8::StaticOrder S; S.init(T, KVQ_N, G, (int)blockIdx.x);
        pg8::EpiBf16 E{(bf16*)(ws + WS_KVQ), KVQ_N};
        pg8::gemm_phase<pg8::EpiBf16, pg8::StaticOrder, true, true>(lds + RING_OFF, g, S, E);
        PE(13);
    }
    SEAM(13);
    if (IN(14)) { PB(14); swa_attention(lds + RING_OFF, (const bf16*)(ws + WS_KVQ), args.in[9], args.in[13], args.in[10], args.in[14], (bf16*)(ws + WS_AO)); PE(14); }
    SEAM(14);
    if (IN(15)) { PB(15);
        pg8::Gemm g{(const bf16*)(ws + WS_AO), W_SWA_OUT, T, 2048, 2048}; pg8::StaticOrder S; S.init(T, 2048, G, (int)blockIdx.x);
        pg8::EpiResF32 E{out, out, 2048, HB, SSP};
        pg8::gemm_phase<pg8::EpiResF32, pg8::StaticOrder, true, true>(lds + RING_OFF, g, S, E);
        PE(15);
    }
    SEAM(15);
    { constexpr int layer = 1; constexpr int pb = 6 + 10 * layer;
    unsigned* gcnt = (unsigned*)(ctl + CW_CNT + layer * 64);
    if (IN(pb + 1)) { PB(pb + 1);
        pg8::Gemm g{HB, W_ROUTER + (size_t)layer * 256 * 2048, T, 256, 2048}; pg8::StaticOrder S; S.init(T, 256, G, (int)blockIdx.x);
        pg8::EpiRouter E{RL};
        pg8::gemm_phase<pg8::EpiRouter, pg8::StaticOrder, true, true>(lds + RING_OFF, g, S, E);
        PE(pb + 1);
    }
    SEAM(pb + 1);
    if (IN(pb + 2)) { PB(pb + 2); moe_route(lds + RING_OFF, RL, SSP, args.in[18] + layer * 4, args.in[20] + layer * 32, gcnt, EP0, EP1, TW0, TW1, RSTD); PE(pb + 2); }
    SEAM(pb + 2);
    if (IN(pb + 3)) { PB(pb + 3); { moe_build_table(lds, gcnt); moe_slots(lds, gcnt, EP0, EP1, RSTD, SL0, SL1, TL, RS); } PE(pb + 3); }
    SEAM(pb + 3);
    if (IN(pb + 4)) { PB(pb + 4);
        moe_build_table(lds, gcnt);
        const int rows = __builtin_amdgcn_readfirstlane(((const LAS int*)(lds + MOE_OFF_OFF))[32]);
        pg8::Gemm g{HB, W_GU, rows, 1024, 2048, TL};
        pg8::GroupedOrder S{(const LAS unsigned char*)(lds + MOE_TEXP_OFF), rows >> 8, 4, G, (int)blockIdx.x};
        pg8::EpiSwiGLU E{(bf16*)(ws + WS_ACT), RS};
        pg8::gemm_phase<pg8::EpiSwiGLU, pg8::GroupedOrder, true, true, true>(lds + RING_OFF, g, S, E);
        PE(pb + 4);
    }
    SEAM(pb + 4);
    if (IN(pb + 5)) { PB(pb + 5);
        moe_build_table(lds, gcnt);
        const int rows = __builtin_amdgcn_readfirstlane(((const LAS int*)(lds + MOE_OFF_OFF))[32]);
        pg8::Gemm g{(const bf16*)(ws + WS_ACT), W_DN, rows, 2048, 512};
        pg8::GroupedOrder S{(const LAS unsigned char*)(lds + MOE_TEXP_OFF), rows >> 8, 8, G, (int)blockIdx.x};
        pg8::EpiBf16 E{(bf16*)(ws + WS_Y), 2048};
        pg8::gemm_phase<pg8::EpiBf16, pg8::GroupedOrder, true, true>(lds + RING_OFF, g, S, E);
        PE(pb + 5);
    }
    SEAM(pb + 5);
    if (IN(pb + 6)) { PB(pb + 6);
        moe_combine(out, (const bf16*)(ws + WS_Y), SL0, SL1, TW0, TW1, HN, layer == 0, gw, NGW, lane);
        if (layer == 0) cvt_moe(args.in[21] + (size_t)NE * 2048 * 512, args.in[22] + (size_t)NE * 2048 * 512, args.in[23] + (size_t)NE * 512 * 2048, args.in[16] + 2048, W_GU, W_DN, gw, NGW, lane);
        PE(pb + 6);
    }
    if (layer == 0) SEAM(pb + 6);
    }
#undef IN
#undef SEAM
}

extern "C" void kernel_launch(void* const* d_in, const int* in_sizes, int n_in, void* d_out, int out_size, void* d_ws, size_t ws_size, hipStream_t stream) {
    static int grid = 0;
    if (grid == 0) {
        if (n_in != 24 || in_sizes[0] != T * D || out_size != T * D || ws_size < WS_END) { fprintf(stderr, "kernel_launch: unexpected shapes / workspace (n_in %d, in0 %d, out %d, ws %zu < %zu)\n", n_in, n_in > 0 ? in_sizes[0] : -1, out_size, ws_size, (size_t)WS_END); grid = -1; return; }
        int dev = 0, cus = 0, per_cu = 0;
        if (hipGetDevice(&dev) != hipSuccess || hipDeviceGetAttribute(&cus, hipDeviceAttributeMultiprocessorCount, dev) != hipSuccess) { grid = -1; return; }
        if (hipFuncSetAttribute((const void*)fwd, hipFuncAttributeMaxDynamicSharedMemorySize, LDS_BYTES) != hipSuccess) { fprintf(stderr, "kernel_launch: hipFuncSetAttribute failed\n"); grid = -1; return; }
        if (hipOccupancyMaxActiveBlocksPerMultiprocessor(&per_cu, (const void*)fwd, NWAVES * 64, LDS_BYTES) != hipSuccess || per_cu < 1) { fprintf(stderr, "kernel_launch: occupancy query says %d\n", per_cu); }
        (void)hipGetLastError();
        grid = cus;
    }
    if (grid < 0) return;
    if (hipMemsetAsync((char*)d_ws + WS_CTL, 0, CTL_ZERO_BYTES, stream) != hipSuccess) return;
    Args a{};
    for (int i = 0; i < 24; ++i) a.in[i] = (const float*)d_in[i];
    a.out = (float*)d_out; a.ws = (unsigned char*)d_ws;
#if MK_PER_PHASE
    for (int p = 0; p < MK_LAST_PHASE; ++p) { a.ph_lo = p; a.ph_hi = p + 1; hipLaunchKernelGGL(fwd, dim3(grid), dim3(NWAVES * 64), LDS_BYTES, stream, a); }
#else
    a.ph_lo = 0; a.ph_hi = MK_LAST_PHASE;
    hipLaunchKernelGGL(fwd, dim3(grid), dim3(NWAVES * 64), LDS_BYTES, stream, a);
#endif
    const hipError_t le = hipPeekAtLastError();
    if (le != hipSuccess) fprintf(stderr, "kernel_launch: launch failed: %s\n", hipGetErrorName(le));
}
```

```cpp
#include <hip/hip_runtime.h>
#include <cstdio>
#include <cstdint>

#ifndef MK_PER_PHASE
#define MK_PER_PHASE 0
#endif
#ifndef MK_LAST_PHASE
#define MK_LAST_PHASE 23
#endif

#ifndef MK_PHASE_MASK
#define MK_PHASE_MASK 0x7fffff
#endif

#ifndef MK_DELAY_MASK
#define MK_DELAY_MASK 0
#endif

namespace pg8 {
#define PG8_LAS __attribute__((address_space(3)))
typedef unsigned short bf16_t;
typedef short bf16x8 __attribute__((ext_vector_type(8)));
typedef float f32x4 __attribute__((ext_vector_type(4)));
typedef unsigned u32x4 __attribute__((ext_vector_type(4)));
constexpr int BM = 256, BK = 64, HALF = 128, HTB = HALF * BK * 2  , STAGE_BYTES = 8 * HTB, NXCD = 8, WGM = 8;

__host__ __device__ __forceinline__ int lds_byte(int r, int c) { const int st = (r >> 4) * 2 + (c >> 5), rr = r & 15, cc = c & 31, ob = rr * 64 + cc * 2; return st * 1024 + (ob ^ (((ob >> 9) & 1) << 5)); }
__host__ __device__ __forceinline__ void stage_rc(int b, int& R, int& C) { const int st = b / 1024, sb = b % 1024, swz = sb ^ (((sb >> 9) & 1) << 5); R = (st >> 1) * 16 + swz / 64; C = (st & 1) * 32 + (swz % 64) / 2; }
__host__ __device__ __forceinline__ int perm32(int rho) { const int n = rho >> 4, i = rho & 15; return 8 * (i >> 2) + 4 * n + (i & 3); }

struct Unit { int pm, pn, pc; };
struct Gemm { const bf16_t* A; const bf16_t* Bt; int M, N, K; const unsigned* rowidx; };


struct StaticOrder {
    int nM, nN, nwg, G, c;
    __host__ __device__ void init(int M, int N, int G_, int c_) { nM = M / BM; nN = N / BM; nwg = nM * nN; G = G_; c = c_; }
    __host__ __device__ bool next(int i, Unit& u) const {
        const long L = (long)i * G + c; if (L >= nwg) return false;
        int wgid = (int)L; { const int q = nwg / NXCD, r = nwg % NXCD, xcd = wgid % NXCD, off = wgid / NXCD; wgid = (xcd < r ? xcd * (q + 1) : r * (q + 1) + (xcd - r) * q) + off; }
        const int nig = WGM * nN, gid = wgid / nig, fm = gid * WGM, gsz = (nM - fm) < WGM ? (nM - fm) : WGM;
        u.pm = fm + ((wgid % nig) % gsz); u.pn = (wgid % nig) / gsz; u.pc = u.pn; return true;
    }
    __device__ __forceinline__ void a_ready(const Unit&) const {}
    __device__ __forceinline__ void done(const Unit&) const {}
};
struct GroupedOrder {
    const PG8_LAS unsigned char* texp; int MT, npn, G, c;
    __device__ __forceinline__ bool next(int i, Unit& u) const {
        const long L = (long)i * G + c; if (L >= (long)MT * npn) return false;
        const int pm = (int)(L / npn), pc = (int)(L % npn);
        const int e = __builtin_amdgcn_readfirstlane((int)texp[pm]);
        u.pm = pm; u.pn = e * npn + pc; u.pc = pc; return true;
    }
    __device__ __forceinline__ void a_ready(const Unit&) const {}
    __device__ __forceinline__ void done(const Unit&) const {}
};

__device__ __forceinline__ unsigned cvt_pk_bf16(float lo, float hi) { unsigned r; asm volatile("v_cvt_pk_bf16_f32 %0, %1, %2" : "=v"(r) : "v"(lo), "v"(hi)); return r; }

struct EpiBf16 {
    static constexpr bool PERM = true, AFTER_DRAIN = false;
    bf16_t* O; int ldc;
    __device__ __forceinline__ void operator()(const f32x4 (&acc)[2][2][4][2], const Unit& u, int wr, int wc, int fr, int fq) const {
        const int row0 = u.pm * BM + wr * 64 + fr, col0 = u.pc * BM + wc * 32 + 8 * fq;
#pragma unroll
        for (int ai = 0; ai < 2; ++ai)
#pragma unroll
            for (int m = 0; m < 4; ++m) { bf16_t* rowp = O + (size_t)(row0 + ai * HALF + m * 16) * ldc + col0;
#pragma unroll
                for (int bj = 0; bj < 2; ++bj) { const f32x4 v0 = acc[ai][bj][m][0], v1 = acc[ai][bj][m][1];
                    u32x4 w; w.x = cvt_pk_bf16(v0[0], v0[1]); w.y = cvt_pk_bf16(v0[2], v0[3]); w.z = cvt_pk_bf16(v1[0], v1[1]); w.w = cvt_pk_bf16(v1[2], v1[3]);
                    *(u32x4*)(rowp + bj * HALF) = w; } }
    }
};
struct EpiGlaProj {
    static constexpr bool PERM = true, AFTER_DRAIN = false;
    bf16_t *QK, *V, *R, *GL;
    __device__ __forceinline__ void operator()(const f32x4 (&acc)[2][2][4][2], const Unit& u, int wr, int wc, int fr, int fq) const {
        bf16_t* base; int ldc, ct;
        if (u.pc < 8) { base = QK; ldc = 2048; ct = u.pc; } else if (u.pc < 16) { base = V; ldc = 2048; ct = u.pc - 8; } else if (u.pc < 24) { base = R; ldc = 2048; ct = u.pc - 16; } else { base = GL; ldc = 256; ct = 0; }
        const int row0 = u.pm * BM + wr * 64 + fr, col0 = ct * BM + wc * 32 + 8 * fq;
#pragma unroll
        for (int ai = 0; ai < 2; ++ai)
#pragma unroll
            for (int m = 0; m < 4; ++m) { bf16_t* rowp = base + (size_t)(row0 + ai * HALF + m * 16) * ldc + col0;
#pragma unroll
                for (int bj = 0; bj < 2; ++bj) { const f32x4 v0 = acc[ai][bj][m][0], v1 = acc[ai][bj][m][1];
                    u32x4 w; w.x = cvt_pk_bf16(v0[0], v0[1]); w.y = cvt_pk_bf16(v0[2], v0[3]); w.z = cvt_pk_bf16(v1[0], v1[1]); w.w = cvt_pk_bf16(v1[2], v1[3]);
                    *(u32x4*)(rowp + bj * HALF) = w; } }
    }
};
struct EpiResF32 {
    static constexpr bool PERM = true, AFTER_DRAIN = false;
    float* C; const float* RES; int ldc; bf16_t* HB; float* SSP;
    __device__ __forceinline__ void operator()(const f32x4 (&acc)[2][2][4][2], const Unit& u, int wr, int wc, int fr, int fq) const {
        const int row0 = u.pm * BM + wr * 64 + fr, col0 = u.pc * BM + wc * 32 + 8 * fq;
#pragma unroll
        for (int ai = 0; ai < 2; ++ai)
#pragma unroll
            for (int m = 0; m < 4; ++m) { const int row = row0 + ai * HALF + m * 16; const size_t off = (size_t)row * ldc + col0;
                f32x4 rv[2][2];
#pragma unroll
                for (int bj = 0; bj < 2; ++bj)
#pragma unroll
                    for (int n = 0; n < 2; ++n) rv[bj][n] = *(const f32x4*)(RES + off + bj * HALF + n * 4);
                float ss = 0.f;
#pragma unroll
                for (int bj = 0; bj < 2; ++bj) { const f32x4 v0 = acc[ai][bj][m][0] + rv[bj][0], v1 = acc[ai][bj][m][1] + rv[bj][1];
                    *(f32x4*)(C + off + bj * HALF) = v0; *(f32x4*)(C + off + bj * HALF + 4) = v1;
                    u32x4 w; w.x = cvt_pk_bf16(v0[0], v0[1]); w.y = cvt_pk_bf16(v0[2], v0[3]); w.z = cvt_pk_bf16(v1[0], v1[1]); w.w = cvt_pk_bf16(v1[2], v1[3]);
                    *(u32x4*)(HB + off + bj * HALF) = w;
                    ss += (v0[0] * v0[0] + v0[1] * v0[1]) + (v0[2] * v0[2] + v0[3] * v0[3]) + (v1[0] * v1[0] + v1[1] * v1[1]) + (v1[2] * v1[2] + v1[3] * v1[3]); }
                ss += __shfl_xor(ss, 16); ss += __shfl_xor(ss, 32);
                if (fq == 0) SSP[(size_t)row * 32 + u.pc * 4 + wc] = ss; }
    }
};
struct EpiRouter {
    static constexpr bool PERM = false, AFTER_DRAIN = false;
    float* RL;
    __device__ __forceinline__ void operator()(const f32x4 (&acc)[2][2][4][2], const Unit& u, int wr, int wc, int fr, int fq) const {
        if (wc >= 2) return;
        const int row0 = u.pm * BM + wr * 64 + fr, col0 = wc * 32 + 4 * fq;
#pragma unroll
        for (int ai = 0; ai < 2; ++ai)
#pragma unroll
            for (int m = 0; m < 4; ++m) { float* rowp = RL + (size_t)(row0 + ai * HALF + m * 16) * 64 + col0;
#pragma unroll
                for (int n = 0; n < 2; ++n) *(f32x4*)(rowp + n * 16) = acc[ai][0][m][n]; }
    }
};
__device__ __forceinline__ float silu_f(float x) { return x * __builtin_amdgcn_rcpf(1.0f + __expf(-x)); }
struct EpiSwiGLU {
    static constexpr bool PERM = true, AFTER_DRAIN = false;
    bf16_t* ACT; const float* RS;
    __device__ __forceinline__ void operator()(const f32x4 (&acc)[2][2][4][2], const Unit& u, int wr, int wc, int fr, int fq) const {
        const int row0 = u.pm * BM + wr * 64 + fr, col0 = u.pc * HALF + wc * 32 + 8 * fq;
#pragma unroll
        for (int ai = 0; ai < 2; ++ai)
#pragma unroll
            for (int m = 0; m < 4; ++m) { const int row = row0 + ai * HALF + m * 16; bf16_t* rowp = ACT + (size_t)row * 512 + col0; const float rs = RS[row];
                const f32x4 g0 = acc[ai][0][m][0] * rs, g1 = acc[ai][0][m][1] * rs, u0 = acc[ai][1][m][0] * rs, u1 = acc[ai][1][m][1] * rs;
                u32x4 w;
                w.x = cvt_pk_bf16(silu_f(g0[0]) * u0[0], silu_f(g0[1]) * u0[1]); w.y = cvt_pk_bf16(silu_f(g0[2]) * u0[2], silu_f(g0[3]) * u0[3]);
                w.z = cvt_pk_bf16(silu_f(g1[0]) * u1[0], silu_f(g1[1]) * u1[1]); w.w = cvt_pk_bf16(silu_f(g1[2]) * u1[2], silu_f(g1[3]) * u1[3]);
                *(u32x4*)rowp = w; }
    }
};

template <class Epi, class Sched, bool ALIGN_EPI = false, bool SP2 = false, bool GATHER = false>
__device__ __forceinline__ void gemm_phase(PG8_LAS unsigned char* lds, const Gemm g, const Sched& S, const Epi& E) {
    const int tid = threadIdx.x, wid = __builtin_amdgcn_readfirstlane(tid >> 6), lane = tid & 63, wr = wid >> 2, wc = wid & 3, fr = lane & 15, fq = lane >> 4;
    const int K = g.K, nt = K / BK;
    unsigned voffA[2], voffB[2];
#pragma unroll
    for (int i = 0; i < 2; ++i) { int R, C; stage_rc(tid * 16 + i * 8192, R, C); const int Rb = Epi::PERM ? ((R & ~31) + perm32(R & 31)) : R;
        voffA[i] = (unsigned)(R * K + C) * 2u; voffB[i] = (unsigned)(Rb * K + C) * 2u; }
    unsigned vA[2][2] = {{0u, 0u}, {0u, 0u}}, vAn[2][2] = {{0u, 0u}, {0u, 0u}}; int rA[2] = {0, 0}; unsigned cbA[2] = {0u, 0u};
    if constexpr (GATHER) {
#pragma unroll
        for (int i = 0; i < 2; ++i) { int R, C; stage_rc(tid * 16 + i * 8192, R, C); rA[i] = R; cbA[i] = (unsigned)C * 2u; } }
#define PG8_GIDX(dst, pmv) do { _Pragma("unroll") for (int _h = 0; _h < 2; ++_h) _Pragma("unroll") for (int _i = 0; _i < 2; ++_i) \
        dst[_h][_i] = g.rowidx[(size_t)(pmv) * BM + _h * HALF + rA[_i]] * (unsigned)(K * 2) + cbA[_i]; } while (0)
    const size_t kstep = (size_t)(BK * 2);
    const size_t hstep = (size_t)HALF * K * 2;
    const size_t tstep = 2 * hstep;
    const unsigned ldsw = (unsigned)wid * 1024u;
    const int aoff = lds_byte(wr * 64 + fr, fq * 8), boff = lds_byte(wc * 32 + fr, fq * 8);
#define PG8_SA(b, h) (((b) * 2 + (h)) * HTB)
#define PG8_SB(b, h) ((4 + (b) * 2 + (h)) * HTB)
#define PG8_STAGE(bufoff, gbase, voff) do { _Pragma("unroll") for (int _i = 0; _i < 2; ++_i) \
        __builtin_amdgcn_global_load_lds((const unsigned*)((const char*)(gbase) + (voff)[_i]), (PG8_LAS unsigned*)(lds + (bufoff) + ldsw + _i * 8192), 16, 0, 0); } while (0)
#define PG8_STAGE_A(bufoff, nx, kb, h) do { if constexpr (GATHER) { const char* _b = (const char*)g.A + (kb); \
        _Pragma("unroll") for (int _i = 0; _i < 2; ++_i) { const unsigned _v = (nx) ? vAn[h][_i] : vA[h][_i]; \
            __builtin_amdgcn_global_load_lds((const unsigned*)(_b + _v), (PG8_LAS unsigned*)(lds + (bufoff) + ldsw + _i * 8192), 16, 0, 0); } } \
    else { const char* _b = ((nx) ? nA : cA) + (kb) + (size_t)(h) * hstep; PG8_STAGE(bufoff, _b, voffA); } } while (0)
#define PG8_LDA(dst, b, h) do { _Pragma("unroll") for (int m = 0; m < 4; ++m) _Pragma("unroll") for (int k = 0; k < 2; ++k) dst[m][k] = *(const PG8_LAS bf16x8*)(lds + PG8_SA(b, h) + aoff + m * 2048 + k * 1024); } while (0)
#define PG8_LDB(dst, b, h) do { _Pragma("unroll") for (int n = 0; n < 2; ++n) _Pragma("unroll") for (int k = 0; k < 2; ++k) dst[n][k] = *(const PG8_LAS bf16x8*)(lds + PG8_SB(b, h) + boff + n * 2048 + k * 1024); } while (0)
#define PG8_MMA(ai, bj, At, Bt) do { __builtin_amdgcn_s_setprio(1); _Pragma("unroll") for (int m = 0; m < 4; ++m) _Pragma("unroll") for (int n = 0; n < 2; ++n) _Pragma("unroll") for (int k = 0; k < 2; ++k) \
        acc[ai][bj][m][n] = __builtin_amdgcn_mfma_f32_16x16x32_bf16(Bt[n][k], At[m][k], acc[ai][bj][m][n], 0, 0, 0); __builtin_amdgcn_s_setprio(0); } while (0)
#define PG8_WAIT_V(n) asm volatile("s_waitcnt vmcnt(" #n ")" ::: "memory")
#define PG8_WAIT_L(n) asm volatile("s_waitcnt lgkmcnt(" #n ")" ::: "memory")
#define PG8_BAR __builtin_amdgcn_s_barrier()
#define PG8_SCHED __builtin_amdgcn_sched_barrier(0)
    Unit cur, nxt; int ui = 0;
    if (!S.next(0, cur)) return;
    f32x4 acc[2][2][4][2];
#pragma unroll
    for (int a = 0; a < 2; ++a)
#pragma unroll
        for (int b = 0; b < 2; ++b)
#pragma unroll
            for (int m = 0; m < 4; ++m)
#pragma unroll
                for (int n = 0; n < 2; ++n) acc[a][b][m][n] = (f32x4){0.f, 0.f, 0.f, 0.f};
    bf16x8 At[4][2], B0[2][2], B1[2][2];
    const char* cA = (const char*)g.A + (size_t)cur.pm * tstep; const char* cB = (const char*)g.Bt + (size_t)cur.pn * tstep;
    const char* nA = cA; const char* nB = cB;
    if constexpr (GATHER) { PG8_GIDX(vA, cur.pm); }
    S.a_ready(cur);
    if constexpr (SP2) {
        PG8_STAGE(PG8_SB(0, 0), cB, voffB); PG8_STAGE(PG8_SB(0, 1), cB + hstep, voffB); PG8_STAGE_A(PG8_SA(0, 0), false, 0, 0); PG8_STAGE_A(PG8_SA(0, 1), false, 0, 1);
        if (wr == 1) PG8_BAR;
        PG8_WAIT_V(2); PG8_BAR;
        PG8_STAGE(PG8_SB(1, 0), cB + kstep, voffB); PG8_STAGE_A(PG8_SA(1, 0), false, kstep, 0); PG8_STAGE(PG8_SB(1, 1), cB + hstep + kstep, voffB);
        PG8_WAIT_V(6); PG8_BAR;
    } else {
        PG8_STAGE(PG8_SB(0, 0), cB, voffB); PG8_STAGE(PG8_SA(0, 0), cA, voffA); PG8_STAGE(PG8_SB(0, 1), cB + hstep, voffB); PG8_STAGE(PG8_SA(0, 1), cA + hstep, voffA);
        if (wr == 1) PG8_BAR;
        PG8_WAIT_V(4); PG8_BAR;
        PG8_STAGE(PG8_SB(1, 0), cB + kstep, voffB); PG8_STAGE(PG8_SA(1, 0), cA + kstep, voffA); PG8_STAGE(PG8_SB(1, 1), cB + hstep + kstep, voffB);
        PG8_WAIT_V(6); PG8_BAR;
    }
    for (;;) {
        const bool has_next = S.next(ui + 1, nxt);
        nA = has_next ? (const char*)g.A + (size_t)nxt.pm * tstep : cA; nB = has_next ? (const char*)g.Bt + (size_t)nxt.pn * tstep : cB;
        if constexpr (GATHER) { if (has_next) { PG8_GIDX(vAn, nxt.pm); } else {
#pragma unroll
            for (int _h = 0; _h < 2; ++_h) { vAn[_h][0] = vA[_h][0]; vAn[_h][1] = vA[_h][1]; } } }
        for (int t = 0; t < nt; t += 2) {
            const bool last = (t == nt - 2);
            const char* a1 = cA + (size_t)(t + 1) * kstep;
            const char* a2 = last ? nA : cA + (size_t)(t + 2) * kstep; const char* b2 = last ? nB : cB + (size_t)(t + 2) * kstep;
            const char* a3 = a2 + kstep; const char* b3 = b2 + kstep;
            const size_t ka1 = (size_t)(t + 1) * kstep, ka2 = last ? (size_t)0 : (size_t)(t + 2) * kstep, ka3 = ka2 + kstep; (void)a1; (void)a3;
            if (last && has_next) S.a_ready(nxt);
            if constexpr (SP2) {
            PG8_LDB(B0, 0, 0); PG8_LDB(B1, 0, 1); PG8_SCHED; PG8_LDA(At, 0, 0); PG8_STAGE_A(PG8_SA(1, 1), false, ka1, 1);
            PG8_WAIT_V(8); PG8_WAIT_L(0); PG8_BAR; PG8_MMA(0, 0, At, B0); PG8_MMA(0, 1, At, B1); PG8_BAR; PG8_SCHED;
            PG8_LDA(At, 0, 1); PG8_STAGE(PG8_SB(0, 0), b2, voffB); PG8_STAGE(PG8_SB(0, 1), b2 + hstep, voffB); PG8_STAGE_A(PG8_SA(0, 0), last, ka2, 0);
            PG8_WAIT_V(8); PG8_WAIT_L(0); PG8_BAR; PG8_MMA(1, 0, At, B0); PG8_MMA(1, 1, At, B1); PG8_BAR; PG8_SCHED;
            PG8_LDB(B0, 1, 0); PG8_LDB(B1, 1, 1); PG8_SCHED; PG8_LDA(At, 1, 0); PG8_STAGE_A(PG8_SA(0, 1), last, ka2, 1);
            PG8_WAIT_V(8); PG8_WAIT_L(0); PG8_BAR; PG8_MMA(0, 0, At, B0); PG8_MMA(0, 1, At, B1); PG8_BAR; PG8_SCHED;
            PG8_LDA(At, 1, 1); PG8_STAGE(PG8_SB(1, 0), b3, voffB); PG8_STAGE(PG8_SB(1, 1), b3 + hstep, voffB); PG8_STAGE_A(PG8_SA(1, 0), last, ka3, 0);
            PG8_WAIT_V(8); PG8_WAIT_L(0); PG8_BAR; PG8_MMA(1, 0, At, B0); PG8_MMA(1, 1, At, B1); PG8_BAR; PG8_SCHED;
            } else {
            PG8_LDB(B0, 0, 0); PG8_SCHED; PG8_LDA(At, 0, 0); PG8_STAGE(PG8_SA(1, 1), a1 + hstep, voffA);
            PG8_WAIT_L(8); PG8_BAR; PG8_WAIT_L(0); PG8_MMA(0, 0, At, B0); PG8_BAR; PG8_SCHED;
            PG8_LDB(B1, 0, 1); PG8_STAGE(PG8_SB(0, 0), b2, voffB);
            PG8_BAR; PG8_WAIT_L(0); PG8_MMA(0, 1, At, B1); PG8_BAR;
            PG8_LDA(At, 0, 1); PG8_STAGE(PG8_SA(0, 0), a2, voffA);
            PG8_BAR; PG8_WAIT_L(0); PG8_MMA(1, 0, At, B0); PG8_BAR; PG8_SCHED;
            PG8_STAGE(PG8_SB(0, 1), b2 + hstep, voffB);
            PG8_WAIT_V(6); PG8_BAR; PG8_MMA(1, 1, At, B1); PG8_BAR;
            PG8_LDB(B0, 1, 0); PG8_SCHED; PG8_LDA(At, 1, 0); PG8_STAGE(PG8_SA(0, 1), a2 + hstep, voffA);
            PG8_WAIT_L(8); PG8_BAR; PG8_WAIT_L(0); PG8_MMA(0, 0, At, B0); PG8_BAR; PG8_SCHED;
            PG8_LDB(B1, 1, 1); PG8_STAGE(PG8_SB(1, 0), b3, voffB);
            PG8_BAR; PG8_WAIT_L(0); PG8_MMA(0, 1, At, B1); PG8_BAR;
            PG8_LDA(At, 1, 1); PG8_STAGE(PG8_SA(1, 0), a3, voffA);
            PG8_BAR; PG8_WAIT_L(0); PG8_MMA(1, 0, At, B0); PG8_BAR; PG8_SCHED;
            PG8_STAGE(PG8_SB(1, 1), b3 + hstep, voffB);
            PG8_WAIT_V(6); PG8_BAR; PG8_MMA(1, 1, At, B1); PG8_BAR;
            }
        }
        if constexpr (ALIGN_EPI) { if (wr == 0) PG8_BAR; }
        if constexpr (!Epi::AFTER_DRAIN) { E(acc, cur, wr, wc, fr, fq); S.done(cur); }
        if (!has_next) break;
#pragma unroll
        for (int a = 0; a < 2; ++a)
#pragma unroll
            for (int b = 0; b < 2; ++b)
#pragma unroll
                for (int m = 0; m < 4; ++m)
#pragma unroll
                    for (int n = 0; n < 2; ++n) acc[a][b][m][n] = (f32x4){0.f, 0.f, 0.f, 0.f};
        cur = nxt; cA = nA; cB = nB; ++ui;
        if constexpr (GATHER) {
#pragma unroll
            for (int _h = 0; _h < 2; ++_h) { vA[_h][0] = vAn[_h][0]; vA[_h][1] = vAn[_h][1]; } }
        if constexpr (ALIGN_EPI) { if (wr == 1) PG8_BAR; }
    }
    PG8_WAIT_V(0);
    if constexpr (!ALIGN_EPI) { if (wr == 0) PG8_BAR; }
    PG8_BAR;
    if constexpr (Epi::AFTER_DRAIN) { E.fused(acc, cur, wr, wc, fr, fq, lds, wid, lane); S.done(cur); }
#undef PG8_SA
#undef PG8_STAGE_A
#undef PG8_GIDX
#undef PG8_SB
#undef PG8_STAGE
#undef PG8_LDA
#undef PG8_LDB
#undef PG8_MMA
#undef PG8_WAIT_V
#undef PG8_WAIT_L
#undef PG8_BAR
#undef PG8_SCHED
}
}

constexpr int NWAVES = 8;
constexpr int T = 32768, D = 2048, SEQ = 16384;
constexpr float RMS_EPS = 1e-6f;
constexpr int GLA_H = 4, GLA_DK = 256, GLA_DV = 512, GLA_C = 64, GLA_NCH = SEQ / GLA_C  , GLA_PROJ_N = 6160, GLA_PROJ_NP = 6400;
constexpr int NITEM_GLA = 2 * GLA_H * GLA_NCH;
constexpr int SWA_HQ = 32, SWA_HKV = 4, SWA_HD = 64, SWA_W = 128, KVQ_N = 2560;
constexpr int NE = 32, FF = 512, MOE_MAXROWS = 2 * T + NE * 256;

constexpr size_t MiB = 1u << 20;
constexpr size_t WS_CTL = 0, CTL_ZERO_BYTES = 1 * MiB;
constexpr size_t WS_W_GLA_IN = 1 * MiB;
constexpr size_t WS_W_GLA_OUT = 26 * MiB;
constexpr size_t WS_W_KVQ = 34 * MiB;
constexpr size_t WS_W_SWA_OUT = 44 * MiB;
constexpr size_t WS_W_ROUTER = 52 * MiB;
constexpr size_t WS_TOK = 54 * MiB;
constexpr size_t WS_RL = 56 * MiB;
constexpr size_t WS_W_GU = 64 * MiB;
constexpr size_t WS_W_DN = 192 * MiB;
constexpr size_t WS_HN = 256 * MiB;
constexpr size_t WS_BIG = 384 * MiB;
constexpr size_t WS_QK = WS_BIG;
constexpr size_t WS_V = WS_BIG + 128 * MiB;
constexpr size_t WS_R = WS_BIG + 256 * MiB;
constexpr size_t WS_GL = WS_BIG + 384 * MiB;
constexpr size_t WS_QEF = WS_BIG + 400 * MiB;
constexpr size_t WS_KLTF = WS_BIG + 464 * MiB;
constexpr size_t WS_ATTF = WS_BIG + 528 * MiB;
constexpr size_t WS_VTF = WS_BIG + 544 * MiB;
constexpr size_t WS_DEC = WS_BIG + 672 * MiB;
constexpr size_t WS_GLA_END = WS_BIG + 674 * MiB;
constexpr size_t WS_SSP = WS_BIG;
constexpr size_t WS_TL = WS_BIG + 8 * MiB;
constexpr size_t WS_RS = WS_BIG + 9 * MiB;
constexpr size_t WS_HB = WS_BIG + 16 * MiB;
constexpr size_t WS_ACT = WS_BIG + 288 * MiB;
constexpr size_t WS_Y = WS_BIG + 360 * MiB;
constexpr size_t WS_KVQ = WS_BIG;
constexpr size_t WS_AO = WS_BIG + 160 * MiB;
constexpr size_t WS_END = WS_GLA_END;
static_assert(WS_Y + (size_t)MOE_MAXROWS * 2048 * 2 <= WS_END && WS_ACT + (size_t)MOE_MAXROWS * 512 * 2 <= WS_Y, "MoE map");
constexpr int CW_BAR = 4096;
constexpr int CW_CNT = 16384;

constexpr int RING_OFF = 0, RING_BYTES = 131072;
constexpr int LDSCTL_OFF = RING_BYTES;
constexpr int MISC_OFF = LDSCTL_OFF + 64;
constexpr int MOE_OFF_OFF = LDSCTL_OFF + 256;
constexpr int MOE_TEXP_OFF = LDSCTL_OFF + 512;
constexpr int LDS_BYTES = 147456;

#define GAS __attribute__((address_space(1)))
#define LAS __attribute__((address_space(3)))
typedef unsigned short bf16;
typedef unsigned v4u __attribute__((ext_vector_type(4)));
typedef unsigned v2u __attribute__((ext_vector_type(2)));
typedef float f32x4 __attribute__((ext_vector_type(4)));
typedef short bf16x8 __attribute__((ext_vector_type(8)));
typedef GAS unsigned gu32;
#define RLX_AGENT __ATOMIC_RELAXED, __HIP_MEMORY_SCOPE_AGENT
#define LDS_WAIT() asm volatile("s_waitcnt lgkmcnt(0)" ::: "memory")
#define VM_WAIT() asm volatile("s_waitcnt vmcnt(0)" ::: "memory")
__device__ __forceinline__ unsigned f2bf(float f) { unsigned u = __builtin_bit_cast(unsigned, f); return (u + 0x7fffu + ((u >> 16) & 1u)) >> 16; }
__device__ __forceinline__ unsigned pk2(float lo, float hi) { return pg8::cvt_pk_bf16(lo, hi); }
__device__ __forceinline__ float bf_lo(unsigned w) { return __builtin_bit_cast(float, w << 16); }
__device__ __forceinline__ float bf_hi(unsigned w) { return __builtin_bit_cast(float, w & 0xffff0000u); }
__device__ __forceinline__ float bf2f(bf16 b) { return __builtin_bit_cast(float, ((unsigned)b) << 16); }
__device__ __forceinline__ float wave_sum(float v) {
#pragma unroll
    for (int o = 1; o < 64; o <<= 1) v += __shfl_xor(v, o);
    return v;
}

#define XB_TMO      128
#define XB_XCNT(j)  (256  + 64 * (j))
#define XB_XSUB(j)  (1280 + 64 * (j))
#define XB_XGEN(j)  (2304 + 64 * (j))
#define XB_TOP      3328
#define XB_TOPGEN   3392
#define XCD_BAR_WORDS 3456
#define XB_SPIN_CAP (1u << 18)

__device__ __forceinline__ unsigned xb_ld(unsigned* p)              { return __hip_atomic_load(p, __ATOMIC_RELAXED, __HIP_MEMORY_SCOPE_AGENT); }
__device__ __forceinline__ unsigned xb_add(unsigned* p, unsigned v) { return __hip_atomic_fetch_add(p, v, __ATOMIC_RELAXED, __HIP_MEMORY_SCOPE_AGENT); }
__device__ __forceinline__ unsigned xb_xcc_id() { return (unsigned)__builtin_amdgcn_s_getreg((3 << 11) | 20) & 0xFu; }
#define XB_SPIN(cond, bar) do { unsigned _sp = 0; while (cond) { __builtin_amdgcn_s_sleep(1); \
    if ((++_sp & 255u) == 0u) { if (xb_ld(&(bar)[XB_TMO])) break; if (_sp > XB_SPIN_CAP) { atomicAdd(&(bar)[XB_TMO], 1u); break; } } } } while (0)

struct XcdBarrier {
    unsigned* bar; unsigned x;
    volatile LAS unsigned* st;
};

__device__ __forceinline__ XcdBarrier xcd_barrier_post(unsigned* bar, volatile LAS unsigned* st) {
    XcdBarrier b; b.bar = bar; b.x = xb_xcc_id(); b.st = st;
    if (threadIdx.x == 0) (void)xb_add(&bar[XB_XCNT(b.x)], 1u);
    return b;
}
__device__ __forceinline__ void xcd_barrier_complete(unsigned* bar, unsigned x, unsigned& nloc, unsigned& nx) {
    const unsigned G = gridDim.x * gridDim.y * gridDim.z;
    unsigned sum, cnt, mine, sp = 0u;
    for (;;) {
        sum = 0u; cnt = 0u; mine = 0u;
#pragma unroll
        for (unsigned j = 0; j < 16; ++j) { const unsigned c = xb_ld(&bar[XB_XCNT(j)]); sum += c; cnt += (c > 0u) ? 1u : 0u; mine = (j == x) ? c : mine; }
        if (sum == G) break;
        __builtin_amdgcn_s_sleep(1);
        if ((++sp & 255u) == 0u) { if (xb_ld(&bar[XB_TMO])) break; if (sp > XB_SPIN_CAP) { atomicAdd(&bar[XB_TMO], 1u); break; } }
    }
    nloc = mine > 0u ? mine : 1u; nx = cnt > 0u ? cnt : 1u;
}

__device__ __forceinline__ void xcd_barrier(const XcdBarrier& b) {
    asm volatile("s_waitcnt vmcnt(0)" ::: "memory");
    __syncthreads();
    if (threadIdx.x == 0) {
        unsigned* bar = b.bar;
        __builtin_amdgcn_s_waitcnt(0);
        unsigned nloc = b.st[0], nx = b.st[1];
        if (nloc == 0u) { xcd_barrier_complete(bar, b.x, nloc, nx); b.st[0] = nloc; b.st[1] = nx; }
        const unsigned old = xb_add(&bar[XB_XSUB(b.x)], 1u);
        const unsigned gen = old / nloc;
        if (old + 1u == (gen + 1u) * nloc) {
            __builtin_amdgcn_fence(__ATOMIC_RELEASE, "agent");
            asm volatile("s_waitcnt vmcnt(0)" ::: "memory");
            const unsigned og = xb_add(&bar[XB_TOP], 1u);
            const unsigned tg = og / nx;
            if (og + 1u == (tg + 1u) * nx) xb_add(&bar[XB_TOPGEN], 1u);
            else XB_SPIN(xb_ld(&bar[XB_TOPGEN]) == tg, bar);
            __builtin_amdgcn_fence(__ATOMIC_ACQUIRE, "agent");
            xb_add(&bar[XB_XGEN(b.x)], 1u);
            asm volatile("s_waitcnt vmcnt(0)" ::: "memory");
        } else {
            XB_SPIN(xb_ld(&bar[XB_XGEN(b.x)]) == gen, bar);
            __builtin_amdgcn_fence(__ATOMIC_ACQUIRE, "agent");
            asm volatile("s_waitcnt vmcnt(0)" ::: "memory");
        }
    }
    __syncthreads();
}


__device__ __forceinline__ void cvt_item(const float* W, int N, const float* gain, bf16* WT, int K, int k0, int n0, size_t dst_row0, int lane) {
    const int q = lane >> 4, c = lane & 15;
    const bool ok = (n0 + 4 * c) < N;
    const GAS f32x4* src = (const GAS f32x4*)(W + (size_t)(k0 + 16 * q) * N + n0 + 4 * c);
    f32x4 v[16];
#pragma unroll
    for (int i = 0; i < 16; ++i) v[i] = ok ? src[(size_t)i * (N / 4)] : (f32x4){0.f, 0.f, 0.f, 0.f};
    if (gain) { const GAS f32x4* gp = (const GAS f32x4*)(gain + k0 + 16 * q);
#pragma unroll
        for (int i4 = 0; i4 < 4; ++i4) { const f32x4 g = gp[i4]; v[4 * i4 + 0] = v[4 * i4 + 0] * g.x; v[4 * i4 + 1] = v[4 * i4 + 1] * g.y; v[4 * i4 + 2] = v[4 * i4 + 2] * g.z; v[4 * i4 + 3] = v[4 * i4 + 3] * g.w; } }
    if (ok) {
#pragma unroll
        for (int e = 0; e < 4; ++e) { bf16* dst = WT + (dst_row0 + 4 * c + e) * (size_t)K + k0 + 16 * q;
            v4u o0, o1;
            o0.x = pk2(v[0][e], v[1][e]); o0.y = pk2(v[2][e], v[3][e]); o0.z = pk2(v[4][e], v[5][e]); o0.w = pk2(v[6][e], v[7][e]);
            o1.x = pk2(v[8][e], v[9][e]); o1.y = pk2(v[10][e], v[11][e]); o1.z = pk2(v[12][e], v[13][e]); o1.w = pk2(v[14][e], v[15][e]);
            *(GAS v4u*)dst = o0; *(GAS v4u*)(dst + 8) = o1; } }
}
__device__ __forceinline__ void cvt_matrix(const float* W, int K, int N, const float* gain, bf16* WT, int rowbase, int gw, int NGW, int lane) {
    const int nblk = (N + 63) / 64, nitems = (K / 64) * nblk;
    for (int it = gw; it < nitems; it += NGW) { const int kb = it / nblk, nb = it - kb * nblk;
        cvt_item(W, N, gain, WT, K, kb * 64, nb * 64, (size_t)(rowbase + nb * 64), lane); }
}
__device__ __forceinline__ void cvt_moe(const float* wg, const float* wu, const float* wd, const float* gain, bf16* WGU, bf16* WDN, int gw, int NGW, int lane) {
    for (int it = gw; it < 2 * 8192; it += NGW) { const int which = it >> 13, r = it & 8191, e = r >> 8, q = r & 255, kb = q >> 3, nb = q & 7, n0 = nb * 64;
        const float* W = (which ? wu : wg) + (size_t)e * 2048 * 512;
        const size_t dst = (size_t)e * 1024 + 256 * (n0 >> 7) + (n0 & 127) + (which ? 128 : 0);
        cvt_item(W, 512, gain, WGU, 2048, kb * 64, n0, dst, lane); }
    for (int it = gw; it < 8192; it += NGW) { const int e = it >> 8, q = it & 255, kb = q >> 5, nb = q & 31;
        cvt_item(wd + (size_t)e * 512 * 2048, 2048, nullptr, WDN + (size_t)e * 2048 * 512, 512, kb * 64, nb * 64, (size_t)(nb * 64), lane); }
}
__device__ __forceinline__ void norm_rows(const float* src, bf16* dst, int gw, int NGW, int lane) {
    for (int m = gw; m < T; m += NGW) {
        const GAS f32x4* xr = (const GAS f32x4*)(src + (size_t)m * D) + lane;
        f32x4 v[8]; float s = 0.f;
#pragma unroll
        for (int j = 0; j < 8; ++j) { v[j] = xr[64 * j]; s += (v[j].x * v[j].x + v[j].y * v[j].y) + (v[j].z * v[j].z + v[j].w * v[j].w); }
        const float rstd = rsqrtf(wave_sum(s) * (1.f / D) + RMS_EPS);
        GAS v2u* o8 = (GAS v2u*)(dst + (size_t)m * D) + lane;
#pragma unroll
        for (int j = 0; j < 8; ++j) { v2u o; o.x = pk2(v[j].x * rstd, v[j].y * rstd); o.y = pk2(v[j].z * rstd, v[j].w * rstd); o8[64 * j] = o; }
    }
}

__device__ __forceinline__ float logsig(float z) { return fminf(z, 0.f) - __logf(1.f + __expf(-fabsf(z))); }
constexpr int GP_QE = 0, GP_KE = 33792, GP_ATT = 67584, GP_TOT = 76800;
__device__ __forceinline__ void gla_prepass(LAS unsigned char* lds, const bf16* QK, const bf16* V, const bf16* GL, const float* Wgu, const float* bgate,
                                            bf16* QEF, bf16* KLTF, bf16* ATTF, bf16* VTF, float* DEC) {
    const int tid = threadIdx.x, lane = tid & 63, wave = __builtin_amdgcn_readfirstlane(tid >> 6);
    LAS bf16* QEl = (LAS bf16*)(lds + GP_QE); LAS bf16* KEl = (LAS bf16*)(lds + GP_KE); LAS bf16* ATl = (LAS bf16*)(lds + GP_ATT);
    LAS float* tot = (LAS float*)(lds + GP_TOT);
    const int cg2 = tid & 127, rg2 = __builtin_amdgcn_readfirstlane(tid >> 7);
    for (int it = blockIdx.x; it < NITEM_GLA; it += gridDim.x) {
        const int bh = it >> 8, n = it & 255, h = bh & 3, b = bh >> 2; const int t0 = b * SEQ + n * GLA_C;
        v2u qv[8], kv[8], vv[16];
        { const bf16* qp = QK + (size_t)(t0 + 8 * wave) * 2048 + h * 256 + 4 * lane;
#pragma unroll
          for (int jj = 0; jj < 8; ++jj) { qv[jj] = *(const GAS v2u*)(qp + (size_t)jj * 2048); kv[jj] = *(const GAS v2u*)(qp + (size_t)jj * 2048 + 1024); }
          const bf16* vp = V + (size_t)(t0 + 16 * rg2) * 2048 + h * 512 + 4 * cg2;
#pragma unroll
          for (int r = 0; r < 16; ++r) vv[r] = *(const GAS v2u*)(vp + (size_t)r * 2048); }
        f32x4 cum[8];
        { f32x4 wg[16];
#pragma unroll
          for (int j = 0; j < 16; ++j) wg[j] = *(const GAS f32x4*)(Wgu + j * 1024 + h * 256 + 4 * lane);
          const f32x4 bg = *(const GAS f32x4*)(bgate + h * 256 + 4 * lane);
          f32x4 run = {0.f, 0.f, 0.f, 0.f};
#pragma unroll
          for (int jj = 0; jj < 8; ++jj) { const unsigned* gp = (const unsigned*)(GL + (size_t)(t0 + 8 * wave + jj) * 256);
              f32x4 z = bg;
#pragma unroll
              for (int j2 = 0; j2 < 8; ++j2) { const unsigned w = gp[j2]; z += wg[2 * j2] * bf_lo(w) + wg[2 * j2 + 1] * bf_hi(w); }
#pragma unroll
              for (int e = 0; e < 4; ++e) run[e] += fmaxf(logsig(z[e]) * 0.0625f, -1.0f);
              cum[jj] = run; }
          *(LAS f32x4*)(tot + wave * 256 + 4 * lane) = run; }
        __syncthreads();
        f32x4 offs = {0.f, 0.f, 0.f, 0.f}, blast = {0.f, 0.f, 0.f, 0.f};
#pragma unroll
        for (int w2 = 0; w2 < 8; ++w2) { const f32x4 tv = *(const LAS f32x4*)(tot + w2 * 256 + 4 * lane); blast += tv; if (w2 < wave) offs += tv; }
        f32x4 dec;
#pragma unroll
        for (int e = 0; e < 4; ++e) dec[e] = __expf(blast[e]);
        { float klv[4][8];
#pragma unroll
          for (int jj = 0; jj < 8; ++jj) { const int c = 8 * wave + jj; const f32x4 bb = cum[jj] + offs;
              const float q4[4] = {bf_lo(qv[jj].x), bf_hi(qv[jj].x), bf_lo(qv[jj].y), bf_hi(qv[jj].y)}, k4[4] = {bf_lo(kv[jj].x), bf_hi(kv[jj].x), bf_lo(kv[jj].y), bf_hi(kv[jj].y)};
              float qe[4], ke[4];
#pragma unroll
              for (int e = 0; e < 4; ++e) { qe[e] = q4[e] * 0.0625f * __expf(bb[e]); ke[e] = k4[e] * __expf(-bb[e]); klv[e][jj] = ke[e] * dec[e]; }
              v2u o; o.x = pk2(qe[0], qe[1]); o.y = pk2(qe[2], qe[3]); *(LAS v2u*)(QEl + c * 264 + 4 * lane) = o;
              o.x = pk2(ke[0], ke[1]); o.y = pk2(ke[2], ke[3]); *(LAS v2u*)(KEl + c * 264 + 4 * lane) = o; }
#pragma unroll
          for (int e = 0; e < 4; ++e) { const int d = 4 * lane + e;
              v4u o; o.x = pk2(klv[e][0], klv[e][1]); o.y = pk2(klv[e][2], klv[e][3]); o.z = pk2(klv[e][4], klv[e][5]); o.w = pk2(klv[e][6], klv[e][7]);
              const size_t fi = ((((size_t)it * 8 + (d >> 5)) * 2 + ((d >> 4) & 1)) * 2 + (wave >> 2)) * 64 + (wave & 3) * 16 + (d & 15);
              *(GAS v4u*)(KLTF + fi * 8) = o; } }
        if (wave == 0) *(GAS f32x4*)(DEC + (size_t)it * 256 + 4 * lane) = dec;
#pragma unroll
        for (int f = 0; f < 2; ++f)
#pragma unroll
            for (int e = 0; e < 4; ++e) { unsigned x[8];
#pragma unroll
                for (int jj = 0; jj < 8; ++jj) { const unsigned wd = (e >> 1) ? vv[8 * f + jj].y : vv[8 * f + jj].x; x[jj] = (e & 1) ? (wd >> 16) : (wd & 0xffffu); }
                v4u o; o.x = x[0] | (x[1] << 16); o.y = x[2] | (x[3] << 16); o.z = x[4] | (x[5] << 16); o.w = x[6] | (x[7] << 16);
                const int v = 4 * cg2 + e;
                const size_t fi = (((size_t)it * 32 + (v >> 4)) * 2 + (rg2 >> 1)) * 64 + (2 * (rg2 & 1) + f) * 16 + (v & 15);
                *(GAS v4u*)(VTF + fi * 8) = o; }
        __syncthreads();
        { const int mt = wave >> 1, i = lane & 15, q = lane >> 4;
#pragma unroll
          for (int nn = 0; nn < 2; ++nn) { const int nt = 2 * (wave & 1) + nn; f32x4 acc = {0.f, 0.f, 0.f, 0.f};
            if (nt <= mt) {
#pragma unroll
                for (int ks = 0; ks < 8; ++ks) { const bf16x8 a = *(const LAS bf16x8*)(QEl + (16 * mt + i) * 264 + 32 * ks + 8 * q); const bf16x8 bb = *(const LAS bf16x8*)(KEl + (16 * nt + i) * 264 + 32 * ks + 8 * q);
                    acc = __builtin_amdgcn_mfma_f32_16x16x32_bf16(a, bb, acc, 0, 0, 0); } }
#pragma unroll
            for (int r = 0; r < 4; ++r) { const int c = 16 * mt + 4 * q + r, cp = 16 * nt + i; ATl[c * 72 + cp] = (bf16)f2bf(cp <= c ? acc[r] : 0.f); } } }
        __syncthreads();
        { const int f = tid, mt = f >> 7, ks = (f >> 6) & 1, l2 = f & 63, i2 = l2 & 15, q2 = l2 >> 4;
          const v4u o = *(const LAS v4u*)(ATl + (16 * mt + i2) * 72 + 32 * ks + 8 * q2);
          *(GAS v4u*)(ATTF + ((size_t)it * 512 + f) * 8) = o; }
#pragma unroll
        for (int k = 0; k < 4; ++k) { const int f = tid + 512 * k, w = f >> 8, mt = (f >> 6) & 3, l2 = f & 63, i2 = l2 & 15, q2 = l2 >> 4;
            const v2u lo = *(const LAS v2u*)(QEl + (16 * mt + i2) * 264 + 32 * w + 4 * q2), hi = *(const LAS v2u*)(QEl + (16 * mt + i2) * 264 + 32 * w + 16 + 4 * q2);
            v4u o; o.x = lo.x; o.y = lo.y; o.z = hi.x; o.w = hi.y;
            *(GAS v4u*)(QEF + ((((size_t)it * 8 + w) * 4 + mt) * 64 + l2) * 8) = o; }
        __syncthreads();
    }
}
struct GStep { bf16x8 qa[4], ka[2][2], vb[2], at; f32x4 dc[2]; };
__device__ __forceinline__ void gla_load(GStep& s, int it, int vs, int w, int lane, const bf16* QEF, const bf16* KLTF, const bf16* ATTF, const bf16* VTF, const float* DEC) {
    const GAS bf16x8* q16 = (const GAS bf16x8*)QEF + (((size_t)it * 8 + w) * 4) * 64 + lane;
#pragma unroll
    for (int mt = 0; mt < 4; ++mt) s.qa[mt] = q16[mt * 64];
    const GAS bf16x8* k16 = (const GAS bf16x8*)KLTF + (((size_t)it * 8 + w) * 4) * 64 + lane;
#pragma unroll
    for (int m = 0; m < 2; ++m)
#pragma unroll
        for (int ks = 0; ks < 2; ++ks) s.ka[m][ks] = k16[(m * 2 + ks) * 64];
    const GAS bf16x8* v16 = (const GAS bf16x8*)VTF + (((size_t)it * 32 + vs) * 2) * 64 + lane;
    s.vb[0] = v16[0]; s.vb[1] = v16[64];
    s.at = ((const GAS bf16x8*)ATTF)[(size_t)it * 512 + w * 64 + lane];
    const GAS f32x4* d4 = (const GAS f32x4*)(DEC + (size_t)it * 256 + 32 * w + 4 * (lane >> 4));
    s.dc[0] = d4[0]; s.dc[1] = d4[4];
}
__device__ __forceinline__ void gla_seq(LAS unsigned char* lds, const bf16* QEF, const bf16* KLTF, const bf16* ATTF, const bf16* VTF, const float* DEC, bf16* O) {
    const int tid = threadIdx.x, lane = tid & 63, w = __builtin_amdgcn_readfirstlane(tid >> 6), q = lane >> 4;
    LAS float* part = (LAS float*)lds;
    for (int wi = blockIdx.x; wi < 256; wi += gridDim.x) {
        const int bh = wi & 7, vs = wi >> 3, h = bh & 3, b = bh >> 2;
        f32x4 S0 = {0.f, 0.f, 0.f, 0.f}, S1 = {0.f, 0.f, 0.f, 0.f};
        GStep cur, nxt;
        gla_load(cur, bh * 256, vs, w, lane, QEF, KLTF, ATTF, VTF, DEC);
        __syncthreads();
        for (int n = 0; n < GLA_NCH; ++n) {
            const int it = bh * 256 + n;
            gla_load(nxt, (n + 1 < GLA_NCH) ? it + 1 : it, vs, w, lane, QEF, KLTF, ATTF, VTF, DEC);
            v4u sbw; sbw.x = pk2(S0[0], S0[1]); sbw.y = pk2(S0[2], S0[3]); sbw.z = pk2(S1[0], S1[1]); sbw.w = pk2(S1[2], S1[3]);
            const bf16x8 sb = __builtin_bit_cast(bf16x8, sbw);
            f32x4 po[4];
#pragma unroll
            for (int mt = 0; mt < 4; ++mt) po[mt] = __builtin_amdgcn_mfma_f32_16x16x32_bf16(cur.qa[mt], sb, (f32x4){0.f, 0.f, 0.f, 0.f}, 0, 0, 0);
            const bf16x8 vsel = (w & 1) ? cur.vb[1] : cur.vb[0];
#pragma unroll
            for (int mt = 0; mt < 4; ++mt) if (mt == (w >> 1)) po[mt] = __builtin_amdgcn_mfma_f32_16x16x32_bf16(cur.at, vsel, po[mt], 0, 0, 0);
            S0 = S0 * cur.dc[0]; S1 = S1 * cur.dc[1];
            S0 = __builtin_amdgcn_mfma_f32_16x16x32_bf16(cur.ka[0][0], cur.vb[0], S0, 0, 0, 0); S0 = __builtin_amdgcn_mfma_f32_16x16x32_bf16(cur.ka[0][1], cur.vb[1], S0, 0, 0, 0);
            S1 = __builtin_amdgcn_mfma_f32_16x16x32_bf16(cur.ka[1][0], cur.vb[0], S1, 0, 0, 0); S1 = __builtin_amdgcn_mfma_f32_16x16x32_bf16(cur.ka[1][1], cur.vb[1], S1, 0, 0, 0);
            LAS float* pb = part + (size_t)((n & 1) * 8 + w) * 1024;
#pragma unroll
            for (int mt = 0; mt < 4; ++mt)
#pragma unroll
                for (int r = 0; r < 4; ++r) pb[(16 * mt + 4 * q + r) * 16 + (lane & 15)] = po[mt][r];
            __syncthreads();
            { const int c = tid >> 3, v2 = (tid & 7) * 2; const LAS float* pr = part + (size_t)((n & 1) * 8) * 1024 + c * 16 + v2; float s0 = 0.f, s1 = 0.f;
#pragma unroll
              for (int ww = 0; ww < 8; ++ww) { s0 += pr[ww * 1024]; s1 += pr[ww * 1024 + 1]; }
              *(GAS unsigned*)(O + (size_t)(b * SEQ + n * GLA_C + c) * 2048 + h * 512 + vs * 16 + v2) = pk2(s0, s1); }
            cur = nxt;
        }
        __syncthreads();
    }
}
__device__ __forceinline__ void gla_gate(const bf16* O, const bf16* R, const float* head_g, bf16* OG, int gw, int NGW, int lane) {
    float hg[8];
#pragma unroll
    for (int j = 0; j < 8; ++j) hg[j] = head_g[8 * lane + j];
    for (int m = gw; m < T; m += NGW) {
#pragma unroll
        for (int h = 0; h < 4; ++h) {
            const v4u ov = *(const GAS v4u*)(O + (size_t)m * 2048 + h * 512 + 8 * lane), rv = *(const GAS v4u*)(R + (size_t)m * 2048 + h * 512 + 8 * lane);
            float o[8] = {bf_lo(ov.x), bf_hi(ov.x), bf_lo(ov.y), bf_hi(ov.y), bf_lo(ov.z), bf_hi(ov.z), bf_lo(ov.w), bf_hi(ov.w)};
            float r[8] = {bf_lo(rv.x), bf_hi(rv.x), bf_lo(rv.y), bf_hi(rv.y), bf_lo(rv.z), bf_hi(rv.z), bf_lo(rv.w), bf_hi(rv.w)};
            float ss = 0.f;
#pragma unroll
            for (int j = 0; j < 8; ++j) ss += o[j] * o[j];
            const float rstd = rsqrtf(wave_sum(ss) * (1.f / 512.f) + RMS_EPS);
            float y[8];
#pragma unroll
            for (int j = 0; j < 8; ++j) y[j] = o[j] * rstd * hg[j] * pg8::silu_f(r[j]);
            v4u w; w.x = pk2(y[0], y[1]); w.y = pk2(y[2], y[3]); w.z = pk2(y[4], y[5]); w.w = pk2(y[6], y[7]);
            *(GAS v4u*)(OG + (size_t)m * 2048 + h * 512 + 8 * lane) = w;
        }
    }
}

__device__ __forceinline__ void moe_route(LAS unsigned char* lds, const float* RL, const float* SSP, const float* bgroup, const float* brouter, unsigned* gcnt, unsigned* EP0, unsigned* EP1, float* W0, float* W1, float* RSTD) {
    const int tid = threadIdx.x; LAS int* lcnt = (LAS int*)lds; LAS int* lbase = lcnt + 32;
    for (int base = blockIdx.x * 128; base < T; base += gridDim.x * 128) {
        if (tid < 32) lcnt[tid] = 0;
        __syncthreads();
        int e0 = 0, e1 = 0, r0 = 0, r1 = 0; float w0 = 0.f, w1 = 0.f;
        if (tid < 128) { const int t = base + tid; const float* rl = RL + (size_t)t * 64;
            float ssq = 0.f; { const GAS f32x4* sp = (const GAS f32x4*)(SSP + (size_t)t * 32);
#pragma unroll
                for (int k = 0; k < 8; ++k) { const f32x4 v = sp[k]; ssq += (v.x + v.y) + (v.z + v.w); } }
            const float rstd = rsqrtf(ssq * (1.f / D) + RMS_EPS); RSTD[t] = rstd;
            const f32x4 g4 = *(const GAS f32x4*)rl; float gl[4] = {g4.x * rstd + bgroup[0], g4.y * rstd + bgroup[1], g4.z * rstd + bgroup[2], g4.w * rstd + bgroup[3]};
            int g = 0; float best = gl[0];
#pragma unroll
            for (int j = 1; j < 4; ++j) if (gl[j] > best) { best = gl[j]; g = j; }
            float se = 0.f;
#pragma unroll
            for (int j = 0; j < 4; ++j) se += __expf(gl[j] - best);
            const float pg = 1.0f / se;
            const f32x4 a4 = *(const GAS f32x4*)(rl + 4 + 8 * g), b4 = *(const GAS f32x4*)(rl + 8 + 8 * g);
            float el[8] = {a4.x, a4.y, a4.z, a4.w, b4.x, b4.y, b4.z, b4.w};
#pragma unroll
            for (int j = 0; j < 8; ++j) el[j] = el[j] * rstd + brouter[8 * g + j];
            int i0 = 0; float v0 = el[0];
#pragma unroll
            for (int j = 1; j < 8; ++j) if (el[j] > v0) { v0 = el[j]; i0 = j; }
            int i1 = -1; float v1 = -3.0e38f;
#pragma unroll
            for (int j = 0; j < 8; ++j) if (j != i0 && el[j] > v1) { v1 = el[j]; i1 = j; }
            w0 = pg / (1.0f + __expf(v1 - v0)); w1 = pg - w0;
            e0 = 8 * g + i0; e1 = 8 * g + i1;
            r0 = __hip_atomic_fetch_add(&lcnt[e0], 1, __ATOMIC_RELAXED, __HIP_MEMORY_SCOPE_WORKGROUP); r1 = __hip_atomic_fetch_add(&lcnt[e1], 1, __ATOMIC_RELAXED, __HIP_MEMORY_SCOPE_WORKGROUP); }
        __syncthreads();
        if (tid < 32) lbase[tid] = (int)__hip_atomic_fetch_add(gcnt + tid, (unsigned)lcnt[tid], RLX_AGENT);
        __syncthreads();
        if (tid < 128) { const int t = base + tid;
            EP0[t] = ((unsigned)e0 << 24) | (unsigned)(lbase[e0] + r0); EP1[t] = ((unsigned)e1 << 24) | (unsigned)(lbase[e1] + r1); W0[t] = w0; W1[t] = w1; }
        __syncthreads();
    }
}
__device__ __forceinline__ void moe_build_table(LAS unsigned char* ldsbase, unsigned* gcnt) {
    LAS int* off = (LAS int*)(ldsbase + MOE_OFF_OFF); LAS unsigned char* texp = ldsbase + MOE_TEXP_OFF;
    __syncthreads();
    if (threadIdx.x == 0) { int acc = 0, ti = 0;
        for (int e = 0; e < NE; ++e) { const int c = (int)__hip_atomic_load(gcnt + e, RLX_AGENT); off[e] = acc; const int nt = (c + 255) >> 8;
            for (int k = 0; k < nt && ti < 288; ++k) texp[ti++] = (unsigned char)e;
            acc += nt * 256; }
        off[32] = acc; }
    __syncthreads();
}
__device__ __forceinline__ void moe_slots(LAS unsigned char* ldsbase, unsigned* gcnt, const unsigned* EP0, const unsigned* EP1, const float* RSTD, unsigned* SL0, unsigned* SL1, unsigned* TL, float* RS) {
    const LAS int* off = (const LAS int*)(ldsbase + MOE_OFF_OFF); const int tid = threadIdx.x;
    for (int t = blockIdx.x * 512 + tid; t < T; t += gridDim.x * 512) {
        const unsigned p0 = EP0[t], p1 = EP1[t]; const float rs = RSTD[t];
        const unsigned s0 = (unsigned)off[p0 >> 24] + (p0 & 0xffffffu), s1 = (unsigned)off[p1 >> 24] + (p1 & 0xffffffu);
        TL[s0] = (unsigned)t; RS[s0] = rs; TL[s1] = (unsigned)t; RS[s1] = rs; SL0[t] = s0; SL1[t] = s1; }
    for (int e = blockIdx.x; e < NE; e += gridDim.x) { const int c = (int)__hip_atomic_load(gcnt + e, RLX_AGENT);
        for (int i = off[e] + c + tid; i < off[e + 1]; i += 512) { TL[i] = 0u; RS[i] = 0.f; } }
}
__device__ __forceinline__ void moe_combine(float* out, const bf16* Y, const unsigned* SL0, const unsigned* SL1, const float* W0, const float* W1, bf16* HN, bool do_norm, int gw, int NGW, int lane) {
    for (int t = gw; t < T; t += NGW) {
        const unsigned s0 = SL0[t], s1 = SL1[t]; const float w0 = W0[t], w1 = W1[t];
        GAS f32x4* xr = (GAS f32x4*)(out + (size_t)t * D) + lane;
        const GAS v2u* y0 = (const GAS v2u*)(Y + (size_t)s0 * 2048) + lane; const GAS v2u* y1 = (const GAS v2u*)(Y + (size_t)s1 * 2048) + lane;
        f32x4 v[8]; float s = 0.f;
#pragma unroll
        for (int j = 0; j < 8; ++j) { const v2u a = y0[64 * j], b = y1[64 * j]; f32x4 x = xr[64 * j];
            x.x += w0 * bf_lo(a.x) + w1 * bf_lo(b.x); x.y += w0 * bf_hi(a.x) + w1 * bf_hi(b.x); x.z += w0 * bf_lo(a.y) + w1 * bf_lo(b.y); x.w += w0 * bf_hi(a.y) + w1 * bf_hi(b.y);
            v[j] = x; xr[64 * j] = x; s += (x.x * x.x + x.y * x.y) + (x.z * x.z + x.w * x.w); }
        if (do_norm) { const float rstd = rsqrtf(wave_sum(s) * (1.f / D) + RMS_EPS);
            GAS v2u* o8 = (GAS v2u*)(HN + (size_t)t * D) + lane;
#pragma unroll
            for (int j = 0; j < 8; ++j) { v2u o; o.x = pk2(v[j].x * rstd, v[j].y * rstd); o.y = pk2(v[j].z * rstd, v[j].w * rstd); o8[64 * j] = o; } }
    }
}

__device__ const unsigned char T5_BUCKET[128] = {0,1,2,3,4,5,6,7,8,9,10,11,12,13,14,15,16,16,16,17,17,18,18,18,19,19,19,20,20,20,20,21,21,21,21,22,22,22,22,22,23,23,23,23,23,23,24,24,24,24,24,24,25,25,25,25,25,25,25,26,26,26,26,26,26,26,26,27,27,27,27,27,27,27,27,27,27,28,28,28,28,28,28,28,28,28,28,29,29,29,29,29,29,29,29,29,29,29,29,30,30,30,30,30,30,30,30,30,30,30,30,30,30,31,31,31,31,31,31,31,31,31,31,31,31,31,31,31};
constexpr int AT_K = 0, AT_VT = 36864, AT_BIAS = 70656;
__device__ __forceinline__ void swa_attention(LAS unsigned char* lds, const bf16* KVQ, const float* knorm, const float* qnorm, const float* relb, const float* sinks, bf16* AO) {
    const int tid = threadIdx.x, lane = tid & 63, g = __builtin_amdgcn_readfirstlane(tid >> 6), li = lane & 15, q = lane >> 4;
    LAS bf16* KL = (LAS bf16*)(lds + AT_K); LAS bf16* VTL = (LAS bf16*)(lds + AT_VT); LAS float* BL = (LAS float*)(lds + AT_BIAS);
    float qn[2][8];
#pragma unroll
    for (int ks = 0; ks < 2; ++ks)
#pragma unroll
        for (int j = 0; j < 8; ++j) qn[ks][j] = qnorm[32 * ks + 8 * q + j] * 0.125f;
    for (int wi = blockIdx.x; wi < 1024; wi += gridDim.x) {
        const int hk = wi & 3, n = (wi >> 2) & 127, b = wi >> 9;
        __syncthreads();
        { const int key = tid >> 1, hf = tid & 1; const bool live = (n > 0) || (key >= 128);
          const size_t tk = (size_t)b * SEQ + (size_t)(n - 1) * 128 + key;
          const bf16* kp = KVQ + tk * KVQ_N + hk * 64 + 32 * hf;
          v4u kw[4], vw[4];
#pragma unroll
          for (int j = 0; j < 4; ++j) { kw[j] = live ? *(const GAS v4u*)(kp + 8 * j) : (v4u){0u, 0u, 0u, 0u}; vw[j] = live ? *(const GAS v4u*)(kp + 256 + 8 * j) : (v4u){0u, 0u, 0u, 0u}; }
          float ss = 0.f;
#pragma unroll
          for (int j = 0; j < 4; ++j) { const float a0 = bf_lo(kw[j].x), a1 = bf_hi(kw[j].x), a2 = bf_lo(kw[j].y), a3 = bf_hi(kw[j].y), a4 = bf_lo(kw[j].z), a5 = bf_hi(kw[j].z), a6 = bf_lo(kw[j].w), a7 = bf_hi(kw[j].w);
              ss += (a0 * a0 + a1 * a1) + (a2 * a2 + a3 * a3) + (a4 * a4 + a5 * a5) + (a6 * a6 + a7 * a7); }
          ss += __shfl_xor(ss, 1);
          const float rstd = rsqrtf(ss * (1.f / 64.f) + RMS_EPS);
#pragma unroll
          for (int j = 0; j < 4; ++j) { const float* kn = knorm + 32 * hf + 8 * j; v4u o;
              o.x = pk2(bf_lo(kw[j].x) * rstd * kn[0], bf_hi(kw[j].x) * rstd * kn[1]); o.y = pk2(bf_lo(kw[j].y) * rstd * kn[2], bf_hi(kw[j].y) * rstd * kn[3]);
              o.z = pk2(bf_lo(kw[j].z) * rstd * kn[4], bf_hi(kw[j].z) * rstd * kn[5]); o.w = pk2(bf_lo(kw[j].w) * rstd * kn[6], bf_hi(kw[j].w) * rstd * kn[7]);
              *(LAS v4u*)(KL + key * 72 + 32 * hf + 8 * j) = o; }
#pragma unroll
          for (int j = 0; j < 4; ++j) { const int d0 = 32 * hf + 8 * j;
              VTL[(d0 + 0) * 264 + key] = (bf16)(vw[j].x & 0xffffu); VTL[(d0 + 1) * 264 + key] = (bf16)(vw[j].x >> 16); VTL[(d0 + 2) * 264 + key] = (bf16)(vw[j].y & 0xffffu); VTL[(d0 + 3) * 264 + key] = (bf16)(vw[j].y >> 16);
              VTL[(d0 + 4) * 264 + key] = (bf16)(vw[j].z & 0xffffu); VTL[(d0 + 5) * 264 + key] = (bf16)(vw[j].z >> 16); VTL[(d0 + 6) * 264 + key] = (bf16)(vw[j].w & 0xffffu); VTL[(d0 + 7) * 264 + key] = (bf16)(vw[j].w >> 16); }
#pragma unroll
          for (int k = 0; k < 2; ++k) { const int e = tid + 512 * k, gg = e >> 7, dist = e & 127; BL[e] = relb[(int)T5_BUCKET[dist] * 32 + hk * 8 + gg]; }
        }
        __syncthreads();
        const int head = hk * 8 + g; const float sink = sinks[head];
        for (int mt = 0; mt < 8; ++mt) {
            const size_t tq = (size_t)b * SEQ + (size_t)n * 128 + 16 * mt + li;
            bf16x8 qf[2];
            { const bf16* qp = KVQ + tq * KVQ_N + 512 + head * 64 + 8 * q; const v4u q0 = *(const GAS v4u*)qp, q1 = *(const GAS v4u*)(qp + 32);
              float a[16] = {bf_lo(q0.x), bf_hi(q0.x), bf_lo(q0.y), bf_hi(q0.y), bf_lo(q0.z), bf_hi(q0.z), bf_lo(q0.w), bf_hi(q0.w), bf_lo(q1.x), bf_hi(q1.x), bf_lo(q1.y), bf_hi(q1.y), bf_lo(q1.z), bf_hi(q1.z), bf_lo(q1.w), bf_hi(q1.w)};
              float ss = 0.f;
#pragma unroll
              for (int j = 0; j < 16; ++j) ss += a[j] * a[j];
              ss += __shfl_xor(ss, 16); ss += __shfl_xor(ss, 32);
              const float rstd = rsqrtf(ss * (1.f / 64.f) + RMS_EPS);
              v4u w0, w1;
              w0.x = pk2(a[0] * rstd * qn[0][0], a[1] * rstd * qn[0][1]); w0.y = pk2(a[2] * rstd * qn[0][2], a[3] * rstd * qn[0][3]); w0.z = pk2(a[4] * rstd * qn[0][4], a[5] * rstd * qn[0][5]); w0.w = pk2(a[6] * rstd * qn[0][6], a[7] * rstd * qn[0][7]);
              w1.x = pk2(a[8] * rstd * qn[1][0], a[9] * rstd * qn[1][1]); w1.y = pk2(a[10] * rstd * qn[1][2], a[11] * rstd * qn[1][3]); w1.z = pk2(a[12] * rstd * qn[1][4], a[13] * rstd * qn[1][5]); w1.w = pk2(a[14] * rstd * qn[1][6], a[15] * rstd * qn[1][7]);
              qf[0] = __builtin_bit_cast(bf16x8, w0); qf[1] = __builtin_bit_cast(bf16x8, w1); }
            f32x4 st[9]; float mx = sink;
#pragma unroll
            for (int tt = 0; tt < 9; ++tt) { const int nt = mt + tt; f32x4 acc = {0.f, 0.f, 0.f, 0.f};
#pragma unroll
                for (int ks = 0; ks < 2; ++ks) { const bf16x8 a = *(const LAS bf16x8*)(KL + (16 * nt + li) * 72 + 32 * ks + 8 * q); acc = __builtin_amdgcn_mfma_f32_16x16x32_bf16(a, qf[ks], acc, 0, 0, 0); }
#pragma unroll
                for (int r = 0; r < 4; ++r) { const int col = 16 * nt + 4 * q + r, row = 16 * mt + li, dist = 128 + row - col;
                    const bool valid = (dist >= 0) && (dist < 128) && ((col >= 128) || (n > 0));
                    const float s = valid ? acc[r] + BL[g * 128 + (dist & 127)] : -__builtin_inff();
                    acc[r] = s; mx = fmaxf(mx, s); }
                st[tt] = acc; }
            mx = fmaxf(mx, __shfl_xor(mx, 16)); mx = fmaxf(mx, __shfl_xor(mx, 32));
            float lsum = 0.f;
#pragma unroll
            for (int tt = 0; tt < 9; ++tt)
#pragma unroll
                for (int r = 0; r < 4; ++r) { const float p = __expf(st[tt][r] - mx); st[tt][r] = p; lsum += p; }
            lsum += __shfl_xor(lsum, 16); lsum += __shfl_xor(lsum, 32);
            const float inv = 1.0f / (lsum + __expf(sink - mx));
            f32x4 oacc[4];
#pragma unroll
            for (int dt = 0; dt < 4; ++dt) oacc[dt] = (f32x4){0.f, 0.f, 0.f, 0.f};
#pragma unroll
            for (int s = 0; s < 5; ++s) {
                v4u pw; pw.x = pk2(st[2 * s][0], st[2 * s][1]); pw.y = pk2(st[2 * s][2], st[2 * s][3]);
                if (s < 4) { pw.z = pk2(st[2 * s + 1][0], st[2 * s + 1][1]); pw.w = pk2(st[2 * s + 1][2], st[2 * s + 1][3]); } else { pw.z = 0u; pw.w = 0u; }
                const bf16x8 pb = __builtin_bit_cast(bf16x8, pw);
                const int k0 = 16 * (mt + 2 * s) + 4 * q; int k1 = 16 * (mt + 2 * s + 1) + 4 * q; if (k1 > 252) k1 = 240 + 4 * q;
#pragma unroll
                for (int dt = 0; dt < 4; ++dt) { const v2u lo = *(const LAS v2u*)(VTL + (16 * dt + li) * 264 + k0), hi = *(const LAS v2u*)(VTL + (16 * dt + li) * 264 + k1);
                    v4u aw; aw.x = lo.x; aw.y = lo.y; aw.z = hi.x; aw.w = hi.y;
                    oacc[dt] = __builtin_amdgcn_mfma_f32_16x16x32_bf16(__builtin_bit_cast(bf16x8, aw), pb, oacc[dt], 0, 0, 0); } }
#pragma unroll
            for (int dt = 0; dt < 4; ++dt) { v2u o; o.x = pk2(oacc[dt][0] * inv, oacc[dt][1] * inv); o.y = pk2(oacc[dt][2] * inv, oacc[dt][3] * inv);
                *(GAS v2u*)(AO + tq * 2048 + head * 64 + 16 * dt + 4 * q) = o; }
        }
    }
}

struct Args { const float* in[24]; float* out; unsigned char* ws; int ph_lo, ph_hi; };
constexpr int N_PHASES = 23;
__global__ void __launch_bounds__(NWAVES * 64, 2) fwd(Args args) {
    extern __shared__ __attribute__((aligned(16))) unsigned char lds_raw[];
    LAS unsigned char* lds = (LAS unsigned char*)lds_raw;
    const int tid = threadIdx.x, lane = tid & 63, wave = __builtin_amdgcn_readfirstlane(tid >> 6);
    const int G = gridDim.x, gw = blockIdx.x * NWAVES + wave, NGW = G * NWAVES;
    unsigned char* ws = args.ws;
    gu32* ctl = (gu32*)(ws + WS_CTL);
    for (int u = tid; u < (LDS_BYTES - LDSCTL_OFF) / 4; u += NWAVES * 64) ((LAS unsigned*)(lds + LDSCTL_OFF))[u] = 0u;
    __syncthreads();
    XcdBarrier bar = xcd_barrier_post((unsigned*)(ctl + CW_BAR), (volatile LAS unsigned*)(lds + MISC_OFF));
    const int lo = args.ph_lo, hi = args.ph_hi;
#define IN(k) ((((MK_PHASE_MASK) >> (k)) & 1) && lo <= (k) && (k) < hi)
#define PB(k) const unsigned long long _pt0 = (((MK_DELAY_MASK) >> (k)) & 1) ? __builtin_amdgcn_s_memrealtime() : 0ull
#define PE(k) do { if (((MK_DELAY_MASK) >> (k)) & 1) { const unsigned long long _pt1 = __builtin_amdgcn_s_memrealtime(), _dt = _pt1 - _pt0; while (__builtin_amdgcn_s_memrealtime() - _pt1 < _dt) __builtin_amdgcn_s_sleep(8); } } while (0)
#define SEAM(k) do { if (IN(k) && IN((k) + 1)) xcd_barrier(bar); } while (0)

    const float* x = args.in[0]; float* out = args.out;
    bf16* W_GLA_IN = (bf16*)(ws + WS_W_GLA_IN); bf16* W_GLA_OUT = (bf16*)(ws + WS_W_GLA_OUT); bf16* W_KVQ = (bf16*)(ws + WS_W_KVQ); bf16* W_SWA_OUT = (bf16*)(ws + WS_W_SWA_OUT);
    bf16* W_ROUTER = (bf16*)(ws + WS_W_ROUTER); bf16* W_GU = (bf16*)(ws + WS_W_GU); bf16* W_DN = (bf16*)(ws + WS_W_DN);
    bf16* HN = (bf16*)(ws + WS_HN);
    unsigned* EP0 = (unsigned*)(ws + WS_TOK); unsigned* EP1 = EP0 + T; unsigned* SL0 = EP1 + T; unsigned* SL1 = SL0 + T; float* TW0 = (float*)(SL1 + T); float* TW1 = TW0 + T; float* RSTD = TW1 + T;
    bf16* HB = (bf16*)(ws + WS_HB); float* SSP = (float*)(ws + WS_SSP); unsigned* TL = (unsigned*)(ws + WS_TL); float* RS = (float*)(ws + WS_RS);
    float* RL = (float*)(ws + WS_RL);

    if (IN(0)) { PB(0);
        cvt_matrix(args.in[2], 2048, GLA_PROJ_N, args.in[1], W_GLA_IN, 0, gw, NGW, lane);
        cvt_matrix(args.in[6], 2048, 2048, nullptr, W_GLA_OUT, 0, gw, NGW, lane);
        cvt_matrix(args.in[8], 2048, 512, args.in[7], W_KVQ, 0, gw, NGW, lane);
        cvt_matrix(args.in[12], 2048, 2048, args.in[11], W_KVQ, 512, gw, NGW, lane);
        cvt_matrix(args.in[15], 2048, 2048, nullptr, W_SWA_OUT, 0, gw, NGW, lane);
        for (int l = 0; l < 2; ++l) {
            cvt_matrix(args.in[17] + (size_t)l * 2048 * 4, 2048, 4, args.in[16] + l * 2048, W_ROUTER + (size_t)l * 256 * 2048, 0, gw, NGW, lane);
            cvt_matrix(args.in[19] + (size_t)l * 2048 * 32, 2048, 32, args.in[16] + l * 2048, W_ROUTER + (size_t)l * 256 * 2048, 4, gw, NGW, lane);
        }
        cvt_moe(args.in[21], args.in[22], args.in[23], args.in[16], W_GU, W_DN, gw, NGW, lane);
        norm_rows(x, HN, gw, NGW, lane);
        PE(0);
    }
    SEAM(0);
    if (IN(1)) { PB(1);
        pg8::Gemm g{HN, W_GLA_IN, T, GLA_PROJ_NP, 2048}; pg8::StaticOrder S; S.init(T, GLA_PROJ_NP, G, (int)blockIdx.x);
        pg8::EpiGlaProj E{(bf16*)(ws + WS_QK), (bf16*)(ws + WS_V), (bf16*)(ws + WS_R), (bf16*)(ws + WS_GL)};
        pg8::gemm_phase<pg8::EpiGlaProj, pg8::StaticOrder, true, true>(lds + RING_OFF, g, S, E);
        PE(1);
    }
    SEAM(1);
    if (IN(2)) { PB(2); gla_prepass(lds + RING_OFF, (const bf16*)(ws + WS_QK), (const bf16*)(ws + WS_V), (const bf16*)(ws + WS_GL), args.in[3], args.in[4],
                           (bf16*)(ws + WS_QEF), (bf16*)(ws + WS_KLTF), (bf16*)(ws + WS_ATTF), (bf16*)(ws + WS_VTF), (float*)(ws + WS_DEC)); PE(2); }
    SEAM(2);
    if (IN(3)) { PB(3); gla_seq(lds + RING_OFF, (const bf16*)(ws + WS_QEF), (const bf16*)(ws + WS_KLTF), (const bf16*)(ws + WS_ATTF), (const bf16*)(ws + WS_VTF), (const float*)(ws + WS_DEC), (bf16*)(ws + WS_QK)); PE(3); }
    SEAM(3);
    if (IN(4)) { PB(4); gla_gate((const bf16*)(ws + WS_QK), (const bf16*)(ws + WS_R), args.in[5], HN, gw, NGW, lane); PE(4); }
    SEAM(4);
    if (IN(5)) { PB(5);
        pg8::Gemm g{HN, W_GLA_OUT, T, 2048, 2048}; pg8::StaticOrder S; S.init(T, 2048, G, (int)blockIdx.x);
        pg8::EpiResF32 E{out, x, 2048, HB, SSP};
        pg8::gemm_phase<pg8::EpiResF32, pg8::StaticOrder, true, true>(lds + RING_OFF, g, S, E);
        PE(5);
    }
    SEAM(5);

    { constexpr int layer = 0; constexpr int pb = 6 + 10 * layer;
    unsigned* gcnt = (unsigned*)(ctl + CW_CNT + layer * 64);
    if (IN(pb + 1)) { PB(pb + 1);
        pg8::Gemm g{HB, W_ROUTER + (size_t)layer * 256 * 2048, T, 256, 2048}; pg8::StaticOrder S; S.init(T, 256, G, (int)blockIdx.x);
        pg8::EpiRouter E{RL};
        pg8::gemm_phase<pg8::EpiRouter, pg8::StaticOrder, true, true>(lds + RING_OFF, g, S, E);
        PE(pb + 1);
    }
    SEAM(pb + 1);
    if (IN(pb + 2)) { PB(pb + 2); moe_route(lds + RING_OFF, RL, SSP, args.in[18] + layer * 4, args.in[20] + layer * 32, gcnt, EP0, EP1, TW0, TW1, RSTD); PE(pb + 2); }
    SEAM(pb + 2);
    if (IN(pb + 3)) { PB(pb + 3); { moe_build_table(lds, gcnt); moe_slots(lds, gcnt, EP0, EP1, RSTD, SL0, SL1, TL, RS); } PE(pb + 3); }
    SEAM(pb + 3);
    if (IN(pb + 4)) { PB(pb + 4);
        moe_build_table(lds, gcnt);
        const int rows = __builtin_amdgcn_readfirstlane(((const LAS int*)(lds + MOE_OFF_OFF))[32]);
        pg8::Gemm g{HB, W_GU, rows, 1024, 2048, TL};
        pg8::GroupedOrder S{(const LAS unsigned char*)(lds + MOE_TEXP_OFF), rows >> 8, 4, G, (int)blockIdx.x};
        pg8::EpiSwiGLU E{(bf16*)(ws + WS_ACT), RS};
        pg8::gemm_phase<pg8::EpiSwiGLU, pg8::GroupedOrder, true, true, true>(lds + RING_OFF, g, S, E);
        PE(pb + 4);
    }
    SEAM(pb + 4);
    if (IN(pb + 5)) { PB(pb + 5);
        moe_build_table(lds, gcnt);
        const int rows = __builtin_amdgcn_readfirstlane(((const LAS int*)(lds + MOE_OFF_OFF))[32]);
        pg8::Gemm g{(const bf16*)(ws + WS_ACT), W_DN, rows, 2048, 512};
        pg8::GroupedOrder S{(const LAS unsigned char*)(lds + MOE_TEXP_OFF), rows >> 8, 8, G, (int)blockIdx.x};
        pg8::EpiBf16 E{(bf16*)(ws + WS_Y), 2048};
        pg8::gemm_phase<pg8::EpiBf16, pg8::GroupedOrder, true, true>(lds + RING_OFF, g, S, E);
        PE(pb + 5);
    }
    SEAM(pb + 5);
    if (IN(pb + 6)) { PB(pb + 6);
        moe_combine(out, (const bf16*)(ws + WS_Y), SL0, SL1, TW0, TW1, HN, layer == 0, gw, NGW, lane);
        if (layer == 0) cvt_moe(args.in[21] + (size_t)NE * 2048 * 512, args.in[22] + (size_t)NE * 2048 * 512, args.in[23] + (size_t)NE * 512 * 2048, args.in[16] + 2048, W_GU, W_DN, gw, NGW, lane);
        PE(pb + 6);
    }
    if (layer == 0) SEAM(pb + 6);
    }
    if (IN(13)) { PB(13);
        pg8::Gemm g{HN, W_KVQ, T, KVQ_N, 2048}; pg8::StaticOrder S; S.init(T, KVQ_N, G, (int)blockIdx.x);
        pg8::EpiBf16 E{(bf16*)(ws + WS_KVQ), KVQ_N};
        pg8::gemm_phase<pg8::EpiBf16, pg8::StaticOrder, true, true>(lds + RING_OFF, g, S, E);
        PE(13);
    }
    SEAM(13);
    if (IN(14)) { PB(14); swa_attention(lds + RING_OFF, (const bf16*)(ws + WS_KVQ), args.in[9], args.in[13], args.in[10], args.in[14], (bf16*)(ws + WS_AO)); PE(14); }
    SEAM(14);
    if (IN(15)) { PB(15);
        pg8::Gemm g{(const bf16*)(ws + WS_AO), W_SWA_OUT, T, 2048, 2048}; pg8::StaticOrder S; S.init(T, 2048, G, (int)blockIdx.x);
        pg8::EpiResF32 E{out, out, 2048, HB, SSP};
        pg8::gemm_phase<pg8::EpiResF32, pg8::StaticOrder, true, true>(lds + RING_OFF, g, S, E);
        PE(15);
    }
    SEAM(15);
    { constexpr int layer = 1; constexpr int pb = 6 + 10 * layer;
    unsigned* gcnt = (unsigned*)(ctl + CW_CNT + layer * 64);
    if (IN(pb + 1)) { PB(pb + 1);
        pg8::Gemm g{HB, W_ROUTER + (size_t)layer * 256 * 2048, T, 256, 2048}; pg8::StaticOrder S; S.init(T, 256, G, (int)blockIdx.x);
        pg8::EpiRouter E{RL};
        pg8::gemm_phase<pg8::EpiRouter, pg8::StaticOrder, true, true>(lds + RING_OFF, g, S, E);
        PE(pb + 1);
    }
    SEAM(pb + 1);
    if (IN(pb + 2)) { PB(pb + 2); moe_route(lds + RING_OFF, RL, SSP, args.in[18] + layer * 4, args.in[20] + layer * 32, gcnt, EP0, EP1, TW0, TW1, RSTD); PE(pb + 2); }
    SEAM(pb + 2);
    if (IN(pb + 3)) { PB(pb + 3); { moe_build_table(lds, gcnt); moe_slots(lds, gcnt, EP0, EP1, RSTD, SL0, SL1, TL, RS); } PE(pb + 3); }
    SEAM(pb + 3);
    if (IN(pb + 4)) { PB(pb + 4);
        moe_build_table(lds, gcnt);
        const int rows = __builtin_amdgcn_readfirstlane(((const LAS int*)(lds + MOE_OFF_OFF))[32]);
        pg8::Gemm g{HB, W_GU, rows, 1024, 2048, TL};
        pg8::GroupedOrder S{(const LAS unsigned char*)(lds + MOE_TEXP_OFF), rows >> 8, 4, G, (int)blockIdx.x};
        pg8::EpiSwiGLU E{(bf16*)(ws + WS_ACT), RS};
        pg8::gemm_phase<pg8::EpiSwiGLU, pg8::GroupedOrder, true, true, true>(lds + RING_OFF, g, S, E);
        PE(pb + 4);
    }
    SEAM(pb + 4);
    if (IN(pb + 5)) { PB(pb + 5);
        moe_build_table(lds, gcnt);
        const int rows = __builtin_amdgcn_readfirstlane(((const LAS int*)(lds + MOE_OFF_OFF))[32]);
        pg8::Gemm g{(const bf16*)(ws + WS_ACT), W_DN, rows, 2048, 512};
        pg8::GroupedOrder S{(const LAS unsigned char*)(lds + MOE_TEXP_OFF), rows >> 8, 8, G, (int)blockIdx.x};
        pg8::EpiBf16 E{(bf16*)(ws + WS_Y), 2048};
        pg8::gemm_phase<pg8::EpiBf16, pg8::GroupedOrder, true, true>(lds + RING_OFF, g, S, E);
        PE(pb + 5);
    }
    SEAM(pb + 5);
    if (IN(pb + 6)) { PB(pb + 6);
        moe_combine(out, (const bf16*)(ws + WS_Y), SL0, SL1, TW0, TW1, HN, layer == 0, gw, NGW, lane);
        if (layer == 0) cvt_moe(args.in[21] + (size_t)NE * 2048 * 512, args.in[22] + (size_t)NE * 2048 * 512, args.in[23] + (size_t)NE * 512 * 2048, args.in[16] + 2048, W_GU, W_DN, gw, NGW, lane);
        PE(pb + 6);
    }
    if (layer == 0) SEAM(pb + 6);
    }
#undef IN
#undef SEAM
}

extern "C" void kernel_launch(void* const* d_in, const int* in_sizes, int n_in, void* d_out, int out_size, void* d_ws, size_t ws_size, hipStream_t stream) {
    static int grid = 0;
    if (grid == 0) {
        if (n_in != 24 || in_sizes[0] != T * D || out_size != T * D || ws_size < WS_END) { fprintf(stderr, "kernel_launch: unexpected shapes / workspace (n_in %d, in0 %d, out %d, ws %zu < %zu)\n", n_in, n_in > 0 ? in_sizes[0] : -1, out_size, ws_size, (size_t)WS_END); grid = -1; return; }
        int dev = 0, cus = 0, per_cu = 0;
        if (hipGetDevice(&dev) != hipSuccess || hipDeviceGetAttribute(&cus, hipDeviceAttributeMultiprocessorCount, dev) != hipSuccess) { grid = -1; return; }
        if (hipFuncSetAttribute((const void*)fwd, hipFuncAttributeMaxDynamicSharedMemorySize, LDS_BYTES) != hipSuccess) { fprintf(stderr, "kernel_launch: hipFuncSetAttribute failed\n"); grid = -1; return; }
        if (hipOccupancyMaxActiveBlocksPerMultiprocessor(&per_cu, (const void*)fwd, NWAVES * 64, LDS_BYTES) != hipSuccess || per_cu < 1) { fprintf(stderr, "kernel_launch: occupancy query says %d\n", per_cu); }
        (void)hipGetLastError();
        grid = cus;
    }
    if (grid < 0) return;
    if (hipMemsetAsync((char*)d_ws + WS_CTL, 0, CTL_ZERO_BYTES, stream) != hipSuccess) return;
    Args a{};
    for (int i = 0; i < 24; ++i) a.in[i] = (const float*)d_in[i];
    a.out = (float*)d_out; a.ws = (unsigned char*)d_ws;
#if MK_PER_PHASE
    for (int p = 0; p < MK_LAST_PHASE; ++p) { a.ph_lo = p; a.ph_hi = p + 1; hipLaunchKernelGGL(fwd, dim3(grid), dim3(NWAVES * 64), LDS_BYTES, stream, a); }
#else
    a.ph_lo = 0; a.ph_hi = MK_LAST_PHASE;
    hipLaunchKernelGGL(fwd, dim3(grid), dim3(NWAVES * 64), LDS_BYTES, stream, a);
#endif
    const hipError_t le = hipPeekAtLastError();
    if (le != hipSuccess) fprintf(stderr, "kernel_launch: launch failed: %s\n", hipGetErrorName(le));
}
```

```cpp
#include <hip/hip_runtime.h>
#include <cstdio>
#include <cstdint>

#ifndef MK_PER_PHASE
#define MK_PER_PHASE 0
#endif
#ifndef MK_LAST_PHASE
#define MK_LAST_PHASE 23
#endif

#ifndef MK_PHASE_MASK
#define MK_PHASE_MASK 0x7fffff
#endif

#ifndef MK_DELAY_MASK
#define MK_DELAY_MASK 0
#endif

namespace pg8 {
#define PG8_LAS __attribute__((address_space(3)))
typedef unsigned short bf16_t;
typedef short bf16x8 __attribute__((ext_vector_type(8)));
typedef float f32x4 __attribute__((ext_vector_type(4)));
typedef unsigned u32x4 __attribute__((ext_vector_type(4)));
constexpr int BM = 256, BK = 64, HALF = 128, HTB = HALF * BK * 2  , STAGE_BYTES = 8 * HTB, NXCD = 8, WGM = 8;

__host__ __device__ __forceinline__ int lds_byte(int r, int c) { const int st = (r >> 4) * 2 + (c >> 5), rr = r & 15, cc = c & 31, ob = rr * 64 + cc * 2; return st * 1024 + (ob ^ (((ob >> 9) & 1) << 5)); }
__host__ __device__ __forceinline__ void stage_rc(int b, int& R, int& C) { const int st = b / 1024, sb = b % 1024, swz = sb ^ (((sb >> 9) & 1) << 5); R = (st >> 1) * 16 + swz / 64; C = (st & 1) * 32 + (swz % 64) / 2; }
__host__ __device__ __forceinline__ int perm32(int rho) { const int n = rho >> 4, i = rho & 15; return 8 * (i >> 2) + 4 * n + (i & 3); }

struct Unit { int pm, pn, pc; };
struct Gemm { const bf16_t* A; const bf16_t* Bt; int M, N, K; const unsigned* rowidx; };


struct StaticOrder {
    int nM, nN, nwg, G, c;
    __host__ __device__ void init(int M, int N, int G_, int c_) { nM = M / BM; nN = N / BM; nwg = nM * nN; G = G_; c = c_; }
    __host__ __device__ bool next(int i, Unit& u) const {
        const long L = (long)i * G + c; if (L >= nwg) return false;
        int wgid = (int)L; { const int q = nwg / NXCD, r = nwg % NXCD, xcd = wgid % NXCD, off = wgid / NXCD; wgid = (xcd < r ? xcd * (q + 1) : r * (q + 1) + (xcd - r) * q) + off; }
        const int nig = WGM * nN, gid = wgid / nig, fm = gid * WGM, gsz = (nM - fm) < WGM ? (nM - fm) : WGM;
        u.pm = fm + ((wgid % nig) % gsz); u.pn = (wgid % nig) / gsz; u.pc = u.pn; return true;
    }
    __device__ __forceinline__ void a_ready(const Unit&) const {}
    __device__ __forceinline__ void done(const Unit&) const {}
};
struct GroupedOrder {
    const PG8_LAS unsigned char* texp; int MT, npn, G, c;
    __device__ __forceinline__ bool next(int i, Unit& u) const {
        const long L = (long)i * G + c; if (L >= (long)MT * npn) return false;
        const int pm = (int)(L / npn), pc = (int)(L % npn);
        const int e = __builtin_amdgcn_readfirstlane((int)texp[pm]);
        u.pm = pm; u.pn = e * npn + pc; u.pc = pc; return true;
    }
    __device__ __forceinline__ void a_ready(const Unit&) const {}
    __device__ __forceinline__ void done(const Unit&) const {}
};

__device__ __forceinline__ unsigned cvt_pk_bf16(float lo, float hi) { unsigned r; asm volatile("v_cvt_pk_bf16_f32 %0, %1, %2" : "=v"(r) : "v"(lo), "v"(hi)); return r; }

struct EpiBf16 {
    static constexpr bool PERM = true, AFTER_DRAIN = false;
    bf16_t* O; int ldc;
    __device__ __forceinline__ void operator()(const f32x4 (&acc)[2][2][4][2], const Unit& u, int wr, int wc, int fr, int fq) const {
        const int row0 = u.pm * BM + wr * 64 + fr, col0 = u.pc * BM + wc * 32 + 8 * fq;
#pragma unroll
        for (int ai = 0; ai < 2; ++ai)
#pragma unroll
            for (int m = 0; m < 4; ++m) { bf16_t* rowp = O + (size_t)(row0 + ai * HALF + m * 16) * ldc + col0;
#pragma unroll
                for (int bj = 0; bj < 2; ++bj) { const f32x4 v0 = acc[ai][bj][m][0], v1 = acc[ai][bj][m][1];
                    u32x4 w; w.x = cvt_pk_bf16(v0[0], v0[1]); w.y = cvt_pk_bf16(v0[2], v0[3]); w.z = cvt_pk_bf16(v1[0], v1[1]); w.w = cvt_pk_bf16(v1[2], v1[3]);
                    *(u32x4*)(rowp + bj * HALF) = w; } }
    }
};
struct EpiGlaProj {
    static constexpr bool PERM = true, AFTER_DRAIN = false;
    bf16_t *QK, *V, *R, *GL;
    __device__ __forceinline__ void operator()(const f32x4 (&acc)[2][2][4][2], const Unit& u, int wr, int wc, int fr, int fq) const {
        bf16_t* base; int ldc, ct;
        if (u.pc < 8) { base = QK; ldc = 2048; ct = u.pc; } else if (u.pc < 16) { base = V; ldc = 2048; ct = u.pc - 8; } else if (u.pc < 24) { base = R; ldc = 2048; ct = u.pc - 16; } else { base = GL; ldc = 256; ct = 0; }
        const int row0 = u.pm * BM + wr * 64 + fr, col0 = ct * BM + wc * 32 + 8 * fq;
#pragma unroll
        for (int ai = 0; ai < 2; ++ai)
#pragma unroll
            for (int m = 0; m < 4; ++m) { bf16_t* rowp = base + (size_t)(row0 + ai * HALF + m * 16) * ldc + col0;
#pragma unroll
                for (int bj = 0; bj < 2; ++bj) { const f32x4 v0 = acc[ai][bj][m][0], v1 = acc[ai][bj][m][1];
                    u32x4 w; w.x = cvt_pk_bf16(v0[0], v0[1]); w.y = cvt_pk_bf16(v0[2], v0[3]); w.z = cvt_pk_bf16(v1[0], v1[1]); w.w = cvt_pk_bf16(v1[2], v1[3]);
                    *(u32x4*)(rowp + bj * HALF) = w; } }
    }
};
struct EpiResF32 {
    static constexpr bool PERM = true, AFTER_DRAIN = false;
    float* C; const float* RES; int ldc; bf16_t* HB; float* SSP;
    __device__ __forceinline__ void operator()(const f32x4 (&acc)[2][2][4][2], const Unit& u, int wr, int wc, int fr, int fq) const {
        const int row0 = u.pm * BM + wr * 64 + fr, col0 = u.pc * BM + wc * 32 + 8 * fq;
#pragma unroll
        for (int ai = 0; ai < 2; ++ai)
#pragma unroll
            for (int m = 0; m < 4; ++m) { const int row = row0 + ai * HALF + m * 16; const size_t off = (size_t)row * ldc + col0;
                f32x4 rv[2][2];
#pragma unroll
                for (int bj = 0; bj < 2; ++bj)
#pragma unroll
                    for (int n = 0; n < 2; ++n) rv[bj][n] = *(const f32x4*)(RES + off + bj * HALF + n * 4);
                float ss = 0.f;
#pragma unroll
                for (int bj = 0; bj < 2; ++bj) { const f32x4 v0 = acc[ai][bj][m][0] + rv[bj][0], v1 = acc[ai][bj][m][1] + rv[bj][1];
                    *(f32x4*)(C + off + bj * HALF) = v0; *(f32x4*)(C + off + bj * HALF + 4) = v1;
                    u32x4 w; w.x = cvt_pk_bf16(v0[0], v0[1]); w.y = cvt_pk_bf16(v0[2], v0[3]); w.z = cvt_pk_bf16(v1[0], v1[1]); w.w = cvt_pk_bf16(v1[2], v1[3]);
                    *(u32x4*)(HB + off + bj * HALF) = w;
                    ss += (v0[0] * v0[0] + v0[1] * v0[1]) + (v0[2] * v0[2] + v0[3] * v0[3]) + (v1[0] * v1[0] + v1[1] * v1[1]) + (v1[2] * v1[2] + v1[3] * v1[3]); }
                ss += __shfl_xor(ss, 16); ss += __shfl_xor(ss, 32);
                if (fq == 0) SSP[(size_t)row * 32 + u.pc * 4 + wc] = ss; }
    }
};
struct EpiRouter {
    static constexpr bool PERM = false, AFTER_DRAIN = false;
    float* RL;
    __device__ __forceinline__ void operator()(const f32x4 (&acc)[2][2][4][2], const Unit& u, int wr, int wc, int fr, int fq) const {
        if (wc >= 2) return;
        const int row0 = u.pm * BM + wr * 64 + fr, col0 = wc * 32 + 4 * fq;
#pragma unroll
        for (int ai = 0; ai < 2; ++ai)
#pragma unroll
            for (int m = 0; m < 4; ++m) { float* rowp = RL + (size_t)(row0 + ai * HALF + m * 16) * 64 + col0;
#pragma unroll
                for (int n = 0; n < 2; ++n) *(f32x4*)(rowp + n * 16) = acc[ai][0][m][n]; }
    }
};
__device__ __forceinline__ float silu_f(float x) { return x * __builtin_amdgcn_rcpf(1.0f + __expf(-x)); }
struct EpiSwiGLU {
    static constexpr bool PERM = true, AFTER_DRAIN = false;
    bf16_t* ACT; const float* RS;
    __device__ __forceinline__ void operator()(const f32x4 (&acc)[2][2][4][2], const Unit& u, int wr, int wc, int fr, int fq) const {
        const int row0 = u.pm * BM + wr * 64 + fr, col0 = u.pc * HALF + wc * 32 + 8 * fq;
#pragma unroll
        for (int ai = 0; ai < 2; ++ai)
#pragma unroll
            for (int m = 0; m < 4; ++m) { const int row = row0 + ai * HALF + m * 16; bf16_t* rowp = ACT + (size_t)row * 512 + col0; const float rs = RS[row];
                const f32x4 g0 = acc[ai][0][m][0] * rs, g1 = acc[ai][0][m][1] * rs, u0 = acc[ai][1][m][0] * rs, u1 = acc[ai][1][m][1] * rs;
                u32x4 w;
                w.x = cvt_pk_bf16(silu_f(g0[0]) * u0[0], silu_f(g0[1]) * u0[1]); w.y = cvt_pk_bf16(silu_f(g0[2]) * u0[2], silu_f(g0[3]) * u0[3]);
                w.z = cvt_pk_bf16(silu_f(g1[0]) * u1[0], silu_f(g1[1]) * u1[1]); w.w = cvt_pk_bf16(silu_f(g1[2]) * u1[2], silu_f(g1[3]) * u1[3]);
                *(u32x4*)rowp = w; }
    }
};

template <class Epi, class Sched, bool ALIGN_EPI = false, bool SP2 = false, bool GATHER = false>
__device__ __forceinline__ void gemm_phase(PG8_LAS unsigned char* lds, const Gemm g, const Sched& S, const Epi& E) {
    const int tid = threadIdx.x, wid = __builtin_amdgcn_readfirstlane(tid >> 6), lane = tid & 63, wr = wid >> 2, wc = wid & 3, fr = lane & 15, fq = lane >> 4;
    const int K = g.K, nt = K / BK;
    unsigned voffA[2], voffB[2];
#pragma unroll
    for (int i = 0; i < 2; ++i) { int R, C; stage_rc(tid * 16 + i * 8192, R, C); const int Rb = Epi::PERM ? ((R & ~31) + perm32(R & 31)) : R;
        voffA[i] = (unsigned)(R * K + C) * 2u; voffB[i] = (unsigned)(Rb * K + C) * 2u; }
    unsigned vA[2][2] = {{0u, 0u}, {0u, 0u}}, vAn[2][2] = {{0u, 0u}, {0u, 0u}}; int rA[2] = {0, 0}; unsigned cbA[2] = {0u, 0u};
    if constexpr (GATHER) {
#pragma unroll
        for (int i = 0; i < 2; ++i) { int R, C; stage_rc(tid * 16 + i * 8192, R, C); rA[i] = R; cbA[i] = (unsigned)C * 2u; } }
#define PG8_GIDX(dst, pmv) do { _Pragma("unroll") for (int _h = 0; _h < 2; ++_h) _Pragma("unroll") for (int _i = 0; _i < 2; ++_i) \
        dst[_h][_i] = g.rowidx[(size_t)(pmv) * BM + _h * HALF + rA[_i]] * (unsigned)(K * 2) + cbA[_i]; } while (0)
    const size_t kstep = (size_t)(BK * 2);
    const size_t hstep = (size_t)HALF * K * 2;
    const size_t tstep = 2 * hstep;
    const unsigned ldsw = (unsigned)wid * 1024u;
    const int aoff = lds_byte(wr * 64 + fr, fq * 8), boff = lds_byte(wc * 32 + fr, fq * 8);
#define PG8_SA(b, h) (((b) * 2 + (h)) * HTB)
#define PG8_SB(b, h) ((4 + (b) * 2 + (h)) * HTB)
#define PG8_STAGE(bufoff, gbase, voff) do { _Pragma("unroll") for (int _i = 0; _i < 2; ++_i) \
        __builtin_amdgcn_global_load_lds((const unsigned*)((const char*)(gbase) + (voff)[_i]), (PG8_LAS unsigned*)(lds + (bufoff) + ldsw + _i * 8192), 16, 0, 0); } while (0)
#define PG8_STAGE_A(bufoff, nx, kb, h) do { if constexpr (GATHER) { const char* _b = (const char*)g.A + (kb); \
        _Pragma("unroll") for (int _i = 0; _i < 2; ++_i) { const unsigned _v = (nx) ? vAn[h][_i] : vA[h][_i]; \
            __builtin_amdgcn_global_load_lds((const unsigned*)(_b + _v), (PG8_LAS unsigned*)(lds + (bufoff) + ldsw + _i * 8192), 16, 0, 0); } } \
    else { const char* _b = ((nx) ? nA : cA) + (kb) + (size_t)(h) * hstep; PG8_STAGE(bufoff, _b, voffA); } } while (0)
#define PG8_LDA(dst, b, h) do { _Pragma("unroll") for (int m = 0; m < 4; ++m) _Pragma("unroll") for (int k = 0; k < 2; ++k) dst[m][k] = *(const PG8_LAS bf16x8*)(lds + PG8_SA(b, h) + aoff + m * 2048 + k * 1024); } while (0)
#define PG8_LDB(dst, b, h) do { _Pragma("unroll") for (int n = 0; n < 2; ++n) _Pragma("unroll") for (int k = 0; k < 2; ++k) dst[n][k] = *(const PG8_LAS bf16x8*)(lds + PG8_SB(b, h) + boff + n * 2048 + k * 1024); } while (0)
#define PG8_MMA(ai, bj, At, Bt) do { __builtin_amdgcn_s_setprio(1); _Pragma("unroll") for (int m = 0; m < 4; ++m) _Pragma("unroll") for (int n = 0; n < 2; ++n) _Pragma("unroll") for (int k = 0; k < 2; ++k) \
        acc[ai][bj][m][n] = __builtin_amdgcn_mfma_f32_16x16x32_bf16(Bt[n][k], At[m][k], acc[ai][bj][m][n], 0, 0, 0); __builtin_amdgcn_s_setprio(0); } while (0)
#define PG8_WAIT_V(n) asm volatile("s_waitcnt vmcnt(" #n ")" ::: "memory")
#define PG8_WAIT_L(n) asm volatile("s_waitcnt lgkmcnt(" #n ")" ::: "memory")
#define PG8_BAR __builtin_amdgcn_s_barrier()
#define PG8_SCHED __builtin_amdgcn_sched_barrier(0)
    Unit cur, nxt; int ui = 0;
    if (!S.next(0, cur)) return;
    f32x4 acc[2][2][4][2];
#pragma unroll
    for (int a = 0; a < 2; ++a)
#pragma unroll
        for (int b = 0; b < 2; ++b)
#pragma unroll
            for (int m = 0; m < 4; ++m)
#pragma unroll
                for (int n = 0; n < 2; ++n) acc[a][b][m][n] = (f32x4){0.f, 0.f, 0.f, 0.f};
    bf16x8 At[4][2], B0[2][2], B1[2][2];
    const char* cA = (const char*)g.A + (size_t)cur.pm * tstep; const char* cB = (const char*)g.Bt + (size_t)cur.pn * tstep;
    const char* nA = cA; const char* nB = cB;
    if constexpr (GATHER) { PG8_GIDX(vA, cur.pm); }
    S.a_ready(cur);
    if constexpr (SP2) {
        PG8_STAGE(PG8_SB(0, 0), cB, voffB); PG8_STAGE(PG8_SB(0, 1), cB + hstep, voffB); PG8_STAGE_A(PG8_SA(0, 0), false, 0, 0); PG8_STAGE_A(PG8_SA(0, 1), false, 0, 1);
        if (wr == 1) PG8_BAR;
        PG8_WAIT_V(2); PG8_BAR;
        PG8_STAGE(PG8_SB(1, 0), cB + kstep, voffB); PG8_STAGE_A(PG8_SA(1, 0), false, kstep, 0); PG8_STAGE(PG8_SB(1, 1), cB + hstep + kstep, voffB);
        PG8_WAIT_V(6); PG8_BAR;
    } else {
        PG8_STAGE(PG8_SB(0, 0), cB, voffB); PG8_STAGE(PG8_SA(0, 0), cA, voffA); PG8_STAGE(PG8_SB(0, 1), cB + hstep, voffB); PG8_STAGE(PG8_SA(0, 1), cA + hstep, voffA);
        if (wr == 1) PG8_BAR;
        PG8_WAIT_V(4); PG8_BAR;
        PG8_STAGE(PG8_SB(1, 0), cB + kstep, voffB); PG8_STAGE(PG8_SA(1, 0), cA + kstep, voffA); PG8_STAGE(PG8_SB(1, 1), cB + hstep + kstep, voffB);
        PG8_WAIT_V(6); PG8_BAR;
    }
    for (;;) {
        const bool has_next = S.next(ui + 1, nxt);
        nA = has_next ? (const char*)g.A + (size_t)nxt.pm * tstep : cA; nB = has_next ? (const char*)g.Bt + (size_t)nxt.pn * tstep : cB;
        if constexpr (GATHER) { if (has_next) { PG8_GIDX(vAn, nxt.pm); } else {
#pragma unroll
            for (int _h = 0; _h < 2; ++_h) { vAn[_h][0] = vA[_h][0]; vAn[_h][1] = vA[_h][1]; } } }
        for (int t = 0; t < nt; t += 2) {
            const bool last = (t == nt - 2);
            const char* a1 = cA + (size_t)(t + 1) * kstep;
            const char* a2 = last ? nA : cA + (size_t)(t + 2) * kstep; const char* b2 = last ? nB : cB + (size_t)(t + 2) * kstep;
            const char* a3 = a2 + kstep; const char* b3 = b2 + kstep;
            const size_t ka1 = (size_t)(t + 1) * kstep, ka2 = last ? (size_t)0 : (size_t)(t + 2) * kstep, ka3 = ka2 + kstep; (void)a1; (void)a3;
            if (last && has_next) S.a_ready(nxt);
            if constexpr (SP2) {
            PG8_LDB(B0, 0, 0); PG8_LDB(B1, 0, 1); PG8_SCHED; PG8_LDA(At, 0, 0); PG8_STAGE_A(PG8_SA(1, 1), false, ka1, 1);
            PG8_WAIT_V(8); PG8_WAIT_L(0); PG8_BAR; PG8_MMA(0, 0, At, B0); PG8_MMA(0, 1, At, B1); PG8_BAR; PG8_SCHED;
            PG8_LDA(At, 0, 1); PG8_STAGE(PG8_SB(0, 0), b2, voffB); PG8_STAGE(PG8_SB(0, 1), b2 + hstep, voffB); PG8_STAGE_A(PG8_SA(0, 0), last, ka2, 0);
            PG8_WAIT_V(8); PG8_WAIT_L(0); PG8_BAR; PG8_MMA(1, 0, At, B0); PG8_MMA(1, 1, At, B1); PG8_BAR; PG8_SCHED;
            PG8_LDB(B0, 1, 0); PG8_LDB(B1, 1, 1); PG8_SCHED; PG8_LDA(At, 1, 0); PG8_STAGE_A(PG8_SA(0, 1), last, ka2, 1);
            PG8_WAIT_V(8); PG8_WAIT_L(0); PG8_BAR; PG8_MMA(0, 0, At, B0); PG8_MMA(0, 1, At, B1); PG8_BAR; PG8_SCHED;
            PG8_LDA(At, 1, 1); PG8_STAGE(PG8_SB(1, 0), b3, voffB); PG8_STAGE(PG8_SB(1, 1), b3 + hstep, voffB); PG8_STAGE_A(PG8_SA(1, 0), last, ka3, 0);
            PG8_WAIT_V(8); PG8_WAIT_L(0); PG8_BAR; PG8_MMA(1, 0, At, B0); PG8_MMA(1, 1, At, B1); PG8_BAR; PG8_SCHED;
            } else {
            PG8_LDB(B0, 0, 0); PG8_SCHED; PG8_LDA(At, 0, 0); PG8_STAGE(PG8_SA(1, 1), a1 + hstep, voffA);
            PG8_WAIT_L(8); PG8_BAR; PG8_WAIT_L(0); PG8_MMA(0, 0, At, B0); PG8_BAR; PG8_SCHED;
            PG8_LDB(B1, 0, 1); PG8_STAGE(PG8_SB(0, 0), b2, voffB);
            PG8_BAR; PG8_WAIT_L(0); PG8_MMA(0, 1, At, B1); PG8_BAR;
            PG8_LDA(At, 0, 1); PG8_STAGE(PG8_SA(0, 0), a2, voffA);
            PG8_BAR; PG8_WAIT_L(0); PG8_MMA(1, 0, At, B0); PG8_BAR; PG8_SCHED;
            PG8_STAGE(PG8_SB(0, 1), b2 + hstep, voffB);
            PG8_WAIT_V(6); PG8_BAR; PG8_MMA(1, 1, At, B1); PG8_BAR;
            PG8_LDB(B0, 1, 0); PG8_SCHED; PG8_LDA(At, 1, 0); PG8_STAGE(PG8_SA(0, 1), a2 + hstep, voffA);
            PG8_WAIT_L(8); PG8_BAR; PG8_WAIT_L(0); PG8_MMA(0, 0, At, B0); PG8_BAR; PG8_SCHED;
            PG8_LDB(B1, 1, 1); PG8_STAGE(PG8_SB(1, 0), b3, voffB);
            PG8_BAR; PG8_WAIT_L(0); PG8_MMA(0, 1, At, B1); PG8_BAR;
            PG8_LDA(At, 1, 1); PG8_STAGE(PG8_SA(1, 0), a3, voffA);
            PG8_BAR; PG8_WAIT_L(0); PG8_MMA(1, 0, At, B0); PG8_BAR; PG8_SCHED;
            PG8_STAGE(PG8_SB(1, 1), b3 + hstep, voffB);
            PG8_WAIT_V(6); PG8_BAR; PG8_MMA(1, 1, At, B1); PG8_BAR;
            }
        }
        if constexpr (ALIGN_EPI) { if (wr == 0) PG8_BAR; }
        if constexpr (!Epi::AFTER_DRAIN) { E(acc, cur, wr, wc, fr, fq); S.done(cur); }
        if (!has_next) break;
#pragma unroll
        for (int a = 0; a < 2; ++a)
#pragma unroll
            for (int b = 0; b < 2; ++b)
#pragma unroll
                for (int m = 0; m < 4; ++m)
#pragma unroll
                    for (int n = 0; n < 2; ++n) acc[a][b][m][n] = (f32x4){0.f, 0.f, 0.f, 0.f};
        cur = nxt; cA = nA; cB = nB; ++ui;
        if constexpr (GATHER) {
#pragma unroll
            for (int _h = 0; _h < 2; ++_h) { vA[_h][0] = vAn[_h][0]; vA[_h][1] = vAn[_h][1]; } }
        if constexpr (ALIGN_EPI) { if (wr == 1) PG8_BAR; }
    }
    PG8_WAIT_V(0);
    if constexpr (!ALIGN_EPI) { if (wr == 0) PG8_BAR; }
    PG8_BAR;
    if constexpr (Epi::AFTER_DRAIN) { E.fused(acc, cur, wr, wc, fr, fq, lds, wid, lane); S.done(cur); }
#undef PG8_SA
#undef PG8_STAGE_A
#undef PG8_GIDX
#undef PG8_SB
#undef PG8_STAGE
#undef PG8_LDA
#undef PG8_LDB
#undef PG8_MMA
#undef PG8_WAIT_V
#undef PG8_WAIT_L
#undef PG8_BAR
#undef PG8_SCHED
}
}

constexpr int NWAVES = 8;
constexpr int T = 32768, D = 2048, SEQ = 16384;
constexpr float RMS_EPS = 1e-6f;
constexpr int GLA_H = 4, GLA_DK = 256, GLA_DV = 512, GLA_C = 64, GLA_NCH = SEQ / GLA_C  , GLA_PROJ_N = 6160, GLA_PROJ_NP = 6400;
constexpr int NITEM_GLA = 2 * GLA_H * GLA_NCH;
constexpr int SWA_HQ = 32, SWA_HKV = 4, SWA_HD = 64, SWA_W = 128, KVQ_N = 2560;
constexpr int NE = 32, FF = 512, MOE_MAXROWS = 2 * T + NE * 256;

constexpr size_t MiB = 1u << 20;
constexpr size_t WS_CTL = 0, CTL_ZERO_BYTES = 1 * MiB;
constexpr size_t WS_W_GLA_IN = 1 * MiB;
constexpr size_t WS_W_GLA_OUT = 26 * MiB;
constexpr size_t WS_W_KVQ = 34 * MiB;
constexpr size_t WS_W_SWA_OUT = 44 * MiB;
constexpr size_t WS_W_ROUTER = 52 * MiB;
constexpr size_t WS_TOK = 54 * MiB;
constexpr size_t WS_RL = 56 * MiB;
constexpr size_t WS_W_GU = 64 * MiB;
constexpr size_t WS_W_DN = 192 * MiB;
constexpr size_t WS_HN = 256 * MiB;
constexpr size_t WS_BIG = 384 * MiB;
constexpr size_t WS_QK = WS_BIG;
constexpr size_t WS_V = WS_BIG + 128 * MiB;
constexpr size_t WS_R = WS_BIG + 256 * MiB;
constexpr size_t WS_GL = WS_BIG + 384 * MiB;
constexpr size_t WS_QEF = WS_BIG + 400 * MiB;
constexpr size_t WS_KLTF = WS_BIG + 464 * MiB;
constexpr size_t WS_ATTF = WS_BIG + 528 * MiB;
constexpr size_t WS_VTF = WS_BIG + 544 * MiB;
constexpr size_t WS_DEC = WS_BIG + 672 * MiB;
constexpr size_t WS_SEND = WS_V;
constexpr size_t WS_DTOT = WS_V + 32 * MiB;
constexpr size_t WS_GLA_END = WS_BIG + 674 * MiB;
constexpr size_t WS_SSP = WS_BIG;
constexpr size_t WS_TL = WS_BIG + 8 * MiB;
constexpr size_t WS_RS = WS_BIG + 9 * MiB;
constexpr size_t WS_HB = WS_BIG + 16 * MiB;
constexpr size_t WS_ACT = WS_BIG + 288 * MiB;
constexpr size_t WS_Y = WS_BIG + 360 * MiB;
constexpr size_t WS_KVQ = WS_BIG;
constexpr size_t WS_AO = WS_BIG + 160 * MiB;
constexpr size_t WS_END = WS_GLA_END;
static_assert(WS_Y + (size_t)MOE_MAXROWS * 2048 * 2 <= WS_END && WS_ACT + (size_t)MOE_MAXROWS * 512 * 2 <= WS_Y, "MoE map");
constexpr int CW_BAR = 4096;
constexpr int CW_CNT = 16384;

constexpr int RING_OFF = 0, RING_BYTES = 149504;
constexpr int LDSCTL_OFF = RING_BYTES;
constexpr int MISC_OFF = LDSCTL_OFF + 64;
constexpr int MOE_OFF_OFF = LDSCTL_OFF + 256;
constexpr int MOE_TEXP_OFF = LDSCTL_OFF + 512;
constexpr int LDS_BYTES = RING_BYTES + 2048;

#define GAS __attribute__((address_space(1)))
#define LAS __attribute__((address_space(3)))
typedef unsigned short bf16;
typedef unsigned v4u __attribute__((ext_vector_type(4)));
typedef unsigned v2u __attribute__((ext_vector_type(2)));
typedef float f32x4 __attribute__((ext_vector_type(4)));
typedef short bf16x8 __attribute__((ext_vector_type(8)));
typedef GAS unsigned gu32;
#define RLX_AGENT __ATOMIC_RELAXED, __HIP_MEMORY_SCOPE_AGENT
#define LDS_WAIT() asm volatile("s_waitcnt lgkmcnt(0)" ::: "memory")
#define VM_WAIT() asm volatile("s_waitcnt vmcnt(0)" ::: "memory")
__device__ __forceinline__ unsigned f2bf(float f) { unsigned u = __builtin_bit_cast(unsigned, f); return (u + 0x7fffu + ((u >> 16) & 1u)) >> 16; }
__device__ __forceinline__ unsigned pk2(float lo, float hi) { return pg8::cvt_pk_bf16(lo, hi); }
__device__ __forceinline__ float bf_lo(unsigned w) { return __builtin_bit_cast(float, w << 16); }
__device__ __forceinline__ float bf_hi(unsigned w) { return __builtin_bit_cast(float, w & 0xffff0000u); }
__device__ __forceinline__ float bf2f(bf16 b) { return __builtin_bit_cast(float, ((unsigned)b) << 16); }
__device__ __forceinline__ float wave_sum(float v) {
#pragma unroll
    for (int o = 1; o < 64; o <<= 1) v += __shfl_xor(v, o);
    return v;
}

#define XB_TMO      128
#define XB_XCNT(j)  (256  + 64 * (j))
#define XB_XSUB(j)  (1280 + 64 * (j))
#define XB_XGEN(j)  (2304 + 64 * (j))
#define XB_TOP      3328
#define XB_TOPGEN   3392
#define XCD_BAR_WORDS 3456
#define XB_SPIN_CAP (1u << 18)

__device__ __forceinline__ unsigned xb_ld(unsigned* p)              { return __hip_atomic_load(p, __ATOMIC_RELAXED, __HIP_MEMORY_SCOPE_AGENT); }
__device__ __forceinline__ unsigned xb_add(unsigned* p, unsigned v) { return __hip_atomic_fetch_add(p, v, __ATOMIC_RELAXED, __HIP_MEMORY_SCOPE_AGENT); }
__device__ __forceinline__ unsigned xb_xcc_id() { return (unsigned)__builtin_amdgcn_s_getreg((3 << 11) | 20) & 0xFu; }
#define XB_SPIN(cond, bar) do { unsigned _sp = 0; while (cond) { __builtin_amdgcn_s_sleep(1); \
    if ((++_sp & 255u) == 0u) { if (xb_ld(&(bar)[XB_TMO])) break; if (_sp > XB_SPIN_CAP) { atomicAdd(&(bar)[XB_TMO], 1u); break; } } } } while (0)

struct XcdBarrier {
    unsigned* bar; unsigned x;
    volatile LAS unsigned* st;
};

__device__ __forceinline__ XcdBarrier xcd_barrier_post(unsigned* bar, volatile LAS unsigned* st) {
    XcdBarrier b; b.bar = bar; b.x = xb_xcc_id(); b.st = st;
    if (threadIdx.x == 0) (void)xb_add(&bar[XB_XCNT(b.x)], 1u);
    return b;
}
__device__ __forceinline__ void xcd_barrier_complete(unsigned* bar, unsigned x, unsigned& nloc, unsigned& nx) {
    const unsigned G = gridDim.x * gridDim.y * gridDim.z;
    unsigned sum, cnt, mine, sp = 0u;
    for (;;) {
        sum = 0u; cnt = 0u; mine = 0u;
#pragma unroll
        for (unsigned j = 0; j < 16; ++j) { const unsigned c = xb_ld(&bar[XB_XCNT(j)]); sum += c; cnt += (c > 0u) ? 1u : 0u; mine = (j == x) ? c : mine; }
        if (sum == G) break;
        __builtin_amdgcn_s_sleep(1);
        if ((++sp & 255u) == 0u) { if (xb_ld(&bar[XB_TMO])) break; if (sp > XB_SPIN_CAP) { atomicAdd(&bar[XB_TMO], 1u); break; } }
    }
    nloc = mine > 0u ? mine : 1u; nx = cnt > 0u ? cnt : 1u;
}

__device__ __forceinline__ void xcd_barrier(const XcdBarrier& b) {
    asm volatile("s_waitcnt vmcnt(0)" ::: "memory");
    __syncthreads();
    if (threadIdx.x == 0) {
        unsigned* bar = b.bar;
        __builtin_amdgcn_s_waitcnt(0);
        unsigned nloc = b.st[0], nx = b.st[1];
        if (nloc == 0u) { xcd_barrier_complete(bar, b.x, nloc, nx); b.st[0] = nloc; b.st[1] = nx; }
        const unsigned old = xb_add(&bar[XB_XSUB(b.x)], 1u);
        const unsigned gen = old / nloc;
        if (old + 1u == (gen + 1u) * nloc) {
            __builtin_amdgcn_fence(__ATOMIC_RELEASE, "agent");
            asm volatile("s_waitcnt vmcnt(0)" ::: "memory");
            const unsigned og = xb_add(&bar[XB_TOP], 1u);
            const unsigned tg = og / nx;
            if (og + 1u == (tg + 1u) * nx) xb_add(&bar[XB_TOPGEN], 1u);
            else XB_SPIN(xb_ld(&bar[XB_TOPGEN]) == tg, bar);
            __builtin_amdgcn_fence(__ATOMIC_ACQUIRE, "agent");
            xb_add(&bar[XB_XGEN(b.x)], 1u);
            asm volatile("s_waitcnt vmcnt(0)" ::: "memory");
        } else {
            XB_SPIN(xb_ld(&bar[XB_XGEN(b.x)]) == gen, bar);
            __builtin_amdgcn_fence(__ATOMIC_ACQUIRE, "agent");
            asm volatile("s_waitcnt vmcnt(0)" ::: "memory");
        }
    }
    __syncthreads();
}


__device__ __forceinline__ void cvt_item(const float* W, int N, const float* gain, bf16* WT, int K, int k0, int n0, size_t dst_row0, int lane) {
    const int q = lane >> 4, c = lane & 15;
    const bool ok = (n0 + 4 * c) < N;
    const GAS f32x4* src = (const GAS f32x4*)(W + (size_t)(k0 + 16 * q) * N + n0 + 4 * c);
    f32x4 v[16];
#pragma unroll
    for (int i = 0; i < 16; ++i) v[i] = ok ? src[(size_t)i * (N / 4)] : (f32x4){0.f, 0.f, 0.f, 0.f};
    if (gain) { const GAS f32x4* gp = (const GAS f32x4*)(gain + k0 + 16 * q);
#pragma unroll
        for (int i4 = 0; i4 < 4; ++i4) { const f32x4 g = gp[i4]; v[4 * i4 + 0] = v[4 * i4 + 0] * g.x; v[4 * i4 + 1] = v[4 * i4 + 1] * g.y; v[4 * i4 + 2] = v[4 * i4 + 2] * g.z; v[4 * i4 + 3] = v[4 * i4 + 3] * g.w; } }
    if (ok) {
#pragma unroll
        for (int e = 0; e < 4; ++e) { bf16* dst = WT + (dst_row0 + 4 * c + e) * (size_t)K + k0 + 16 * q;
            v4u o0, o1;
            o0.x = pk2(v[0][e], v[1][e]); o0.y = pk2(v[2][e], v[3][e]); o0.z = pk2(v[4][e], v[5][e]); o0.w = pk2(v[6][e], v[7][e]);
            o1.x = pk2(v[8][e], v[9][e]); o1.y = pk2(v[10][e], v[11][e]); o1.z = pk2(v[12][e], v[13][e]); o1.w = pk2(v[14][e], v[15][e]);
            *(GAS v4u*)dst = o0; *(GAS v4u*)(dst + 8) = o1; } }
}
__device__ __forceinline__ void cvt_matrix(const float* W, int K, int N, const float* gain, bf16* WT, int rowbase, int gw, int NGW, int lane) {
    const int nblk = (N + 63) / 64, nitems = (K / 64) * nblk;
    for (int it = gw; it < nitems; it += NGW) { const int kb = it / nblk, nb = it - kb * nblk;
        cvt_item(W, N, gain, WT, K, kb * 64, nb * 64, (size_t)(rowbase + nb * 64), lane); }
}
__device__ __forceinline__ void cvt_moe(const float* wg, const float* wu, const float* wd, const float* gain, bf16* WGU, bf16* WDN, int gw, int NGW, int lane) {
    for (int it = gw; it < 2 * 8192; it += NGW) { const int which = it >> 13, r = it & 8191, e = r >> 8, q = r & 255, kb = q >> 3, nb = q & 7, n0 = nb * 64;
        const float* W = (which ? wu : wg) + (size_t)e * 2048 * 512;
        const size_t dst = (size_t)e * 1024 + 256 * (n0 >> 7) + (n0 & 127) + (which ? 128 : 0);
        cvt_item(W, 512, gain, WGU, 2048, kb * 64, n0, dst, lane); }
    for (int it = gw; it < 8192; it += NGW) { const int e = it >> 8, q = it & 255, kb = q >> 5, nb = q & 31;
        cvt_item(wd + (size_t)e * 512 * 2048, 2048, nullptr, WDN + (size_t)e * 2048 * 512, 512, kb * 64, nb * 64, (size_t)(nb * 64), lane); }
}
__device__ __forceinline__ void norm_rows(const float* src, bf16* dst, int gw, int NGW, int lane) {
    for (int m = gw; m < T; m += NGW) {
        const GAS f32x4* xr = (const GAS f32x4*)(src + (size_t)m * D) + lane;
        f32x4 v[8]; float s = 0.f;
#pragma unroll
        for (int j = 0; j < 8; ++j) { v[j] = xr[64 * j]; s += (v[j].x * v[j].x + v[j].y * v[j].y) + (v[j].z * v[j].z + v[j].w * v[j].w); }
        const float rstd = rsqrtf(wave_sum(s) * (1.f / D) + RMS_EPS);
        GAS v2u* o8 = (GAS v2u*)(dst + (size_t)m * D) + lane;
#pragma unroll
        for (int j = 0; j < 8; ++j) { v2u o; o.x = pk2(v[j].x * rstd, v[j].y * rstd); o.y = pk2(v[j].z * rstd, v[j].w * rstd); o8[64 * j] = o; }
    }
}

__device__ __forceinline__ float logsig(float z) { return fminf(z, 0.f) - __logf(1.f + __expf(-fabsf(z))); }
constexpr int GP_QE = 0, GP_KE = 33792, GP_ATT = 67584, GP_TOT = 76800;
__device__ __forceinline__ void gla_prepass(LAS unsigned char* lds, const bf16* QK, const bf16* V, const bf16* GL, const float* Wgu, const float* bgate,
                                            bf16* QEF, bf16* KLTF, bf16* ATTF, bf16* VTF, float* DEC) {
    const int tid = threadIdx.x, lane = tid & 63, wave = __builtin_amdgcn_readfirstlane(tid >> 6);
    LAS bf16* QEl = (LAS bf16*)(lds + GP_QE); LAS bf16* KEl = (LAS bf16*)(lds + GP_KE); LAS bf16* ATl = (LAS bf16*)(lds + GP_ATT);
    LAS float* tot = (LAS float*)(lds + GP_TOT);
    const int cg2 = tid & 127, rg2 = __builtin_amdgcn_readfirstlane(tid >> 7);
    for (int it = blockIdx.x; it < NITEM_GLA; it += gridDim.x) {
        const int bh = it >> 8, n = it & 255, h = bh & 3, b = bh >> 2; const int t0 = b * SEQ + n * GLA_C;
        v2u qv[8], kv[8], vv[16];
        { const bf16* qp = QK + (size_t)(t0 + 8 * wave) * 2048 + h * 256 + 4 * lane;
#pragma unroll
          for (int jj = 0; jj < 8; ++jj) { qv[jj] = *(const GAS v2u*)(qp + (size_t)jj * 2048); kv[jj] = *(const GAS v2u*)(qp + (size_t)jj * 2048 + 1024); }
          const bf16* vp = V + (size_t)(t0 + 16 * rg2) * 2048 + h * 512 + 4 * cg2;
#pragma unroll
          for (int r = 0; r < 16; ++r) vv[r] = *(const GAS v2u*)(vp + (size_t)r * 2048); }
        f32x4 cum[8];
        { f32x4 wg[16];
#pragma unroll
          for (int j = 0; j < 16; ++j) wg[j] = *(const GAS f32x4*)(Wgu + j * 1024 + h * 256 + 4 * lane);
          const f32x4 bg = *(const GAS f32x4*)(bgate + h * 256 + 4 * lane);
          f32x4 run = {0.f, 0.f, 0.f, 0.f};
#pragma unroll
          for (int jj = 0; jj < 8; ++jj) { const unsigned* gp = (const unsigned*)(GL + (size_t)(t0 + 8 * wave + jj) * 256);
              f32x4 z = bg;
#pragma unroll
              for (int j2 = 0; j2 < 8; ++j2) { const unsigned w = gp[j2]; z += wg[2 * j2] * bf_lo(w) + wg[2 * j2 + 1] * bf_hi(w); }
#pragma unroll
              for (int e = 0; e < 4; ++e) run[e] += fmaxf(logsig(z[e]) * 0.0625f, -1.0f);
              cum[jj] = run; }
          *(LAS f32x4*)(tot + wave * 256 + 4 * lane) = run; }
        __syncthreads();
        f32x4 offs = {0.f, 0.f, 0.f, 0.f}, blast = {0.f, 0.f, 0.f, 0.f};
#pragma unroll
        for (int w2 = 0; w2 < 8; ++w2) { const f32x4 tv = *(const LAS f32x4*)(tot + w2 * 256 + 4 * lane); blast += tv; if (w2 < wave) offs += tv; }
        f32x4 dec;
#pragma unroll
        for (int e = 0; e < 4; ++e) dec[e] = __expf(blast[e]);
        { float klv[4][8];
#pragma unroll
          for (int jj = 0; jj < 8; ++jj) { const int c = 8 * wave + jj; const f32x4 bb = cum[jj] + offs;
              const float q4[4] = {bf_lo(qv[jj].x), bf_hi(qv[jj].x), bf_lo(qv[jj].y), bf_hi(qv[jj].y)}, k4[4] = {bf_lo(kv[jj].x), bf_hi(kv[jj].x), bf_lo(kv[jj].y), bf_hi(kv[jj].y)};
              float qe[4], ke[4];
#pragma unroll
              for (int e = 0; e < 4; ++e) { qe[e] = q4[e] * 0.0625f * __expf(bb[e]); ke[e] = k4[e] * __expf(-bb[e]); klv[e][jj] = ke[e] * dec[e]; }
              v2u o; o.x = pk2(qe[0], qe[1]); o.y = pk2(qe[2], qe[3]); *(LAS v2u*)(QEl + c * 264 + 4 * lane) = o;
              o.x = pk2(ke[0], ke[1]); o.y = pk2(ke[2], ke[3]); *(LAS v2u*)(KEl + c * 264 + 4 * lane) = o; }
#pragma unroll
          for (int e = 0; e < 4; ++e) { const int d = 4 * lane + e;
              v4u o; o.x = pk2(klv[e][0], klv[e][1]); o.y = pk2(klv[e][2], klv[e][3]); o.z = pk2(klv[e][4], klv[e][5]); o.w = pk2(klv[e][6], klv[e][7]);
              const size_t fi = ((((size_t)it * 8 + (d >> 5)) * 2 + ((d >> 4) & 1)) * 2 + (wave >> 2)) * 64 + (wave & 3) * 16 + (d & 15);
              *(GAS v4u*)(KLTF + fi * 8) = o; } }
        if (wave == 0) *(GAS f32x4*)(DEC + (size_t)it * 256 + 4 * lane) = dec;
#pragma unroll
        for (int f = 0; f < 2; ++f)
#pragma unroll
            for (int e = 0; e < 4; ++e) { unsigned x[8];
#pragma unroll
                for (int jj = 0; jj < 8; ++jj) { const unsigned wd = (e >> 1) ? vv[8 * f + jj].y : vv[8 * f + jj].x; x[jj] = (e & 1) ? (wd >> 16) : (wd & 0xffffu); }
                v4u o; o.x = x[0] | (x[1] << 16); o.y = x[2] | (x[3] << 16); o.z = x[4] | (x[5] << 16); o.w = x[6] | (x[7] << 16);
                const int v = 4 * cg2 + e;
                const size_t fi = (((size_t)it * 32 + (v >> 4)) * 2 + (rg2 >> 1)) * 64 + (2 * (rg2 & 1) + f) * 16 + (v & 15);
                *(GAS v4u*)(VTF + fi * 8) = o; }
        __syncthreads();
        { const int mt = wave >> 1, i = lane & 15, q = lane >> 4;
#pragma unroll
          for (int nn = 0; nn < 2; ++nn) { const int nt = 2 * (wave & 1) + nn; f32x4 acc = {0.f, 0.f, 0.f, 0.f};
            if (nt <= mt) {
#pragma unroll
                for (int ks = 0; ks < 8; ++ks) { const bf16x8 a = *(const LAS bf16x8*)(QEl + (16 * mt + i) * 264 + 32 * ks + 8 * q); const bf16x8 bb = *(const LAS bf16x8*)(KEl + (16 * nt + i) * 264 + 32 * ks + 8 * q);
                    acc = __builtin_amdgcn_mfma_f32_16x16x32_bf16(a, bb, acc, 0, 0, 0); } }
#pragma unroll
            for (int r = 0; r < 4; ++r) { const int c = 16 * mt + 4 * q + r, cp = 16 * nt + i; ATl[c * 72 + cp] = (bf16)f2bf(cp <= c ? acc[r] : 0.f); } } }
        __syncthreads();
        { const int f = tid, mt = f >> 7, ks = (f >> 6) & 1, l2 = f & 63, i2 = l2 & 15, q2 = l2 >> 4;
          const v4u o = *(const LAS v4u*)(ATl + (16 * mt + i2) * 72 + 32 * ks + 8 * q2);
          *(GAS v4u*)(ATTF + ((size_t)it * 512 + f) * 8) = o; }
#pragma unroll
        for (int k = 0; k < 4; ++k) { const int f = tid + 512 * k, w = f >> 8, mt = (f >> 6) & 3, l2 = f & 63, i2 = l2 & 15, q2 = l2 >> 4;
            const v2u lo = *(const LAS v2u*)(QEl + (16 * mt + i2) * 264 + 32 * w + 4 * q2), hi = *(const LAS v2u*)(QEl + (16 * mt + i2) * 264 + 32 * w + 16 + 4 * q2);
            v4u o; o.x = lo.x; o.y = lo.y; o.z = hi.x; o.w = hi.y;
            *(GAS v4u*)(QEF + ((((size_t)it * 8 + w) * 4 + mt) * 64 + l2) * 8) = o; }
        __syncthreads();
    }
}
constexpr int GS_QE = 0, GS_KLT = 32768, GS_ATT = 65536, GS_DEC = 73728, GS_STAGE = 74752;
constexpr int GLA_NSEG = 8, GLA_SEGLEN = 32;
template <int PASS>
__device__ __forceinline__ void gla_scan(LAS unsigned char* lds, const bf16* QEF, const bf16* KLTF, const bf16* ATTF, const bf16* VTF, const float* DEC, float* SEND, float* DTOT, bf16* O) {
    const int tid = threadIdx.x, lane = tid & 63, w = __builtin_amdgcn_readfirstlane(tid >> 6), q = lane >> 4, li = lane & 15;
#define GS_ISSUE(itv, bufv) do { LAS unsigned char* _st = lds + (bufv) * GS_STAGE; const size_t _it = (size_t)(itv); \
        _Pragma("unroll") for (int _k = 0; _k < 4; ++_k) { const int _f = 4 * w + _k; \
            if (PASS == 1) __builtin_amdgcn_global_load_lds((const unsigned*)(QEF + (_it * 32 + _f) * 512 + lane * 8), (LAS unsigned*)(_st + GS_QE + _f * 1024), 16, 0, 0); \
            __builtin_amdgcn_global_load_lds((const unsigned*)(KLTF + (_it * 32 + _f) * 512 + lane * 8), (LAS unsigned*)(_st + GS_KLT + _f * 1024), 16, 0, 0); } \
        if (PASS == 1) __builtin_amdgcn_global_load_lds((const unsigned*)(ATTF + (_it * 8 + w) * 512 + lane * 8), (LAS unsigned*)(_st + GS_ATT + w * 1024), 16, 0, 0); \
        if (w == 0) __builtin_amdgcn_global_load_lds((const unsigned*)(DEC + _it * 256 + lane * 4), (LAS unsigned*)(_st + GS_DEC), 16, 0, 0); } while (0)
    for (int wi = blockIdx.x; wi < 256; wi += gridDim.x) {
        const int bh = wi & 7, rest = wi >> 3, seg = rest >> 2, vsl = rest & 3, h = bh & 3, b = bh >> 2;
        const int it0 = bh * 256 + seg * GLA_SEGLEN, vs16 = vsl * 8 + w;
        f32x4 S[16];
#pragma unroll
        for (int m = 0; m < 16; ++m) S[m] = (f32x4){0.f, 0.f, 0.f, 0.f};
        if (PASS == 1) {
            for (int s2 = 0; s2 < seg; ++s2) { const float* se = SEND + ((size_t)((bh * GLA_NSEG + s2) * 32 + vs16) * 16) * 256; const float* dt = DTOT + (size_t)(bh * GLA_NSEG + s2) * 256;
#pragma unroll
                for (int m = 0; m < 16; ++m) { const f32x4 dv = *(const GAS f32x4*)(dt + 16 * m + 4 * q), sv = *(const GAS f32x4*)(se + (m * 64 + lane) * 4); S[m] = S[m] * dv + sv; } }
        } else if (vsl == 0 && tid < 256) { float p = 1.f;
            for (int n = 0; n < GLA_SEGLEN; ++n) p *= DEC[(size_t)(it0 + n) * 256 + tid];
            DTOT[(size_t)(bh * GLA_NSEG + seg) * 256 + tid] = p; }
        __syncthreads();
        GS_ISSUE(it0, 0);
        const GAS bf16x8* v16 = (const GAS bf16x8*)VTF + (((size_t)it0 * 32 + vs16) * 2) * 64 + lane;
        bf16x8 vb0 = v16[0], vb1 = v16[64], nvb0 = vb0, nvb1 = vb1;
        for (int n = 0; n < GLA_SEGLEN; ++n) {
            VM_WAIT(); __syncthreads();
            if (n + 1 < GLA_SEGLEN) { GS_ISSUE(it0 + n + 1, (n + 1) & 1); nvb0 = v16[(size_t)(n + 1) * 4096]; nvb1 = v16[(size_t)(n + 1) * 4096 + 64]; }
            const LAS unsigned char* st = lds + (n & 1) * GS_STAGE;
            f32x4 po[4];
            if (PASS == 1) {
                bf16x8 sb[8];
#pragma unroll
                for (int ks = 0; ks < 8; ++ks) { v4u x; x.x = pk2(S[2 * ks][0], S[2 * ks][1]); x.y = pk2(S[2 * ks][2], S[2 * ks][3]); x.z = pk2(S[2 * ks + 1][0], S[2 * ks + 1][1]); x.w = pk2(S[2 * ks + 1][2], S[2 * ks + 1][3]); sb[ks] = __builtin_bit_cast(bf16x8, x); }
#pragma unroll
                for (int mt = 0; mt < 4; ++mt) { f32x4 a = {0.f, 0.f, 0.f, 0.f};
#pragma unroll
                    for (int ks = 0; ks < 8; ++ks) a = __builtin_amdgcn_mfma_f32_16x16x32_bf16(*(const LAS bf16x8*)(st + GS_QE + (ks * 4 + mt) * 1024 + lane * 16), sb[ks], a, 0, 0, 0);
                    a = __builtin_amdgcn_mfma_f32_16x16x32_bf16(*(const LAS bf16x8*)(st + GS_ATT + (mt * 2 + 0) * 1024 + lane * 16), vb0, a, 0, 0, 0);
                    a = __builtin_amdgcn_mfma_f32_16x16x32_bf16(*(const LAS bf16x8*)(st + GS_ATT + (mt * 2 + 1) * 1024 + lane * 16), vb1, a, 0, 0, 0);
                    po[mt] = a; }
            }
#pragma unroll
            for (int m = 0; m < 16; ++m) { const f32x4 dv = *(const LAS f32x4*)(st + GS_DEC + (16 * m + 4 * q) * 4);
                f32x4 s = S[m] * dv;
                s = __builtin_amdgcn_mfma_f32_16x16x32_bf16(*(const LAS bf16x8*)(st + GS_KLT + (m * 2 + 0) * 1024 + lane * 16), vb0, s, 0, 0, 0);
                s = __builtin_amdgcn_mfma_f32_16x16x32_bf16(*(const LAS bf16x8*)(st + GS_KLT + (m * 2 + 1) * 1024 + lane * 16), vb1, s, 0, 0, 0);
                S[m] = s; }
            if (PASS == 1) { bf16* op = O + (size_t)(b * SEQ + (seg * GLA_SEGLEN + n) * GLA_C + 4 * q) * 2048 + h * 512 + vsl * 128 + w * 16 + li;
#pragma unroll
                for (int mt = 0; mt < 4; ++mt)
#pragma unroll
                    for (int r = 0; r < 4; ++r) { const float x = po[mt][r], y = __shfl_xor(x, 1); if ((lane & 1) == 0) *(GAS unsigned*)(op + (size_t)(16 * mt + r) * 2048) = pk2(x, y); } }
            vb0 = nvb0; vb1 = nvb1;
        }
        if (PASS == 0) { float* se = SEND + ((size_t)((bh * GLA_NSEG + seg) * 32 + vs16) * 16) * 256;
#pragma unroll
            for (int m = 0; m < 16; ++m) *(GAS f32x4*)(se + (m * 64 + lane) * 4) = S[m]; }
        __syncthreads();
    }
#undef GS_ISSUE
}
__device__ __forceinline__ void gla_gate(const bf16* O, const bf16* R, const float* head_g, bf16* OG, int gw, int NGW, int lane) {
    float hg[8];
#pragma unroll
    for (int j = 0; j < 8; ++j) hg[j] = head_g[8 * lane + j];
    for (int m = gw; m < T; m += NGW) {
#pragma unroll
        for (int h = 0; h < 4; ++h) {
            const v4u ov = *(const GAS v4u*)(O + (size_t)m * 2048 + h * 512 + 8 * lane), rv = *(const GAS v4u*)(R + (size_t)m * 2048 + h * 512 + 8 * lane);
            float o[8] = {bf_lo(ov.x), bf_hi(ov.x), bf_lo(ov.y), bf_hi(ov.y), bf_lo(ov.z), bf_hi(ov.z), bf_lo(ov.w), bf_hi(ov.w)};
            float r[8] = {bf_lo(rv.x), bf_hi(rv.x), bf_lo(rv.y), bf_hi(rv.y), bf_lo(rv.z), bf_hi(rv.z), bf_lo(rv.w), bf_hi(rv.w)};
            float ss = 0.f;
#pragma unroll
            for (int j = 0; j < 8; ++j) ss += o[j] * o[j];
            const float rstd = rsqrtf(wave_sum(ss) * (1.f / 512.f) + RMS_EPS);
            float y[8];
#pragma unroll
            for (int j = 0; j < 8; ++j) y[j] = o[j] * rstd * hg[j] * pg8::silu_f(r[j]);
            v4u w; w.x = pk2(y[0], y[1]); w.y = pk2(y[2], y[3]); w.z = pk2(y[4], y[5]); w.w = pk2(y[6], y[7]);
            *(GAS v4u*)(OG + (size_t)m * 2048 + h * 512 + 8 * lane) = w;
        }
    }
}

__device__ __forceinline__ void moe_route(LAS unsigned char* lds, const float* RL, const float* SSP, const float* bgroup, const float* brouter, unsigned* gcnt, unsigned* EP0, unsigned* EP1, float* W0, float* W1, float* RSTD) {
    const int tid = threadIdx.x; LAS int* lcnt = (LAS int*)lds; LAS int* lbase = lcnt + 32;
    for (int base = blockIdx.x * 128; base < T; base += gridDim.x * 128) {
        if (tid < 32) lcnt[tid] = 0;
        __syncthreads();
        int e0 = 0, e1 = 0, r0 = 0, r1 = 0; float w0 = 0.f, w1 = 0.f;
        if (tid < 128) { const int t = base + tid; const float* rl = RL + (size_t)t * 64;
            float ssq = 0.f; { const GAS f32x4* sp = (const GAS f32x4*)(SSP + (size_t)t * 32);
#pragma unroll
                for (int k = 0; k < 8; ++k) { const f32x4 v = sp[k]; ssq += (v.x + v.y) + (v.z + v.w); } }
            const float rstd = rsqrtf(ssq * (1.f / D) + RMS_EPS); RSTD[t] = rstd;
            const f32x4 g4 = *(const GAS f32x4*)rl; float gl[4] = {g4.x * rstd + bgroup[0], g4.y * rstd + bgroup[1], g4.z * rstd + bgroup[2], g4.w * rstd + bgroup[3]};
            int g = 0; float best = gl[0];
#pragma unroll
            for (int j = 1; j < 4; ++j) if (gl[j] > best) { best = gl[j]; g = j; }
            float se = 0.f;
#pragma unroll
            for (int j = 0; j < 4; ++j) se += __expf(gl[j] - best);
            const float pg = 1.0f / se;
            const f32x4 a4 = *(const GAS f32x4*)(rl + 4 + 8 * g), b4 = *(const GAS f32x4*)(rl + 8 + 8 * g);
            float el[8] = {a4.x, a4.y, a4.z, a4.w, b4.x, b4.y, b4.z, b4.w};
#pragma unroll
            for (int j = 0; j < 8; ++j) el[j] = el[j] * rstd + brouter[8 * g + j];
            int i0 = 0; float v0 = el[0];
#pragma unroll
            for (int j = 1; j < 8; ++j) if (el[j] > v0) { v0 = el[j]; i0 = j; }
            int i1 = -1; float v1 = -3.0e38f;
#pragma unroll
            for (int j = 0; j < 8; ++j) if (j != i0 && el[j] > v1) { v1 = el[j]; i1 = j; }
            w0 = pg / (1.0f + __expf(v1 - v0)); w1 = pg - w0;
            e0 = 8 * g + i0; e1 = 8 * g + i1;
            r0 = __hip_atomic_fetch_add(&lcnt[e0], 1, __ATOMIC_RELAXED, __HIP_MEMORY_SCOPE_WORKGROUP); r1 = __hip_atomic_fetch_add(&lcnt[e1], 1, __ATOMIC_RELAXED, __HIP_MEMORY_SCOPE_WORKGROUP); }
        __syncthreads();
        if (tid < 32) lbase[tid] = (int)__hip_atomic_fetch_add(gcnt + tid, (unsigned)lcnt[tid], RLX_AGENT);
        __syncthreads();
        if (tid < 128) { const int t = base + tid;
            EP0[t] = ((unsigned)e0 << 24) | (unsigned)(lbase[e0] + r0); EP1[t] = ((unsigned)e1 << 24) | (unsigned)(lbase[e1] + r1); W0[t] = w0; W1[t] = w1; }
        __syncthreads();
    }
}
__device__ __forceinline__ void moe_build_table(LAS unsigned char* ldsbase, unsigned* gcnt) {
    LAS int* off = (LAS int*)(ldsbase + MOE_OFF_OFF); LAS unsigned char* texp = ldsbase + MOE_TEXP_OFF;
    __syncthreads();
    if (threadIdx.x == 0) { int acc = 0, ti = 0;
        for (int e = 0; e < NE; ++e) { const int c = (int)__hip_atomic_load(gcnt + e, RLX_AGENT); off[e] = acc; const int nt = (c + 255) >> 8;
            for (int k = 0; k < nt && ti < 288; ++k) texp[ti++] = (unsigned char)e;
            acc += nt * 256; }
        off[32] = acc; }
    __syncthreads();
}
__device__ __forceinline__ void moe_slots(LAS unsigned char* ldsbase, unsigned* gcnt, const unsigned* EP0, const unsigned* EP1, const float* RSTD, unsigned* SL0, unsigned* SL1, unsigned* TL, float* RS) {
    const LAS int* off = (const LAS int*)(ldsbase + MOE_OFF_OFF); const int tid = threadIdx.x;
    for (int t = blockIdx.x * 512 + tid; t < T; t += gridDim.x * 512) {
        const unsigned p0 = EP0[t], p1 = EP1[t]; const float rs = RSTD[t];
        const unsigned s0 = (unsigned)off[p0 >> 24] + (p0 & 0xffffffu), s1 = (unsigned)off[p1 >> 24] + (p1 & 0xffffffu);
        TL[s0] = (unsigned)t; RS[s0] = rs; TL[s1] = (unsigned)t; RS[s1] = rs; SL0[t] = s0; SL1[t] = s1; }
    for (int e = blockIdx.x; e < NE; e += gridDim.x) { const int c = (int)__hip_atomic_load(gcnt + e, RLX_AGENT);
        for (int i = off[e] + c + tid; i < off[e + 1]; i += 512) { TL[i] = 0u; RS[i] = 0.f; } }
}
__device__ __forceinline__ void moe_combine(float* out, const bf16* Y, const unsigned* SL0, const unsigned* SL1, const float* W0, const float* W1, bf16* HN, bool do_norm, int gw, int NGW, int lane) {
    for (int t = gw; t < T; t += NGW) {
        const unsigned s0 = SL0[t], s1 = SL1[t]; const float w0 = W0[t], w1 = W1[t];
        GAS f32x4* xr = (GAS f32x4*)(out + (size_t)t * D) + lane;
        const GAS v2u* y0 = (const GAS v2u*)(Y + (size_t)s0 * 2048) + lane; const GAS v2u* y1 = (const GAS v2u*)(Y + (size_t)s1 * 2048) + lane;
        f32x4 v[8]; float s = 0.f;
#pragma unroll
        for (int j = 0; j < 8; ++j) { const v2u a = y0[64 * j], b = y1[64 * j]; f32x4 x = xr[64 * j];
            x.x += w0 * bf_lo(a.x) + w1 * bf_lo(b.x); x.y += w0 * bf_hi(a.x) + w1 * bf_hi(b.x); x.z += w0 * bf_lo(a.y) + w1 * bf_lo(b.y); x.w += w0 * bf_hi(a.y) + w1 * bf_hi(b.y);
            v[j] = x; xr[64 * j] = x; s += (x.x * x.x + x.y * x.y) + (x.z * x.z + x.w * x.w); }
        if (do_norm) { const float rstd = rsqrtf(wave_sum(s) * (1.f / D) + RMS_EPS);
            GAS v2u* o8 = (GAS v2u*)(HN + (size_t)t * D) + lane;
#pragma unroll
            for (int j = 0; j < 8; ++j) { v2u o; o.x = pk2(v[j].x * rstd, v[j].y * rstd); o.y = pk2(v[j].z * rstd, v[j].w * rstd); o8[64 * j] = o; } }
    }
}

__device__ const unsigned char T5_BUCKET[128] = {0,1,2,3,4,5,6,7,8,9,10,11,12,13,14,15,16,16,16,17,17,18,18,18,19,19,19,20,20,20,20,21,21,21,21,22,22,22,22,22,23,23,23,23,23,23,24,24,24,24,24,24,25,25,25,25,25,25,25,26,26,26,26,26,26,26,26,27,27,27,27,27,27,27,27,27,27,28,28,28,28,28,28,28,28,28,28,29,29,29,29,29,29,29,29,29,29,29,29,30,30,30,30,30,30,30,30,30,30,30,30,30,30,31,31,31,31,31,31,31,31,31,31,31,31,31,31,31};
constexpr int AT_K = 0, AT_VT = 36864, AT_BIAS = 70656;
__device__ __forceinline__ void swa_attention(LAS unsigned char* lds, const bf16* KVQ, const float* knorm, const float* qnorm, const float* relb, const float* sinks, bf16* AO) {
    const int tid = threadIdx.x, lane = tid & 63, g = __builtin_amdgcn_readfirstlane(tid >> 6), li = lane & 15, q = lane >> 4;
    LAS bf16* KL = (LAS bf16*)(lds + AT_K); LAS bf16* VTL = (LAS bf16*)(lds + AT_VT); LAS float* BL = (LAS float*)(lds + AT_BIAS);
    float qn[2][8];
#pragma unroll
    for (int ks = 0; ks < 2; ++ks)
#pragma unroll
        for (int j = 0; j < 8; ++j) qn[ks][j] = qnorm[32 * ks + 8 * q + j] * 0.125f;
    for (int wi = blockIdx.x; wi < 1024; wi += gridDim.x) {
        const int hk = wi & 3, n = (wi >> 2) & 127, b = wi >> 9;
        __syncthreads();
        { const int key = tid >> 1, hf = tid & 1; const bool live = (n > 0) || (key >= 128);
          const size_t tk = (size_t)b * SEQ + (size_t)(n - 1) * 128 + key;
          const bf16* kp = KVQ + tk * KVQ_N + hk * 64 + 32 * hf;
          v4u kw[4], vw[4];
#pragma unroll
          for (int j = 0; j < 4; ++j) { kw[j] = live ? *(const GAS v4u*)(kp + 8 * j) : (v4u){0u, 0u, 0u, 0u}; vw[j] = live ? *(const GAS v4u*)(kp + 256 + 8 * j) : (v4u){0u, 0u, 0u, 0u}; }
          float ss = 0.f;
#pragma unroll
          for (int j = 0; j < 4; ++j) { const float a0 = bf_lo(kw[j].x), a1 = bf_hi(kw[j].x), a2 = bf_lo(kw[j].y), a3 = bf_hi(kw[j].y), a4 = bf_lo(kw[j].z), a5 = bf_hi(kw[j].z), a6 = bf_lo(kw[j].w), a7 = bf_hi(kw[j].w);
              ss += (a0 * a0 + a1 * a1) + (a2 * a2 + a3 * a3) + (a4 * a4 + a5 * a5) + (a6 * a6 + a7 * a7); }
          ss += __shfl_xor(ss, 1);
          const float rstd = rsqrtf(ss * (1.f / 64.f) + RMS_EPS);
#pragma unroll
          for (int j = 0; j < 4; ++j) { const float* kn = knorm + 32 * hf + 8 * j; v4u o;
              o.x = pk2(bf_lo(kw[j].x) * rstd * kn[0], bf_hi(kw[j].x) * rstd * kn[1]); o.y = pk2(bf_lo(kw[j].y) * rstd * kn[2], bf_hi(kw[j].y) * rstd * kn[3]);
              o.z = pk2(bf_lo(kw[j].z) * rstd * kn[4], bf_hi(kw[j].z) * rstd * kn[5]); o.w = pk2(bf_lo(kw[j].w) * rstd * kn[6], bf_hi(kw[j].w) * rstd * kn[7]);
              *(LAS v4u*)(KL + key * 72 + 32 * hf + 8 * j) = o; }
#pragma unroll
          for (int j = 0; j < 4; ++j) { const int d0 = 32 * hf + 8 * j;
              VTL[(d0 + 0) * 264 + key] = (bf16)(vw[j].x & 0xffffu); VTL[(d0 + 1) * 264 + key] = (bf16)(vw[j].x >> 16); VTL[(d0 + 2) * 264 + key] = (bf16)(vw[j].y & 0xffffu); VTL[(d0 + 3) * 264 + key] = (bf16)(vw[j].y >> 16);
              VTL[(d0 + 4) * 264 + key] = (bf16)(vw[j].z & 0xffffu); VTL[(d0 + 5) * 264 + key] = (bf16)(vw[j].z >> 16); VTL[(d0 + 6) * 264 + key] = (bf16)(vw[j].w & 0xffffu); VTL[(d0 + 7) * 264 + key] = (bf16)(vw[j].w >> 16); }
#pragma unroll
          for (int k = 0; k < 2; ++k) { const int e = tid + 512 * k, gg = e >> 7, dist = e & 127; BL[e] = relb[(int)T5_BUCKET[dist] * 32 + hk * 8 + gg]; }
        }
        __syncthreads();
        const int head = hk * 8 + g; const float sink = sinks[head];
        for (int mt = 0; mt < 8; ++mt) {
            const size_t tq = (size_t)b * SEQ + (size_t)n * 128 + 16 * mt + li;
            bf16x8 qf[2];
            { const bf16* qp = KVQ + tq * KVQ_N + 512 + head * 64 + 8 * q; const v4u q0 = *(const GAS v4u*)qp, q1 = *(const GAS v4u*)(qp + 32);
              float a[16] = {bf_lo(q0.x), bf_hi(q0.x), bf_lo(q0.y), bf_hi(q0.y), bf_lo(q0.z), bf_hi(q0.z), bf_lo(q0.w), bf_hi(q0.w), bf_lo(q1.x), bf_hi(q1.x), bf_lo(q1.y), bf_hi(q1.y), bf_lo(q1.z), bf_hi(q1.z), bf_lo(q1.w), bf_hi(q1.w)};
              float ss = 0.f;
#pragma unroll
              for (int j = 0; j < 16; ++j) ss += a[j] * a[j];
              ss += __shfl_xor(ss, 16); ss += __shfl_xor(ss, 32);
              const float rstd = rsqrtf(ss * (1.f / 64.f) + RMS_EPS);
              v4u w0, w1;
              w0.x = pk2(a[0] * rstd * qn[0][0], a[1] * rstd * qn[0][1]); w0.y = pk2(a[2] * rstd * qn[0][2], a[3] * rstd * qn[0][3]); w0.z = pk2(a[4] * rstd * qn[0][4], a[5] * rstd * qn[0][5]); w0.w = pk2(a[6] * rstd * qn[0][6], a[7] * rstd * qn[0][7]);
              w1.x = pk2(a[8] * rstd * qn[1][0], a[9] * rstd * qn[1][1]); w1.y = pk2(a[10] * rstd * qn[1][2], a[11] * rstd * qn[1][3]); w1.z = pk2(a[12] * rstd * qn[1][4], a[13] * rstd * qn[1][5]); w1.w = pk2(a[14] * rstd * qn[1][6], a[15] * rstd * qn[1][7]);
              qf[0] = __builtin_bit_cast(bf16x8, w0); qf[1] = __builtin_bit_cast(bf16x8, w1); }
            f32x4 st[9]; float mx = sink;
#pragma unroll
            for (int tt = 0; tt < 9; ++tt) { const int nt = mt + tt; f32x4 acc = {0.f, 0.f, 0.f, 0.f};
#pragma unroll
                for (int ks = 0; ks < 2; ++ks) { const bf16x8 a = *(const LAS bf16x8*)(KL + (16 * nt + li) * 72 + 32 * ks + 8 * q); acc = __builtin_amdgcn_mfma_f32_16x16x32_bf16(a, qf[ks], acc, 0, 0, 0); }
#pragma unroll
                for (int r = 0; r < 4; ++r) { const int col = 16 * nt + 4 * q + r, row = 16 * mt + li, dist = 128 + row - col;
                    const bool valid = (dist >= 0) && (dist < 128) && ((col >= 128) || (n > 0));
                    const float s = valid ? acc[r] + BL[g * 128 + (dist & 127)] : -__builtin_inff();
                    acc[r] = s; mx = fmaxf(mx, s); }
                st[tt] = acc; }
            mx = fmaxf(mx, __shfl_xor(mx, 16)); mx = fmaxf(mx, __shfl_xor(mx, 32));
            float lsum = 0.f;
#pragma unroll
            for (int tt = 0; tt < 9; ++tt)
#pragma unroll
                for (int r = 0; r < 4; ++r) { const float p = __expf(st[tt][r] - mx); st[tt][r] = p; lsum += p; }
            lsum += __shfl_xor(lsum, 16); lsum += __shfl_xor(lsum, 32);
            const float inv = 1.0f / (lsum + __expf(sink - mx));
            f32x4 oacc[4];
#pragma unroll
            for (int dt = 0; dt < 4; ++dt) oacc[dt] = (f32x4){0.f, 0.f, 0.f, 0.f};
#pragma unroll
            for (int s = 0; s < 5; ++s) {
                v4u pw; pw.x = pk2(st[2 * s][0], st[2 * s][1]); pw.y = pk2(st[2 * s][2], st[2 * s][3]);
                if (s < 4) { pw.z = pk2(st[2 * s + 1][0], st[2 * s + 1][1]); pw.w = pk2(st[2 * s + 1][2], st[2 * s + 1][3]); } else { pw.z = 0u; pw.w = 0u; }
                const bf16x8 pb = __builtin_bit_cast(bf16x8, pw);
                const int k0 = 16 * (mt + 2 * s) + 4 * q; int k1 = 16 * (mt + 2 * s + 1) + 4 * q; if (k1 > 252) k1 = 240 + 4 * q;
#pragma unroll
                for (int dt = 0; dt < 4; ++dt) { const v2u lo = *(const LAS v2u*)(VTL + (16 * dt + li) * 264 + k0), hi = *(const LAS v2u*)(VTL + (16 * dt + li) * 264 + k1);
                    v4u aw; aw.x = lo.x; aw.y = lo.y; aw.z = hi.x; aw.w = hi.y;
                    oacc[dt] = __builtin_amdgcn_mfma_f32_16x16x32_bf16(__builtin_bit_cast(bf16x8, aw), pb, oacc[dt], 0, 0, 0); } }
#pragma unroll
            for (int dt = 0; dt < 4; ++dt) { v2u o; o.x = pk2(oacc[dt][0] * inv, oacc[dt][1] * inv); o.y = pk2(oacc[dt][2] * inv, oacc[dt][3] * inv);
                *(GAS v2u*)(AO + tq * 2048 + head * 64 + 16 * dt + 4 * q) = o; }
        }
    }
}

struct Args { const float* in[24]; float* out; unsigned char* ws; int ph_lo, ph_hi; };
constexpr int N_PHASES = 23;
__global__ void __launch_bounds__(NWAVES * 64, 2) fwd(Args args) {
    extern __shared__ __attribute__((aligned(16))) unsigned char lds_raw[];
    LAS unsigned char* lds = (LAS unsigned char*)lds_raw;
    const int tid = threadIdx.x, lane = tid & 63, wave = __builtin_amdgcn_readfirstlane(tid >> 6);
    const int G = gridDim.x, gw = blockIdx.x * NWAVES + wave, NGW = G * NWAVES;
    unsigned char* ws = args.ws;
    gu32* ctl = (gu32*)(ws + WS_CTL);
    for (int u = tid; u < (LDS_BYTES - LDSCTL_OFF) / 4; u += NWAVES * 64) ((LAS unsigned*)(lds + LDSCTL_OFF))[u] = 0u;
    __syncthreads();
    XcdBarrier bar = xcd_barrier_post((unsigned*)(ctl + CW_BAR), (volatile LAS unsigned*)(lds + MISC_OFF));
    const int lo = args.ph_lo, hi = args.ph_hi;
#define IN(k) ((((MK_PHASE_MASK) >> (k)) & 1) && lo <= (k) && (k) < hi)
#define PB(k) const unsigned long long _pt0 = (((MK_DELAY_MASK) >> (k)) & 1) ? __builtin_amdgcn_s_memrealtime() : 0ull
#define PE(k) do { if (((MK_DELAY_MASK) >> (k)) & 1) { const unsigned long long _pt1 = __builtin_amdgcn_s_memrealtime(), _dt = _pt1 - _pt0; while (__builtin_amdgcn_s_memrealtime() - _pt1 < _dt) __builtin_amdgcn_s_sleep(8); } } while (0)
#define SEAM(k) do { if (IN(k) && IN((k) + 1)) xcd_barrier(bar); } while (0)

    const float* x = args.in[0]; float* out = args.out;
    bf16* W_GLA_IN = (bf16*)(ws + WS_W_GLA_IN); bf16* W_GLA_OUT = (bf16*)(ws + WS_W_GLA_OUT); bf16* W_KVQ = (bf16*)(ws + WS_W_KVQ); bf16* W_SWA_OUT = (bf16*)(ws + WS_W_SWA_OUT);
    bf16* W_ROUTER = (bf16*)(ws + WS_W_ROUTER); bf16* W_GU = (bf16*)(ws + WS_W_GU); bf16* W_DN = (bf16*)(ws + WS_W_DN);
    bf16* HN = (bf16*)(ws + WS_HN);
    unsigned* EP0 = (unsigned*)(ws + WS_TOK); unsigned* EP1 = EP0 + T; unsigned* SL0 = EP1 + T; unsigned* SL1 = SL0 + T; float* TW0 = (float*)(SL1 + T); float* TW1 = TW0 + T; float* RSTD = TW1 + T;
    bf16* HB = (bf16*)(ws + WS_HB); float* SSP = (float*)(ws + WS_SSP); unsigned* TL = (unsigned*)(ws + WS_TL); float* RS = (float*)(ws + WS_RS);
    float* RL = (float*)(ws + WS_RL);

    if (IN(0)) { PB(0);
        cvt_matrix(args.in[2], 2048, GLA_PROJ_N, args.in[1], W_GLA_IN, 0, gw, NGW, lane);
        cvt_matrix(args.in[6], 2048, 2048, nullptr, W_GLA_OUT, 0, gw, NGW, lane);
        cvt_matrix(args.in[8], 2048, 512, args.in[7], W_KVQ, 0, gw, NGW, lane);
        cvt_matrix(args.in[12], 2048, 2048, args.in[11], W_KVQ, 512, gw, NGW, lane);
        cvt_matrix(args.in[15], 2048, 2048, nullptr, W_SWA_OUT, 0, gw, NGW, lane);
        for (int l = 0; l < 2; ++l) {
            cvt_matrix(args.in[17] + (size_t)l * 2048 * 4, 2048, 4, args.in[16] + l * 2048, W_ROUTER + (size_t)l * 256 * 2048, 0, gw, NGW, lane);
            cvt_matrix(args.in[19] + (size_t)l * 2048 * 32, 2048, 32, args.in[16] + l * 2048, W_ROUTER + (size_t)l * 256 * 2048, 4, gw, NGW, lane);
        }
        cvt_moe(args.in[21], args.in[22], args.in[23], args.in[16], W_GU, W_DN, gw, NGW, lane);
        norm_rows(x, HN, gw, NGW, lane);
        PE(0);
    }
    SEAM(0);
    if (IN(1)) { PB(1);
        pg8::Gemm g{HN, W_GLA_IN, T, GLA_PROJ_NP, 2048}; pg8::StaticOrder S; S.init(T, GLA_PROJ_NP, G, (int)blockIdx.x);
        pg8::EpiGlaProj E{(bf16*)(ws + WS_QK), (bf16*)(ws + WS_V), (bf16*)(ws + WS_R), (bf16*)(ws + WS_GL)};
        pg8::gemm_phase<pg8::EpiGlaProj, pg8::StaticOrder, true, true>(lds + RING_OFF, g, S, E);
        PE(1);
    }
    SEAM(1);
    if (IN(2)) { PB(2); gla_prepass(lds + RING_OFF, (const bf16*)(ws + WS_QK), (const bf16*)(ws + WS_V), (const bf16*)(ws + WS_GL), args.in[3], args.in[4],
                           (bf16*)(ws + WS_QEF), (bf16*)(ws + WS_KLTF), (bf16*)(ws + WS_ATTF), (bf16*)(ws + WS_VTF), (float*)(ws + WS_DEC)); PE(2); }
    SEAM(2);
    if (IN(3)) { PB(3); gla_scan<0>(lds + RING_OFF, (const bf16*)(ws + WS_QEF), (const bf16*)(ws + WS_KLTF), (const bf16*)(ws + WS_ATTF), (const bf16*)(ws + WS_VTF), (const float*)(ws + WS_DEC), (float*)(ws + WS_SEND), (float*)(ws + WS_DTOT), (bf16*)(ws + WS_QK)); PE(3); }
    SEAM(3);
    if (IN(4)) { PB(4); gla_scan<1>(lds + RING_OFF, (const bf16*)(ws + WS_QEF), (const bf16*)(ws + WS_KLTF), (const bf16*)(ws + WS_ATTF), (const bf16*)(ws + WS_VTF), (const float*)(ws + WS_DEC), (float*)(ws + WS_SEND), (float*)(ws + WS_DTOT), (bf16*)(ws + WS_QK)); PE(4); }
    SEAM(4);
    if (IN(5)) { PB(5); gla_gate((const bf16*)(ws + WS_QK), (const bf16*)(ws + WS_R), args.in[5], HN, gw, NGW, lane); PE(5); }
    SEAM(5);
    if (IN(6)) { PB(6);
        pg8::Gemm g{HN, W_GLA_OUT, T, 2048, 2048}; pg8::StaticOrder S; S.init(T, 2048, G, (int)blockIdx.x);
        pg8::EpiResF32 E{out, x, 2048, HB, SSP};
        pg8::gemm_phase<pg8::EpiResF32, pg8::StaticOrder, true, true>(lds + RING_OFF, g, S, E);
        PE(6);
    }
    SEAM(6);

    { constexpr int layer = 0; constexpr int pb = 6 + 10 * layer;
    unsigned* gcnt = (unsigned*)(ctl + CW_CNT + layer * 64);
    if (IN(pb + 1)) { PB(pb + 1);
        pg8::Gemm g{HB, W_ROUTER + (size_t)layer * 256 * 2048, T, 256, 2048}; pg8::StaticOrder S; S.init(T, 256, G, (int)blockIdx.x);
        pg8::EpiRouter E{RL};
        pg8::gemm_phase<pg8::EpiRouter, pg8::StaticOrder, true, true>(lds + RING_OFF, g, S, E);
        PE(pb + 1);
    }
    SEAM(pb + 1);
    if (IN(pb + 2)) { PB(pb + 2); moe_route(lds + RING_OFF, RL, SSP, args.in[18] + layer * 4, args.in[20] + layer * 32, gcnt, EP0, EP1, TW0, TW1, RSTD); PE(pb + 2); }
    SEAM(pb + 2);
    if (IN(pb + 3)) { PB(pb + 3); { moe_build_table(lds, gcnt); moe_slots(lds, gcnt, EP0, EP1, RSTD, SL0, SL1, TL, RS); } PE(pb + 3); }
    SEAM(pb + 3);
    if (IN(pb + 4)) { PB(pb + 4);
        moe_build_table(lds, gcnt);
        const int rows = __builtin_amdgcn_readfirstlane(((const LAS int*)(lds + MOE_OFF_OFF))[32]);
        pg8::Gemm g{HB, W_GU, rows, 1024, 2048, TL};
        pg8::GroupedOrder S{(const LAS unsigned char*)(lds + MOE_TEXP_OFF), rows >> 8, 4, G, (int)blockIdx.x};
        pg8::EpiSwiGLU E{(bf16*)(ws + WS_ACT), RS};
        pg8::gemm_phase<pg8::EpiSwiGLU, pg8::GroupedOrder, true, true, true>(lds + RING_OFF, g, S, E);
        PE(pb + 4);
    }
    SEAM(pb + 4);
    if (IN(pb + 5)) { PB(pb + 5);
        moe_build_table(lds, gcnt);
        const int rows = __builtin_amdgcn_readfirstlane(((const LAS int*)(lds + MOE_OFF_OFF))[32]);
        pg8::Gemm g{(const bf16*)(ws + WS_ACT), W_DN, rows, 2048, 512};
        pg8::GroupedOrder S{(const LAS unsigned char*)(lds + MOE_TEXP_OFF), rows >> 8, 8, G, (int)blockIdx.x};
        pg8::EpiBf16 E{(bf16*)(ws + WS_Y), 2048};
        pg8::gemm_phase<pg8::EpiBf16, pg8::GroupedOrder, true, true>(lds + RING_OFF, g, S, E);
        PE(pb + 5);
    }
    SEAM(pb + 5);
    if (IN(pb + 6)) { PB(pb + 6);
        moe_combine(out, (const bf16*)(ws + WS_Y), SL0, SL1, TW0, TW1, HN, layer == 0, gw, NGW, lane);
        if (layer == 0) cvt_moe(args.in[21] + (size_t)NE * 2048 * 512, args.in[22] + (size_t)NE * 2048 * 512, args.in[23] + (size_t)NE * 512 * 2048, args.in[16] + 2048, W_GU, W_DN, gw, NGW, lane);
        PE(pb + 6);
    }
    if (layer == 0) SEAM(pb + 6);
    }
    if (IN(13)) { PB(13);
        pg8::Gemm g{HN, W_KVQ, T, KVQ_N, 2048}; pg8::StaticOrder S; S.init(T, KVQ_N, G, (int)blockIdx.x);
        pg8::EpiBf16 E{(bf16*)(ws + WS_KVQ), KVQ_N};
        pg8::gemm_phase<pg8::EpiBf16, pg8::StaticOrder, true, true>(lds + RING_OFF, g, S, E);
        PE(13);
    }
    SEAM(13);
    if (IN(14)) { PB(14); swa_attention(lds + RING_OFF, (const bf16*)(ws + WS_KVQ), args.in[9], args.in[13], args.in[10], args.in[14], (bf16*)(ws + WS_AO)); PE(14); }
    SEAM(14);
    if (IN(15)) { PB(15);
        pg8::Gemm g{(const bf16*)(ws + WS_AO), W_SWA_OUT, T, 2048, 2048}; pg8::StaticOrder S; S.init(T, 2048, G, (int)blockIdx.x);
        pg8::EpiResF32 E{out, out, 2048, HB, SSP};
        pg8::gemm_phase<pg8::EpiResF32, pg8::StaticOrder, true, true>(lds + RING_OFF, g, S, E);
        PE(15);
    }
    SEAM(15);
    { constexpr int layer = 1; constexpr int pb = 6 + 10 * layer;
    unsigned* gcnt = (unsigned*)(ctl + CW_CNT + layer * 64);
    if (IN(pb + 1)) { PB(pb + 1);
        pg8::Gemm g{HB, W_ROUTER + (size_t)layer * 256 * 2048, T, 256, 2048}; pg8::StaticOrder S; S.init(T, 256, G, (int)blockIdx.x);
        pg8::EpiRouter E{RL};
        pg8::gemm_phase<pg8::EpiRouter, pg8::StaticOrder, true, true>(lds + RING_OFF, g, S, E);
        PE(pb + 1);
    }
    SEAM(pb + 1);
    if (IN(pb + 2)) { PB(pb + 2); moe_route(lds + RING_OFF, RL, SSP, args.in[18] + layer * 4, args.in[20] + layer * 32, gcnt, EP0, EP1, TW0, TW1, RSTD); PE(pb + 2); }
    SEAM(pb + 2);
    if (IN(pb + 3)) { PB(pb + 3); { moe_build_table(lds, gcnt); moe_slots(lds, gcnt, EP0, EP1, RSTD, SL0, SL1, TL, RS); } PE(pb + 3); }
    SEAM(pb + 3);
    if (IN(pb + 4)) { PB(pb + 4);
        moe_build_table(lds, gcnt);
        const int rows = __builtin_amdgcn_readfirstlane(((const LAS int*)(lds + MOE_OFF_OFF))[32]);
        pg8::Gemm g{HB, W_GU, rows, 1024, 2048, TL};
        pg8::GroupedOrder S{(const LAS unsigned char*)(lds + MOE_TEXP_OFF), rows >> 8, 4, G, (int)blockIdx.x};
        pg8::EpiSwiGLU E{(bf16*)(ws + WS_ACT), RS};
        pg8::gemm_phase<pg8::EpiSwiGLU, pg8::GroupedOrder, true, true, true>(lds + RING_OFF, g, S, E);
        PE(pb + 4);
    }
    SEAM(pb + 4);
    if (IN(pb + 5)) { PB(pb + 5);
        moe_build_table(lds, gcnt);
        const int rows = __builtin_amdgcn_readfirstlane(((const LAS int*)(lds + MOE_OFF_OFF))[32]);
        pg8::Gemm g{(const bf16*)(ws + WS_ACT), W_DN, rows, 2048, 512};
        pg8::GroupedOrder S{(const LAS unsigned char*)(lds + MOE_TEXP_OFF), rows >> 8, 8, G, (int)blockIdx.x};
        pg8::EpiBf16 E{(bf16*)(ws + WS_Y), 2048};
        pg8::gemm_phase<pg8::EpiBf16, pg8::GroupedOrder, true, true>(lds + RING_OFF, g, S, E);
        PE(pb + 5);
    }
    SEAM(pb + 5);
    if (IN(pb + 6)) { PB(pb + 6);
        moe_combine(out, (const bf16*)(ws + WS_Y), SL0, SL1, TW0, TW1, HN, layer == 0, gw, NGW, lane);
        if (layer == 0) cvt_moe(args.in[21] + (size_t)NE * 2048 * 512, args.in[22] + (size_t)NE * 2048 * 512, args.in[23] + (size_t)NE * 512 * 2048, args.in[16] + 2048, W_GU, W_DN, gw, NGW, lane);
        PE(pb + 6);
    }
    if (layer == 0) SEAM(pb + 6);
    }
#undef IN
#undef SEAM
}

extern "C" void kernel_launch(void* const* d_in, const int* in_sizes, int n_in, void* d_out, int out_size, void* d_ws, size_t ws_size, hipStream_t stream) {
    static int grid = 0;
    if (grid == 0) {
        if (n_in != 24 || in_sizes[0] != T * D || out_size != T * D || ws_size < WS_END) { fprintf(stderr, "kernel_launch: unexpected shapes / workspace (n_in %d, in0 %d, out %d, ws %zu < %zu)\n", n_in, n_in > 0 ? in_sizes[0] : -1, out_size, ws_size, (size_t)WS_END); grid = -1; return; }
        int dev = 0, cus = 0, per_cu = 0;
        if (hipGetDevice(&dev) != hipSuccess || hipDeviceGetAttribute(&cus, hipDeviceAttributeMultiprocessorCount, dev) != hipSuccess) { grid = -1; return; }
        if (hipFuncSetAttribute((const void*)fwd, hipFuncAttributeMaxDynamicSharedMemorySize, LDS_BYTES) != hipSuccess) { fprintf(stderr, "kernel_launch: hipFuncSetAttribute failed\n"); grid = -1; return; }
        if (hipOccupancyMaxActiveBlocksPerMultiprocessor(&per_cu, (const void*)fwd, NWAVES * 64, LDS_BYTES) != hipSuccess || per_cu < 1) { fprintf(stderr, "kernel_launch: occupancy query says %d\n", per_cu); }
        (void)hipGetLastError();
        grid = cus;
    }
    if (grid < 0) return;
    if (hipMemsetAsync((char*)d_ws + WS_CTL, 0, CTL_ZERO_BYTES, stream) != hipSuccess) return;
    Args a{};
    for (int i = 0; i < 24; ++i) a.in[i] = (const float*)d_in[i];
    a.out = (float*)d_out; a.ws = (unsigned char*)d_ws;
#if MK_PER_PHASE
    for (int p = 0; p < MK_LAST_PHASE; ++p) { a.ph_lo = p; a.ph_hi = p + 1; hipLaunchKernelGGL(fwd, dim3(grid), dim3(NWAVES * 64), LDS_BYTES, stream, a); }
#else
    a.ph_lo = 0; a.ph_hi = MK_LAST_PHASE;
    hipLaunchKernelGGL(fwd, dim3(grid), dim3(NWAVES * 64), LDS_BYTES, stream, a);
#endif
    const hipError_t le = hipPeekAtLastError();
    if (le != hipSuccess) fprintf(stderr, "kernel_launch: launch failed: %s\n", hipGetErrorName(le));
}
```

```cpp
#include <hip/hip_runtime.h>
#include <cstdio>
#include <cstdint>

#ifndef MK_PER_PHASE
#define MK_PER_PHASE 0
#endif
#ifndef MK_LAST_PHASE
#define MK_LAST_PHASE 23
#endif

#ifndef MK_PHASE_MASK
#define MK_PHASE_MASK 0x7fffff
#endif

#ifndef MK_DELAY_MASK
#define MK_DELAY_MASK 0
#endif

namespace pg8 {
#define PG8_LAS __attribute__((address_space(3)))
typedef unsigned short bf16_t;
typedef short bf16x8 __attribute__((ext_vector_type(8)));
typedef float f32x4 __attribute__((ext_vector_type(4)));
typedef unsigned u32x4 __attribute__((ext_vector_type(4)));
constexpr int BM = 256, BK = 64, HALF = 128, HTB = HALF * BK * 2  , STAGE_BYTES = 8 * HTB, NXCD = 8, WGM = 8;

__host__ __device__ __forceinline__ int lds_byte(int r, int c) { const int st = (r >> 4) * 2 + (c >> 5), rr = r & 15, cc = c & 31, ob = rr * 64 + cc * 2; return st * 1024 + (ob ^ (((ob >> 9) & 1) << 5)); }
__host__ __device__ __forceinline__ void stage_rc(int b, int& R, int& C) { const int st = b / 1024, sb = b % 1024, swz = sb ^ (((sb >> 9) & 1) << 5); R = (st >> 1) * 16 + swz / 64; C = (st & 1) * 32 + (swz % 64) / 2; }
__host__ __device__ __forceinline__ int perm32(int rho) { const int n = rho >> 4, i = rho & 15; return 8 * (i >> 2) + 4 * n + (i & 3); }

struct Unit { int pm, pn, pc; };
struct Gemm { const bf16_t* A; const bf16_t* Bt; int M, N, K; const unsigned* rowidx; };


struct StaticOrder {
    int nM, nN, nwg, G, c;
    __host__ __device__ void init(int M, int N, int G_, int c_) { nM = M / BM; nN = N / BM; nwg = nM * nN; G = G_; c = c_; }
    __host__ __device__ bool next(int i, Unit& u) const {
        const long L = (long)i * G + c; if (L >= nwg) return false;
        int wgid = (int)L; { const int q = nwg / NXCD, r = nwg % NXCD, xcd = wgid % NXCD, off = wgid / NXCD; wgid = (xcd < r ? xcd * (q + 1) : r * (q + 1) + (xcd - r) * q) + off; }
        const int nig = WGM * nN, gid = wgid / nig, fm = gid * WGM, gsz = (nM - fm) < WGM ? (nM - fm) : WGM;
        u.pm = fm + ((wgid % nig) % gsz); u.pn = (wgid % nig) / gsz; u.pc = u.pn; return true;
    }
    __device__ __forceinline__ void a_ready(const Unit&) const {}
    __device__ __forceinline__ void done(const Unit&) const {}
};
struct GroupedOrder {
    const PG8_LAS unsigned char* texp; int MT, npn, G, c;
    __device__ __forceinline__ bool next(int i, Unit& u) const {
        const long L = (long)i * G + c; if (L >= (long)MT * npn) return false;
        const int pm = (int)(L / npn), pc = (int)(L % npn);
        const int e = __builtin_amdgcn_readfirstlane((int)texp[pm]);
        u.pm = pm; u.pn = e * npn + pc; u.pc = pc; return true;
    }
    __device__ __forceinline__ void a_ready(const Unit&) const {}
    __device__ __forceinline__ void done(const Unit&) const {}
};

__device__ __forceinline__ unsigned cvt_pk_bf16(float lo, float hi) { unsigned r; asm volatile("v_cvt_pk_bf16_f32 %0, %1, %2" : "=v"(r) : "v"(lo), "v"(hi)); return r; }

struct EpiBf16 {
    static constexpr bool PERM = true, AFTER_DRAIN = false;
    bf16_t* O; int ldc;
    __device__ __forceinline__ void operator()(const f32x4 (&acc)[2][2][4][2], const Unit& u, int wr, int wc, int fr, int fq) const {
        const int row0 = u.pm * BM + wr * 64 + fr, col0 = u.pc * BM + wc * 32 + 8 * fq;
#pragma unroll
        for (int ai = 0; ai < 2; ++ai)
#pragma unroll
            for (int m = 0; m < 4; ++m) { bf16_t* rowp = O + (size_t)(row0 + ai * HALF + m * 16) * ldc + col0;
#pragma unroll
                for (int bj = 0; bj < 2; ++bj) { const f32x4 v0 = acc[ai][bj][m][0], v1 = acc[ai][bj][m][1];
                    u32x4 w; w.x = cvt_pk_bf16(v0[0], v0[1]); w.y = cvt_pk_bf16(v0[2], v0[3]); w.z = cvt_pk_bf16(v1[0], v1[1]); w.w = cvt_pk_bf16(v1[2], v1[3]);
                    *(u32x4*)(rowp + bj * HALF) = w; } }
    }
};
struct EpiGlaProj {
    static constexpr bool PERM = true, AFTER_DRAIN = false;
    bf16_t *QK, *V, *R, *GL;
    __device__ __forceinline__ void operator()(const f32x4 (&acc)[2][2][4][2], const Unit& u, int wr, int wc, int fr, int fq) const {
        bf16_t* base; int ldc, ct;
        if (u.pc < 8) { base = QK; ldc = 2048; ct = u.pc; } else if (u.pc < 16) { base = V; ldc = 2048; ct = u.pc - 8; } else if (u.pc < 24) { base = R; ldc = 2048; ct = u.pc - 16; } else { base = GL; ldc = 256; ct = 0; }
        const int row0 = u.pm * BM + wr * 64 + fr, col0 = ct * BM + wc * 32 + 8 * fq;
#pragma unroll
        for (int ai = 0; ai < 2; ++ai)
#pragma unroll
            for (int m = 0; m < 4; ++m) { bf16_t* rowp = base + (size_t)(row0 + ai * HALF + m * 16) * ldc + col0;
#pragma unroll
                for (int bj = 0; bj < 2; ++bj) { const f32x4 v0 = acc[ai][bj][m][0], v1 = acc[ai][bj][m][1];
                    u32x4 w; w.x = cvt_pk_bf16(v0[0], v0[1]); w.y = cvt_pk_bf16(v0[2], v0[3]); w.z = cvt_pk_bf16(v1[0], v1[1]); w.w = cvt_pk_bf16(v1[2], v1[3]);
                    *(u32x4*)(rowp + bj * HALF) = w; } }
    }
};
struct EpiResF32 {
    static constexpr bool PERM = true, AFTER_DRAIN = false;
    float* C; const float* RES; int ldc; bf16_t* HB; float* SSP;
    __device__ __forceinline__ void operator()(const f32x4 (&acc)[2][2][4][2], const Unit& u, int wr, int wc, int fr, int fq) const {
        const int row0 = u.pm * BM + wr * 64 + fr, col0 = u.pc * BM + wc * 32 + 8 * fq;
#pragma unroll
        for (int ai = 0; ai < 2; ++ai)
#pragma unroll
            for (int m = 0; m < 4; ++m) { const int row = row0 + ai * HALF + m * 16; const size_t off = (size_t)row * ldc + col0;
                f32x4 rv[2][2];
#pragma unroll
                for (int bj = 0; bj < 2; ++bj)
#pragma unroll
                    for (int n = 0; n < 2; ++n) rv[bj][n] = *(const f32x4*)(RES + off + bj * HALF + n * 4);
                float ss = 0.f;
#pragma unroll
                for (int bj = 0; bj < 2; ++bj) { const f32x4 v0 = acc[ai][bj][m][0] + rv[bj][0], v1 = acc[ai][bj][m][1] + rv[bj][1];
                    *(f32x4*)(C + off + bj * HALF) = v0; *(f32x4*)(C + off + bj * HALF + 4) = v1;
                    u32x4 w; w.x = cvt_pk_bf16(v0[0], v0[1]); w.y = cvt_pk_bf16(v0[2], v0[3]); w.z = cvt_pk_bf16(v1[0], v1[1]); w.w = cvt_pk_bf16(v1[2], v1[3]);
                    *(u32x4*)(HB + off + bj * HALF) = w;
                    ss += (v0[0] * v0[0] + v0[1] * v0[1]) + (v0[2] * v0[2] + v0[3] * v0[3]) + (v1[0] * v1[0] + v1[1] * v1[1]) + (v1[2] * v1[2] + v1[3] * v1[3]); }
                ss += __shfl_xor(ss, 16); ss += __shfl_xor(ss, 32);
                if (fq == 0) SSP[(size_t)row * 32 + u.pc * 4 + wc] = ss; }
    }
};
struct EpiRouter {
    static constexpr bool PERM = false, AFTER_DRAIN = false;
    float* RL;
    __device__ __forceinline__ void operator()(const f32x4 (&acc)[2][2][4][2], const Unit& u, int wr, int wc, int fr, int fq) const {
        if (wc >= 2) return;
        const int row0 = u.pm * BM + wr * 64 + fr, col0 = wc * 32 + 4 * fq;
#pragma unroll
        for (int ai = 0; ai < 2; ++ai)
#pragma unroll
            for (int m = 0; m < 4; ++m) { float* rowp = RL + (size_t)(row0 + ai * HALF + m * 16) * 64 + col0;
#pragma unroll
                for (int n = 0; n < 2; ++n) *(f32x4*)(rowp + n * 16) = acc[ai][0][m][n]; }
    }
};
__device__ __forceinline__ float silu_f(float x) { return x * __builtin_amdgcn_rcpf(1.0f + __expf(-x)); }
struct EpiSwiGLU {
    static constexpr bool PERM = true, AFTER_DRAIN = false;
    bf16_t* ACT; const float* RS;
    __device__ __forceinline__ void operator()(const f32x4 (&acc)[2][2][4][2], const Unit& u, int wr, int wc, int fr, int fq) const {
        const int row0 = u.pm * BM + wr * 64 + fr, col0 = u.pc * HALF + wc * 32 + 8 * fq;
#pragma unroll
        for (int ai = 0; ai < 2; ++ai)
#pragma unroll
            for (int m = 0; m < 4; ++m) { const int row = row0 + ai * HALF + m * 16; bf16_t* rowp = ACT + (size_t)row * 512 + col0; const float rs = RS[row];
                const f32x4 g0 = acc[ai][0][m][0] * rs, g1 = acc[ai][0][m][1] * rs, u0 = acc[ai][1][m][0] * rs, u1 = acc[ai][1][m][1] * rs;
                u32x4 w;
                w.x = cvt_pk_bf16(silu_f(g0[0]) * u0[0], silu_f(g0[1]) * u0[1]); w.y = cvt_pk_bf16(silu_f(g0[2]) * u0[2], silu_f(g0[3]) * u0[3]);
                w.z = cvt_pk_bf16(silu_f(g1[0]) * u1[0], silu_f(g1[1]) * u1[1]); w.w = cvt_pk_bf16(silu_f(g1[2]) * u1[2], silu_f(g1[3]) * u1[3]);
                *(u32x4*)rowp = w; }
    }
};

template <class Epi, class Sched, bool ALIGN_EPI = false, bool SP2 = false, bool GATHER = false>
__device__ __forceinline__ void gemm_phase(PG8_LAS unsigned char* lds, const Gemm g, const Sched& S, const Epi& E) {
    const int tid = threadIdx.x, wid = __builtin_amdgcn_readfirstlane(tid >> 6), lane = tid & 63, wr = wid >> 2, wc = wid & 3, fr = lane & 15, fq = lane >> 4;
    const int K = g.K, nt = K / BK;
    unsigned voffA[2], voffB[2];
#pragma unroll
    for (int i = 0; i < 2; ++i) { int R, C; stage_rc(tid * 16 + i * 8192, R, C); const int Rb = Epi::PERM ? ((R & ~31) + perm32(R & 31)) : R;
        voffA[i] = (unsigned)(R * K + C) * 2u; voffB[i] = (unsigned)(Rb * K + C) * 2u; }
    unsigned vA[2][2] = {{0u, 0u}, {0u, 0u}}, vAn[2][2] = {{0u, 0u}, {0u, 0u}}; int rA[2] = {0, 0}; unsigned cbA[2] = {0u, 0u};
    if constexpr (GATHER) {
#pragma unroll
        for (int i = 0; i < 2; ++i) { int R, C; stage_rc(tid * 16 + i * 8192, R, C); rA[i] = R; cbA[i] = (unsigned)C * 2u; } }
#define PG8_GIDX(dst, pmv) do { _Pragma("unroll") for (int _h = 0; _h < 2; ++_h) _Pragma("unroll") for (int _i = 0; _i < 2; ++_i) \
        dst[_h][_i] = g.rowidx[(size_t)(pmv) * BM + _h * HALF + rA[_i]] * (unsigned)(K * 2) + cbA[_i]; } while (0)
    const size_t kstep = (size_t)(BK * 2);
    const size_t hstep = (size_t)HALF * K * 2;
    const size_t tstep = 2 * hstep;
    const unsigned ldsw = (unsigned)wid * 1024u;
    const int aoff = lds_byte(wr * 64 + fr, fq * 8), boff = lds_byte(wc * 32 + fr, fq * 8);
#define PG8_SA(b, h) (((b) * 2 + (h)) * HTB)
#define PG8_SB(b, h) ((4 + (b) * 2 + (h)) * HTB)
#define PG8_STAGE(bufoff, gbase, voff) do { _Pragma("unroll") for (int _i = 0; _i < 2; ++_i) \
        __builtin_amdgcn_global_load_lds((const unsigned*)((const char*)(gbase) + (voff)[_i]), (PG8_LAS unsigned*)(lds + (bufoff) + ldsw + _i * 8192), 16, 0, 0); } while (0)
#define PG8_STAGE_A(bufoff, nx, kb, h) do { if constexpr (GATHER) { const char* _b = (const char*)g.A + (kb); \
        _Pragma("unroll") for (int _i = 0; _i < 2; ++_i) { const unsigned _v = (nx) ? vAn[h][_i] : vA[h][_i]; \
            __builtin_amdgcn_global_load_lds((const unsigned*)(_b + _v), (PG8_LAS unsigned*)(lds + (bufoff) + ldsw + _i * 8192), 16, 0, 0); } } \
    else { const char* _b = ((nx) ? nA : cA) + (kb) + (size_t)(h) * hstep; PG8_STAGE(bufoff, _b, voffA); } } while (0)
#define PG8_LDA(dst, b, h) do { _Pragma("unroll") for (int m = 0; m < 4; ++m) _Pragma("unroll") for (int k = 0; k < 2; ++k) dst[m][k] = *(const PG8_LAS bf16x8*)(lds + PG8_SA(b, h) + aoff + m * 2048 + k * 1024); } while (0)
#define PG8_LDB(dst, b, h) do { _Pragma("unroll") for (int n = 0; n < 2; ++n) _Pragma("unroll") for (int k = 0; k < 2; ++k) dst[n][k] = *(const PG8_LAS bf16x8*)(lds + PG8_SB(b, h) + boff + n * 2048 + k * 1024); } while (0)
#define PG8_MMA(ai, bj, At, Bt) do { __builtin_amdgcn_s_setprio(1); _Pragma("unroll") for (int m = 0; m < 4; ++m) _Pragma("unroll") for (int n = 0; n < 2; ++n) _Pragma("unroll") for (int k = 0; k < 2; ++k) \
        acc[ai][bj][m][n] = __builtin_amdgcn_mfma_f32_16x16x32_bf16(Bt[n][k], At[m][k], acc[ai][bj][m][n], 0, 0, 0); __builtin_amdgcn_s_setprio(0); } while (0)
#define PG8_WAIT_V(n) asm volatile("s_waitcnt vmcnt(" #n ")" ::: "memory")
#define PG8_WAIT_L(n) asm volatile("s_waitcnt lgkmcnt(" #n ")" ::: "memory")
#define PG8_BAR __builtin_amdgcn_s_barrier()
#define PG8_SCHED __builtin_amdgcn_sched_barrier(0)
    Unit cur, nxt; int ui = 0;
    if (!S.next(0, cur)) return;
    f32x4 acc[2][2][4][2];
#pragma unroll
    for (int a = 0; a < 2; ++a)
#pragma unroll
        for (int b = 0; b < 2; ++b)
#pragma unroll
            for (int m = 0; m < 4; ++m)
#pragma unroll
                for (int n = 0; n < 2; ++n) acc[a][b][m][n] = (f32x4){0.f, 0.f, 0.f, 0.f};
    bf16x8 At[4][2], B0[2][2], B1[2][2];
    const char* cA = (const char*)g.A + (size_t)cur.pm * tstep; const char* cB = (const char*)g.Bt + (size_t)cur.pn * tstep;
    const char* nA = cA; const char* nB = cB;
    if constexpr (GATHER) { PG8_GIDX(vA, cur.pm); }
    S.a_ready(cur);
    if constexpr (SP2) {
        PG8_STAGE(PG8_SB(0, 0), cB, voffB); PG8_STAGE(PG8_SB(0, 1), cB + hstep, voffB); PG8_STAGE_A(PG8_SA(0, 0), false, 0, 0); PG8_STAGE_A(PG8_SA(0, 1), false, 0, 1);
        if (wr == 1) PG8_BAR;
        PG8_WAIT_V(2); PG8_BAR;
        PG8_STAGE(PG8_SB(1, 0), cB + kstep, voffB); PG8_STAGE_A(PG8_SA(1, 0), false, kstep, 0); PG8_STAGE(PG8_SB(1, 1), cB + hstep + kstep, voffB);
        PG8_WAIT_V(6); PG8_BAR;
    } else {
        PG8_STAGE(PG8_SB(0, 0), cB, voffB); PG8_STAGE(PG8_SA(0, 0), cA, voffA); PG8_STAGE(PG8_SB(0, 1), cB + hstep, voffB); PG8_STAGE(PG8_SA(0, 1), cA + hstep, voffA);
        if (wr == 1) PG8_BAR;
        PG8_WAIT_V(4); PG8_BAR;
        PG8_STAGE(PG8_SB(1, 0), cB + kstep, voffB); PG8_STAGE(PG8_SA(1, 0), cA + kstep, voffA); PG8_STAGE(PG8_SB(1, 1), cB + hstep + kstep, voffB);
        PG8_WAIT_V(6); PG8_BAR;
    }
    for (;;) {
        const bool has_next = S.next(ui + 1, nxt);
        nA = has_next ? (const char*)g.A + (size_t)nxt.pm * tstep : cA; nB = has_next ? (const char*)g.Bt + (size_t)nxt.pn * tstep : cB;
        if constexpr (GATHER) { if (has_next) { PG8_GIDX(vAn, nxt.pm); } else {
#pragma unroll
            for (int _h = 0; _h < 2; ++_h) { vAn[_h][0] = vA[_h][0]; vAn[_h][1] = vA[_h][1]; } } }
        for (int t = 0; t < nt; t += 2) {
            const bool last = (t == nt - 2);
            const char* a1 = cA + (size_t)(t + 1) * kstep;
            const char* a2 = last ? nA : cA + (size_t)(t + 2) * kstep; const char* b2 = last ? nB : cB + (size_t)(t + 2) * kstep;
            const char* a3 = a2 + kstep; const char* b3 = b2 + kstep;
            const size_t ka1 = (size_t)(t + 1) * kstep, ka2 = last ? (size_t)0 : (size_t)(t + 2) * kstep, ka3 = ka2 + kstep; (void)a1; (void)a3;
            if (last && has_next) S.a_ready(nxt);
            if constexpr (SP2) {
            PG8_LDB(B0, 0, 0); PG8_LDB(B1, 0, 1); PG8_SCHED; PG8_LDA(At, 0, 0); PG8_STAGE_A(PG8_SA(1, 1), false, ka1, 1);
            PG8_WAIT_V(8); PG8_WAIT_L(0); PG8_BAR; PG8_MMA(0, 0, At, B0); PG8_MMA(0, 1, At, B1); PG8_BAR; PG8_SCHED;
            PG8_LDA(At, 0, 1); PG8_STAGE(PG8_SB(0, 0), b2, voffB); PG8_STAGE(PG8_SB(0, 1), b2 + hstep, voffB); PG8_STAGE_A(PG8_SA(0, 0), last, ka2, 0);
            PG8_WAIT_V(8); PG8_WAIT_L(0); PG8_BAR; PG8_MMA(1, 0, At, B0); PG8_MMA(1, 1, At, B1); PG8_BAR; PG8_SCHED;
            PG8_LDB(B0, 1, 0); PG8_LDB(B1, 1, 1); PG8_SCHED; PG8_LDA(At, 1, 0); PG8_STAGE_A(PG8_SA(0, 1), last, ka2, 1);
            PG8_WAIT_V(8); PG8_WAIT_L(0); PG8_BAR; PG8_MMA(0, 0, At, B0); PG8_MMA(0, 1, At, B1); PG8_BAR; PG8_SCHED;
            PG8_LDA(At, 1, 1); PG8_STAGE(PG8_SB(1, 0), b3, voffB); PG8_STAGE(PG8_SB(1, 1), b3 + hstep, voffB); PG8_STAGE_A(PG8_SA(1, 0), last, ka3, 0);
            PG8_WAIT_V(8); PG8_WAIT_L(0); PG8_BAR; PG8_MMA(1, 0, At, B0); PG8_MMA(1, 1, At, B1); PG8_BAR; PG8_SCHED;
            } else {
            PG8_LDB(B0, 0, 0); PG8_SCHED; PG8_LDA(At, 0, 0); PG8_STAGE(PG8_SA(1, 1), a1 + hstep, voffA);
            PG8_WAIT_L(8); PG8_BAR; PG8_WAIT_L(0); PG8_MMA(0, 0, At, B0); PG8_BAR; PG8_SCHED;
            PG8_LDB(B1, 0, 1); PG8_STAGE(PG8_SB(0, 0), b2, voffB);
            PG8_BAR; PG8_WAIT_L(0); PG8_MMA(0, 1, At, B1); PG8_BAR;
            PG8_LDA(At, 0, 1); PG8_STAGE(PG8_SA(0, 0), a2, voffA);
            PG8_BAR; PG8_WAIT_L(0); PG8_MMA(1, 0, At, B0); PG8_BAR; PG8_SCHED;
            PG8_STAGE(PG8_SB(0, 1), b2 + hstep, voffB);
            PG8_WAIT_V(6); PG8_BAR; PG8_MMA(1, 1, At, B1); PG8_BAR;
            PG8_LDB(B0, 1, 0); PG8_SCHED; PG8_LDA(At, 1, 0); PG8_STAGE(PG8_SA(0, 1), a2 + hstep, voffA);
            PG8_WAIT_L(8); PG8_BAR; PG8_WAIT_L(0); PG8_MMA(0, 0, At, B0); PG8_BAR; PG8_SCHED;
            PG8_LDB(B1, 1, 1); PG8_STAGE(PG8_SB(1, 0), b3, voffB);
            PG8_BAR; PG8_WAIT_L(0); PG8_MMA(0, 1, At, B1); PG8_BAR;
            PG8_LDA(At, 1, 1); PG8_STAGE(PG8_SA(1, 0), a3, voffA);
            PG8_BAR; PG8_WAIT_L(0); PG8_MMA(1, 0, At, B0); PG8_BAR; PG8_SCHED;
            PG8_STAGE(PG8_SB(1, 1), b3 + hstep, voffB);
            PG8_WAIT_V(6); PG8_BAR; PG8_MMA(1, 1, At, B1); PG8_BAR;
            }
        }
        if constexpr (ALIGN_EPI) { if (wr == 0) PG8_BAR; }
        if constexpr (!Epi::AFTER_DRAIN) { E(acc, cur, wr, wc, fr, fq); S.done(cur); }
        if (!has_next) break;
#pragma unroll
        for (int a = 0; a < 2; ++a)
#pragma unroll
            for (int b = 0; b < 2; ++b)
#pragma unroll
                for (int m = 0; m < 4; ++m)
#pragma unroll
                    for (int n = 0; n < 2; ++n) acc[a][b][m][n] = (f32x4){0.f, 0.f, 0.f, 0.f};
        cur = nxt; cA = nA; cB = nB; ++ui;
        if constexpr (GATHER) {
#pragma unroll
            for (int _h = 0; _h < 2; ++_h) { vA[_h][0] = vAn[_h][0]; vA[_h][1] = vAn[_h][1]; } }
        if constexpr (ALIGN_EPI) { if (wr == 1) PG8_BAR; }
    }
    PG8_WAIT_V(0);
    if constexpr (!ALIGN_EPI) { if (wr == 0) PG8_BAR; }
    PG8_BAR;
    if constexpr (Epi::AFTER_DRAIN) { E.fused(acc, cur, wr, wc, fr, fq, lds, wid, lane); S.done(cur); }
#undef PG8_SA
#undef PG8_STAGE_A
#undef PG8_GIDX
#undef PG8_SB
#undef PG8_STAGE
#undef PG8_LDA
#undef PG8_LDB
#undef PG8_MMA
#undef PG8_WAIT_V
#undef PG8_WAIT_L
#undef PG8_BAR
#undef PG8_SCHED
}
}

constexpr int NWAVES = 8;
constexpr int T = 32768, D = 2048, SEQ = 16384;
constexpr float RMS_EPS = 1e-6f;
constexpr int GLA_H = 4, GLA_DK = 256, GLA_DV = 512, GLA_C = 64, GLA_NCH = SEQ / GLA_C  , GLA_PROJ_N = 6160, GLA_PROJ_NP = 6400;
constexpr int NITEM_GLA = 2 * GLA_H * GLA_NCH;
constexpr int SWA_HQ = 32, SWA_HKV = 4, SWA_HD = 64, SWA_W = 128, KVQ_N = 2560;
constexpr int NE = 32, FF = 512, MOE_MAXROWS = 2 * T + NE * 256;

constexpr size_t MiB = 1u << 20;
constexpr size_t WS_CTL = 0, CTL_ZERO_BYTES = 1 * MiB;
constexpr size_t WS_W_GLA_IN = 1 * MiB;
constexpr size_t WS_W_GLA_OUT = 26 * MiB;
constexpr size_t WS_W_KVQ = 34 * MiB;
constexpr size_t WS_W_SWA_OUT = 44 * MiB;
constexpr size_t WS_W_ROUTER = 52 * MiB;
constexpr size_t WS_TOK = 54 * MiB;
constexpr size_t WS_RL = 56 * MiB;
constexpr size_t WS_W_GU = 64 * MiB;
constexpr size_t WS_W_DN = 192 * MiB;
constexpr size_t WS_HN = 256 * MiB;
constexpr size_t WS_BIG = 384 * MiB;
constexpr size_t WS_QK = WS_BIG;
constexpr size_t WS_V = WS_BIG + 128 * MiB;
constexpr size_t WS_R = WS_BIG + 256 * MiB;
constexpr size_t WS_GL = WS_BIG + 384 * MiB;
constexpr size_t WS_QEF = WS_BIG + 400 * MiB;
constexpr size_t WS_KLTF = WS_BIG + 464 * MiB;
constexpr size_t WS_ATTF = WS_BIG + 528 * MiB;
constexpr size_t WS_VTF = WS_BIG + 544 * MiB;
constexpr size_t WS_DEC = WS_BIG + 672 * MiB;
constexpr size_t WS_SEND = WS_V;
constexpr size_t WS_DTOT = WS_V + 32 * MiB;
constexpr size_t WS_GLA_END = WS_BIG + 674 * MiB;
constexpr size_t WS_SSP = WS_BIG;
constexpr size_t WS_TL = WS_BIG + 8 * MiB;
constexpr size_t WS_RS = WS_BIG + 9 * MiB;
constexpr size_t WS_HB = WS_BIG + 16 * MiB;
constexpr size_t WS_ACT = WS_BIG + 288 * MiB;
constexpr size_t WS_Y = WS_BIG + 360 * MiB;
constexpr size_t WS_KVQ = WS_BIG;
constexpr size_t WS_AO = WS_BIG + 160 * MiB;
constexpr size_t WS_END = WS_GLA_END;
static_assert(WS_Y + (size_t)MOE_MAXROWS * 2048 * 2 <= WS_END && WS_ACT + (size_t)MOE_MAXROWS * 512 * 2 <= WS_Y, "MoE map");
constexpr int CW_BAR = 4096;
constexpr int CW_CNT = 16384;

constexpr int RING_OFF = 0, RING_BYTES = 149504;
constexpr int LDSCTL_OFF = RING_BYTES;
constexpr int MISC_OFF = LDSCTL_OFF + 64;
constexpr int MOE_OFF_OFF = LDSCTL_OFF + 256;
constexpr int MOE_TEXP_OFF = LDSCTL_OFF + 512;
constexpr int LDS_BYTES = RING_BYTES + 2048;

#define GAS __attribute__((address_space(1)))
#define LAS __attribute__((address_space(3)))
typedef unsigned short bf16;
typedef unsigned v4u __attribute__((ext_vector_type(4)));
typedef unsigned v2u __attribute__((ext_vector_type(2)));
typedef float f32x4 __attribute__((ext_vector_type(4)));
typedef short bf16x8 __attribute__((ext_vector_type(8)));
typedef GAS unsigned gu32;
#define RLX_AGENT __ATOMIC_RELAXED, __HIP_MEMORY_SCOPE_AGENT
#define LDS_WAIT() asm volatile("s_waitcnt lgkmcnt(0)" ::: "memory")
#define VM_WAIT() asm volatile("s_waitcnt vmcnt(0)" ::: "memory")
__device__ __forceinline__ unsigned f2bf(float f) { unsigned u = __builtin_bit_cast(unsigned, f); return (u + 0x7fffu + ((u >> 16) & 1u)) >> 16; }
__device__ __forceinline__ unsigned pk2(float lo, float hi) { return pg8::cvt_pk_bf16(lo, hi); }
__device__ __forceinline__ float bf_lo(unsigned w) { return __builtin_bit_cast(float, w << 16); }
__device__ __forceinline__ float bf_hi(unsigned w) { return __builtin_bit_cast(float, w & 0xffff0000u); }
__device__ __forceinline__ float bf2f(bf16 b) { return __builtin_bit_cast(float, ((unsigned)b) << 16); }
__device__ __forceinline__ float wave_sum(float v) {
#pragma unroll
    for (int o = 1; o < 64; o <<= 1) v += __shfl_xor(v, o);
    return v;
}

#define XB_TMO      128
#define XB_XCNT(j)  (256  + 64 * (j))
#define XB_XSUB(j)  (1280 + 64 * (j))
#define XB_XGEN(j)  (2304 + 64 * (j))
#define XB_TOP      3328
#define XB_TOPGEN   3392
#define XCD_BAR_WORDS 3456
#define XB_SPIN_CAP (1u << 18)

__device__ __forceinline__ unsigned xb_ld(unsigned* p)              { return __hip_atomic_load(p, __ATOMIC_RELAXED, __HIP_MEMORY_SCOPE_AGENT); }
__device__ __forceinline__ unsigned xb_add(unsigned* p, unsigned v) { return __hip_atomic_fetch_add(p, v, __ATOMIC_RELAXED, __HIP_MEMORY_SCOPE_AGENT); }
__device__ __forceinline__ unsigned xb_xcc_id() { return (unsigned)__builtin_amdgcn_s_getreg((3 << 11) | 20) & 0xFu; }
#define XB_SPIN(cond, bar) do { unsigned _sp = 0; while (cond) { __builtin_amdgcn_s_sleep(1); \
    if ((++_sp & 255u) == 0u) { if (xb_ld(&(bar)[XB_TMO])) break; if (_sp > XB_SPIN_CAP) { atomicAdd(&(bar)[XB_TMO], 1u); break; } } } } while (0)

struct XcdBarrier {
    unsigned* bar; unsigned x;
    volatile LAS unsigned* st;
};

__device__ __forceinline__ XcdBarrier xcd_barrier_post(unsigned* bar, volatile LAS unsigned* st) {
    XcdBarrier b; b.bar = bar; b.x = xb_xcc_id(); b.st = st;
    if (threadIdx.x == 0) (void)xb_add(&bar[XB_XCNT(b.x)], 1u);
    return b;
}
__device__ __forceinline__ void xcd_barrier_complete(unsigned* bar, unsigned x, unsigned& nloc, unsigned& nx) {
    const unsigned G = gridDim.x * gridDim.y * gridDim.z;
    unsigned sum, cnt, mine, sp = 0u;
    for (;;) {
        sum = 0u; cnt = 0u; mine = 0u;
#pragma unroll
        for (unsigned j = 0; j < 16; ++j) { const unsigned c = xb_ld(&bar[XB_XCNT(j)]); sum += c; cnt += (c > 0u) ? 1u : 0u; mine = (j == x) ? c : mine; }
        if (sum == G) break;
        __builtin_amdgcn_s_sleep(1);
        if ((++sp & 255u) == 0u) { if (xb_ld(&bar[XB_TMO])) break; if (sp > XB_SPIN_CAP) { atomicAdd(&bar[XB_TMO], 1u); break; } }
    }
    nloc = mine > 0u ? mine : 1u; nx = cnt > 0u ? cnt : 1u;
}

__device__ __forceinline__ void xcd_barrier(const XcdBarrier& b) {
    asm volatile("s_waitcnt vmcnt(0)" ::: "memory");
    __syncthreads();
    if (threadIdx.x == 0) {
        unsigned* bar = b.bar;
        __builtin_amdgcn_s_waitcnt(0);
        unsigned nloc = b.st[0], nx = b.st[1];
        if (nloc == 0u) { xcd_barrier_complete(bar, b.x, nloc, nx); b.st[0] = nloc; b.st[1] = nx; }
        const unsigned old = xb_add(&bar[XB_XSUB(b.x)], 1u);
        const unsigned gen = old / nloc;
        if (old + 1u == (gen + 1u) * nloc) {
            __builtin_amdgcn_fence(__ATOMIC_RELEASE, "agent");
            asm volatile("s_waitcnt vmcnt(0)" ::: "memory");
            const unsigned og = xb_add(&bar[XB_TOP], 1u);
            const unsigned tg = og / nx;
            if (og + 1u == (tg + 1u) * nx) xb_add(&bar[XB_TOPGEN], 1u);
            else XB_SPIN(xb_ld(&bar[XB_TOPGEN]) == tg, bar);
            __builtin_amdgcn_fence(__ATOMIC_ACQUIRE, "agent");
            xb_add(&bar[XB_XGEN(b.x)], 1u);
            asm volatile("s_waitcnt vmcnt(0)" ::: "memory");
        } else {
            XB_SPIN(xb_ld(&bar[XB_XGEN(b.x)]) == gen, bar);
            __builtin_amdgcn_fence(__ATOMIC_ACQUIRE, "agent");
            asm volatile("s_waitcnt vmcnt(0)" ::: "memory");
        }
    }
    __syncthreads();
}


__device__ __forceinline__ void cvt_item(const float* W, int N, const float* gain, bf16* WT, int K, int k0, int n0, size_t dst_row0, int lane) {
    const int q = lane >> 4, c = lane & 15;
    const bool ok = (n0 + 4 * c) < N;
    const GAS f32x4* src = (const GAS f32x4*)(W + (size_t)(k0 + 16 * q) * N + n0 + 4 * c);
    f32x4 v[16];
#pragma unroll
    for (int i = 0; i < 16; ++i) v[i] = ok ? src[(size_t)i * (N / 4)] : (f32x4){0.f, 0.f, 0.f, 0.f};
    if (gain) { const GAS f32x4* gp = (const GAS f32x4*)(gain + k0 + 16 * q);
#pragma unroll
        for (int i4 = 0; i4 < 4; ++i4) { const f32x4 g = gp[i4]; v[4 * i4 + 0] = v[4 * i4 + 0] * g.x; v[4 * i4 + 1] = v[4 * i4 + 1] * g.y; v[4 * i4 + 2] = v[4 * i4 + 2] * g.z; v[4 * i4 + 3] = v[4 * i4 + 3] * g.w; } }
    if (ok) {
#pragma unroll
        for (int e = 0; e < 4; ++e) { bf16* dst = WT + (dst_row0 + 4 * c + e) * (size_t)K + k0 + 16 * q;
            v4u o0, o1;
            o0.x = pk2(v[0][e], v[1][e]); o0.y = pk2(v[2][e], v[3][e]); o0.z = pk2(v[4][e], v[5][e]); o0.w = pk2(v[6][e], v[7][e]);
            o1.x = pk2(v[8][e], v[9][e]); o1.y = pk2(v[10][e], v[11][e]); o1.z = pk2(v[12][e], v[13][e]); o1.w = pk2(v[14][e], v[15][e]);
            *(GAS v4u*)dst = o0; *(GAS v4u*)(dst + 8) = o1; } }
}
__device__ __forceinline__ void cvt_matrix(const float* W, int K, int N, const float* gain, bf16* WT, int rowbase, int gw, int NGW, int lane) {
    const int nblk = (N + 63) / 64, nitems = (K / 64) * nblk;
    for (int it = gw; it < nitems; it += NGW) { const int kb = it / nblk, nb = it - kb * nblk;
        cvt_item(W, N, gain, WT, K, kb * 64, nb * 64, (size_t)(rowbase + nb * 64), lane); }
}
__device__ __forceinline__ void cvt_moe(const float* wg, const float* wu, const float* wd, const float* gain, bf16* WGU, bf16* WDN, int gw, int NGW, int lane) {
    for (int it = gw; it < 2 * 8192; it += NGW) { const int which = it >> 13, r = it & 8191, e = r >> 8, q = r & 255, kb = q >> 3, nb = q & 7, n0 = nb * 64;
        const float* W = (which ? wu : wg) + (size_t)e * 2048 * 512;
        const size_t dst = (size_t)e * 1024 + 256 * (n0 >> 7) + (n0 & 127) + (which ? 128 : 0);
        cvt_item(W, 512, gain, WGU, 2048, kb * 64, n0, dst, lane); }
    for (int it = gw; it < 8192; it += NGW) { const int e = it >> 8, q = it & 255, kb = q >> 5, nb = q & 31;
        cvt_item(wd + (size_t)e * 512 * 2048, 2048, nullptr, WDN + (size_t)e * 2048 * 512, 512, kb * 64, nb * 64, (size_t)(nb * 64), lane); }
}
__device__ __forceinline__ void norm_rows(const float* src, bf16* dst, int gw, int NGW, int lane) {
    for (int m = gw; m < T; m += NGW) {
        const GAS f32x4* xr = (const GAS f32x4*)(src + (size_t)m * D) + lane;
        f32x4 v[8]; float s = 0.f;
#pragma unroll
        for (int j = 0; j < 8; ++j) { v[j] = xr[64 * j]; s += (v[j].x * v[j].x + v[j].y * v[j].y) + (v[j].z * v[j].z + v[j].w * v[j].w); }
        const float rstd = rsqrtf(wave_sum(s) * (1.f / D) + RMS_EPS);
        GAS v2u* o8 = (GAS v2u*)(dst + (size_t)m * D) + lane;
#pragma unroll
        for (int j = 0; j < 8; ++j) { v2u o; o.x = pk2(v[j].x * rstd, v[j].y * rstd); o.y = pk2(v[j].z * rstd, v[j].w * rstd); o8[64 * j] = o; }
    }
}

__device__ __forceinline__ float logsig(float z) { return fminf(z, 0.f) - __logf(1.f + __expf(-fabsf(z))); }
constexpr int GP_QE = 0, GP_KE = 33792, GP_ATT = 67584, GP_TOT = 76800;
__device__ __forceinline__ void gla_prepass(LAS unsigned char* lds, const bf16* QK, const bf16* V, const bf16* GL, const float* Wgu, const float* bgate,
                                            bf16* QEF, bf16* KLTF, bf16* ATTF, bf16* VTF, float* DEC) {
    const int tid = threadIdx.x, lane = tid & 63, wave = __builtin_amdgcn_readfirstlane(tid >> 6);
    LAS bf16* QEl = (LAS bf16*)(lds + GP_QE); LAS bf16* KEl = (LAS bf16*)(lds + GP_KE); LAS bf16* ATl = (LAS bf16*)(lds + GP_ATT);
    LAS float* tot = (LAS float*)(lds + GP_TOT);
    const int cg2 = tid & 127, rg2 = __builtin_amdgcn_readfirstlane(tid >> 7);
    for (int it = blockIdx.x; it < NITEM_GLA; it += gridDim.x) {
        const int bh = it >> 8, n = it & 255, h = bh & 3, b = bh >> 2; const int t0 = b * SEQ + n * GLA_C;
        v2u qv[8], kv[8], vv[16];
        { const bf16* qp = QK + (size_t)(t0 + 8 * wave) * 2048 + h * 256 + 4 * lane;
#pragma unroll
          for (int jj = 0; jj < 8; ++jj) { qv[jj] = *(const GAS v2u*)(qp + (size_t)jj * 2048); kv[jj] = *(const GAS v2u*)(qp + (size_t)jj * 2048 + 1024); }
          const bf16* vp = V + (size_t)(t0 + 16 * rg2) * 2048 + h * 512 + 4 * cg2;
#pragma unroll
          for (int r = 0; r < 16; ++r) vv[r] = *(const GAS v2u*)(vp + (size_t)r * 2048); }
        f32x4 cum[8];
        { f32x4 wg[16];
#pragma unroll
          for (int j = 0; j < 16; ++j) wg[j] = *(const GAS f32x4*)(Wgu + j * 1024 + h * 256 + 4 * lane);
          const f32x4 bg = *(const GAS f32x4*)(bgate + h * 256 + 4 * lane);
          f32x4 run = {0.f, 0.f, 0.f, 0.f};
#pragma unroll
          for (int jj = 0; jj < 8; ++jj) { const unsigned* gp = (const unsigned*)(GL + (size_t)(t0 + 8 * wave + jj) * 256);
              f32x4 z = bg;
#pragma unroll
              for (int j2 = 0; j2 < 8; ++j2) { const unsigned w = gp[j2]; z += wg[2 * j2] * bf_lo(w) + wg[2 * j2 + 1] * bf_hi(w); }
#pragma unroll
              for (int e = 0; e < 4; ++e) run[e] += fmaxf(logsig(z[e]) * 0.0625f, -1.0f);
              cum[jj] = run; }
          *(LAS f32x4*)(tot + wave * 256 + 4 * lane) = run; }
        __syncthreads();
        f32x4 offs = {0.f, 0.f, 0.f, 0.f}, blast = {0.f, 0.f, 0.f, 0.f};
#pragma unroll
        for (int w2 = 0; w2 < 8; ++w2) { const f32x4 tv = *(const LAS f32x4*)(tot + w2 * 256 + 4 * lane); blast += tv; if (w2 < wave) offs += tv; }
        f32x4 dec;
#pragma unroll
        for (int e = 0; e < 4; ++e) dec[e] = __expf(blast[e]);
        { float klv[4][8];
#pragma unroll
          for (int jj = 0; jj < 8; ++jj) { const int c = 8 * wave + jj; const f32x4 bb = cum[jj] + offs;
              const float q4[4] = {bf_lo(qv[jj].x), bf_hi(qv[jj].x), bf_lo(qv[jj].y), bf_hi(qv[jj].y)}, k4[4] = {bf_lo(kv[jj].x), bf_hi(kv[jj].x), bf_lo(kv[jj].y), bf_hi(kv[jj].y)};
              float qe[4], ke[4];
#pragma unroll
              for (int e = 0; e < 4; ++e) { qe[e] = q4[e] * 0.0625f * __expf(bb[e]); ke[e] = k4[e] * __expf(-bb[e]); klv[e][jj] = ke[e] * dec[e]; }
              v2u o; o.x = pk2(qe[0], qe[1]); o.y = pk2(qe[2], qe[3]); *(LAS v2u*)(QEl + c * 264 + 4 * lane) = o;
              o.x = pk2(ke[0], ke[1]); o.y = pk2(ke[2], ke[3]); *(LAS v2u*)(KEl + c * 264 + 4 * lane) = o; }
#pragma unroll
          for (int e = 0; e < 4; ++e) { const int d = 4 * lane + e;
              v4u o; o.x = pk2(klv[e][0], klv[e][1]); o.y = pk2(klv[e][2], klv[e][3]); o.z = pk2(klv[e][4], klv[e][5]); o.w = pk2(klv[e][6], klv[e][7]);
              const size_t fi = ((((size_t)it * 8 + (d >> 5)) * 2 + ((d >> 4) & 1)) * 2 + (wave >> 2)) * 64 + (wave & 3) * 16 + (d & 15);
              *(GAS v4u*)(KLTF + fi * 8) = o; } }
        if (wave == 0) *(GAS f32x4*)(DEC + (size_t)it * 256 + 4 * lane) = dec;
#pragma unroll
        for (int f = 0; f < 2; ++f)
#pragma unroll
            for (int e = 0; e < 4; ++e) { unsigned x[8];
#pragma unroll
                for (int jj = 0; jj < 8; ++jj) { const unsigned wd = (e >> 1) ? vv[8 * f + jj].y : vv[8 * f + jj].x; x[jj] = (e & 1) ? (wd >> 16) : (wd & 0xffffu); }
                v4u o; o.x = x[0] | (x[1] << 16); o.y = x[2] | (x[3] << 16); o.z = x[4] | (x[5] << 16); o.w = x[6] | (x[7] << 16);
                const int v = 4 * cg2 + e;
                const size_t fi = (((size_t)it * 32 + (v >> 4)) * 2 + (rg2 >> 1)) * 64 + (2 * (rg2 & 1) + f) * 16 + (v & 15);
                *(GAS v4u*)(VTF + fi * 8) = o; }
        __syncthreads();
        { const int mt = wave >> 1, i = lane & 15, q = lane >> 4;
#pragma unroll
          for (int nn = 0; nn < 2; ++nn) { const int nt = 2 * (wave & 1) + nn; f32x4 acc = {0.f, 0.f, 0.f, 0.f};
            if (nt <= mt) {
#pragma unroll
                for (int ks = 0; ks < 8; ++ks) { const bf16x8 a = *(const LAS bf16x8*)(QEl + (16 * mt + i) * 264 + 32 * ks + 8 * q); const bf16x8 bb = *(const LAS bf16x8*)(KEl + (16 * nt + i) * 264 + 32 * ks + 8 * q);
                    acc = __builtin_amdgcn_mfma_f32_16x16x32_bf16(a, bb, acc, 0, 0, 0); } }
#pragma unroll
            for (int r = 0; r < 4; ++r) { const int c = 16 * mt + 4 * q + r, cp = 16 * nt + i; ATl[c * 72 + cp] = (bf16)f2bf(cp <= c ? acc[r] : 0.f); } } }
        __syncthreads();
        { const int f = tid, mt = f >> 7, ks = (f >> 6) & 1, l2 = f & 63, i2 = l2 & 15, q2 = l2 >> 4;
          const v4u o = *(const LAS v4u*)(ATl + (16 * mt + i2) * 72 + 32 * ks + 8 * q2);
          *(GAS v4u*)(ATTF + ((size_t)it * 512 + f) * 8) = o; }
#pragma unroll
        for (int k = 0; k < 4; ++k) { const int f = tid + 512 * k, w = f >> 8, mt = (f >> 6) & 3, l2 = f & 63, i2 = l2 & 15, q2 = l2 >> 4;
            const v2u lo = *(const LAS v2u*)(QEl + (16 * mt + i2) * 264 + 32 * w + 4 * q2), hi = *(const LAS v2u*)(QEl + (16 * mt + i2) * 264 + 32 * w + 16 + 4 * q2);
            v4u o; o.x = lo.x; o.y = lo.y; o.z = hi.x; o.w = hi.y;
            *(GAS v4u*)(QEF + ((((size_t)it * 8 + w) * 4 + mt) * 64 + l2) * 8) = o; }
        __syncthreads();
    }
}
constexpr int GS_QE = 0, GS_KLT = 32768, GS_ATT = 65536, GS_DEC = 73728, GS_STAGE = 74752;
constexpr int GLA_NSEG = 8, GLA_SEGLEN = 32;
template <int PASS>
__device__ __forceinline__ void gla_scan(LAS unsigned char* lds, const bf16* QEF, const bf16* KLTF, const bf16* ATTF, const bf16* VTF, const float* DEC, float* SEND, float* DTOT, bf16* O) {
    const int tid = threadIdx.x, lane = tid & 63, w = __builtin_amdgcn_readfirstlane(tid >> 6), q = lane >> 4, li = lane & 15;
#define GS_ISSUE(itv, bufv) do { LAS unsigned char* _st = lds + (bufv) * GS_STAGE; const size_t _it = (size_t)(itv); \
        _Pragma("unroll") for (int _k = 0; _k < 4; ++_k) { const int _f = 4 * w + _k; \
            if (PASS == 1) __builtin_amdgcn_global_load_lds((const unsigned*)(QEF + (_it * 32 + _f) * 512 + lane * 8), (LAS unsigned*)(_st + GS_QE + _f * 1024), 16, 0, 0); \
            __builtin_amdgcn_global_load_lds((const unsigned*)(KLTF + (_it * 32 + _f) * 512 + lane * 8), (LAS unsigned*)(_st + GS_KLT + _f * 1024), 16, 0, 0); } \
        if (PASS == 1) __builtin_amdgcn_global_load_lds((const unsigned*)(ATTF + (_it * 8 + w) * 512 + lane * 8), (LAS unsigned*)(_st + GS_ATT + w * 1024), 16, 0, 0); \
        if (w == 0) __builtin_amdgcn_global_load_lds((const unsigned*)(DEC + _it * 256 + lane * 4), (LAS unsigned*)(_st + GS_DEC), 16, 0, 0); } while (0)
    for (int wi = blockIdx.x; wi < 256; wi += gridDim.x) {
        const int bh = wi & 7, rest = wi >> 3, seg = rest >> 2, vsl = rest & 3, h = bh & 3, b = bh >> 2;
        const int it0 = bh * 256 + seg * GLA_SEGLEN, vs16 = vsl * 8 + w;
        f32x4 S[16];
#pragma unroll
        for (int m = 0; m < 16; ++m) S[m] = (f32x4){0.f, 0.f, 0.f, 0.f};
        if (PASS == 1) {
            for (int s2 = 0; s2 < seg; ++s2) { const float* se = SEND + ((size_t)((bh * GLA_NSEG + s2) * 32 + vs16) * 16) * 256; const float* dt = DTOT + (size_t)(bh * GLA_NSEG + s2) * 256;
#pragma unroll
                for (int m = 0; m < 16; ++m) { const f32x4 dv = *(const GAS f32x4*)(dt + 16 * m + 4 * q), sv = *(const GAS f32x4*)(se + (m * 64 + lane) * 4); S[m] = S[m] * dv + sv; } }
        } else if (vsl == 0 && tid < 256) { float p = 1.f;
            for (int n = 0; n < GLA_SEGLEN; ++n) p *= DEC[(size_t)(it0 + n) * 256 + tid];
            DTOT[(size_t)(bh * GLA_NSEG + seg) * 256 + tid] = p; }
        __syncthreads();
        GS_ISSUE(it0, 0);
        const GAS bf16x8* v16 = (const GAS bf16x8*)VTF + (((size_t)it0 * 32 + vs16) * 2) * 64 + lane;
        bf16x8 vb0 = v16[0], vb1 = v16[64], nvb0 = vb0, nvb1 = vb1;
        for (int n = 0; n < GLA_SEGLEN; ++n) {
            VM_WAIT(); __syncthreads();
            if (n + 1 < GLA_SEGLEN) { GS_ISSUE(it0 + n + 1, (n + 1) & 1); nvb0 = v16[(size_t)(n + 1) * 4096]; nvb1 = v16[(size_t)(n + 1) * 4096 + 64]; }
            const LAS unsigned char* st = lds + (n & 1) * GS_STAGE;
            f32x4 po[4];
            if (PASS == 1) {
                bf16x8 sb[8];
#pragma unroll
                for (int ks = 0; ks < 8; ++ks) { v4u x; x.x = pk2(S[2 * ks][0], S[2 * ks][1]); x.y = pk2(S[2 * ks][2], S[2 * ks][3]); x.z = pk2(S[2 * ks + 1][0], S[2 * ks + 1][1]); x.w = pk2(S[2 * ks + 1][2], S[2 * ks + 1][3]); sb[ks] = __builtin_bit_cast(bf16x8, x); }
#pragma unroll
                for (int mt = 0; mt < 4; ++mt) { f32x4 a = {0.f, 0.f, 0.f, 0.f};
#pragma unroll
                    for (int ks = 0; ks < 8; ++ks) a = __builtin_amdgcn_mfma_f32_16x16x32_bf16(*(const LAS bf16x8*)(st + GS_QE + (ks * 4 + mt) * 1024 + lane * 16), sb[ks], a, 0, 0, 0);
                    a = __builtin_amdgcn_mfma_f32_16x16x32_bf16(*(const LAS bf16x8*)(st + GS_ATT + (mt * 2 + 0) * 1024 + lane * 16), vb0, a, 0, 0, 0);
                    a = __builtin_amdgcn_mfma_f32_16x16x32_bf16(*(const LAS bf16x8*)(st + GS_ATT + (mt * 2 + 1) * 1024 + lane * 16), vb1, a, 0, 0, 0);
                    po[mt] = a; }
            }
#pragma unroll
            for (int m = 0; m < 16; ++m) { const f32x4 dv = *(const LAS f32x4*)(st + GS_DEC + (16 * m + 4 * q) * 4);
                f32x4 s = S[m] * dv;
                s = __builtin_amdgcn_mfma_f32_16x16x32_bf16(*(const LAS bf16x8*)(st + GS_KLT + (m * 2 + 0) * 1024 + lane * 16), vb0, s, 0, 0, 0);
                s = __builtin_amdgcn_mfma_f32_16x16x32_bf16(*(const LAS bf16x8*)(st + GS_KLT + (m * 2 + 1) * 1024 + lane * 16), vb1, s, 0, 0, 0);
                S[m] = s; }
            if (PASS == 1) { bf16* op = O + (size_t)(b * SEQ + (seg * GLA_SEGLEN + n) * GLA_C + 4 * q) * 2048 + h * 512 + vsl * 128 + w * 16 + li;
#pragma unroll
                for (int mt = 0; mt < 4; ++mt)
#pragma unroll
                    for (int r = 0; r < 4; ++r) { const float x = po[mt][r], y = __shfl_xor(x, 1); if ((lane & 1) == 0) *(GAS unsigned*)(op + (size_t)(16 * mt + r) * 2048) = pk2(x, y); } }
            vb0 = nvb0; vb1 = nvb1;
        }
        if (PASS == 0) { float* se = SEND + ((size_t)((bh * GLA_NSEG + seg) * 32 + vs16) * 16) * 256;
#pragma unroll
            for (int m = 0; m < 16; ++m) *(GAS f32x4*)(se + (m * 64 + lane) * 4) = S[m]; }
        __syncthreads();
    }
#undef GS_ISSUE
}
__device__ __forceinline__ void gla_gate(const bf16* O, const bf16* R, const float* head_g, bf16* OG, int gw, int NGW, int lane) {
    float hg[8];
#pragma unroll
    for (int j = 0; j < 8; ++j) hg[j] = head_g[8 * lane + j];
    for (int m = gw; m < T; m += NGW) {
#pragma unroll
        for (int h = 0; h < 4; ++h) {
            const v4u ov = *(const GAS v4u*)(O + (size_t)m * 2048 + h * 512 + 8 * lane), rv = *(const GAS v4u*)(R + (size_t)m * 2048 + h * 512 + 8 * lane);
            float o[8] = {bf_lo(ov.x), bf_hi(ov.x), bf_lo(ov.y), bf_hi(ov.y), bf_lo(ov.z), bf_hi(ov.z), bf_lo(ov.w), bf_hi(ov.w)};
            float r[8] = {bf_lo(rv.x), bf_hi(rv.x), bf_lo(rv.y), bf_hi(rv.y), bf_lo(rv.z), bf_hi(rv.z), bf_lo(rv.w), bf_hi(rv.w)};
            float ss = 0.f;
#pragma unroll
            for (int j = 0; j < 8; ++j) ss += o[j] * o[j];
            const float rstd = rsqrtf(wave_sum(ss) * (1.f / 512.f) + RMS_EPS);
            float y[8];
#pragma unroll
            for (int j = 0; j < 8; ++j) y[j] = o[j] * rstd * hg[j] * pg8::silu_f(r[j]);
            v4u w; w.x = pk2(y[0], y[1]); w.y = pk2(y[2], y[3]); w.z = pk2(y[4], y[5]); w.w = pk2(y[6], y[7]);
            *(GAS v4u*)(OG + (size_t)m * 2048 + h * 512 + 8 * lane) = w;
        }
    }
}

__device__ __forceinline__ void moe_route(LAS unsigned char* lds, const float* RL, const float* SSP, const float* bgroup, const float* brouter, unsigned* gcnt, unsigned* EP0, unsigned* EP1, float* W0, float* W1, float* RSTD) {
    const int tid = threadIdx.x; LAS int* lcnt = (LAS int*)lds; LAS int* lbase = lcnt + 32;
    for (int base = blockIdx.x * 128; base < T; base += gridDim.x * 128) {
        if (tid < 32) lcnt[tid] = 0;
        __syncthreads();
        int e0 = 0, e1 = 0, r0 = 0, r1 = 0; float w0 = 0.f, w1 = 0.f;
        if (tid < 128) { const int t = base + tid; const float* rl = RL + (size_t)t * 64;
            float ssq = 0.f; { const GAS f32x4* sp = (const GAS f32x4*)(SSP + (size_t)t * 32);
#pragma unroll
                for (int k = 0; k < 8; ++k) { const f32x4 v = sp[k]; ssq += (v.x + v.y) + (v.z + v.w); } }
            const float rstd = rsqrtf(ssq * (1.f / D) + RMS_EPS); RSTD[t] = rstd;
            const f32x4 g4 = *(const GAS f32x4*)rl; float gl[4] = {g4.x * rstd + bgroup[0], g4.y * rstd + bgroup[1], g4.z * rstd + bgroup[2], g4.w * rstd + bgroup[3]};
            int g = 0; float best = gl[0];
#pragma unroll
            for (int j = 1; j < 4; ++j) if (gl[j] > best) { best = gl[j]; g = j; }
            float se = 0.f;
#pragma unroll
            for (int j = 0; j < 4; ++j) se += __expf(gl[j] - best);
            const float pg = 1.0f / se;
            const f32x4 a4 = *(const GAS f32x4*)(rl + 4 + 8 * g), b4 = *(const GAS f32x4*)(rl + 8 + 8 * g);
            float el[8] = {a4.x, a4.y, a4.z, a4.w, b4.x, b4.y, b4.z, b4.w};
#pragma unroll
            for (int j = 0; j < 8; ++j) el[j] = el[j] * rstd + brouter[8 * g + j];
            int i0 = 0; float v0 = el[0];
#pragma unroll
            for (int j = 1; j < 8; ++j) if (el[j] > v0) { v0 = el[j]; i0 = j; }
            int i1 = -1; float v1 = -3.0e38f;
#pragma unroll
            for (int j = 0; j < 8; ++j) if (j != i0 && el[j] > v1) { v1 = el[j]; i1 = j; }
            w0 = pg / (1.0f + __expf(v1 - v0)); w1 = pg - w0;
            e0 = 8 * g + i0; e1 = 8 * g + i1;
            r0 = __hip_atomic_fetch_add(&lcnt[e0], 1, __ATOMIC_RELAXED, __HIP_MEMORY_SCOPE_WORKGROUP); r1 = __hip_atomic_fetch_add(&lcnt[e1], 1, __ATOMIC_RELAXED, __HIP_MEMORY_SCOPE_WORKGROUP); }
        __syncthreads();
        if (tid < 32) lbase[tid] = (int)__hip_atomic_fetch_add(gcnt + tid, (unsigned)lcnt[tid], RLX_AGENT);
        __syncthreads();
        if (tid < 128) { const int t = base + tid;
            EP0[t] = ((unsigned)e0 << 24) | (unsigned)(lbase[e0] + r0); EP1[t] = ((unsigned)e1 << 24) | (unsigned)(lbase[e1] + r1); W0[t] = w0; W1[t] = w1; }
        __syncthreads();
    }
}
__device__ __forceinline__ void moe_build_table(LAS unsigned char* ldsbase, unsigned* gcnt) {
    LAS int* off = (LAS int*)(ldsbase + MOE_OFF_OFF); LAS unsigned char* texp = ldsbase + MOE_TEXP_OFF;
    __syncthreads();
    if (threadIdx.x == 0) { int acc = 0, ti = 0;
        for (int e = 0; e < NE; ++e) { const int c = (int)__hip_atomic_load(gcnt + e, RLX_AGENT); off[e] = acc; const int nt = (c + 255) >> 8;
            for (int k = 0; k < nt && ti < 288; ++k) texp[ti++] = (unsigned char)e;
            acc += nt * 256; }
        off[32] = acc; }
    __syncthreads();
}
__device__ __forceinline__ void moe_slots(LAS unsigned char* ldsbase, unsigned* gcnt, const unsigned* EP0, const unsigned* EP1, const float* RSTD, unsigned* SL0, unsigned* SL1, unsigned* TL, float* RS) {
    const LAS int* off = (const LAS int*)(ldsbase + MOE_OFF_OFF); const int tid = threadIdx.x;
    for (int t = blockIdx.x * 512 + tid; t < T; t += gridDim.x * 512) {
        const unsigned p0 = EP0[t], p1 = EP1[t]; const float rs = RSTD[t];
        const unsigned s0 = (unsigned)off[p0 >> 24] + (p0 & 0xffffffu), s1 = (unsigned)off[p1 >> 24] + (p1 & 0xffffffu);
        TL[s0] = (unsigned)t; RS[s0] = rs; TL[s1] = (unsigned)t; RS[s1] = rs; SL0[t] = s0; SL1[t] = s1; }
    for (int e = blockIdx.x; e < NE; e += gridDim.x) { const int c = (int)__hip_atomic_load(gcnt + e, RLX_AGENT);
        for (int i = off[e] + c + tid; i < off[e + 1]; i += 512) { TL[i] = 0u; RS[i] = 0.f; } }
}
__device__ __forceinline__ void moe_combine(float* out, const bf16* Y, const unsigned* SL0, const unsigned* SL1, const float* W0, const float* W1, bf16* HN, bool do_norm, int gw, int NGW, int lane) {
    for (int t = gw; t < T; t += NGW) {
        const unsigned s0 = SL0[t], s1 = SL1[t]; const float w0 = W0[t], w1 = W1[t];
        GAS f32x4* xr = (GAS f32x4*)(out + (size_t)t * D) + lane;
        const GAS v2u* y0 = (const GAS v2u*)(Y + (size_t)s0 * 2048) + lane; const GAS v2u* y1 = (const GAS v2u*)(Y + (size_t)s1 * 2048) + lane;
        f32x4 v[8]; float s = 0.f;
#pragma unroll
        for (int j = 0; j < 8; ++j) { const v2u a = y0[64 * j], b = y1[64 * j]; f32x4 x = xr[64 * j];
            x.x += w0 * bf_lo(a.x) + w1 * bf_lo(b.x); x.y += w0 * bf_hi(a.x) + w1 * bf_hi(b.x); x.z += w0 * bf_lo(a.y) + w1 * bf_lo(b.y); x.w += w0 * bf_hi(a.y) + w1 * bf_hi(b.y);
            v[j] = x; xr[64 * j] = x; s += (x.x * x.x + x.y * x.y) + (x.z * x.z + x.w * x.w); }
        if (do_norm) { const float rstd = rsqrtf(wave_sum(s) * (1.f / D) + RMS_EPS);
            GAS v2u* o8 = (GAS v2u*)(HN + (size_t)t * D) + lane;
#pragma unroll
            for (int j = 0; j < 8; ++j) { v2u o; o.x = pk2(v[j].x * rstd, v[j].y * rstd); o.y = pk2(v[j].z * rstd, v[j].w * rstd); o8[64 * j] = o; } }
    }
}

__device__ const unsigned char T5_BUCKET[128] = {0,1,2,3,4,5,6,7,8,9,10,11,12,13,14,15,16,16,16,17,17,18,18,18,19,19,19,20,20,20,20,21,21,21,21,22,22,22,22,22,23,23,23,23,23,23,24,24,24,24,24,24,25,25,25,25,25,25,25,26,26,26,26,26,26,26,26,27,27,27,27,27,27,27,27,27,27,28,28,28,28,28,28,28,28,28,28,29,29,29,29,29,29,29,29,29,29,29,29,30,30,30,30,30,30,30,30,30,30,30,30,30,30,31,31,31,31,31,31,31,31,31,31,31,31,31,31,31};
constexpr int AT_K = 0, AT_VT = 36864, AT_BIAS = 70656;
__device__ __forceinline__ void swa_attention(LAS unsigned char* lds, const bf16* KVQ, const float* knorm, const float* qnorm, const float* relb, const float* sinks, bf16* AO) {
    const int tid = threadIdx.x, lane = tid & 63, g = __builtin_amdgcn_readfirstlane(tid >> 6), li = lane & 15, q = lane >> 4;
    LAS bf16* KL = (LAS bf16*)(lds + AT_K); LAS bf16* VTL = (LAS bf16*)(lds + AT_VT); LAS float* BL = (LAS float*)(lds + AT_BIAS);
    float qn[2][8];
#pragma unroll
    for (int ks = 0; ks < 2; ++ks)
#pragma unroll
        for (int j = 0; j < 8; ++j) qn[ks][j] = qnorm[32 * ks + 8 * q + j] * 0.125f;
    for (int wi = blockIdx.x; wi < 1024; wi += gridDim.x) {
        const int hk = wi & 3, n = (wi >> 2) & 127, b = wi >> 9;
        __syncthreads();
        { const int key = tid >> 1, hf = tid & 1; const bool live = (n > 0) || (key >= 128);
          const size_t tk = (size_t)b * SEQ + (size_t)(n - 1) * 128 + key;
          const bf16* kp = KVQ + tk * KVQ_N + hk * 64 + 32 * hf;
          v4u kw[4], vw[4];
#pragma unroll
          for (int j = 0; j < 4; ++j) { kw[j] = live ? *(const GAS v4u*)(kp + 8 * j) : (v4u){0u, 0u, 0u, 0u}; vw[j] = live ? *(const GAS v4u*)(kp + 256 + 8 * j) : (v4u){0u, 0u, 0u, 0u}; }
          float ss = 0.f;
#pragma unroll
          for (int j = 0; j < 4; ++j) { const float a0 = bf_lo(kw[j].x), a1 = bf_hi(kw[j].x), a2 = bf_lo(kw[j].y), a3 = bf_hi(kw[j].y), a4 = bf_lo(kw[j].z), a5 = bf_hi(kw[j].z), a6 = bf_lo(kw[j].w), a7 = bf_hi(kw[j].w);
              ss += (a0 * a0 + a1 * a1) + (a2 * a2 + a3 * a3) + (a4 * a4 + a5 * a5) + (a6 * a6 + a7 * a7); }
          ss += __shfl_xor(ss, 1);
          const float rstd = rsqrtf(ss * (1.f / 64.f) + RMS_EPS);
#pragma unroll
          for (int j = 0; j < 4; ++j) { const float* kn = knorm + 32 * hf + 8 * j; v4u o;
              o.x = pk2(bf_lo(kw[j].x) * rstd * kn[0], bf_hi(kw[j].x) * rstd * kn[1]); o.y = pk2(bf_lo(kw[j].y) * rstd * kn[2], bf_hi(kw[j].y) * rstd * kn[3]);
              o.z = pk2(bf_lo(kw[j].z) * rstd * kn[4], bf_hi(kw[j].z) * rstd * kn[5]); o.w = pk2(bf_lo(kw[j].w) * rstd * kn[6], bf_hi(kw[j].w) * rstd * kn[7]);
              *(LAS v4u*)(KL + key * 72 + 32 * hf + 8 * j) = o; }
#pragma unroll
          for (int j = 0; j < 4; ++j) { const int d0 = 32 * hf + 8 * j;
              VTL[(d0 + 0) * 264 + key] = (bf16)(vw[j].x & 0xffffu); VTL[(d0 + 1) * 264 + key] = (bf16)(vw[j].x >> 16); VTL[(d0 + 2) * 264 + key] = (bf16)(vw[j].y & 0xffffu); VTL[(d0 + 3) * 264 + key] = (bf16)(vw[j].y >> 16);
              VTL[(d0 + 4) * 264 + key] = (bf16)(vw[j].z & 0xffffu); VTL[(d0 + 5) * 264 + key] = (bf16)(vw[j].z >> 16); VTL[(d0 + 6) * 264 + key] = (bf16)(vw[j].w & 0xffffu); VTL[(d0 + 7) * 264 + key] = (bf16)(vw[j].w >> 16); }
#pragma unroll
          for (int k = 0; k < 2; ++k) { const int e = tid + 512 * k, gg = e >> 7, dist = e & 127; BL[e] = relb[(int)T5_BUCKET[dist] * 32 + hk * 8 + gg]; }
        }
        __syncthreads();
        const int head = hk * 8 + g; const float sink = sinks[head];
        for (int mt = 0; mt < 8; ++mt) {
            const size_t tq = (size_t)b * SEQ + (size_t)n * 128 + 16 * mt + li;
            bf16x8 qf[2];
            { const bf16* qp = KVQ + tq * KVQ_N + 512 + head * 64 + 8 * q; const v4u q0 = *(const GAS v4u*)qp, q1 = *(const GAS v4u*)(qp + 32);
              float a[16] = {bf_lo(q0.x), bf_hi(q0.x), bf_lo(q0.y), bf_hi(q0.y), bf_lo(q0.z), bf_hi(q0.z), bf_lo(q0.w), bf_hi(q0.w), bf_lo(q1.x), bf_hi(q1.x), bf_lo(q1.y), bf_hi(q1.y), bf_lo(q1.z), bf_hi(q1.z), bf_lo(q1.w), bf_hi(q1.w)};
              float ss = 0.f;
#pragma unroll
              for (int j = 0; j < 16; ++j) ss += a[j] * a[j];
              ss += __shfl_xor(ss, 16); ss += __shfl_xor(ss, 32);
              const float rstd = rsqrtf(ss * (1.f / 64.f) + RMS_EPS);
              v4u w0, w1;
              w0.x = pk2(a[0] * rstd * qn[0][0], a[1] * rstd * qn[0][1]); w0.y = pk2(a[2] * rstd * qn[0][2], a[3] * rstd * qn[0][3]); w0.z = pk2(a[4] * rstd * qn[0][4], a[5] * rstd * qn[0][5]); w0.w = pk2(a[6] * rstd * qn[0][6], a[7] * rstd * qn[0][7]);
              w1.x = pk2(a[8] * rstd * qn[1][0], a[9] * rstd * qn[1][1]); w1.y = pk2(a[10] * rstd * qn[1][2], a[11] * rstd * qn[1][3]); w1.z = pk2(a[12] * rstd * qn[1][4], a[13] * rstd * qn[1][5]); w1.w = pk2(a[14] * rstd * qn[1][6], a[15] * rstd * qn[1][7]);
              qf[0] = __builtin_bit_cast(bf16x8, w0); qf[1] = __builtin_bit_cast(bf16x8, w1); }
            f32x4 st[9]; float mx = sink;
#pragma unroll
            for (int tt = 0; tt < 9; ++tt) { const int nt = mt + tt; f32x4 acc = {0.f, 0.f, 0.f, 0.f};
#pragma unroll
                for (int ks = 0; ks < 2; ++ks) { const bf16x8 a = *(const LAS bf16x8*)(KL + (16 * nt + li) * 72 + 32 * ks + 8 * q); acc = __builtin_amdgcn_mfma_f32_16x16x32_bf16(a, qf[ks], acc, 0, 0, 0); }
#pragma unroll
                for (int r = 0; r < 4; ++r) { const int col = 16 * nt + 4 * q + r, row = 16 * mt + li, dist = 128 + row - col;
                    const bool valid = (dist >= 0) && (dist < 128) && ((col >= 128) || (n > 0));
                    const float s = valid ? acc[r] + BL[g * 128 + (dist & 127)] : -__builtin_inff();
                    acc[r] = s; mx = fmaxf(mx, s); }
                st[tt] = acc; }
            mx = fmaxf(mx, __shfl_xor(mx, 16)); mx = fmaxf(mx, __shfl_xor(mx, 32));
            float lsum = 0.f;
#pragma unroll
            for (int tt = 0; tt < 9; ++tt)
#pragma unroll
                for (int r = 0; r < 4; ++r) { const float p = __expf(st[tt][r] - mx); st[tt][r] = p; lsum += p; }
            lsum += __shfl_xor(lsum, 16); lsum += __shfl_xor(lsum, 32);
            const float inv = 1.0f / (lsum + __expf(sink - mx));
            f32x4 oacc[4];
#pragma unroll
            for (int dt = 0; dt < 4; ++dt) oacc[dt] = (f32x4){0.f, 0.f, 0.f, 0.f};
#pragma unroll
            for (int s = 0; s < 5; ++s) {
                v4u pw; pw.x = pk2(st[2 * s][0], st[2 * s][1]); pw.y = pk2(st[2 * s][2], st[2 * s][3]);
                if (s < 4) { pw.z = pk2(st[2 * s + 1][0], st[2 * s + 1][1]); pw.w = pk2(st[2 * s + 1][2], st[2 * s + 1][3]); } else { pw.z = 0u; pw.w = 0u; }
                const bf16x8 pb = __builtin_bit_cast(bf16x8, pw);
                const int k0 = 16 * (mt + 2 * s) + 4 * q; int k1 = 16 * (mt + 2 * s + 1) + 4 * q; if (k1 > 252) k1 = 240 + 4 * q;
#pragma unroll
                for (int dt = 0; dt < 4; ++dt) { const v2u lo = *(const LAS v2u*)(VTL + (16 * dt + li) * 264 + k0), hi = *(const LAS v2u*)(VTL + (16 * dt + li) * 264 + k1);
                    v4u aw; aw.x = lo.x; aw.y = lo.y; aw.z = hi.x; aw.w = hi.y;
                    oacc[dt] = __builtin_amdgcn_mfma_f32_16x16x32_bf16(__builtin_bit_cast(bf16x8, aw), pb, oacc[dt], 0, 0, 0); } }
#pragma unroll
            for (int dt = 0; dt < 4; ++dt) { v2u o; o.x = pk2(oacc[dt][0] * inv, oacc[dt][1] * inv); o.y = pk2(oacc[dt][2] * inv, oacc[dt][3] * inv);
                *(GAS v2u*)(AO + tq * 2048 + head * 64 + 16 * dt + 4 * q) = o; }
        }
    }
}

struct Args { const float* in[24]; float* out; unsigned char* ws; int ph_lo, ph_hi; };
constexpr int N_PHASES = 23;
#define CAS __attribute__((address_space(4)))
template <int WHICH> struct OrderCvt : pg8::StaticOrder {
    int tpm, tpn, gw, NGW, lane;
    __device__ __forceinline__ void set_trigger(int when) { pg8::Unit u; if (!next(when, u)) (void)next(0, u); tpm = u.pm; tpn = u.pn; }
    __device__ __forceinline__ void done(const pg8::Unit& u) const {
        if (u.pm != tpm || u.pn != tpn) return;
        const CAS Args* a = (const CAS Args*)__builtin_amdgcn_kernarg_segment_ptr();
        unsigned char* ws = a->ws;
        if (WHICH == 0) {
            cvt_matrix(a->in[6], 2048, 2048, nullptr, (bf16*)(ws + WS_W_GLA_OUT), 0, gw, NGW, lane);
            cvt_matrix(a->in[8], 2048, 512, a->in[7], (bf16*)(ws + WS_W_KVQ), 0, gw, NGW, lane);
            cvt_matrix(a->in[12], 2048, 2048, a->in[11], (bf16*)(ws + WS_W_KVQ), 512, gw, NGW, lane);
            cvt_matrix(a->in[15], 2048, 2048, nullptr, (bf16*)(ws + WS_W_SWA_OUT), 0, gw, NGW, lane);
            for (int l = 0; l < 2; ++l) {
                cvt_matrix(a->in[17] + (size_t)l * 2048 * 4, 2048, 4, a->in[16] + l * 2048, (bf16*)(ws + WS_W_ROUTER) + (size_t)l * 256 * 2048, 0, gw, NGW, lane);
                cvt_matrix(a->in[19] + (size_t)l * 2048 * 32, 2048, 32, a->in[16] + l * 2048, (bf16*)(ws + WS_W_ROUTER) + (size_t)l * 256 * 2048, 4, gw, NGW, lane);
            }
            cvt_moe(a->in[21], a->in[22], a->in[23], a->in[16], (bf16*)(ws + WS_W_GU), (bf16*)(ws + WS_W_DN), gw, NGW, lane);
        } else {
            cvt_moe(a->in[21] + (size_t)NE * 2048 * 512, a->in[22] + (size_t)NE * 2048 * 512, a->in[23] + (size_t)NE * 512 * 2048, a->in[16] + 2048, (bf16*)(ws + WS_W_GU), (bf16*)(ws + WS_W_DN), gw, NGW, lane);
        }
    }
};
__global__ void __launch_bounds__(NWAVES * 64, 2) fwd(Args args) {
    extern __shared__ __attribute__((aligned(16))) unsigned char lds_raw[];
    LAS unsigned char* lds = (LAS unsigned char*)lds_raw;
    const int tid = threadIdx.x, lane = tid & 63, wave = __builtin_amdgcn_readfirstlane(tid >> 6);
    const int G = gridDim.x, gw = blockIdx.x * NWAVES + wave, NGW = G * NWAVES;
    unsigned char* ws = args.ws;
    gu32* ctl = (gu32*)(ws + WS_CTL);
    for (int u = tid; u < (LDS_BYTES - LDSCTL_OFF) / 4; u += NWAVES * 64) ((LAS unsigned*)(lds + LDSCTL_OFF))[u] = 0u;
    __syncthreads();
    XcdBarrier bar = xcd_barrier_post((unsigned*)(ctl + CW_BAR), (volatile LAS unsigned*)(lds + MISC_OFF));
    const int lo = args.ph_lo, hi = args.ph_hi;
#define IN(k) ((((MK_PHASE_MASK) >> (k)) & 1) && lo <= (k) && (k) < hi)
#define PB(k) const unsigned long long _pt0 = (((MK_DELAY_MASK) >> (k)) & 1) ? __builtin_amdgcn_s_memrealtime() : 0ull
#define PE(k) do { if (((MK_DELAY_MASK) >> (k)) & 1) { const unsigned long long _pt1 = __builtin_amdgcn_s_memrealtime(), _dt = _pt1 - _pt0; while (__builtin_amdgcn_s_memrealtime() - _pt1 < _dt) __builtin_amdgcn_s_sleep(8); } } while (0)
#define SEAM(k) do { if (IN(k) && IN((k) + 1)) xcd_barrier(bar); } while (0)

    const float* x = args.in[0]; float* out = args.out;
    bf16* W_GLA_IN = (bf16*)(ws + WS_W_GLA_IN); bf16* W_GLA_OUT = (bf16*)(ws + WS_W_GLA_OUT); bf16* W_KVQ = (bf16*)(ws + WS_W_KVQ); bf16* W_SWA_OUT = (bf16*)(ws + WS_W_SWA_OUT);
    bf16* W_ROUTER = (bf16*)(ws + WS_W_ROUTER); bf16* W_GU = (bf16*)(ws + WS_W_GU); bf16* W_DN = (bf16*)(ws + WS_W_DN);
    bf16* HN = (bf16*)(ws + WS_HN);
    unsigned* EP0 = (unsigned*)(ws + WS_TOK); unsigned* EP1 = EP0 + T; unsigned* SL0 = EP1 + T; unsigned* SL1 = SL0 + T; float* TW0 = (float*)(SL1 + T); float* TW1 = TW0 + T; float* RSTD = TW1 + T;
    bf16* HB = (bf16*)(ws + WS_HB); float* SSP = (float*)(ws + WS_SSP); unsigned* TL = (unsigned*)(ws + WS_TL); float* RS = (float*)(ws + WS_RS);
    float* RL = (float*)(ws + WS_RL);

    if (IN(0)) { PB(0);
        cvt_matrix(args.in[2], 2048, GLA_PROJ_N, args.in[1], W_GLA_IN, 0, gw, NGW, lane);
        norm_rows(x, HN, gw, NGW, lane);
        PE(0);
    }
    SEAM(0);
    if (IN(1)) { PB(1);
        pg8::Gemm g{HN, W_GLA_IN, T, GLA_PROJ_NP, 2048}; OrderCvt<0> S; S.init(T, GLA_PROJ_NP, G, (int)blockIdx.x); S.gw = gw; S.NGW = NGW; S.lane = lane; S.set_trigger((int)(blockIdx.x % 12));
        pg8::EpiGlaProj E{(bf16*)(ws + WS_QK), (bf16*)(ws + WS_V), (bf16*)(ws + WS_R), (bf16*)(ws + WS_GL)};
        pg8::gemm_phase<pg8::EpiGlaProj, OrderCvt<0>, true, true>(lds + RING_OFF, g, S, E);
        PE(1);
    }
    SEAM(1);
    if (IN(2)) { PB(2); gla_prepass(lds + RING_OFF, (const bf16*)(ws + WS_QK), (const bf16*)(ws + WS_V), (const bf16*)(ws + WS_GL), args.in[3], args.in[4],
                           (bf16*)(ws + WS_QEF), (bf16*)(ws + WS_KLTF), (bf16*)(ws + WS_ATTF), (bf16*)(ws + WS_VTF), (float*)(ws + WS_DEC)); PE(2); }
    SEAM(2);
    if (IN(3)) { PB(3); gla_scan<0>(lds + RING_OFF, (const bf16*)(ws + WS_QEF), (const bf16*)(ws + WS_KLTF), (const bf16*)(ws + WS_ATTF), (const bf16*)(ws + WS_VTF), (const float*)(ws + WS_DEC), (float*)(ws + WS_SEND), (float*)(ws + WS_DTOT), (bf16*)(ws + WS_QK)); PE(3); }
    SEAM(3);
    if (IN(4)) { PB(4); gla_scan<1>(lds + RING_OFF, (const bf16*)(ws + WS_QEF), (const bf16*)(ws + WS_KLTF), (const bf16*)(ws + WS_ATTF), (const bf16*)(ws + WS_VTF), (const float*)(ws + WS_DEC), (float*)(ws + WS_SEND), (float*)(ws + WS_DTOT), (bf16*)(ws + WS_QK)); PE(4); }
    SEAM(4);
    if (IN(5)) { PB(5); gla_gate((const bf16*)(ws + WS_QK), (const bf16*)(ws + WS_R), args.in[5], HN, gw, NGW, lane); PE(5); }
    SEAM(5);
    if (IN(6)) { PB(6);
        pg8::Gemm g{HN, W_GLA_OUT, T, 2048, 2048}; pg8::StaticOrder S; S.init(T, 2048, G, (int)blockIdx.x);
        pg8::EpiResF32 E{out, x, 2048, HB, SSP};
        pg8::gemm_phase<pg8::EpiResF32, pg8::StaticOrder, true, true>(lds + RING_OFF, g, S, E);
        PE(6);
    }
    SEAM(6);

    { constexpr int layer = 0; constexpr int pb = 6 + 10 * layer;
    unsigned* gcnt = (unsigned*)(ctl + CW_CNT + layer * 64);
    if (IN(pb + 1)) { PB(pb + 1);
        pg8::Gemm g{HB, W_ROUTER + (size_t)layer * 256 * 2048, T, 256, 2048}; pg8::StaticOrder S; S.init(T, 256, G, (int)blockIdx.x);
        pg8::EpiRouter E{RL};
        pg8::gemm_phase<pg8::EpiRouter, pg8::StaticOrder, true, true>(lds + RING_OFF, g, S, E);
        PE(pb + 1);
    }
    SEAM(pb + 1);
    if (IN(pb + 2)) { PB(pb + 2); moe_route(lds + RING_OFF, RL, SSP, args.in[18] + layer * 4, args.in[20] + layer * 32, gcnt, EP0, EP1, TW0, TW1, RSTD); PE(pb + 2); }
    SEAM(pb + 2);
    if (IN(pb + 3)) { PB(pb + 3); { moe_build_table(lds, gcnt); moe_slots(lds, gcnt, EP0, EP1, RSTD, SL0, SL1, TL, RS); } PE(pb + 3); }
    SEAM(pb + 3);
    if (IN(pb + 4)) { PB(pb + 4);
        moe_build_table(lds, gcnt);
        const int rows = __builtin_amdgcn_readfirstlane(((const LAS int*)(lds + MOE_OFF_OFF))[32]);
        pg8::Gemm g{HB, W_GU, rows, 1024, 2048, TL};
        pg8::GroupedOrder S{(const LAS unsigned char*)(lds + MOE_TEXP_OFF), rows >> 8, 4, G, (int)blockIdx.x};
        pg8::EpiSwiGLU E{(bf16*)(ws + WS_ACT), RS};
        pg8::gemm_phase<pg8::EpiSwiGLU, pg8::GroupedOrder, true, true, true>(lds + RING_OFF, g, S, E);
        PE(pb + 4);
    }
    SEAM(pb + 4);
    if (IN(pb + 5)) { PB(pb + 5);
        moe_build_table(lds, gcnt);
        const int rows = __builtin_amdgcn_readfirstlane(((const LAS int*)(lds + MOE_OFF_OFF))[32]);
        pg8::Gemm g{(const bf16*)(ws + WS_ACT), W_DN, rows, 2048, 512};
        pg8::GroupedOrder S{(const LAS unsigned char*)(lds + MOE_TEXP_OFF), rows >> 8, 8, G, (int)blockIdx.x};
        pg8::EpiBf16 E{(bf16*)(ws + WS_Y), 2048};
        pg8::gemm_phase<pg8::EpiBf16, pg8::GroupedOrder, true, true>(lds + RING_OFF, g, S, E);
        PE(pb + 5);
    }
    SEAM(pb + 5);
    if (IN(pb + 6)) { PB(pb + 6);
        moe_combine(out, (const bf16*)(ws + WS_Y), SL0, SL1, TW0, TW1, HN, layer == 0, gw, NGW, lane);
        PE(pb + 6);
    }
    if (layer == 0) SEAM(pb + 6);
    }
    if (IN(13)) { PB(13);
        pg8::Gemm g{HN, W_KVQ, T, KVQ_N, 2048}; OrderCvt<1> S; S.init(T, KVQ_N, G, (int)blockIdx.x); S.gw = gw; S.NGW = NGW; S.lane = lane; S.set_trigger((int)(blockIdx.x % 5));
        pg8::EpiBf16 E{(bf16*)(ws + WS_KVQ), KVQ_N};
        pg8::gemm_phase<pg8::EpiBf16, OrderCvt<1>, true, true>(lds + RING_OFF, g, S, E);
        PE(13);
    }
    SEAM(13);
    if (IN(14)) { PB(14); swa_attention(lds + RING_OFF, (const bf16*)(ws + WS_KVQ), args.in[9], args.in[13], args.in[10], args.in[14], (bf16*)(ws + WS_AO)); PE(14); }
    SEAM(14);
    if (IN(15)) { PB(15);
        pg8::Gemm g{(const bf16*)(ws + WS_AO), W_SWA_OUT, T, 2048, 2048}; pg8::StaticOrder S; S.init(T, 2048, G, (int)blockIdx.x);
        pg8::EpiResF32 E{out, out, 2048, HB, SSP};
        pg8::gemm_phase<pg8::EpiResF32, pg8::StaticOrder, true, true>(lds + RING_OFF, g, S, E);
        PE(15);
    }
    SEAM(15);
    { constexpr int layer = 1; constexpr int pb = 6 + 10 * layer;
    unsigned* gcnt = (unsigned*)(ctl + CW_CNT + layer * 64);
    if (IN(pb + 1)) { PB(pb + 1);
        pg8::Gemm g{HB, W_ROUTER + (size_t)layer * 256 * 2048, T, 256, 2048}; pg8::StaticOrder S; S.init(T, 256, G, (int)blockIdx.x);
        pg8::EpiRouter E{RL};
        pg8::gemm_phase<pg8::EpiRouter, pg8::StaticOrder, true, true>(lds + RING_OFF, g, S, E);
        PE(pb + 1);
    }
    SEAM(pb + 1);
    if (IN(pb + 2)) { PB(pb + 2); moe_route(lds + RING_OFF, RL, SSP, args.in[18] + layer * 4, args.in[20] + layer * 32, gcnt, EP0, EP1, TW0, TW1, RSTD); PE(pb + 2); }
    SEAM(pb + 2);
    if (IN(pb + 3)) { PB(pb + 3); { moe_build_table(lds, gcnt); moe_slots(lds, gcnt, EP0, EP1, RSTD, SL0, SL1, TL, RS); } PE(pb + 3); }
    SEAM(pb + 3);
    if (IN(pb + 4)) { PB(pb + 4);
        moe_build_table(lds, gcnt);
        const int rows = __builtin_amdgcn_readfirstlane(((const LAS int*)(lds + MOE_OFF_OFF))[32]);
        pg8::Gemm g{HB, W_GU, rows, 1024, 2048, TL};
        pg8::GroupedOrder S{(const LAS unsigned char*)(lds + MOE_TEXP_OFF), rows >> 8, 4, G, (int)blockIdx.x};
        pg8::EpiSwiGLU E{(bf16*)(ws + WS_ACT), RS};
        pg8::gemm_phase<pg8::EpiSwiGLU, pg8::GroupedOrder, true, true, true>(lds + RING_OFF, g, S, E);
        PE(pb + 4);
    }
    SEAM(pb + 4);
    if (IN(pb + 5)) { PB(pb + 5);
        moe_build_table(lds, gcnt);
        const int rows = __builtin_amdgcn_readfirstlane(((const LAS int*)(lds + MOE_OFF_OFF))[32]);
        pg8::Gemm g{(const bf16*)(ws + WS_ACT), W_DN, rows, 2048, 512};
        pg8::GroupedOrder S{(const LAS unsigned char*)(lds + MOE_TEXP_OFF), rows >> 8, 8, G, (int)blockIdx.x};
        pg8::EpiBf16 E{(bf16*)(ws + WS_Y), 2048};
        pg8::gemm_phase<pg8::EpiBf16, pg8::GroupedOrder, true, true>(lds + RING_OFF, g, S, E);
        PE(pb + 5);
    }
    SEAM(pb + 5);
    if (IN(pb + 6)) { PB(pb + 6);
        moe_combine(out, (const bf16*)(ws + WS_Y), SL0, SL1, TW0, TW1, HN, layer == 0, gw, NGW, lane);
        PE(pb + 6);
    }
    if (layer == 0) SEAM(pb + 6);
    }
#undef IN
#undef SEAM
}

extern "C" void kernel_launch(void* const* d_in, const int* in_sizes, int n_in, void* d_out, int out_size, void* d_ws, size_t ws_size, hipStream_t stream) {
    static int grid = 0;
    if (grid == 0) {
        if (n_in != 24 || in_sizes[0] != T * D || out_size != T * D || ws_size < WS_END) { fprintf(stderr, "kernel_launch: unexpected shapes / workspace (n_in %d, in0 %d, out %d, ws %zu < %zu)\n", n_in, n_in > 0 ? in_sizes[0] : -1, out_size, ws_size, (size_t)WS_END); grid = -1; return; }
        int dev = 0, cus = 0, per_cu = 0;
        if (hipGetDevice(&dev) != hipSuccess || hipDeviceGetAttribute(&cus, hipDeviceAttributeMultiprocessorCount, dev) != hipSuccess) { grid = -1; return; }
        if (hipFuncSetAttribute((const void*)fwd, hipFuncAttributeMaxDynamicSharedMemorySize, LDS_BYTES) != hipSuccess) { fprintf(stderr, "kernel_launch: hipFuncSetAttribute failed\n"); grid = -1; return; }
        if (hipOccupancyMaxActiveBlocksPerMultiprocessor(&per_cu, (const void*)fwd, NWAVES * 64, LDS_BYTES) != hipSuccess || per_cu < 1) { fprintf(stderr, "kernel_launch: occupancy query says %d\n", per_cu); }
        (void)hipGetLastError();
        grid = cus;
    }
    if (grid < 0) return;
    if (hipMemsetAsync((char*)d_ws + WS_CTL, 0, CTL_ZERO_BYTES, stream) != hipSuccess) return;
    Args a{};
    for (int i = 0; i < 24; ++i) a.in[i] = (const float*)d_in[i];
    a.out = (float*)d_out; a.ws = (unsigned char*)d_ws;
#if MK_PER_PHASE
    for (int p = 0; p < MK_LAST_PHASE; ++p) { a.ph_lo = p; a.ph_hi = p + 1; hipLaunchKernelGGL(fwd, dim3(grid), dim3(NWAVES * 64), LDS_BYTES, stream, a); }
#else
    a.ph_lo = 0; a.ph_hi = MK_LAST_PHASE;
    hipLaunchKernelGGL(fwd, dim3(grid), dim3(NWAVES * 64), LDS_BYTES, stream, a);
#endif
    const hipError_t le = hipPeekAtLastError();
    if (le != hipSuccess) fprintf(stderr, "kernel_launch: launch failed: %s\n", hipGetErrorName(le));
}
```

```cpp
#include <hip/hip_runtime.h>
#include <cstdio>
#include <cstdint>

#ifndef MK_PER_PHASE
#define MK_PER_PHASE 0
#endif
#ifndef MK_LAST_PHASE
#define MK_LAST_PHASE 23
#endif

#ifndef MK_PHASE_MASK
#define MK_PHASE_MASK 0x7fffff
#endif

#ifndef MK_DELAY_MASK
#define MK_DELAY_MASK 0
#endif

namespace pg8 {
#define PG8_LAS __attribute__((address_space(3)))
typedef unsigned short bf16_t;
typedef short bf16x8 __attribute__((ext_vector_type(8)));
typedef float f32x4 __attribute__((ext_vector_type(4)));
typedef unsigned u32x4 __attribute__((ext_vector_type(4)));
constexpr int BM = 256, BK = 64, HALF = 128, HTB = HALF * BK * 2  , STAGE_BYTES = 8 * HTB, NXCD = 8, WGM = 8;

__host__ __device__ __forceinline__ int lds_byte(int r, int c) { const int st = (r >> 4) * 2 + (c >> 5), rr = r & 15, cc = c & 31, ob = rr * 64 + cc * 2; return st * 1024 + (ob ^ (((ob >> 9) & 1) << 5)); }
__host__ __device__ __forceinline__ void stage_rc(int b, int& R, int& C) { const int st = b / 1024, sb = b % 1024, swz = sb ^ (((sb >> 9) & 1) << 5); R = (st >> 1) * 16 + swz / 64; C = (st & 1) * 32 + (swz % 64) / 2; }
__host__ __device__ __forceinline__ int perm32(int rho) { const int n = rho >> 4, i = rho & 15; return 8 * (i >> 2) + 4 * n + (i & 3); }

struct Unit { int pm, pn, pc; };
struct Gemm { const bf16_t* A; const bf16_t* Bt; int M, N, K; const unsigned* rowidx; };


struct StaticOrder {
    int nM, nN, nwg, G, c;
    __host__ __device__ void init(int M, int N, int G_, int c_) { nM = M / BM; nN = N / BM; nwg = nM * nN; G = G_; c = c_; }
    __host__ __device__ bool next(int i, Unit& u) const {
        const long L = (long)i * G + c; if (L >= nwg) return false;
        int wgid = (int)L; { const int q = nwg / NXCD, r = nwg % NXCD, xcd = wgid % NXCD, off = wgid / NXCD; wgid = (xcd < r ? xcd * (q + 1) : r * (q + 1) + (xcd - r) * q) + off; }
        const int nig = WGM * nN, gid = wgid / nig, fm = gid * WGM, gsz = (nM - fm) < WGM ? (nM - fm) : WGM;
        u.pm = fm + ((wgid % nig) % gsz); u.pn = (wgid % nig) / gsz; u.pc = u.pn; return true;
    }
    __device__ __forceinline__ void a_ready(const Unit&) const {}
    __device__ __forceinline__ void done(const Unit&) const {}
};
struct GroupedOrder {
    const PG8_LAS unsigned char* texp; int MT, npn, G, c;
    __device__ __forceinline__ bool next(int i, Unit& u) const {
        const long L = (long)i * G + c; if (L >= (long)MT * npn) return false;
        const int pm = (int)(L / npn), pc = (int)(L % npn);
        const int e = __builtin_amdgcn_readfirstlane((int)texp[pm]);
        u.pm = pm; u.pn = e * npn + pc; u.pc = pc; return true;
    }
    __device__ __forceinline__ void a_ready(const Unit&) const {}
    __device__ __forceinline__ void done(const Unit&) const {}
};

__device__ __forceinline__ unsigned cvt_pk_bf16(float lo, float hi) { unsigned r; asm volatile("v_cvt_pk_bf16_f32 %0, %1, %2" : "=v"(r) : "v"(lo), "v"(hi)); return r; }

struct EpiBf16 {
    static constexpr bool PERM = true, AFTER_DRAIN = false;
    bf16_t* O; int ldc;
    __device__ __forceinline__ void operator()(const f32x4 (&acc)[2][2][4][2], const Unit& u, int wr, int wc, int fr, int fq) const {
        const int row0 = u.pm * BM + wr * 64 + fr, col0 = u.pc * BM + wc * 32 + 8 * fq;
#pragma unroll
        for (int ai = 0; ai < 2; ++ai)
#pragma unroll
            for (int m = 0; m < 4; ++m) { bf16_t* rowp = O + (size_t)(row0 + ai * HALF + m * 16) * ldc + col0;
#pragma unroll
                for (int bj = 0; bj < 2; ++bj) { const f32x4 v0 = acc[ai][bj][m][0], v1 = acc[ai][bj][m][1];
                    u32x4 w; w.x = cvt_pk_bf16(v0[0], v0[1]); w.y = cvt_pk_bf16(v0[2], v0[3]); w.z = cvt_pk_bf16(v1[0], v1[1]); w.w = cvt_pk_bf16(v1[2], v1[3]);
                    *(u32x4*)(rowp + bj * HALF) = w; } }
    }
};
struct EpiKVQ {
    static constexpr bool PERM = true, AFTER_DRAIN = false;
    bf16_t* O; bf16_t* VT;
    __device__ __forceinline__ void operator()(const f32x4 (&acc)[2][2][4][2], const Unit& u, int wr, int wc, int fr, int fq) const {
        const int row0 = u.pm * BM + wr * 64 + fr;
        if (u.pc == 1) {
#pragma unroll
            for (int ai = 0; ai < 2; ++ai)
#pragma unroll
                for (int m = 0; m < 4; ++m) { const int t = row0 + ai * HALF + m * 16, b = t >> 14, s = t & 16383;
#pragma unroll
                    for (int bj = 0; bj < 2; ++bj)
#pragma unroll
                        for (int n = 0; n < 2; ++n) { const int cv = bj * HALF + wc * 32 + 8 * fq + 4 * n; bf16_t* p = VT + ((size_t)(b * 4 + (cv >> 6)) * 64 + (cv & 63)) * 16384 + s;
                            const unsigned w0 = cvt_pk_bf16(acc[ai][bj][m][n][0], acc[ai][bj][m][n][1]), w1 = cvt_pk_bf16(acc[ai][bj][m][n][2], acc[ai][bj][m][n][3]);
                            p[0] = (bf16_t)(w0 & 0xffffu); p[16384] = (bf16_t)(w0 >> 16); p[2 * 16384] = (bf16_t)(w1 & 0xffffu); p[3 * 16384] = (bf16_t)(w1 >> 16); } }
            return; }
        const int col0 = u.pc * BM + wc * 32 + 8 * fq;
#pragma unroll
        for (int ai = 0; ai < 2; ++ai)
#pragma unroll
            for (int m = 0; m < 4; ++m) { bf16_t* rowp = O + (size_t)(row0 + ai * HALF + m * 16) * 2560 + col0;
#pragma unroll
                for (int bj = 0; bj < 2; ++bj) { const f32x4 v0 = acc[ai][bj][m][0], v1 = acc[ai][bj][m][1];
                    u32x4 w; w.x = cvt_pk_bf16(v0[0], v0[1]); w.y = cvt_pk_bf16(v0[2], v0[3]); w.z = cvt_pk_bf16(v1[0], v1[1]); w.w = cvt_pk_bf16(v1[2], v1[3]);
                    *(u32x4*)(rowp + bj * HALF) = w; } }
    }
};
struct EpiGlaProj {
    static constexpr bool PERM = true, AFTER_DRAIN = false;
    bf16_t *QK, *V, *R, *GL;
    __device__ __forceinline__ void operator()(const f32x4 (&acc)[2][2][4][2], const Unit& u, int wr, int wc, int fr, int fq) const {
        bf16_t* base; int ldc, ct;
        if (u.pc < 8) { base = QK; ldc = 2048; ct = u.pc; } else if (u.pc < 16) { base = V; ldc = 2048; ct = u.pc - 8; } else if (u.pc < 24) { base = R; ldc = 2048; ct = u.pc - 16; } else { base = GL; ldc = 256; ct = 0; }
        const int row0 = u.pm * BM + wr * 64 + fr, col0 = ct * BM + wc * 32 + 8 * fq;
#pragma unroll
        for (int ai = 0; ai < 2; ++ai)
#pragma unroll
            for (int m = 0; m < 4; ++m) { bf16_t* rowp = base + (size_t)(row0 + ai * HALF + m * 16) * ldc + col0;
#pragma unroll
                for (int bj = 0; bj < 2; ++bj) { const f32x4 v0 = acc[ai][bj][m][0], v1 = acc[ai][bj][m][1];
                    u32x4 w; w.x = cvt_pk_bf16(v0[0], v0[1]); w.y = cvt_pk_bf16(v0[2], v0[3]); w.z = cvt_pk_bf16(v1[0], v1[1]); w.w = cvt_pk_bf16(v1[2], v1[3]);
                    *(u32x4*)(rowp + bj * HALF) = w; } }
    }
};
struct EpiResF32 {
    static constexpr bool PERM = true, AFTER_DRAIN = false;
    float* C; const float* RES; int ldc; bf16_t* HB; float* SSP;
    __device__ __forceinline__ void operator()(const f32x4 (&acc)[2][2][4][2], const Unit& u, int wr, int wc, int fr, int fq) const {
        const int row0 = u.pm * BM + wr * 64 + fr, col0 = u.pc * BM + wc * 32 + 8 * fq;
#pragma unroll
        for (int ai = 0; ai < 2; ++ai)
#pragma unroll
            for (int m = 0; m < 4; ++m) { const int row = row0 + ai * HALF + m * 16; const size_t off = (size_t)row * ldc + col0;
                f32x4 rv[2][2];
#pragma unroll
                for (int bj = 0; bj < 2; ++bj)
#pragma unroll
                    for (int n = 0; n < 2; ++n) rv[bj][n] = *(const f32x4*)(RES + off + bj * HALF + n * 4);
                float ss = 0.f;
#pragma unroll
                for (int bj = 0; bj < 2; ++bj) { const f32x4 v0 = acc[ai][bj][m][0] + rv[bj][0], v1 = acc[ai][bj][m][1] + rv[bj][1];
                    *(f32x4*)(C + off + bj * HALF) = v0; *(f32x4*)(C + off + bj * HALF + 4) = v1;
                    u32x4 w; w.x = cvt_pk_bf16(v0[0], v0[1]); w.y = cvt_pk_bf16(v0[2], v0[3]); w.z = cvt_pk_bf16(v1[0], v1[1]); w.w = cvt_pk_bf16(v1[2], v1[3]);
                    *(u32x4*)(HB + off + bj * HALF) = w;
                    ss += (v0[0] * v0[0] + v0[1] * v0[1]) + (v0[2] * v0[2] + v0[3] * v0[3]) + (v1[0] * v1[0] + v1[1] * v1[1]) + (v1[2] * v1[2] + v1[3] * v1[3]); }
                ss += __shfl_xor(ss, 16); ss += __shfl_xor(ss, 32);
                if (fq == 0) SSP[(size_t)row * 32 + u.pc * 4 + wc] = ss; }
    }
};
struct EpiRouter {
    static constexpr bool PERM = false, AFTER_DRAIN = false;
    float* RL;
    __device__ __forceinline__ void operator()(const f32x4 (&acc)[2][2][4][2], const Unit& u, int wr, int wc, int fr, int fq) const {
        if (wc >= 2) return;
        const int row0 = u.pm * BM + wr * 64 + fr, col0 = wc * 32 + 4 * fq;
#pragma unroll
        for (int ai = 0; ai < 2; ++ai)
#pragma unroll
            for (int m = 0; m < 4; ++m) { float* rowp = RL + (size_t)(row0 + ai * HALF + m * 16) * 64 + col0;
#pragma unroll
                for (int n = 0; n < 2; ++n) *(f32x4*)(rowp + n * 16) = acc[ai][0][m][n]; }
    }
};
__device__ __forceinline__ float silu_f(float x) { return x * __builtin_amdgcn_rcpf(1.0f + __expf(-x)); }
struct EpiSwiGLU {
    static constexpr bool PERM = true, AFTER_DRAIN = false;
    bf16_t* ACT; const float* RS;
    __device__ __forceinline__ void operator()(const f32x4 (&acc)[2][2][4][2], const Unit& u, int wr, int wc, int fr, int fq) const {
        const int row0 = u.pm * BM + wr * 64 + fr, col0 = u.pc * HALF + wc * 32 + 8 * fq;
#pragma unroll
        for (int ai = 0; ai < 2; ++ai)
#pragma unroll
            for (int m = 0; m < 4; ++m) { const int row = row0 + ai * HALF + m * 16; bf16_t* rowp = ACT + (size_t)row * 512 + col0; const float rs = RS[row];
                const f32x4 g0 = acc[ai][0][m][0] * rs, g1 = acc[ai][0][m][1] * rs, u0 = acc[ai][1][m][0] * rs, u1 = acc[ai][1][m][1] * rs;
                u32x4 w;
                w.x = cvt_pk_bf16(silu_f(g0[0]) * u0[0], silu_f(g0[1]) * u0[1]); w.y = cvt_pk_bf16(silu_f(g0[2]) * u0[2], silu_f(g0[3]) * u0[3]);
                w.z = cvt_pk_bf16(silu_f(g1[0]) * u1[0], silu_f(g1[1]) * u1[1]); w.w = cvt_pk_bf16(silu_f(g1[2]) * u1[2], silu_f(g1[3]) * u1[3]);
                *(u32x4*)rowp = w; }
    }
};

template <class Epi, class Sched, bool ALIGN_EPI = false, bool SP2 = false, bool GATHER = false>
__device__ __forceinline__ void gemm_phase(PG8_LAS unsigned char* lds, const Gemm g, const Sched& S, const Epi& E) {
    const int tid = threadIdx.x, wid = __builtin_amdgcn_readfirstlane(tid >> 6), lane = tid & 63, wr = wid >> 2, wc = wid & 3, fr = lane & 15, fq = lane >> 4;
    const int K = g.K, nt = K / BK;
    unsigned voffA[2], voffB[2];
#pragma unroll
    for (int i = 0; i < 2; ++i) { int R, C; stage_rc(tid * 16 + i * 8192, R, C); const int Rb = Epi::PERM ? ((R & ~31) + perm32(R & 31)) : R;
        voffA[i] = (unsigned)(R * K + C) * 2u; voffB[i] = (unsigned)(Rb * K + C) * 2u; }
    unsigned vA[2][2] = {{0u, 0u}, {0u, 0u}}, vAn[2][2] = {{0u, 0u}, {0u, 0u}}; int rA[2] = {0, 0}; unsigned cbA[2] = {0u, 0u};
    if constexpr (GATHER) {
#pragma unroll
        for (int i = 0; i < 2; ++i) { int R, C; stage_rc(tid * 16 + i * 8192, R, C); rA[i] = R; cbA[i] = (unsigned)C * 2u; } }
#define PG8_GIDX(dst, pmv) do { _Pragma("unroll") for (int _h = 0; _h < 2; ++_h) _Pragma("unroll") for (int _i = 0; _i < 2; ++_i) \
        dst[_h][_i] = g.rowidx[(size_t)(pmv) * BM + _h * HALF + rA[_i]] * (unsigned)(K * 2) + cbA[_i]; } while (0)
    const size_t kstep = (size_t)(BK * 2);
    const size_t hstep = (size_t)HALF * K * 2;
    const size_t tstep = 2 * hstep;
    const unsigned ldsw = (unsigned)wid * 1024u;
    const int aoff = lds_byte(wr * 64 + fr, fq * 8), boff = lds_byte(wc * 32 + fr, fq * 8);
#define PG8_SA(b, h) (((b) * 2 + (h)) * HTB)
#define PG8_SB(b, h) ((4 + (b) * 2 + (h)) * HTB)
#define PG8_STAGE(bufoff, gbase, voff) do { _Pragma("unroll") for (int _i = 0; _i < 2; ++_i) \
        __builtin_amdgcn_global_load_lds((const unsigned*)((const char*)(gbase) + (voff)[_i]), (PG8_LAS unsigned*)(lds + (bufoff) + ldsw + _i * 8192), 16, 0, 0); } while (0)
#define PG8_STAGE_A(bufoff, nx, kb, h) do { if constexpr (GATHER) { const char* _b = (const char*)g.A + (kb); \
        _Pragma("unroll") for (int _i = 0; _i < 2; ++_i) { const unsigned _v = (nx) ? vAn[h][_i] : vA[h][_i]; \
            __builtin_amdgcn_global_load_lds((const unsigned*)(_b + _v), (PG8_LAS unsigned*)(lds + (bufoff) + ldsw + _i * 8192), 16, 0, 0); } } \
    else { const char* _b = ((nx) ? nA : cA) + (kb) + (size_t)(h) * hstep; PG8_STAGE(bufoff, _b, voffA); } } while (0)
#define PG8_LDA(dst, b, h) do { _Pragma("unroll") for (int m = 0; m < 4; ++m) _Pragma("unroll") for (int k = 0; k < 2; ++k) dst[m][k] = *(const PG8_LAS bf16x8*)(lds + PG8_SA(b, h) + aoff + m * 2048 + k * 1024); } while (0)
#define PG8_LDB(dst, b, h) do { _Pragma("unroll") for (int n = 0; n < 2; ++n) _Pragma("unroll") for (int k = 0; k < 2; ++k) dst[n][k] = *(const PG8_LAS bf16x8*)(lds + PG8_SB(b, h) + boff + n * 2048 + k * 1024); } while (0)
#define PG8_MMA(ai, bj, At, Bt) do { __builtin_amdgcn_s_setprio(1); _Pragma("unroll") for (int m = 0; m < 4; ++m) _Pragma("unroll") for (int n = 0; n < 2; ++n) _Pragma("unroll") for (int k = 0; k < 2; ++k) \
        acc[ai][bj][m][n] = __builtin_amdgcn_mfma_f32_16x16x32_bf16(Bt[n][k], At[m][k], acc[ai][bj][m][n], 0, 0, 0); __builtin_amdgcn_s_setprio(0); } while (0)
#define PG8_WAIT_V(n) asm volatile("s_waitcnt vmcnt(" #n ")" ::: "memory")
#define PG8_WAIT_L(n) asm volatile("s_waitcnt lgkmcnt(" #n ")" ::: "memory")
#define PG8_BAR __builtin_amdgcn_s_barrier()
#define PG8_SCHED __builtin_amdgcn_sched_barrier(0)
    Unit cur, nxt; int ui = 0;
    if (!S.next(0, cur)) return;
    f32x4 acc[2][2][4][2];
#pragma unroll
    for (int a = 0; a < 2; ++a)
#pragma unroll
        for (int b = 0; b < 2; ++b)
#pragma unroll
            for (int m = 0; m < 4; ++m)
#pragma unroll
                for (int n = 0; n < 2; ++n) acc[a][b][m][n] = (f32x4){0.f, 0.f, 0.f, 0.f};
    bf16x8 At[4][2], B0[2][2], B1[2][2];
    const char* cA = (const char*)g.A + (size_t)cur.pm * tstep; const char* cB = (const char*)g.Bt + (size_t)cur.pn * tstep;
    const char* nA = cA; const char* nB = cB;
    if constexpr (GATHER) { PG8_GIDX(vA, cur.pm); }
    S.a_ready(cur);
    if constexpr (SP2) {
        PG8_STAGE(PG8_SB(0, 0), cB, voffB); PG8_STAGE(PG8_SB(0, 1), cB + hstep, voffB); PG8_STAGE_A(PG8_SA(0, 0), false, 0, 0); PG8_STAGE_A(PG8_SA(0, 1), false, 0, 1);
        if (wr == 1) PG8_BAR;
        PG8_WAIT_V(2); PG8_BAR;
        PG8_STAGE(PG8_SB(1, 0), cB + kstep, voffB); PG8_STAGE_A(PG8_SA(1, 0), false, kstep, 0); PG8_STAGE(PG8_SB(1, 1), cB + hstep + kstep, voffB);
        PG8_WAIT_V(6); PG8_BAR;
    } else {
        PG8_STAGE(PG8_SB(0, 0), cB, voffB); PG8_STAGE(PG8_SA(0, 0), cA, voffA); PG8_STAGE(PG8_SB(0, 1), cB + hstep, voffB); PG8_STAGE(PG8_SA(0, 1), cA + hstep, voffA);
        if (wr == 1) PG8_BAR;
        PG8_WAIT_V(4); PG8_BAR;
        PG8_STAGE(PG8_SB(1, 0), cB + kstep, voffB); PG8_STAGE(PG8_SA(1, 0), cA + kstep, voffA); PG8_STAGE(PG8_SB(1, 1), cB + hstep + kstep, voffB);
        PG8_WAIT_V(6); PG8_BAR;
    }
    for (;;) {
        const bool has_next = S.next(ui + 1, nxt);
        nA = has_next ? (const char*)g.A + (size_t)nxt.pm * tstep : cA; nB = has_next ? (const char*)g.Bt + (size_t)nxt.pn * tstep : cB;
        if constexpr (GATHER) { if (has_next) { PG8_GIDX(vAn, nxt.pm); } else {
#pragma unroll
            for (int _h = 0; _h < 2; ++_h) { vAn[_h][0] = vA[_h][0]; vAn[_h][1] = vA[_h][1]; } } }
        for (int t = 0; t < nt; t += 2) {
            const bool last = (t == nt - 2);
            const char* a1 = cA + (size_t)(t + 1) * kstep;
            const char* a2 = last ? nA : cA + (size_t)(t + 2) * kstep; const char* b2 = last ? nB : cB + (size_t)(t + 2) * kstep;
            const char* a3 = a2 + kstep; const char* b3 = b2 + kstep;
            const size_t ka1 = (size_t)(t + 1) * kstep, ka2 = last ? (size_t)0 : (size_t)(t + 2) * kstep, ka3 = ka2 + kstep; (void)a1; (void)a3;
            if (last && has_next) S.a_ready(nxt);
            if constexpr (SP2) {
            PG8_LDB(B0, 0, 0); PG8_LDB(B1, 0, 1); PG8_SCHED; PG8_LDA(At, 0, 0); PG8_STAGE_A(PG8_SA(1, 1), false, ka1, 1);
            PG8_WAIT_V(8); PG8_WAIT_L(0); PG8_BAR; PG8_MMA(0, 0, At, B0); PG8_MMA(0, 1, At, B1); PG8_BAR; PG8_SCHED;
            PG8_LDA(At, 0, 1); PG8_STAGE(PG8_SB(0, 0), b2, voffB); PG8_STAGE(PG8_SB(0, 1), b2 + hstep, voffB); PG8_STAGE_A(PG8_SA(0, 0), last, ka2, 0);
            PG8_WAIT_V(8); PG8_WAIT_L(0); PG8_BAR; PG8_MMA(1, 0, At, B0); PG8_MMA(1, 1, At, B1); PG8_BAR; PG8_SCHED;
            PG8_LDB(B0, 1, 0); PG8_LDB(B1, 1, 1); PG8_SCHED; PG8_LDA(At, 1, 0); PG8_STAGE_A(PG8_SA(0, 1), last, ka2, 1);
            PG8_WAIT_V(8); PG8_WAIT_L(0); PG8_BAR; PG8_MMA(0, 0, At, B0); PG8_MMA(0, 1, At, B1); PG8_BAR; PG8_SCHED;
            PG8_LDA(At, 1, 1); PG8_STAGE(PG8_SB(1, 0), b3, voffB); PG8_STAGE(PG8_SB(1, 1), b3 + hstep, voffB); PG8_STAGE_A(PG8_SA(1, 0), last, ka3, 0);
            PG8_WAIT_V(8); PG8_WAIT_L(0); PG8_BAR; PG8_MMA(1, 0, At, B0); PG8_MMA(1, 1, At, B1); PG8_BAR; PG8_SCHED;
            } else {
            PG8_LDB(B0, 0, 0); PG8_SCHED; PG8_LDA(At, 0, 0); PG8_STAGE(PG8_SA(1, 1), a1 + hstep, voffA);
            PG8_WAIT_L(8); PG8_BAR; PG8_WAIT_L(0); PG8_MMA(0, 0, At, B0); PG8_BAR; PG8_SCHED;
            PG8_LDB(B1, 0, 1); PG8_STAGE(PG8_SB(0, 0), b2, voffB);
            PG8_BAR; PG8_WAIT_L(0); PG8_MMA(0, 1, At, B1); PG8_BAR;
            PG8_LDA(At, 0, 1); PG8_STAGE(PG8_SA(0, 0), a2, voffA);
            PG8_BAR; PG8_WAIT_L(0); PG8_MMA(1, 0, At, B0); PG8_BAR; PG8_SCHED;
            PG8_STAGE(PG8_SB(0, 1), b2 + hstep, voffB);
            PG8_WAIT_V(6); PG8_BAR; PG8_MMA(1, 1, At, B1); PG8_BAR;
            PG8_LDB(B0, 1, 0); PG8_SCHED; PG8_LDA(At, 1, 0); PG8_STAGE(PG8_SA(0, 1), a2 + hstep, voffA);
            PG8_WAIT_L(8); PG8_BAR; PG8_WAIT_L(0); PG8_MMA(0, 0, At, B0); PG8_BAR; PG8_SCHED;
            PG8_LDB(B1, 1, 1); PG8_STAGE(PG8_SB(1, 0), b3, voffB);
            PG8_BAR; PG8_WAIT_L(0); PG8_MMA(0, 1, At, B1); PG8_BAR;
            PG8_LDA(At, 1, 1); PG8_STAGE(PG8_SA(1, 0), a3, voffA);
            PG8_BAR; PG8_WAIT_L(0); PG8_MMA(1, 0, At, B0); PG8_BAR; PG8_SCHED;
            PG8_STAGE(PG8_SB(1, 1), b3 + hstep, voffB);
            PG8_WAIT_V(6); PG8_BAR; PG8_MMA(1, 1, At, B1); PG8_BAR;
            }
        }
        if constexpr (ALIGN_EPI) { if (wr == 0) PG8_BAR; }
        if constexpr (!Epi::AFTER_DRAIN) { E(acc, cur, wr, wc, fr, fq); S.done(cur); }
        if (!has_next) break;
#pragma unroll
        for (int a = 0; a < 2; ++a)
#pragma unroll
            for (int b = 0; b < 2; ++b)
#pragma unroll
                for (int m = 0; m < 4; ++m)
#pragma unroll
                    for (int n = 0; n < 2; ++n) acc[a][b][m][n] = (f32x4){0.f, 0.f, 0.f, 0.f};
        cur = nxt; cA = nA; cB = nB; ++ui;
        if constexpr (GATHER) {
#pragma unroll
            for (int _h = 0; _h < 2; ++_h) { vA[_h][0] = vAn[_h][0]; vA[_h][1] = vAn[_h][1]; } }
        if constexpr (ALIGN_EPI) { if (wr == 1) PG8_BAR; }
    }
    PG8_WAIT_V(0);
    if constexpr (!ALIGN_EPI) { if (wr == 0) PG8_BAR; }
    PG8_BAR;
    if constexpr (Epi::AFTER_DRAIN) { E.fused(acc, cur, wr, wc, fr, fq, lds, wid, lane); S.done(cur); }
#undef PG8_SA
#undef PG8_STAGE_A
#undef PG8_GIDX
#undef PG8_SB
#undef PG8_STAGE
#undef PG8_LDA
#undef PG8_LDB
#undef PG8_MMA
#undef PG8_WAIT_V
#undef PG8_WAIT_L
#undef PG8_BAR
#undef PG8_SCHED
}
}

constexpr int NWAVES = 8;
constexpr int T = 32768, D = 2048, SEQ = 16384;
constexpr float RMS_EPS = 1e-6f;
constexpr int GLA_H = 4, GLA_DK = 256, GLA_DV = 512, GLA_C = 64, GLA_NCH = SEQ / GLA_C  , GLA_PROJ_N = 6160, GLA_PROJ_NP = 6400;
constexpr int NITEM_GLA = 2 * GLA_H * GLA_NCH;
constexpr int SWA_HQ = 32, SWA_HKV = 4, SWA_HD = 64, SWA_W = 128, KVQ_N = 2560;
constexpr int NE = 32, FF = 512, MOE_MAXROWS = 2 * T + NE * 256;

constexpr size_t MiB = 1u << 20;
constexpr size_t WS_CTL = 0, CTL_ZERO_BYTES = 1 * MiB;
constexpr size_t WS_W_GLA_IN = 1 * MiB;
constexpr size_t WS_W_GLA_OUT = 26 * MiB;
constexpr size_t WS_W_KVQ = 34 * MiB;
constexpr size_t WS_W_SWA_OUT = 44 * MiB;
constexpr size_t WS_W_ROUTER = 52 * MiB;
constexpr size_t WS_TOK = 54 * MiB;
constexpr size_t WS_RL = 56 * MiB;
constexpr size_t WS_W_GU = 64 * MiB;
constexpr size_t WS_W_DN = 192 * MiB;
constexpr size_t WS_HN = 256 * MiB;
constexpr size_t WS_BIG = 384 * MiB;
constexpr size_t WS_QK = WS_BIG;
constexpr size_t WS_V = WS_BIG + 128 * MiB;
constexpr size_t WS_R = WS_BIG + 256 * MiB;
constexpr size_t WS_GL = WS_BIG + 384 * MiB;
constexpr size_t WS_QEF = WS_BIG + 400 * MiB;
constexpr size_t WS_KLTF = WS_BIG + 464 * MiB;
constexpr size_t WS_ATTF = WS_BIG + 528 * MiB;
constexpr size_t WS_VTF = WS_BIG + 544 * MiB;
constexpr size_t WS_DEC = WS_BIG + 672 * MiB;
constexpr size_t WS_SEND = WS_V;
constexpr size_t WS_DTOT = WS_V + 32 * MiB;
constexpr size_t WS_GLA_END = WS_BIG + 674 * MiB;
constexpr size_t WS_SSP = WS_BIG;
constexpr size_t WS_TL = WS_BIG + 8 * MiB;
constexpr size_t WS_RS = WS_BIG + 9 * MiB;
constexpr size_t WS_HB = WS_BIG + 16 * MiB;
constexpr size_t WS_ACT = WS_BIG + 288 * MiB;
constexpr size_t WS_Y = WS_BIG + 360 * MiB;
constexpr size_t WS_KVQ = WS_BIG;
constexpr size_t WS_AO = WS_BIG + 160 * MiB;
constexpr size_t WS_VT = WS_BIG + 288 * MiB;
constexpr size_t WS_END = WS_GLA_END;
static_assert(WS_Y + (size_t)MOE_MAXROWS * 2048 * 2 <= WS_END && WS_ACT + (size_t)MOE_MAXROWS * 512 * 2 <= WS_Y, "MoE map");
constexpr int CW_BAR = 4096;
constexpr int CW_CNT = 16384;

constexpr int RING_OFF = 0, RING_BYTES = 149504;
constexpr int LDSCTL_OFF = RING_BYTES;
constexpr int MISC_OFF = LDSCTL_OFF + 64;
constexpr int MOE_OFF_OFF = LDSCTL_OFF + 256;
constexpr int MOE_TEXP_OFF = LDSCTL_OFF + 512;
constexpr int LDS_BYTES = RING_BYTES + 2048;

#define GAS __attribute__((address_space(1)))
#define LAS __attribute__((address_space(3)))
typedef unsigned short bf16;
typedef unsigned v4u __attribute__((ext_vector_type(4)));
typedef unsigned v2u __attribute__((ext_vector_type(2)));
typedef float f32x4 __attribute__((ext_vector_type(4)));
typedef short bf16x8 __attribute__((ext_vector_type(8)));
typedef GAS unsigned gu32;
#define RLX_AGENT __ATOMIC_RELAXED, __HIP_MEMORY_SCOPE_AGENT
#define LDS_WAIT() asm volatile("s_waitcnt lgkmcnt(0)" ::: "memory")
#define VM_WAIT() asm volatile("s_waitcnt vmcnt(0)" ::: "memory")
__device__ __forceinline__ unsigned f2bf(float f) { unsigned u = __builtin_bit_cast(unsigned, f); return (u + 0x7fffu + ((u >> 16) & 1u)) >> 16; }
__device__ __forceinline__ unsigned pk2(float lo, float hi) { return pg8::cvt_pk_bf16(lo, hi); }
__device__ __forceinline__ float bf_lo(unsigned w) { return __builtin_bit_cast(float, w << 16); }
__device__ __forceinline__ float bf_hi(unsigned w) { return __builtin_bit_cast(float, w & 0xffff0000u); }
__device__ __forceinline__ float bf2f(bf16 b) { return __builtin_bit_cast(float, ((unsigned)b) << 16); }
__device__ __forceinline__ float wave_sum(float v) {
#pragma unroll
    for (int o = 1; o < 64; o <<= 1) v += __shfl_xor(v, o);
    return v;
}

#define XB_TMO      128
#define XB_XCNT(j)  (256  + 64 * (j))
#define XB_XSUB(j)  (1280 + 64 * (j))
#define XB_XGEN(j)  (2304 + 64 * (j))
#define XB_TOP      3328
#define XB_TOPGEN   3392
#define XCD_BAR_WORDS 3456
#define XB_SPIN_CAP (1u << 18)

__device__ __forceinline__ unsigned xb_ld(unsigned* p)              { return __hip_atomic_load(p, __ATOMIC_RELAXED, __HIP_MEMORY_SCOPE_AGENT); }
__device__ __forceinline__ unsigned xb_add(unsigned* p, unsigned v) { return __hip_atomic_fetch_add(p, v, __ATOMIC_RELAXED, __HIP_MEMORY_SCOPE_AGENT); }
__device__ __forceinline__ unsigned xb_xcc_id() { return (unsigned)__builtin_amdgcn_s_getreg((3 << 11) | 20) & 0xFu; }
#define XB_SPIN(cond, bar) do { unsigned _sp = 0; while (cond) { __builtin_amdgcn_s_sleep(1); \
    if ((++_sp & 255u) == 0u) { if (xb_ld(&(bar)[XB_TMO])) break; if (_sp > XB_SPIN_CAP) { atomicAdd(&(bar)[XB_TMO], 1u); break; } } } } while (0)

struct XcdBarrier {
    unsigned* bar; unsigned x;
    volatile LAS unsigned* st;
};

__device__ __forceinline__ XcdBarrier xcd_barrier_post(unsigned* bar, volatile LAS unsigned* st) {
    XcdBarrier b; b.bar = bar; b.x = xb_xcc_id(); b.st = st;
    if (threadIdx.x == 0) (void)xb_add(&bar[XB_XCNT(b.x)], 1u);
    return b;
}
__device__ __forceinline__ void xcd_barrier_complete(unsigned* bar, unsigned x, unsigned& nloc, unsigned& nx) {
    const unsigned G = gridDim.x * gridDim.y * gridDim.z;
    unsigned sum, cnt, mine, sp = 0u;
    for (;;) {
        sum = 0u; cnt = 0u; mine = 0u;
#pragma unroll
        for (unsigned j = 0; j < 16; ++j) { const unsigned c = xb_ld(&bar[XB_XCNT(j)]); sum += c; cnt += (c > 0u) ? 1u : 0u; mine = (j == x) ? c : mine; }
        if (sum == G) break;
        __builtin_amdgcn_s_sleep(1);
        if ((++sp & 255u) == 0u) { if (xb_ld(&bar[XB_TMO])) break; if (sp > XB_SPIN_CAP) { atomicAdd(&bar[XB_TMO], 1u); break; } }
    }
    nloc = mine > 0u ? mine : 1u; nx = cnt > 0u ? cnt : 1u;
}

__device__ __forceinline__ void xcd_barrier(const XcdBarrier& b) {
    asm volatile("s_waitcnt vmcnt(0)" ::: "memory");
    __syncthreads();
    if (threadIdx.x == 0) {
        unsigned* bar = b.bar;
        __builtin_amdgcn_s_waitcnt(0);
        unsigned nloc = b.st[0], nx = b.st[1];
        if (nloc == 0u) { xcd_barrier_complete(bar, b.x, nloc, nx); b.st[0] = nloc; b.st[1] = nx; }
        const unsigned old = xb_add(&bar[XB_XSUB(b.x)], 1u);
        const unsigned gen = old / nloc;
        if (old + 1u == (gen + 1u) * nloc) {
            __builtin_amdgcn_fence(__ATOMIC_RELEASE, "agent");
            asm volatile("s_waitcnt vmcnt(0)" ::: "memory");
            const unsigned og = xb_add(&bar[XB_TOP], 1u);
            const unsigned tg = og / nx;
            if (og + 1u == (tg + 1u) * nx) xb_add(&bar[XB_TOPGEN], 1u);
            else XB_SPIN(xb_ld(&bar[XB_TOPGEN]) == tg, bar);
            __builtin_amdgcn_fence(__ATOMIC_ACQUIRE, "agent");
            xb_add(&bar[XB_XGEN(b.x)], 1u);
            asm volatile("s_waitcnt vmcnt(0)" ::: "memory");
        } else {
            XB_SPIN(xb_ld(&bar[XB_XGEN(b.x)]) == gen, bar);
            __builtin_amdgcn_fence(__ATOMIC_ACQUIRE, "agent");
            asm volatile("s_waitcnt vmcnt(0)" ::: "memory");
        }
    }
    __syncthreads();
}


__device__ __forceinline__ void cvt_item(const float* W, int N, const float* gain, bf16* WT, int K, int k0, int n0, size_t dst_row0, int lane) {
    const int q = lane >> 4, c = lane & 15;
    const bool ok = (n0 + 4 * c) < N;
    const GAS f32x4* src = (const GAS f32x4*)(W + (size_t)(k0 + 16 * q) * N + n0 + 4 * c);
    f32x4 v[16];
#pragma unroll
    for (int i = 0; i < 16; ++i) v[i] = ok ? src[(size_t)i * (N / 4)] : (f32x4){0.f, 0.f, 0.f, 0.f};
    if (gain) { const GAS f32x4* gp = (const GAS f32x4*)(gain + k0 + 16 * q);
#pragma unroll
        for (int i4 = 0; i4 < 4; ++i4) { const f32x4 g = gp[i4]; v[4 * i4 + 0] = v[4 * i4 + 0] * g.x; v[4 * i4 + 1] = v[4 * i4 + 1] * g.y; v[4 * i4 + 2] = v[4 * i4 + 2] * g.z; v[4 * i4 + 3] = v[4 * i4 + 3] * g.w; } }
    if (ok) {
#pragma unroll
        for (int e = 0; e < 4; ++e) { bf16* dst = WT + (dst_row0 + 4 * c + e) * (size_t)K + k0 + 16 * q;
            v4u o0, o1;
            o0.x = pk2(v[0][e], v[1][e]); o0.y = pk2(v[2][e], v[3][e]); o0.z = pk2(v[4][e], v[5][e]); o0.w = pk2(v[6][e], v[7][e]);
            o1.x = pk2(v[8][e], v[9][e]); o1.y = pk2(v[10][e], v[11][e]); o1.z = pk2(v[12][e], v[13][e]); o1.w = pk2(v[14][e], v[15][e]);
            *(GAS v4u*)dst = o0; *(GAS v4u*)(dst + 8) = o1; } }
}
__device__ __forceinline__ void cvt_matrix(const float* W, int K, int N, const float* gain, bf16* WT, int rowbase, int gw, int NGW, int lane) {
    const int nblk = (N + 63) / 64, nitems = (K / 64) * nblk;
    for (int it = gw; it < nitems; it += NGW) { const int kb = it / nblk, nb = it - kb * nblk;
        cvt_item(W, N, gain, WT, K, kb * 64, nb * 64, (size_t)(rowbase + nb * 64), lane); }
}
__device__ __forceinline__ void cvt_moe(const float* wg, const float* wu, const float* wd, const float* gain, bf16* WGU, bf16* WDN, int gw, int NGW, int lane) {
    for (int it = gw; it < 2 * 8192; it += NGW) { const int which = it >> 13, r = it & 8191, e = r >> 8, q = r & 255, kb = q >> 3, nb = q & 7, n0 = nb * 64;
        const float* W = (which ? wu : wg) + (size_t)e * 2048 * 512;
        const size_t dst = (size_t)e * 1024 + 256 * (n0 >> 7) + (n0 & 127) + (which ? 128 : 0);
        cvt_item(W, 512, gain, WGU, 2048, kb * 64, n0, dst, lane); }
    for (int it = gw; it < 8192; it += NGW) { const int e = it >> 8, q = it & 255, kb = q >> 5, nb = q & 31;
        cvt_item(wd + (size_t)e * 512 * 2048, 2048, nullptr, WDN + (size_t)e * 2048 * 512, 512, kb * 64, nb * 64, (size_t)(nb * 64), lane); }
}
__device__ __forceinline__ void norm_rows(const float* src, bf16* dst, int gw, int NGW, int lane) {
    for (int m = gw; m < T; m += NGW) {
        const GAS f32x4* xr = (const GAS f32x4*)(src + (size_t)m * D) + lane;
        f32x4 v[8]; float s = 0.f;
#pragma unroll
        for (int j = 0; j < 8; ++j) { v[j] = xr[64 * j]; s += (v[j].x * v[j].x + v[j].y * v[j].y) + (v[j].z * v[j].z + v[j].w * v[j].w); }
        const float rstd = rsqrtf(wave_sum(s) * (1.f / D) + RMS_EPS);
        GAS v2u* o8 = (GAS v2u*)(dst + (size_t)m * D) + lane;
#pragma unroll
        for (int j = 0; j < 8; ++j) { v2u o; o.x = pk2(v[j].x * rstd, v[j].y * rstd); o.y = pk2(v[j].z * rstd, v[j].w * rstd); o8[64 * j] = o; }
    }
}

__device__ __forceinline__ float logsig(float z) { return fminf(z, 0.f) - __logf(1.f + __expf(-fabsf(z))); }
constexpr int GP_QE = 0, GP_KE = 33792, GP_ATT = 67584, GP_TOT = 76800;
__device__ __forceinline__ void gla_prepass(LAS unsigned char* lds, const bf16* QK, const bf16* V, const bf16* GL, const float* Wgu, const float* bgate,
                                            bf16* QEF, bf16* KLTF, bf16* ATTF, bf16* VTF, float* DEC) {
    const int tid = threadIdx.x, lane = tid & 63, wave = __builtin_amdgcn_readfirstlane(tid >> 6);
    LAS bf16* QEl = (LAS bf16*)(lds + GP_QE); LAS bf16* KEl = (LAS bf16*)(lds + GP_KE); LAS bf16* ATl = (LAS bf16*)(lds + GP_ATT);
    LAS float* tot = (LAS float*)(lds + GP_TOT);
    const int cg2 = tid & 127, rg2 = __builtin_amdgcn_readfirstlane(tid >> 7);
    for (int it = blockIdx.x; it < NITEM_GLA; it += gridDim.x) {
        const int bh = it >> 8, n = it & 255, h = bh & 3, b = bh >> 2; const int t0 = b * SEQ + n * GLA_C;
        v2u qv[8], kv[8], vv[16];
        { const bf16* qp = QK + (size_t)(t0 + 8 * wave) * 2048 + h * 256 + 4 * lane;
#pragma unroll
          for (int jj = 0; jj < 8; ++jj) { qv[jj] = *(const GAS v2u*)(qp + (size_t)jj * 2048); kv[jj] = *(const GAS v2u*)(qp + (size_t)jj * 2048 + 1024); }
          const bf16* vp = V + (size_t)(t0 + 16 * rg2) * 2048 + h * 512 + 4 * cg2;
#pragma unroll
          for (int r = 0; r < 16; ++r) vv[r] = *(const GAS v2u*)(vp + (size_t)r * 2048); }
        f32x4 cum[8];
        { f32x4 wg[16];
#pragma unroll
          for (int j = 0; j < 16; ++j) wg[j] = *(const GAS f32x4*)(Wgu + j * 1024 + h * 256 + 4 * lane);
          const f32x4 bg = *(const GAS f32x4*)(bgate + h * 256 + 4 * lane);
          f32x4 run = {0.f, 0.f, 0.f, 0.f};
#pragma unroll
          for (int jj = 0; jj < 8; ++jj) { const unsigned* gp = (const unsigned*)(GL + (size_t)(t0 + 8 * wave + jj) * 256);
              f32x4 z = bg;
#pragma unroll
              for (int j2 = 0; j2 < 8; ++j2) { const unsigned w = gp[j2]; z += wg[2 * j2] * bf_lo(w) + wg[2 * j2 + 1] * bf_hi(w); }
#pragma unroll
              for (int e = 0; e < 4; ++e) run[e] += fmaxf(logsig(z[e]) * 0.0625f, -1.0f);
              cum[jj] = run; }
          *(LAS f32x4*)(tot + wave * 256 + 4 * lane) = run; }
        __syncthreads();
        f32x4 offs = {0.f, 0.f, 0.f, 0.f}, blast = {0.f, 0.f, 0.f, 0.f};
#pragma unroll
        for (int w2 = 0; w2 < 8; ++w2) { const f32x4 tv = *(const LAS f32x4*)(tot + w2 * 256 + 4 * lane); blast += tv; if (w2 < wave) offs += tv; }
        f32x4 dec;
#pragma unroll
        for (int e = 0; e < 4; ++e) dec[e] = __expf(blast[e]);
        { float klv[4][8];
#pragma unroll
          for (int jj = 0; jj < 8; ++jj) { const int c = 8 * wave + jj; const f32x4 bb = cum[jj] + offs;
              const float q4[4] = {bf_lo(qv[jj].x), bf_hi(qv[jj].x), bf_lo(qv[jj].y), bf_hi(qv[jj].y)}, k4[4] = {bf_lo(kv[jj].x), bf_hi(kv[jj].x), bf_lo(kv[jj].y), bf_hi(kv[jj].y)};
              float qe[4], ke[4];
#pragma unroll
              for (int e = 0; e < 4; ++e) { qe[e] = q4[e] * 0.0625f * __expf(bb[e]); ke[e] = k4[e] * __expf(-bb[e]); klv[e][jj] = ke[e] * dec[e]; }
              v2u o; o.x = pk2(qe[0], qe[1]); o.y = pk2(qe[2], qe[3]); *(LAS v2u*)(QEl + c * 264 + 4 * lane) = o;
              o.x = pk2(ke[0], ke[1]); o.y = pk2(ke[2], ke[3]); *(LAS v2u*)(KEl + c * 264 + 4 * lane) = o; }
#pragma unroll
          for (int e = 0; e < 4; ++e) { const int d = 4 * lane + e;
              v4u o; o.x = pk2(klv[e][0], klv[e][1]); o.y = pk2(klv[e][2], klv[e][3]); o.z = pk2(klv[e][4], klv[e][5]); o.w = pk2(klv[e][6], klv[e][7]);
              const size_t fi = ((((size_t)it * 8 + (d >> 5)) * 2 + ((d >> 4) & 1)) * 2 + (wave >> 2)) * 64 + (wave & 3) * 16 + (d & 15);
              *(GAS v4u*)(KLTF + fi * 8) = o; } }
        if (wave == 0) *(GAS f32x4*)(DEC + (size_t)it * 256 + 4 * lane) = dec;
#pragma unroll
        for (int f = 0; f < 2; ++f)
#pragma unroll
            for (int e = 0; e < 4; ++e) { unsigned x[8];
#pragma unroll
                for (int jj = 0; jj < 8; ++jj) { const unsigned wd = (e >> 1) ? vv[8 * f + jj].y : vv[8 * f + jj].x; x[jj] = (e & 1) ? (wd >> 16) : (wd & 0xffffu); }
                v4u o; o.x = x[0] | (x[1] << 16); o.y = x[2] | (x[3] << 16); o.z = x[4] | (x[5] << 16); o.w = x[6] | (x[7] << 16);
                const int v = 4 * cg2 + e;
                const size_t fi = (((size_t)it * 32 + (v >> 4)) * 2 + (rg2 >> 1)) * 64 + (2 * (rg2 & 1) + f) * 16 + (v & 15);
                *(GAS v4u*)(VTF + fi * 8) = o; }
        __syncthreads();
        { const int mt = wave >> 1, i = lane & 15, q = lane >> 4;
#pragma unroll
          for (int nn = 0; nn < 2; ++nn) { const int nt = 2 * (wave & 1) + nn; f32x4 acc = {0.f, 0.f, 0.f, 0.f};
            if (nt <= mt) {
#pragma unroll
                for (int ks = 0; ks < 8; ++ks) { const bf16x8 a = *(const LAS bf16x8*)(QEl + (16 * mt + i) * 264 + 32 * ks + 8 * q); const bf16x8 bb = *(const LAS bf16x8*)(KEl + (16 * nt + i) * 264 + 32 * ks + 8 * q);
                    acc = __builtin_amdgcn_mfma_f32_16x16x32_bf16(a, bb, acc, 0, 0, 0); } }
#pragma unroll
            for (int r = 0; r < 4; ++r) { const int c = 16 * mt + 4 * q + r, cp = 16 * nt + i; ATl[c * 72 + cp] = (bf16)f2bf(cp <= c ? acc[r] : 0.f); } } }
        __syncthreads();
        { const int f = tid, mt = f >> 7, ks = (f >> 6) & 1, l2 = f & 63, i2 = l2 & 15, q2 = l2 >> 4;
          const v4u o = *(const LAS v4u*)(ATl + (16 * mt + i2) * 72 + 32 * ks + 8 * q2);
          *(GAS v4u*)(ATTF + ((size_t)it * 512 + f) * 8) = o; }
#pragma unroll
        for (int k = 0; k < 4; ++k) { const int f = tid + 512 * k, w = f >> 8, mt = (f >> 6) & 3, l2 = f & 63, i2 = l2 & 15, q2 = l2 >> 4;
            const v2u lo = *(const LAS v2u*)(QEl + (16 * mt + i2) * 264 + 32 * w + 4 * q2), hi = *(const LAS v2u*)(QEl + (16 * mt + i2) * 264 + 32 * w + 16 + 4 * q2);
            v4u o; o.x = lo.x; o.y = lo.y; o.z = hi.x; o.w = hi.y;
            *(GAS v4u*)(QEF + ((((size_t)it * 8 + w) * 4 + mt) * 64 + l2) * 8) = o; }
        __syncthreads();
    }
}
constexpr int GS_QE = 0, GS_KLT = 32768, GS_ATT = 65536, GS_DEC = 73728, GS_STAGE = 74752;
constexpr int GLA_NSEG = 8, GLA_SEGLEN = 32;
template <int PASS>
__device__ __forceinline__ void gla_scan(LAS unsigned char* lds, const bf16* QEF, const bf16* KLTF, const bf16* ATTF, const bf16* VTF, const float* DEC, float* SEND, float* DTOT, bf16* O) {
    const int tid = threadIdx.x, lane = tid & 63, w = __builtin_amdgcn_readfirstlane(tid >> 6), q = lane >> 4, li = lane & 15;
#define GS_ISSUE(itv, bufv) do { LAS unsigned char* _st = lds + (bufv) * GS_STAGE; const size_t _it = (size_t)(itv); \
        _Pragma("unroll") for (int _k = 0; _k < 4; ++_k) { const int _f = 4 * w + _k; \
            if (PASS == 1) __builtin_amdgcn_global_load_lds((const unsigned*)(QEF + (_it * 32 + _f) * 512 + lane * 8), (LAS unsigned*)(_st + GS_QE + _f * 1024), 16, 0, 0); \
            __builtin_amdgcn_global_load_lds((const unsigned*)(KLTF + (_it * 32 + _f) * 512 + lane * 8), (LAS unsigned*)(_st + GS_KLT + _f * 1024), 16, 0, 0); } \
        if (PASS == 1) __builtin_amdgcn_global_load_lds((const unsigned*)(ATTF + (_it * 8 + w) * 512 + lane * 8), (LAS unsigned*)(_st + GS_ATT + w * 1024), 16, 0, 0); \
        if (w == 0) __builtin_amdgcn_global_load_lds((const unsigned*)(DEC + _it * 256 + lane * 4), (LAS unsigned*)(_st + GS_DEC), 16, 0, 0); } while (0)
    for (int wi = blockIdx.x; wi < 256; wi += gridDim.x) {
        const int bh = wi & 7, rest = wi >> 3, seg = rest >> 2, vsl = rest & 3, h = bh & 3, b = bh >> 2;
        const int it0 = bh * 256 + seg * GLA_SEGLEN, vs16 = vsl * 8 + w;
        f32x4 S[16];
#pragma unroll
        for (int m = 0; m < 16; ++m) S[m] = (f32x4){0.f, 0.f, 0.f, 0.f};
        if (PASS == 1) {
            for (int s2 = 0; s2 < seg; ++s2) { const float* se = SEND + ((size_t)((bh * GLA_NSEG + s2) * 32 + vs16) * 16) * 256; const float* dt = DTOT + (size_t)(bh * GLA_NSEG + s2) * 256;
#pragma unroll
                for (int m = 0; m < 16; ++m) { const f32x4 dv = *(const GAS f32x4*)(dt + 16 * m + 4 * q), sv = *(const GAS f32x4*)(se + (m * 64 + lane) * 4); S[m] = S[m] * dv + sv; } }
        } else if (vsl == 0 && tid < 256) { float p = 1.f;
            for (int n = 0; n < GLA_SEGLEN; ++n) p *= DEC[(size_t)(it0 + n) * 256 + tid];
            DTOT[(size_t)(bh * GLA_NSEG + seg) * 256 + tid] = p; }
        __syncthreads();
        GS_ISSUE(it0, 0);
        const GAS bf16x8* v16 = (const GAS bf16x8*)VTF + (((size_t)it0 * 32 + vs16) * 2) * 64 + lane;
        bf16x8 vb0 = v16[0], vb1 = v16[64], nvb0 = vb0, nvb1 = vb1;
        for (int n = 0; n < GLA_SEGLEN; ++n) {
            VM_WAIT(); __syncthreads();
            if (n + 1 < GLA_SEGLEN) { GS_ISSUE(it0 + n + 1, (n + 1) & 1); nvb0 = v16[(size_t)(n + 1) * 4096]; nvb1 = v16[(size_t)(n + 1) * 4096 + 64]; }
            const LAS unsigned char* st = lds + (n & 1) * GS_STAGE;
            f32x4 po[4];
            if (PASS == 1) {
                bf16x8 sb[8];
#pragma unroll
                for (int ks = 0; ks < 8; ++ks) { v4u x; x.x = pk2(S[2 * ks][0], S[2 * ks][1]); x.y = pk2(S[2 * ks][2], S[2 * ks][3]); x.z = pk2(S[2 * ks + 1][0], S[2 * ks + 1][1]); x.w = pk2(S[2 * ks + 1][2], S[2 * ks + 1][3]); sb[ks] = __builtin_bit_cast(bf16x8, x); }
#pragma unroll
                for (int mt = 0; mt < 4; ++mt) { f32x4 a = {0.f, 0.f, 0.f, 0.f};
#pragma unroll
                    for (int ks = 0; ks < 8; ++ks) a = __builtin_amdgcn_mfma_f32_16x16x32_bf16(*(const LAS bf16x8*)(st + GS_QE + (ks * 4 + mt) * 1024 + lane * 16), sb[ks], a, 0, 0, 0);
                    a = __builtin_amdgcn_mfma_f32_16x16x32_bf16(*(const LAS bf16x8*)(st + GS_ATT + (mt * 2 + 0) * 1024 + lane * 16), vb0, a, 0, 0, 0);
                    a = __builtin_amdgcn_mfma_f32_16x16x32_bf16(*(const LAS bf16x8*)(st + GS_ATT + (mt * 2 + 1) * 1024 + lane * 16), vb1, a, 0, 0, 0);
                    po[mt] = a; }
            }
#pragma unroll
            for (int m = 0; m < 16; ++m) { const f32x4 dv = *(const LAS f32x4*)(st + GS_DEC + (16 * m + 4 * q) * 4);
                f32x4 s = S[m] * dv;
                s = __builtin_amdgcn_mfma_f32_16x16x32_bf16(*(const LAS bf16x8*)(st + GS_KLT + (m * 2 + 0) * 1024 + lane * 16), vb0, s, 0, 0, 0);
                s = __builtin_amdgcn_mfma_f32_16x16x32_bf16(*(const LAS bf16x8*)(st + GS_KLT + (m * 2 + 1) * 1024 + lane * 16), vb1, s, 0, 0, 0);
                S[m] = s; }
            if (PASS == 1) { bf16* op = O + (size_t)(b * SEQ + (seg * GLA_SEGLEN + n) * GLA_C + 4 * q) * 2048 + h * 512 + vsl * 128 + w * 16 + li;
#pragma unroll
                for (int mt = 0; mt < 4; ++mt)
#pragma unroll
                    for (int r = 0; r < 4; ++r) { const float x = po[mt][r], y = __shfl_xor(x, 1); if ((lane & 1) == 0) *(GAS unsigned*)(op + (size_t)(16 * mt + r) * 2048) = pk2(x, y); } }
            vb0 = nvb0; vb1 = nvb1;
        }
        if (PASS == 0) { float* se = SEND + ((size_t)((bh * GLA_NSEG + seg) * 32 + vs16) * 16) * 256;
#pragma unroll
            for (int m = 0; m < 16; ++m) *(GAS f32x4*)(se + (m * 64 + lane) * 4) = S[m]; }
        __syncthreads();
    }
#undef GS_ISSUE
}
__device__ __forceinline__ void gla_gate(const bf16* O, const bf16* R, const float* head_g, bf16* OG, int gw, int NGW, int lane) {
    float hg[8];
#pragma unroll
    for (int j = 0; j < 8; ++j) hg[j] = head_g[8 * lane + j];
    for (int m = gw; m < T; m += NGW) {
#pragma unroll
        for (int h = 0; h < 4; ++h) {
            const v4u ov = *(const GAS v4u*)(O + (size_t)m * 2048 + h * 512 + 8 * lane), rv = *(const GAS v4u*)(R + (size_t)m * 2048 + h * 512 + 8 * lane);
            float o[8] = {bf_lo(ov.x), bf_hi(ov.x), bf_lo(ov.y), bf_hi(ov.y), bf_lo(ov.z), bf_hi(ov.z), bf_lo(ov.w), bf_hi(ov.w)};
            float r[8] = {bf_lo(rv.x), bf_hi(rv.x), bf_lo(rv.y), bf_hi(rv.y), bf_lo(rv.z), bf_hi(rv.z), bf_lo(rv.w), bf_hi(rv.w)};
            float ss = 0.f;
#pragma unroll
            for (int j = 0; j < 8; ++j) ss += o[j] * o[j];
            const float rstd = rsqrtf(wave_sum(ss) * (1.f / 512.f) + RMS_EPS);
            float y[8];
#pragma unroll
            for (int j = 0; j < 8; ++j) y[j] = o[j] * rstd * hg[j] * pg8::silu_f(r[j]);
            v4u w; w.x = pk2(y[0], y[1]); w.y = pk2(y[2], y[3]); w.z = pk2(y[4], y[5]); w.w = pk2(y[6], y[7]);
            *(GAS v4u*)(OG + (size_t)m * 2048 + h * 512 + 8 * lane) = w;
        }
    }
}

__device__ __forceinline__ void moe_route(LAS unsigned char* lds, const float* RL, const float* SSP, const float* bgroup, const float* brouter, unsigned* gcnt, unsigned* EP0, unsigned* EP1, float* W0, float* W1, float* RSTD) {
    const int tid = threadIdx.x; LAS int* lcnt = (LAS int*)lds; LAS int* lbase = lcnt + 32;
    for (int base = blockIdx.x * 128; base < T; base += gridDim.x * 128) {
        if (tid < 32) lcnt[tid] = 0;
        __syncthreads();
        int e0 = 0, e1 = 0, r0 = 0, r1 = 0; float w0 = 0.f, w1 = 0.f;
        if (tid < 128) { const int t = base + tid; const float* rl = RL + (size_t)t * 64;
            float ssq = 0.f; { const GAS f32x4* sp = (const GAS f32x4*)(SSP + (size_t)t * 32);
#pragma unroll
                for (int k = 0; k < 8; ++k) { const f32x4 v = sp[k]; ssq += (v.x + v.y) + (v.z + v.w); } }
            const float rstd = rsqrtf(ssq * (1.f / D) + RMS_EPS); RSTD[t] = rstd;
            const f32x4 g4 = *(const GAS f32x4*)rl; float gl[4] = {g4.x * rstd + bgroup[0], g4.y * rstd + bgroup[1], g4.z * rstd + bgroup[2], g4.w * rstd + bgroup[3]};
            int g = 0; float best = gl[0];
#pragma unroll
            for (int j = 1; j < 4; ++j) if (gl[j] > best) { best = gl[j]; g = j; }
            float se = 0.f;
#pragma unroll
            for (int j = 0; j < 4; ++j) se += __expf(gl[j] - best);
            const float pg = 1.0f / se;
            const f32x4 a4 = *(const GAS f32x4*)(rl + 4 + 8 * g), b4 = *(const GAS f32x4*)(rl + 8 + 8 * g);
            float el[8] = {a4.x, a4.y, a4.z, a4.w, b4.x, b4.y, b4.z, b4.w};
#pragma unroll
            for (int j = 0; j < 8; ++j) el[j] = el[j] * rstd + brouter[8 * g + j];
            int i0 = 0; float v0 = el[0];
#pragma unroll
            for (int j = 1; j < 8; ++j) if (el[j] > v0) { v0 = el[j]; i0 = j; }
            int i1 = -1; float v1 = -3.0e38f;
#pragma unroll
            for (int j = 0; j < 8; ++j) if (j != i0 && el[j] > v1) { v1 = el[j]; i1 = j; }
            w0 = pg / (1.0f + __expf(v1 - v0)); w1 = pg - w0;
            e0 = 8 * g + i0; e1 = 8 * g + i1;
            r0 = __hip_atomic_fetch_add(&lcnt[e0], 1, __ATOMIC_RELAXED, __HIP_MEMORY_SCOPE_WORKGROUP); r1 = __hip_atomic_fetch_add(&lcnt[e1], 1, __ATOMIC_RELAXED, __HIP_MEMORY_SCOPE_WORKGROUP); }
        __syncthreads();
        if (tid < 32) lbase[tid] = (int)__hip_atomic_fetch_add(gcnt + tid, (unsigned)lcnt[tid], RLX_AGENT);
        __syncthreads();
        if (tid < 128) { const int t = base + tid;
            EP0[t] = ((unsigned)e0 << 24) | (unsigned)(lbase[e0] + r0); EP1[t] = ((unsigned)e1 << 24) | (unsigned)(lbase[e1] + r1); W0[t] = w0; W1[t] = w1; }
        __syncthreads();
    }
}
__device__ __forceinline__ void moe_build_table(LAS unsigned char* ldsbase, unsigned* gcnt) {
    LAS int* off = (LAS int*)(ldsbase + MOE_OFF_OFF); LAS unsigned char* texp = ldsbase + MOE_TEXP_OFF;
    __syncthreads();
    if (threadIdx.x == 0) { int acc = 0, ti = 0;
        for (int e = 0; e < NE; ++e) { const int c = (int)__hip_atomic_load(gcnt + e, RLX_AGENT); off[e] = acc; const int nt = (c + 255) >> 8;
            for (int k = 0; k < nt && ti < 288; ++k) texp[ti++] = (unsigned char)e;
            acc += nt * 256; }
        off[32] = acc; }
    __syncthreads();
}
__device__ __forceinline__ void moe_slots(LAS unsigned char* ldsbase, unsigned* gcnt, const unsigned* EP0, const unsigned* EP1, const float* RSTD, unsigned* SL0, unsigned* SL1, unsigned* TL, float* RS) {
    const LAS int* off = (const LAS int*)(ldsbase + MOE_OFF_OFF); const int tid = threadIdx.x;
    for (int t = blockIdx.x * 512 + tid; t < T; t += gridDim.x * 512) {
        const unsigned p0 = EP0[t], p1 = EP1[t]; const float rs = RSTD[t];
        const unsigned s0 = (unsigned)off[p0 >> 24] + (p0 & 0xffffffu), s1 = (unsigned)off[p1 >> 24] + (p1 & 0xffffffu);
        TL[s0] = (unsigned)t; RS[s0] = rs; TL[s1] = (unsigned)t; RS[s1] = rs; SL0[t] = s0; SL1[t] = s1; }
    for (int e = blockIdx.x; e < NE; e += gridDim.x) { const int c = (int)__hip_atomic_load(gcnt + e, RLX_AGENT);
        for (int i = off[e] + c + tid; i < off[e + 1]; i += 512) { TL[i] = 0u; RS[i] = 0.f; } }
}
__device__ __forceinline__ void moe_combine(float* out, const bf16* Y, const unsigned* SL0, const unsigned* SL1, const float* W0, const float* W1, bf16* HN, bool do_norm, int gw, int NGW, int lane) {
    for (int t = gw; t < T; t += NGW) {
        const unsigned s0 = SL0[t], s1 = SL1[t]; const float w0 = W0[t], w1 = W1[t];
        GAS f32x4* xr = (GAS f32x4*)(out + (size_t)t * D) + lane;
        const GAS v2u* y0 = (const GAS v2u*)(Y + (size_t)s0 * 2048) + lane; const GAS v2u* y1 = (const GAS v2u*)(Y + (size_t)s1 * 2048) + lane;
        f32x4 v[8]; float s = 0.f;
#pragma unroll
        for (int j = 0; j < 8; ++j) { const v2u a = y0[64 * j], b = y1[64 * j]; f32x4 x = xr[64 * j];
            x.x += w0 * bf_lo(a.x) + w1 * bf_lo(b.x); x.y += w0 * bf_hi(a.x) + w1 * bf_hi(b.x); x.z += w0 * bf_lo(a.y) + w1 * bf_lo(b.y); x.w += w0 * bf_hi(a.y) + w1 * bf_hi(b.y);
            v[j] = x; xr[64 * j] = x; s += (x.x * x.x + x.y * x.y) + (x.z * x.z + x.w * x.w); }
        if (do_norm) { const float rstd = rsqrtf(wave_sum(s) * (1.f / D) + RMS_EPS);
            GAS v2u* o8 = (GAS v2u*)(HN + (size_t)t * D) + lane;
#pragma unroll
            for (int j = 0; j < 8; ++j) { v2u o; o.x = pk2(v[j].x * rstd, v[j].y * rstd); o.y = pk2(v[j].z * rstd, v[j].w * rstd); o8[64 * j] = o; } }
    }
}

__device__ const unsigned char T5_BUCKET[128] = {0,1,2,3,4,5,6,7,8,9,10,11,12,13,14,15,16,16,16,17,17,18,18,18,19,19,19,20,20,20,20,21,21,21,21,22,22,22,22,22,23,23,23,23,23,23,24,24,24,24,24,24,25,25,25,25,25,25,25,26,26,26,26,26,26,26,26,27,27,27,27,27,27,27,27,27,27,28,28,28,28,28,28,28,28,28,28,29,29,29,29,29,29,29,29,29,29,29,29,30,30,30,30,30,30,30,30,30,30,30,30,30,30,31,31,31,31,31,31,31,31,31,31,31,31,31,31,31};
constexpr int AT_K = 0, AT_VT = 36864, AT_BIAS = 70656;
__device__ __forceinline__ void swa_attention(LAS unsigned char* lds, const bf16* KVQ, const bf16* VT, const float* knorm, const float* qnorm, const float* relb, const float* sinks, bf16* AO) {
    const int tid = threadIdx.x, lane = tid & 63, g = __builtin_amdgcn_readfirstlane(tid >> 6), li = lane & 15, q = lane >> 4;
    LAS bf16* KL = (LAS bf16*)(lds + AT_K); LAS bf16* VTL = (LAS bf16*)(lds + AT_VT); LAS float* BL = (LAS float*)(lds + AT_BIAS);
    constexpr float LOG2E = 1.4426950408889634f;
    float qn[2][8];
#pragma unroll
    for (int ks = 0; ks < 2; ++ks)
#pragma unroll
        for (int j = 0; j < 8; ++j) qn[ks][j] = qnorm[32 * ks + 8 * q + j] * (0.125f * LOG2E);
    const int key = tid >> 1, hf = tid & 1, vd = tid >> 3, vc = tid & 7;
    float kn[32];
#pragma unroll
    for (int j = 0; j < 32; ++j) kn[j] = knorm[32 * hf + j];
    v4u kw[4], vw[4];
#define AT_PREFETCH(wiv) do { const int _hk = (wiv) & 3, _n = ((wiv) >> 2) & 127, _b = (wiv) >> 9; \
        const bool _live = (_n > 0) || (key >= 128); const size_t _tk = (size_t)_b * SEQ + (size_t)(_n - 1) * 128 + key; \
        const bf16* _kp = KVQ + _tk * KVQ_N + _hk * 64 + 32 * hf; \
        _Pragma("unroll") for (int _j = 0; _j < 4; ++_j) kw[_j] = _live ? *(const GAS v4u*)(_kp + 8 * _j) : (v4u){0u, 0u, 0u, 0u}; \
        const bf16* _vp = VT + ((size_t)(_b * 4 + _hk) * 64 + vd) * SEQ + (size_t)(_n - 1) * 128; \
        _Pragma("unroll") for (int _j = 0; _j < 4; ++_j) { const int _c = vc + 8 * _j; vw[_j] = ((_n > 0) || (_c >= 16)) ? *(const GAS v4u*)(_vp + 8 * _c) : (v4u){0u, 0u, 0u, 0u}; } } while (0)
    if (blockIdx.x < 1024) AT_PREFETCH(blockIdx.x);
    for (int wi = blockIdx.x; wi < 1024; wi += gridDim.x) {
        const int hk = wi & 3, n = (wi >> 2) & 127, b = wi >> 9;
        __syncthreads();
        { float ss = 0.f;
#pragma unroll
          for (int j = 0; j < 4; ++j) { const float a0 = bf_lo(kw[j].x), a1 = bf_hi(kw[j].x), a2 = bf_lo(kw[j].y), a3 = bf_hi(kw[j].y), a4 = bf_lo(kw[j].z), a5 = bf_hi(kw[j].z), a6 = bf_lo(kw[j].w), a7 = bf_hi(kw[j].w);
              ss += (a0 * a0 + a1 * a1) + (a2 * a2 + a3 * a3) + (a4 * a4 + a5 * a5) + (a6 * a6 + a7 * a7); }
          ss += __shfl_xor(ss, 1);
          const float rstd = rsqrtf(ss * (1.f / 64.f) + RMS_EPS);
#pragma unroll
          for (int j = 0; j < 4; ++j) { v4u o;
              o.x = pk2(bf_lo(kw[j].x) * rstd * kn[8 * j + 0], bf_hi(kw[j].x) * rstd * kn[8 * j + 1]); o.y = pk2(bf_lo(kw[j].y) * rstd * kn[8 * j + 2], bf_hi(kw[j].y) * rstd * kn[8 * j + 3]);
              o.z = pk2(bf_lo(kw[j].z) * rstd * kn[8 * j + 4], bf_hi(kw[j].z) * rstd * kn[8 * j + 5]); o.w = pk2(bf_lo(kw[j].w) * rstd * kn[8 * j + 6], bf_hi(kw[j].w) * rstd * kn[8 * j + 7]);
              *(LAS v4u*)(KL + key * 72 + 32 * hf + 8 * j) = o; }
#pragma unroll
          for (int j = 0; j < 4; ++j) *(LAS v4u*)(VTL + vd * 264 + 8 * (vc + 8 * j)) = vw[j];
#pragma unroll
          for (int k = 0; k < 2; ++k) { const int e = tid + 512 * k, gg = e >> 7, dist = e & 127; BL[e] = relb[(int)T5_BUCKET[dist] * 32 + hk * 8 + gg] * LOG2E; }
        }
        __syncthreads();
        if (wi + (int)gridDim.x < 1024) AT_PREFETCH(wi + (int)gridDim.x);
        const int head = hk * 8 + g; const float sink = sinks[head] * LOG2E;
        float bz[9][4];
#pragma unroll
        for (int tt = 0; tt < 9; ++tt)
#pragma unroll
            for (int r = 0; r < 4; ++r) { const int dist = 128 - 16 * tt + li - (4 * q + r); const bool ok = (dist >= 0) && (dist < 128);
                bz[tt][r] = ok ? BL[g * 128 + (dist & 127)] : -__builtin_inff(); }
        v4u qr0, qr1;
        { const bf16* qp = KVQ + ((size_t)b * SEQ + (size_t)n * 128 + li) * KVQ_N + 512 + head * 64 + 8 * q; qr0 = *(const GAS v4u*)qp; qr1 = *(const GAS v4u*)(qp + 32); }
        for (int mt = 0; mt < 8; ++mt) {
            const size_t tq = (size_t)b * SEQ + (size_t)n * 128 + 16 * mt + li;
            bf16x8 qf[2];
            { const v4u q0 = qr0, q1 = qr1;
              if (mt < 7) { const bf16* qp = KVQ + (tq + 16) * KVQ_N + 512 + head * 64 + 8 * q; qr0 = *(const GAS v4u*)qp; qr1 = *(const GAS v4u*)(qp + 32); }
              float a[16] = {bf_lo(q0.x), bf_hi(q0.x), bf_lo(q0.y), bf_hi(q0.y), bf_lo(q0.z), bf_hi(q0.z), bf_lo(q0.w), bf_hi(q0.w), bf_lo(q1.x), bf_hi(q1.x), bf_lo(q1.y), bf_hi(q1.y), bf_lo(q1.z), bf_hi(q1.z), bf_lo(q1.w), bf_hi(q1.w)};
              float ss = 0.f;
#pragma unroll
              for (int j = 0; j < 16; ++j) ss += a[j] * a[j];
              ss += __shfl_xor(ss, 16); ss += __shfl_xor(ss, 32);
              const float rstd = rsqrtf(ss * (1.f / 64.f) + RMS_EPS);
              v4u w0, w1;
              w0.x = pk2(a[0] * rstd * qn[0][0], a[1] * rstd * qn[0][1]); w0.y = pk2(a[2] * rstd * qn[0][2], a[3] * rstd * qn[0][3]); w0.z = pk2(a[4] * rstd * qn[0][4], a[5] * rstd * qn[0][5]); w0.w = pk2(a[6] * rstd * qn[0][6], a[7] * rstd * qn[0][7]);
              w1.x = pk2(a[8] * rstd * qn[1][0], a[9] * rstd * qn[1][1]); w1.y = pk2(a[10] * rstd * qn[1][2], a[11] * rstd * qn[1][3]); w1.z = pk2(a[12] * rstd * qn[1][4], a[13] * rstd * qn[1][5]); w1.w = pk2(a[14] * rstd * qn[1][6], a[15] * rstd * qn[1][7]);
              qf[0] = __builtin_bit_cast(bf16x8, w0); qf[1] = __builtin_bit_cast(bf16x8, w1); }
            f32x4 st[9]; float mx = sink;
#pragma unroll
            for (int tt = 0; tt < 9; ++tt) { const int nt = mt + tt;
                if (n == 0 && nt < 8) { st[tt] = (f32x4){-__builtin_inff(), -__builtin_inff(), -__builtin_inff(), -__builtin_inff()}; }
                else { f32x4 acc = {0.f, 0.f, 0.f, 0.f};
#pragma unroll
                    for (int ks = 0; ks < 2; ++ks) { const bf16x8 a = *(const LAS bf16x8*)(KL + (16 * nt + li) * 72 + 32 * ks + 8 * q); acc = __builtin_amdgcn_mfma_f32_16x16x32_bf16(a, qf[ks], acc, 0, 0, 0); }
#pragma unroll
                    for (int r = 0; r < 4; ++r) { acc[r] += bz[tt][r]; mx = fmaxf(mx, acc[r]); }
                    st[tt] = acc; } }
            mx = fmaxf(mx, __shfl_xor(mx, 16)); mx = fmaxf(mx, __shfl_xor(mx, 32));
            float lsum = 0.f;
#pragma unroll
            for (int tt = 0; tt < 9; ++tt)
#pragma unroll
                for (int r = 0; r < 4; ++r) { const float p = __builtin_amdgcn_exp2f(st[tt][r] - mx); st[tt][r] = p; lsum += p; }
            lsum += __shfl_xor(lsum, 16); lsum += __shfl_xor(lsum, 32);
            const float inv = 1.0f / (lsum + __builtin_amdgcn_exp2f(sink - mx));
            f32x4 oacc[4];
#pragma unroll
            for (int dt = 0; dt < 4; ++dt) oacc[dt] = (f32x4){0.f, 0.f, 0.f, 0.f};
#pragma unroll
            for (int s = 0; s < 5; ++s) {
                v4u pw; pw.x = pk2(st[2 * s][0], st[2 * s][1]); pw.y = pk2(st[2 * s][2], st[2 * s][3]);
                if (s < 4) { pw.z = pk2(st[2 * s + 1][0], st[2 * s + 1][1]); pw.w = pk2(st[2 * s + 1][2], st[2 * s + 1][3]); } else { pw.z = 0u; pw.w = 0u; }
                const bf16x8 pb = __builtin_bit_cast(bf16x8, pw);
                const int k0 = 16 * (mt + 2 * s) + 4 * q; int k1 = 16 * (mt + 2 * s + 1) + 4 * q; if (k1 > 252) k1 = 240 + 4 * q;
#pragma unroll
                for (int dt = 0; dt < 4; ++dt) { const v2u lo = *(const LAS v2u*)(VTL + (16 * dt + li) * 264 + k0), hi = *(const LAS v2u*)(VTL + (16 * dt + li) * 264 + k1);
                    v4u aw; aw.x = lo.x; aw.y = lo.y; aw.z = hi.x; aw.w = hi.y;
                    oacc[dt] = __builtin_amdgcn_mfma_f32_16x16x32_bf16(__builtin_bit_cast(bf16x8, aw), pb, oacc[dt], 0, 0, 0); } }
#pragma unroll
            for (int dt = 0; dt < 4; ++dt) { v2u o; o.x = pk2(oacc[dt][0] * inv, oacc[dt][1] * inv); o.y = pk2(oacc[dt][2] * inv, oacc[dt][3] * inv);
                *(GAS v2u*)(AO + tq * 2048 + head * 64 + 16 * dt + 4 * q) = o; }
        }
    }
#undef AT_PREFETCH
}

struct Args { const float* in[24]; float* out; unsigned char* ws; int ph_lo, ph_hi; };
constexpr int N_PHASES = 23;
#define CAS __attribute__((address_space(4)))
template <int WHICH> struct OrderCvt : pg8::StaticOrder {
    int tpm, tpn, gw, NGW, lane;
    __device__ __forceinline__ void set_trigger(int when) { pg8::Unit u; if (!next(when, u)) (void)next(0, u); tpm = u.pm; tpn = u.pn; }
    __device__ __forceinline__ void done(const pg8::Unit& u) const {
        if (u.pm != tpm || u.pn != tpn) return;
        const CAS Args* a = (const CAS Args*)__builtin_amdgcn_kernarg_segment_ptr();
        unsigned char* ws = a->ws;
        if (WHICH == 0) {
            cvt_matrix(a->in[6], 2048, 2048, nullptr, (bf16*)(ws + WS_W_GLA_OUT), 0, gw, NGW, lane);
            cvt_matrix(a->in[8], 2048, 512, a->in[7], (bf16*)(ws + WS_W_KVQ), 0, gw, NGW, lane);
            cvt_matrix(a->in[12], 2048, 2048, a->in[11], (bf16*)(ws + WS_W_KVQ), 512, gw, NGW, lane);
            cvt_matrix(a->in[15], 2048, 2048, nullptr, (bf16*)(ws + WS_W_SWA_OUT), 0, gw, NGW, lane);
            for (int l = 0; l < 2; ++l) {
                cvt_matrix(a->in[17] + (size_t)l * 2048 * 4, 2048, 4, a->in[16] + l * 2048, (bf16*)(ws + WS_W_ROUTER) + (size_t)l * 256 * 2048, 0, gw, NGW, lane);
                cvt_matrix(a->in[19] + (size_t)l * 2048 * 32, 2048, 32, a->in[16] + l * 2048, (bf16*)(ws + WS_W_ROUTER) + (size_t)l * 256 * 2048, 4, gw, NGW, lane);
            }
            cvt_moe(a->in[21], a->in[22], a->in[23], a->in[16], (bf16*)(ws + WS_W_GU), (bf16*)(ws + WS_W_DN), gw, NGW, lane);
        } else {
            cvt_moe(a->in[21] + (size_t)NE * 2048 * 512, a->in[22] + (size_t)NE * 2048 * 512, a->in[23] + (size_t)NE * 512 * 2048, a->in[16] + 2048, (bf16*)(ws + WS_W_GU), (bf16*)(ws + WS_W_DN), gw, NGW, lane);
        }
    }
};
__global__ void __launch_bounds__(NWAVES * 64, 2) fwd(Args args) {
    extern __shared__ __attribute__((aligned(16))) unsigned char lds_raw[];
    LAS unsigned char* lds = (LAS unsigned char*)lds_raw;
    const int tid = threadIdx.x, lane = tid & 63, wave = __builtin_amdgcn_readfirstlane(tid >> 6);
    const int G = gridDim.x, gw = blockIdx.x * NWAVES + wave, NGW = G * NWAVES;
    unsigned char* ws = args.ws;
    gu32* ctl = (gu32*)(ws + WS_CTL);
    for (int u = tid; u < (LDS_BYTES - LDSCTL_OFF) / 4; u += NWAVES * 64) ((LAS unsigned*)(lds + LDSCTL_OFF))[u] = 0u;
    __syncthreads();
    XcdBarrier bar = xcd_barrier_post((unsigned*)(ctl + CW_BAR), (volatile LAS unsigned*)(lds + MISC_OFF));
    const int lo = args.ph_lo, hi = args.ph_hi;
#define IN(k) ((((MK_PHASE_MASK) >> (k)) & 1) && lo <= (k) && (k) < hi)
#define PB(k) const unsigned long long _pt0 = (((MK_DELAY_MASK) >> (k)) & 1) ? __builtin_amdgcn_s_memrealtime() : 0ull
#define PE(k) do { if (((MK_DELAY_MASK) >> (k)) & 1) { const unsigned long long _pt1 = __builtin_amdgcn_s_memrealtime(), _dt = _pt1 - _pt0; while (__builtin_amdgcn_s_memrealtime() - _pt1 < _dt) __builtin_amdgcn_s_sleep(8); } } while (0)
#define SEAM(k) do { if (IN(k) && IN((k) + 1)) xcd_barrier(bar); } while (0)

    const float* x = args.in[0]; float* out = args.out;
    bf16* W_GLA_IN = (bf16*)(ws + WS_W_GLA_IN); bf16* W_GLA_OUT = (bf16*)(ws + WS_W_GLA_OUT); bf16* W_KVQ = (bf16*)(ws + WS_W_KVQ); bf16* W_SWA_OUT = (bf16*)(ws + WS_W_SWA_OUT);
    bf16* W_ROUTER = (bf16*)(ws + WS_W_ROUTER); bf16* W_GU = (bf16*)(ws + WS_W_GU); bf16* W_DN = (bf16*)(ws + WS_W_DN);
    bf16* HN = (bf16*)(ws + WS_HN);
    unsigned* EP0 = (unsigned*)(ws + WS_TOK); unsigned* EP1 = EP0 + T; unsigned* SL0 = EP1 + T; unsigned* SL1 = SL0 + T; float* TW0 = (float*)(SL1 + T); float* TW1 = TW0 + T; float* RSTD = TW1 + T;
    bf16* HB = (bf16*)(ws + WS_HB); float* SSP = (float*)(ws + WS_SSP); unsigned* TL = (unsigned*)(ws + WS_TL); float* RS = (float*)(ws + WS_RS);
    float* RL = (float*)(ws + WS_RL);

    if (IN(0)) { PB(0);
        cvt_matrix(args.in[2], 2048, GLA_PROJ_N, args.in[1], W_GLA_IN, 0, gw, NGW, lane);
        norm_rows(x, HN, gw, NGW, lane);
        PE(0);
    }
    SEAM(0);
    if (IN(1)) { PB(1);
        pg8::Gemm g{HN, W_GLA_IN, T, GLA_PROJ_NP, 2048}; OrderCvt<0> S; S.init(T, GLA_PROJ_NP, G, (int)blockIdx.x); S.gw = gw; S.NGW = NGW; S.lane = lane; S.set_trigger((int)(blockIdx.x % 12));
        pg8::EpiGlaProj E{(bf16*)(ws + WS_QK), (bf16*)(ws + WS_V), (bf16*)(ws + WS_R), (bf16*)(ws + WS_GL)};
        pg8::gemm_phase<pg8::EpiGlaProj, OrderCvt<0>, true, true>(lds + RING_OFF, g, S, E);
        PE(1);
    }
    SEAM(1);
    if (IN(2)) { PB(2); gla_prepass(lds + RING_OFF, (const bf16*)(ws + WS_QK), (const bf16*)(ws + WS_V), (const bf16*)(ws + WS_GL), args.in[3], args.in[4],
                           (bf16*)(ws + WS_QEF), (bf16*)(ws + WS_KLTF), (bf16*)(ws + WS_ATTF), (bf16*)(ws + WS_VTF), (float*)(ws + WS_DEC)); PE(2); }
    SEAM(2);
    if (IN(3)) { PB(3); gla_scan<0>(lds + RING_OFF, (const bf16*)(ws + WS_QEF), (const bf16*)(ws + WS_KLTF), (const bf16*)(ws + WS_ATTF), (const bf16*)(ws + WS_VTF), (const float*)(ws + WS_DEC), (float*)(ws + WS_SEND), (float*)(ws + WS_DTOT), (bf16*)(ws + WS_QK)); PE(3); }
    SEAM(3);
    if (IN(4)) { PB(4); gla_scan<1>(lds + RING_OFF, (const bf16*)(ws + WS_QEF), (const bf16*)(ws + WS_KLTF), (const bf16*)(ws + WS_ATTF), (const bf16*)(ws + WS_VTF), (const float*)(ws + WS_DEC), (float*)(ws + WS_SEND), (float*)(ws + WS_DTOT), (bf16*)(ws + WS_QK)); PE(4); }
    SEAM(4);
    if (IN(5)) { PB(5); gla_gate((const bf16*)(ws + WS_QK), (const bf16*)(ws + WS_R), args.in[5], HN, gw, NGW, lane); PE(5); }
    SEAM(5);
    if (IN(6)) { PB(6);
        pg8::Gemm g{HN, W_GLA_OUT, T, 2048, 2048}; pg8::StaticOrder S; S.init(T, 2048, G, (int)blockIdx.x);
        pg8::EpiResF32 E{out, x, 2048, HB, SSP};
        pg8::gemm_phase<pg8::EpiResF32, pg8::StaticOrder, true, true>(lds + RING_OFF, g, S, E);
        PE(6);
    }
    SEAM(6);

    { constexpr int layer = 0; constexpr int pb = 6 + 10 * layer;
    unsigned* gcnt = (unsigned*)(ctl + CW_CNT + layer * 64);
    if (IN(pb + 1)) { PB(pb + 1);
        pg8::Gemm g{HB, W_ROUTER + (size_t)layer * 256 * 2048, T, 256, 2048}; pg8::StaticOrder S; S.init(T, 256, G, (int)blockIdx.x);
        pg8::EpiRouter E{RL};
        pg8::gemm_phase<pg8::EpiRouter, pg8::StaticOrder, true, true>(lds + RING_OFF, g, S, E);
        PE(pb + 1);
    }
    SEAM(pb + 1);
    if (IN(pb + 2)) { PB(pb + 2); moe_route(lds + RING_OFF, RL, SSP, args.in[18] + layer * 4, args.in[20] + layer * 32, gcnt, EP0, EP1, TW0, TW1, RSTD); PE(pb + 2); }
    SEAM(pb + 2);
    if (IN(pb + 3)) { PB(pb + 3); { moe_build_table(lds, gcnt); moe_slots(lds, gcnt, EP0, EP1, RSTD, SL0, SL1, TL, RS); } PE(pb + 3); }
    SEAM(pb + 3);
    if (IN(pb + 4)) { PB(pb + 4);
        moe_build_table(lds, gcnt);
        const int rows = __builtin_amdgcn_readfirstlane(((const LAS int*)(lds + MOE_OFF_OFF))[32]);
        pg8::Gemm g{HB, W_GU, rows, 1024, 2048, TL};
        pg8::GroupedOrder S{(const LAS unsigned char*)(lds + MOE_TEXP_OFF), rows >> 8, 4, G, (int)blockIdx.x};
        pg8::EpiSwiGLU E{(bf16*)(ws + WS_ACT), RS};
        pg8::gemm_phase<pg8::EpiSwiGLU, pg8::GroupedOrder, true, true, true>(lds + RING_OFF, g, S, E);
        PE(pb + 4);
    }
    SEAM(pb + 4);
    if (IN(pb + 5)) { PB(pb + 5);
        moe_build_table(lds, gcnt);
        const int rows = __builtin_amdgcn_readfirstlane(((const LAS int*)(lds + MOE_OFF_OFF))[32]);
        pg8::Gemm g{(const bf16*)(ws + WS_ACT), W_DN, rows, 2048, 512};
        pg8::GroupedOrder S{(const LAS unsigned char*)(lds + MOE_TEXP_OFF), rows >> 8, 8, G, (int)blockIdx.x};
        pg8::EpiBf16 E{(bf16*)(ws + WS_Y), 2048};
        pg8::gemm_phase<pg8::EpiBf16, pg8::GroupedOrder, true, true>(lds + RING_OFF, g, S, E);
        PE(pb + 5);
    }
    SEAM(pb + 5);
    if (IN(pb + 6)) { PB(pb + 6);
        moe_combine(out, (const bf16*)(ws + WS_Y), SL0, SL1, TW0, TW1, HN, layer == 0, gw, NGW, lane);
        PE(pb + 6);
    }
    if (layer == 0) SEAM(pb + 6);
    }
    if (IN(13)) { PB(13);
        pg8::Gemm g{HN, W_KVQ, T, KVQ_N, 2048}; OrderCvt<1> S; S.init(T, KVQ_N, G, (int)blockIdx.x); S.gw = gw; S.NGW = NGW; S.lane = lane; S.set_trigger((int)(blockIdx.x % 5));
        pg8::EpiKVQ E{(bf16*)(ws + WS_KVQ), (bf16*)(ws + WS_VT)};
        pg8::gemm_phase<pg8::EpiKVQ, OrderCvt<1>, true, true>(lds + RING_OFF, g, S, E);
        PE(13);
    }
    SEAM(13);
    if (IN(14)) { PB(14); swa_attention(lds + RING_OFF, (const bf16*)(ws + WS_KVQ), (const bf16*)(ws + WS_VT), args.in[9], args.in[13], args.in[10], args.in[14], (bf16*)(ws + WS_AO)); PE(14); }
    SEAM(14);
    if (IN(15)) { PB(15);
        pg8::Gemm g{(const bf16*)(ws + WS_AO), W_SWA_OUT, T, 2048, 2048}; pg8::StaticOrder S; S.init(T, 2048, G, (int)blockIdx.x);
        pg8::EpiResF32 E{out, out, 2048, HB, SSP};
        pg8::gemm_phase<pg8::EpiResF32, pg8::StaticOrder, true, true>(lds + RING_OFF, g, S, E);
        PE(15);
    }
    SEAM(15);
    { constexpr int layer = 1; constexpr int pb = 6 + 10 * layer;
    unsigned* gcnt = (unsigned*)(ctl + CW_CNT + layer * 64);
    if (IN(pb + 1)) { PB(pb + 1);
        pg8::Gemm g{HB, W_ROUTER + (size_t)layer * 256 * 2048, T, 256, 2048}; pg8::StaticOrder S; S.init(T, 256, G, (int)blockIdx.x);
        pg8::EpiRouter E{RL};
        pg8::gemm_phase<pg8::EpiRouter, pg8::StaticOrder, true, true>(lds + RING_OFF, g, S, E);
        PE(pb + 1);
    }
    SEAM(pb + 1);
    if (IN(pb + 2)) { PB(pb + 2); moe_route(lds + RING_OFF, RL, SSP, args.in[18] + layer * 4, args.in[20] + layer * 32, gcnt, EP0, EP1, TW0, TW1, RSTD); PE(pb + 2); }
    SEAM(pb + 2);
    if (IN(pb + 3)) { PB(pb + 3); { moe_build_table(lds, gcnt); moe_slots(lds, gcnt, EP0, EP1, RSTD, SL0, SL1, TL, RS); } PE(pb + 3); }
    SEAM(pb + 3);
    if (IN(pb + 4)) { PB(pb + 4);
        moe_build_table(lds, gcnt);
        const int rows = __builtin_amdgcn_readfirstlane(((const LAS int*)(lds + MOE_OFF_OFF))[32]);
        pg8::Gemm g{HB, W_GU, rows, 1024, 2048, TL};
        pg8::GroupedOrder S{(const LAS unsigned char*)(lds + MOE_TEXP_OFF), rows >> 8, 4, G, (int)blockIdx.x};
        pg8::EpiSwiGLU E{(bf16*)(ws + WS_ACT), RS};
        pg8::gemm_phase<pg8::EpiSwiGLU, pg8::GroupedOrder, true, true, true>(lds + RING_OFF, g, S, E);
        PE(pb + 4);
    }
    SEAM(pb + 4);
    if (IN(pb + 5)) { PB(pb + 5);
        moe_build_table(lds, gcnt);
        const int rows = __builtin_amdgcn_readfirstlane(((const LAS int*)(lds + MOE_OFF_OFF))[32]);
        pg8::Gemm g{(const bf16*)(ws + WS_ACT), W_DN, rows, 2048, 512};
        pg8::GroupedOrder S{(const LAS unsigned char*)(lds + MOE_TEXP_OFF), rows >> 8, 8, G, (int)blockIdx.x};
        pg8::EpiBf16 E{(bf16*)(ws + WS_Y), 2048};
        pg8::gemm_phase<pg8::EpiBf16, pg8::GroupedOrder, true, true>(lds + RING_OFF, g, S, E);
        PE(pb + 5);
    }
    SEAM(pb + 5);
    if (IN(pb + 6)) { PB(pb + 6);
        moe_combine(out, (const bf16*)(ws + WS_Y), SL0, SL1, TW0, TW1, HN, layer == 0, gw, NGW, lane);
        PE(pb + 6);
    }
    if (layer == 0) SEAM(pb + 6);
    }
#undef IN
#undef SEAM
}

extern "C" void kernel_launch(void* const* d_in, const int* in_sizes, int n_in, void* d_out, int out_size, void* d_ws, size_t ws_size, hipStream_t stream) {
    static int grid = 0;
    if (grid == 0) {
        if (n_in != 24 || in_sizes[0] != T * D || out_size != T * D || ws_size < WS_END) { fprintf(stderr, "kernel_launch: unexpected shapes / workspace (n_in %d, in0 %d, out %d, ws %zu < %zu)\n", n_in, n_in > 0 ? in_sizes[0] : -1, out_size, ws_size, (size_t)WS_END); grid = -1; return; }
        int dev = 0, cus = 0, per_cu = 0;
        if (hipGetDevice(&dev) != hipSuccess || hipDeviceGetAttribute(&cus, hipDeviceAttributeMultiprocessorCount, dev) != hipSuccess) { grid = -1; return; }
        if (hipFuncSetAttribute((const void*)fwd, hipFuncAttributeMaxDynamicSharedMemorySize, LDS_BYTES) != hipSuccess) { fprintf(stderr, "kernel_launch: hipFuncSetAttribute failed\n"); grid = -1; return; }
        if (hipOccupancyMaxActiveBlocksPerMultiprocessor(&per_cu, (const void*)fwd, NWAVES * 64, LDS_BYTES) != hipSuccess || per_cu < 1) { fprintf(stderr, "kernel_launch: occupancy query says %d\n", per_cu); }
        (void)hipGetLastError();
        grid = cus;
    }
    if (grid < 0) return;
    if (hipMemsetAsync((char*)d_ws + WS_CTL, 0, CTL_ZERO_BYTES, stream) != hipSuccess) return;
    Args a{};
    for (int i = 0; i < 24; ++i) a.in[i] = (const float*)d_in[i];
    a.out = (float*)d_out; a.ws = (unsigned char*)d_ws;
#if MK_PER_PHASE
    for (int p = 0; p < MK_LAST_PHASE; ++p) { a.ph_lo = p; a.ph_hi = p + 1; hipLaunchKernelGGL(fwd, dim3(grid), dim3(NWAVES * 64), LDS_BYTES, stream, a); }
#else
    a.ph_lo = 0; a.ph_hi = MK_LAST_PHASE;
    hipLaunchKernelGGL(fwd, dim3(grid), dim3(NWAVES * 64), LDS_BYTES, stream, a);
#endif
    const hipError_t le = hipPeekAtLastError();
    if (le != hipSuccess) fprintf(stderr, "kernel_launch: launch failed: %s\n", hipGetErrorName(le));
}
```

```cpp
#include <hip/hip_runtime.h>
#include <cstdio>
#include <cstdint>

#ifndef MK_PER_PHASE
#define MK_PER_PHASE 0
#endif
#ifndef MK_LAST_PHASE
#define MK_LAST_PHASE 23
#endif

#ifndef MK_PHASE_MASK
#define MK_PHASE_MASK 0x7fffff
#endif

#ifndef MK_DELAY_MASK
#define MK_DELAY_MASK 0
#endif

namespace pg8 {
#define PG8_LAS __attribute__((address_space(3)))
typedef unsigned short bf16_t;
typedef short bf16x8 __attribute__((ext_vector_type(8)));
typedef float f32x4 __attribute__((ext_vector_type(4)));
typedef unsigned u32x4 __attribute__((ext_vector_type(4)));
constexpr int BM = 256, BK = 64, HALF = 128, HTB = HALF * BK * 2  , STAGE_BYTES = 8 * HTB, NXCD = 8, WGM = 8;

__host__ __device__ __forceinline__ int lds_byte(int r, int c) { const int st = (r >> 4) * 2 + (c >> 5), rr = r & 15, cc = c & 31, ob = rr * 64 + cc * 2; return st * 1024 + (ob ^ (((ob >> 9) & 1) << 5)); }
__host__ __device__ __forceinline__ void stage_rc(int b, int& R, int& C) { const int st = b / 1024, sb = b % 1024, swz = sb ^ (((sb >> 9) & 1) << 5); R = (st >> 1) * 16 + swz / 64; C = (st & 1) * 32 + (swz % 64) / 2; }
__host__ __device__ __forceinline__ int perm32(int rho) { const int n = rho >> 4, i = rho & 15; return 8 * (i >> 2) + 4 * n + (i & 3); }

struct Unit { int pm, pn, pc; };
struct Gemm { const bf16_t* A; const bf16_t* Bt; int M, N, K; const unsigned* rowidx; };


struct StaticOrder {
    int nM, nN, nwg, G, c;
    __host__ __device__ void init(int M, int N, int G_, int c_) { nM = M / BM; nN = N / BM; nwg = nM * nN; G = G_; c = c_; }
    __host__ __device__ bool next(int i, Unit& u) const {
        const long L = (long)i * G + c; if (L >= nwg) return false;
        int wgid = (int)L; { const int q = nwg / NXCD, r = nwg % NXCD, xcd = wgid % NXCD, off = wgid / NXCD; wgid = (xcd < r ? xcd * (q + 1) : r * (q + 1) + (xcd - r) * q) + off; }
        const int nig = WGM * nN, gid = wgid / nig, fm = gid * WGM, gsz = (nM - fm) < WGM ? (nM - fm) : WGM;
        u.pm = fm + ((wgid % nig) % gsz); u.pn = (wgid % nig) / gsz; u.pc = u.pn; return true;
    }
    __device__ __forceinline__ void a_ready(const Unit&) const {}
    __device__ __forceinline__ void done(const Unit&) const {}
};
struct GroupedOrder {
    const PG8_LAS unsigned char* texp; int MT, npn, G, c;
    __device__ __forceinline__ bool next(int i, Unit& u) const {
        const long L = (long)i * G + c; if (L >= (long)MT * npn) return false;
        const int pm = (int)(L / npn), pc = (int)(L % npn);
        const int e = __builtin_amdgcn_readfirstlane((int)texp[pm]);
        u.pm = pm; u.pn = e * npn + pc; u.pc = pc; return true;
    }
    __device__ __forceinline__ void a_ready(const Unit&) const {}
    __device__ __forceinline__ void done(const Unit&) const {}
};

__device__ __forceinline__ unsigned cvt_pk_bf16(float lo, float hi) { unsigned r; asm volatile("v_cvt_pk_bf16_f32 %0, %1, %2" : "=v"(r) : "v"(lo), "v"(hi)); return r; }

struct EpiBf16 {
    static constexpr bool PERM = true, AFTER_DRAIN = false;
    bf16_t* O; int ldc;
    __device__ __forceinline__ void operator()(const f32x4 (&acc)[2][2][4][2], const Unit& u, int wr, int wc, int fr, int fq) const {
        const int row0 = u.pm * BM + wr * 64 + fr, col0 = u.pc * BM + wc * 32 + 8 * fq;
#pragma unroll
        for (int ai = 0; ai < 2; ++ai)
#pragma unroll
            for (int m = 0; m < 4; ++m) { bf16_t* rowp = O + (size_t)(row0 + ai * HALF + m * 16) * ldc + col0;
#pragma unroll
                for (int bj = 0; bj < 2; ++bj) { const f32x4 v0 = acc[ai][bj][m][0], v1 = acc[ai][bj][m][1];
                    u32x4 w; w.x = cvt_pk_bf16(v0[0], v0[1]); w.y = cvt_pk_bf16(v0[2], v0[3]); w.z = cvt_pk_bf16(v1[0], v1[1]); w.w = cvt_pk_bf16(v1[2], v1[3]);
                    *(u32x4*)(rowp + bj * HALF) = w; } }
    }
};
struct EpiGlaProj {
    static constexpr bool PERM = true, AFTER_DRAIN = false;
    bf16_t *QK, *V, *R, *GL;
    __device__ __forceinline__ void operator()(const f32x4 (&acc)[2][2][4][2], const Unit& u, int wr, int wc, int fr, int fq) const {
        bf16_t* base; int ldc, ct;
        if (u.pc < 8) { base = QK; ldc = 2048; ct = u.pc; } else if (u.pc < 16) { base = V; ldc = 2048; ct = u.pc - 8; } else if (u.pc < 24) { base = R; ldc = 2048; ct = u.pc - 16; } else { base = GL; ldc = 256; ct = 0; }
        const int row0 = u.pm * BM + wr * 64 + fr, col0 = ct * BM + wc * 32 + 8 * fq;
#pragma unroll
        for (int ai = 0; ai < 2; ++ai)
#pragma unroll
            for (int m = 0; m < 4; ++m) { bf16_t* rowp = base + (size_t)(row0 + ai * HALF + m * 16) * ldc + col0;
#pragma unroll
                for (int bj = 0; bj < 2; ++bj) { const f32x4 v0 = acc[ai][bj][m][0], v1 = acc[ai][bj][m][1];
                    u32x4 w; w.x = cvt_pk_bf16(v0[0], v0[1]); w.y = cvt_pk_bf16(v0[2], v0[3]); w.z = cvt_pk_bf16(v1[0], v1[1]); w.w = cvt_pk_bf16(v1[2], v1[3]);
                    *(u32x4*)(rowp + bj * HALF) = w; } }
    }
};
template <bool RES_BF16> struct EpiResBf16 {
    static constexpr bool PERM = true, AFTER_DRAIN = false;
    const void* RES; int ldc; bf16_t* HB; float* SSP;
    __device__ __forceinline__ void operator()(const f32x4 (&acc)[2][2][4][2], const Unit& u, int wr, int wc, int fr, int fq) const {
        const int row0 = u.pm * BM + wr * 64 + fr, col0 = u.pc * BM + wc * 32 + 8 * fq;
#pragma unroll
        for (int ai = 0; ai < 2; ++ai)
#pragma unroll
            for (int m = 0; m < 4; ++m) { const int row = row0 + ai * HALF + m * 16; const size_t off = (size_t)row * ldc + col0;
                f32x4 rv[2][2];
#pragma unroll
                for (int bj = 0; bj < 2; ++bj) {
                    if constexpr (RES_BF16) { const u32x4 w = *(const u32x4*)((const bf16_t*)RES + off + bj * HALF);
                        rv[bj][0] = (f32x4){__builtin_bit_cast(float, w.x << 16), __builtin_bit_cast(float, w.x & 0xffff0000u), __builtin_bit_cast(float, w.y << 16), __builtin_bit_cast(float, w.y & 0xffff0000u)};
                        rv[bj][1] = (f32x4){__builtin_bit_cast(float, w.z << 16), __builtin_bit_cast(float, w.z & 0xffff0000u), __builtin_bit_cast(float, w.w << 16), __builtin_bit_cast(float, w.w & 0xffff0000u)}; }
                    else { rv[bj][0] = *(const f32x4*)((const float*)RES + off + bj * HALF); rv[bj][1] = *(const f32x4*)((const float*)RES + off + bj * HALF + 4); } }
                float ss = 0.f;
#pragma unroll
                for (int bj = 0; bj < 2; ++bj) { const f32x4 v0 = acc[ai][bj][m][0] + rv[bj][0], v1 = acc[ai][bj][m][1] + rv[bj][1];
                    u32x4 w; w.x = cvt_pk_bf16(v0[0], v0[1]); w.y = cvt_pk_bf16(v0[2], v0[3]); w.z = cvt_pk_bf16(v1[0], v1[1]); w.w = cvt_pk_bf16(v1[2], v1[3]);
                    *(u32x4*)(HB + off + bj * HALF) = w;
                    ss += (v0[0] * v0[0] + v0[1] * v0[1]) + (v0[2] * v0[2] + v0[3] * v0[3]) + (v1[0] * v1[0] + v1[1] * v1[1]) + (v1[2] * v1[2] + v1[3] * v1[3]); }
                ss += __shfl_xor(ss, 16); ss += __shfl_xor(ss, 32);
                if (fq == 0) SSP[(size_t)row * 32 + u.pc * 4 + wc] = ss; }
    }
};
struct EpiRouter {
    static constexpr bool PERM = false, AFTER_DRAIN = false;
    float* RL;
    __device__ __forceinline__ void operator()(const f32x4 (&acc)[2][2][4][2], const Unit& u, int wr, int wc, int fr, int fq) const {
        if (wc >= 2) return;
        const int row0 = u.pm * BM + wr * 64 + fr, col0 = wc * 32 + 4 * fq;
#pragma unroll
        for (int ai = 0; ai < 2; ++ai)
#pragma unroll
            for (int m = 0; m < 4; ++m) { float* rowp = RL + (size_t)(row0 + ai * HALF + m * 16) * 64 + col0;
#pragma unroll
                for (int n = 0; n < 2; ++n) *(f32x4*)(rowp + n * 16) = acc[ai][0][m][n]; }
    }
};
__device__ __forceinline__ float silu_f(float x) { return x * __builtin_amdgcn_rcpf(1.0f + __expf(-x)); }
struct EpiSwiGLU {
    static constexpr bool PERM = true, AFTER_DRAIN = false;
    bf16_t* ACT; const float* RS;
    __device__ __forceinline__ void operator()(const f32x4 (&acc)[2][2][4][2], const Unit& u, int wr, int wc, int fr, int fq) const {
        const int row0 = u.pm * BM + wr * 64 + fr, col0 = u.pc * HALF + wc * 32 + 8 * fq;
#pragma unroll
        for (int ai = 0; ai < 2; ++ai)
#pragma unroll
            for (int m = 0; m < 4; ++m) { const int row = row0 + ai * HALF + m * 16; bf16_t* rowp = ACT + (size_t)row * 512 + col0; const float rs = RS[row];
                const f32x4 g0 = acc[ai][0][m][0] * rs, g1 = acc[ai][0][m][1] * rs, u0 = acc[ai][1][m][0] * rs, u1 = acc[ai][1][m][1] * rs;
                u32x4 w;
                w.x = cvt_pk_bf16(silu_f(g0[0]) * u0[0], silu_f(g0[1]) * u0[1]); w.y = cvt_pk_bf16(silu_f(g0[2]) * u0[2], silu_f(g0[3]) * u0[3]);
                w.z = cvt_pk_bf16(silu_f(g1[0]) * u1[0], silu_f(g1[1]) * u1[1]); w.w = cvt_pk_bf16(silu_f(g1[2]) * u1[2], silu_f(g1[3]) * u1[3]);
                *(u32x4*)rowp = w; }
    }
};

template <class Epi, class Sched, bool ALIGN_EPI = false, bool SP2 = false, bool GATHER = false>
__device__ __forceinline__ void gemm_phase(PG8_LAS unsigned char* lds, const Gemm g, const Sched& S, const Epi& E) {
    const int tid = threadIdx.x, wid = __builtin_amdgcn_readfirstlane(tid >> 6), lane = tid & 63, wr = wid >> 2, wc = wid & 3, fr = lane & 15, fq = lane >> 4;
    const int K = g.K, nt = K / BK;
    unsigned voffA[2], voffB[2];
#pragma unroll
    for (int i = 0; i < 2; ++i) { int R, C; stage_rc(tid * 16 + i * 8192, R, C); const int Rb = Epi::PERM ? ((R & ~31) + perm32(R & 31)) : R;
        voffA[i] = (unsigned)(R * K + C) * 2u; voffB[i] = (unsigned)(Rb * K + C) * 2u; }
    unsigned vA[2][2] = {{0u, 0u}, {0u, 0u}}, vAn[2][2] = {{0u, 0u}, {0u, 0u}}; int rA[2] = {0, 0}; unsigned cbA[2] = {0u, 0u};
    if constexpr (GATHER) {
#pragma unroll
        for (int i = 0; i < 2; ++i) { int R, C; stage_rc(tid * 16 + i * 8192, R, C); rA[i] = R; cbA[i] = (unsigned)C * 2u; } }
#define PG8_GIDX(dst, pmv) do { _Pragma("unroll") for (int _h = 0; _h < 2; ++_h) _Pragma("unroll") for (int _i = 0; _i < 2; ++_i) \
        dst[_h][_i] = g.rowidx[(size_t)(pmv) * BM + _h * HALF + rA[_i]] * (unsigned)(K * 2) + cbA[_i]; } while (0)
    const size_t kstep = (size_t)(BK * 2);
    const size_t hstep = (size_t)HALF * K * 2;
    const size_t tstep = 2 * hstep;
    const unsigned ldsw = (unsigned)wid * 1024u;
    const int aoff = lds_byte(wr * 64 + fr, fq * 8), boff = lds_byte(wc * 32 + fr, fq * 8);
#define PG8_SA(b, h) (((b) * 2 + (h)) * HTB)
#define PG8_SB(b, h) ((4 + (b) * 2 + (h)) * HTB)
#define PG8_STAGE(bufoff, gbase, voff) do { _Pragma("unroll") for (int _i = 0; _i < 2; ++_i) \
        __builtin_amdgcn_global_load_lds((const unsigned*)((const char*)(gbase) + (voff)[_i]), (PG8_LAS unsigned*)(lds + (bufoff) + ldsw + _i * 8192), 16, 0, 0); } while (0)
#define PG8_STAGE_A(bufoff, nx, kb, h) do { if constexpr (GATHER) { const char* _b = (const char*)g.A + (kb); \
        _Pragma("unroll") for (int _i = 0; _i < 2; ++_i) { const unsigned _v = (nx) ? vAn[h][_i] : vA[h][_i]; \
            __builtin_amdgcn_global_load_lds((const unsigned*)(_b + _v), (PG8_LAS unsigned*)(lds + (bufoff) + ldsw + _i * 8192), 16, 0, 0); } } \
    else { const char* _b = ((nx) ? nA : cA) + (kb) + (size_t)(h) * hstep; PG8_STAGE(bufoff, _b, voffA); } } while (0)
#define PG8_LDA(dst, b, h) do { _Pragma("unroll") for (int m = 0; m < 4; ++m) _Pragma("unroll") for (int k = 0; k < 2; ++k) dst[m][k] = *(const PG8_LAS bf16x8*)(lds + PG8_SA(b, h) + aoff + m * 2048 + k * 1024); } while (0)
#define PG8_LDB(dst, b, h) do { _Pragma("unroll") for (int n = 0; n < 2; ++n) _Pragma("unroll") for (int k = 0; k < 2; ++k) dst[n][k] = *(const PG8_LAS bf16x8*)(lds + PG8_SB(b, h) + boff + n * 2048 + k * 1024); } while (0)
#define PG8_MMA(ai, bj, At, Bt) do { __builtin_amdgcn_s_setprio(1); _Pragma("unroll") for (int m = 0; m < 4; ++m) _Pragma("unroll") for (int n = 0; n < 2; ++n) _Pragma("unroll") for (int k = 0; k < 2; ++k) \
        acc[ai][bj][m][n] = __builtin_amdgcn_mfma_f32_16x16x32_bf16(Bt[n][k], At[m][k], acc[ai][bj][m][n], 0, 0, 0); __builtin_amdgcn_s_setprio(0); } while (0)
#define PG8_WAIT_V(n) asm volatile("s_waitcnt vmcnt(" #n ")" ::: "memory")
#define PG8_WAIT_L(n) asm volatile("s_waitcnt lgkmcnt(" #n ")" ::: "memory")
#define PG8_BAR __builtin_amdgcn_s_barrier()
#define PG8_SCHED __builtin_amdgcn_sched_barrier(0)
    Unit cur, nxt; int ui = 0;
    if (!S.next(0, cur)) return;
    f32x4 acc[2][2][4][2];
#pragma unroll
    for (int a = 0; a < 2; ++a)
#pragma unroll
        for (int b = 0; b < 2; ++b)
#pragma unroll
            for (int m = 0; m < 4; ++m)
#pragma unroll
                for (int n = 0; n < 2; ++n) acc[a][b][m][n] = (f32x4){0.f, 0.f, 0.f, 0.f};
    bf16x8 At[4][2], B0[2][2], B1[2][2];
    const char* cA = (const char*)g.A + (size_t)cur.pm * tstep; const char* cB = (const char*)g.Bt + (size_t)cur.pn * tstep;
    const char* nA = cA; const char* nB = cB;
    if constexpr (GATHER) { PG8_GIDX(vA, cur.pm); }
    S.a_ready(cur);
    if constexpr (SP2) {
        PG8_STAGE(PG8_SB(0, 0), cB, voffB); PG8_STAGE(PG8_SB(0, 1), cB + hstep, voffB); PG8_STAGE_A(PG8_SA(0, 0), false, 0, 0); PG8_STAGE_A(PG8_SA(0, 1), false, 0, 1);
        if (wr == 1) PG8_BAR;
        PG8_WAIT_V(2); PG8_BAR;
        PG8_STAGE(PG8_SB(1, 0), cB + kstep, voffB); PG8_STAGE_A(PG8_SA(1, 0), false, kstep, 0); PG8_STAGE(PG8_SB(1, 1), cB + hstep + kstep, voffB);
        PG8_WAIT_V(6); PG8_BAR;
    } else {
        PG8_STAGE(PG8_SB(0, 0), cB, voffB); PG8_STAGE(PG8_SA(0, 0), cA, voffA); PG8_STAGE(PG8_SB(0, 1), cB + hstep, voffB); PG8_STAGE(PG8_SA(0, 1), cA + hstep, voffA);
        if (wr == 1) PG8_BAR;
        PG8_WAIT_V(4); PG8_BAR;
        PG8_STAGE(PG8_SB(1, 0), cB + kstep, voffB); PG8_STAGE(PG8_SA(1, 0), cA + kstep, voffA); PG8_STAGE(PG8_SB(1, 1), cB + hstep + kstep, voffB);
        PG8_WAIT_V(6); PG8_BAR;
    }
    for (;;) {
        const bool has_next = S.next(ui + 1, nxt);
        nA = has_next ? (const char*)g.A + (size_t)nxt.pm * tstep : cA; nB = has_next ? (const char*)g.Bt + (size_t)nxt.pn * tstep : cB;
        if constexpr (GATHER) { if (has_next) { PG8_GIDX(vAn, nxt.pm); } else {
#pragma unroll
            for (int _h = 0; _h < 2; ++_h) { vAn[_h][0] = vA[_h][0]; vAn[_h][1] = vA[_h][1]; } } }
        for (int t = 0; t < nt; t += 2) {
            const bool last = (t == nt - 2);
            const char* a1 = cA + (size_t)(t + 1) * kstep;
            const char* a2 = last ? nA : cA + (size_t)(t + 2) * kstep; const char* b2 = last ? nB : cB + (size_t)(t + 2) * kstep;
            const char* a3 = a2 + kstep; const char* b3 = b2 + kstep;
            const size_t ka1 = (size_t)(t + 1) * kstep, ka2 = last ? (size_t)0 : (size_t)(t + 2) * kstep, ka3 = ka2 + kstep; (void)a1; (void)a3;
            if (last && has_next) S.a_ready(nxt);
            if constexpr (SP2) {
            PG8_LDB(B0, 0, 0); PG8_LDB(B1, 0, 1); PG8_SCHED; PG8_LDA(At, 0, 0); PG8_STAGE_A(PG8_SA(1, 1), false, ka1, 1);
            PG8_WAIT_V(8); PG8_WAIT_L(0); PG8_BAR; PG8_MMA(0, 0, At, B0); PG8_MMA(0, 1, At, B1); PG8_BAR; PG8_SCHED;
            PG8_LDA(At, 0, 1); PG8_STAGE(PG8_SB(0, 0), b2, voffB); PG8_STAGE(PG8_SB(0, 1), b2 + hstep, voffB); PG8_STAGE_A(PG8_SA(0, 0), last, ka2, 0);
            PG8_WAIT_V(8); PG8_WAIT_L(0); PG8_BAR; PG8_MMA(1, 0, At, B0); PG8_MMA(1, 1, At, B1); PG8_BAR; PG8_SCHED;
            PG8_LDB(B0, 1, 0); PG8_LDB(B1, 1, 1); PG8_SCHED; PG8_LDA(At, 1, 0); PG8_STAGE_A(PG8_SA(0, 1), last, ka2, 1);
            PG8_WAIT_V(8); PG8_WAIT_L(0); PG8_BAR; PG8_MMA(0, 0, At, B0); PG8_MMA(0, 1, At, B1); PG8_BAR; PG8_SCHED;
            PG8_LDA(At, 1, 1); PG8_STAGE(PG8_SB(1, 0), b3, voffB); PG8_STAGE(PG8_SB(1, 1), b3 + hstep, voffB); PG8_STAGE_A(PG8_SA(1, 0), last, ka3, 0);
            PG8_WAIT_V(8); PG8_WAIT_L(0); PG8_BAR; PG8_MMA(1, 0, At, B0); PG8_MMA(1, 1, At, B1); PG8_BAR; PG8_SCHED;
            } else {
            PG8_LDB(B0, 0, 0); PG8_SCHED; PG8_LDA(At, 0, 0); PG8_STAGE(PG8_SA(1, 1), a1 + hstep, voffA);
            PG8_WAIT_L(8); PG8_BAR; PG8_WAIT_L(0); PG8_MMA(0, 0, At, B0); PG8_BAR; PG8_SCHED;
            PG8_LDB(B1, 0, 1); PG8_STAGE(PG8_SB(0, 0), b2, voffB);
            PG8_BAR; PG8_WAIT_L(0); PG8_MMA(0, 1, At, B1); PG8_BAR;
            PG8_LDA(At, 0, 1); PG8_STAGE(PG8_SA(0, 0), a2, voffA);
            PG8_BAR; PG8_WAIT_L(0); PG8_MMA(1, 0, At, B0); PG8_BAR; PG8_SCHED;
            PG8_STAGE(PG8_SB(0, 1), b2 + hstep, voffB);
            PG8_WAIT_V(6); PG8_BAR; PG8_MMA(1, 1, At, B1); PG8_BAR;
            PG8_LDB(B0, 1, 0); PG8_SCHED; PG8_LDA(At, 1, 0); PG8_STAGE(PG8_SA(0, 1), a2 + hstep, voffA);
            PG8_WAIT_L(8); PG8_BAR; PG8_WAIT_L(0); PG8_MMA(0, 0, At, B0); PG8_BAR; PG8_SCHED;
            PG8_LDB(B1, 1, 1); PG8_STAGE(PG8_SB(1, 0), b3, voffB);
            PG8_BAR; PG8_WAIT_L(0); PG8_MMA(0, 1, At, B1); PG8_BAR;
            PG8_LDA(At, 1, 1); PG8_STAGE(PG8_SA(1, 0), a3, voffA);
            PG8_BAR; PG8_WAIT_L(0); PG8_MMA(1, 0, At, B0); PG8_BAR; PG8_SCHED;
            PG8_STAGE(PG8_SB(1, 1), b3 + hstep, voffB);
            PG8_WAIT_V(6); PG8_BAR; PG8_MMA(1, 1, At, B1); PG8_BAR;
            }
        }
        if constexpr (ALIGN_EPI) { if (wr == 0) PG8_BAR; }
        if constexpr (!Epi::AFTER_DRAIN) { E(acc, cur, wr, wc, fr, fq); S.done(cur); }
        if (!has_next) break;
#pragma unroll
        for (int a = 0; a < 2; ++a)
#pragma unroll
            for (int b = 0; b < 2; ++b)
#pragma unroll
                for (int m = 0; m < 4; ++m)
#pragma unroll
                    for (int n = 0; n < 2; ++n) acc[a][b][m][n] = (f32x4){0.f, 0.f, 0.f, 0.f};
        cur = nxt; cA = nA; cB = nB; ++ui;
        if constexpr (GATHER) {
#pragma unroll
            for (int _h = 0; _h < 2; ++_h) { vA[_h][0] = vAn[_h][0]; vA[_h][1] = vAn[_h][1]; } }
        if constexpr (ALIGN_EPI) { if (wr == 1) PG8_BAR; }
    }
    PG8_WAIT_V(0);
    if constexpr (!ALIGN_EPI) { if (wr == 0) PG8_BAR; }
    PG8_BAR;
    if constexpr (Epi::AFTER_DRAIN) { E.fused(acc, cur, wr, wc, fr, fq, lds, wid, lane); S.done(cur); }
#undef PG8_SA
#undef PG8_STAGE_A
#undef PG8_GIDX
#undef PG8_SB
#undef PG8_STAGE
#undef PG8_LDA
#undef PG8_LDB
#undef PG8_MMA
#undef PG8_WAIT_V
#undef PG8_WAIT_L
#undef PG8_BAR
#undef PG8_SCHED
}
}

constexpr int NWAVES = 8;
constexpr int T = 32768, D = 2048, SEQ = 16384;
constexpr float RMS_EPS = 1e-6f;
constexpr int GLA_H = 4, GLA_DK = 256, GLA_DV = 512, GLA_C = 64, GLA_NCH = SEQ / GLA_C  , GLA_PROJ_N = 6160, GLA_PROJ_NP = 6400;
constexpr int NITEM_GLA = 2 * GLA_H * GLA_NCH;
constexpr int SWA_HQ = 32, SWA_HKV = 4, SWA_HD = 64, SWA_W = 128, KVQ_N = 2560;
constexpr int NE = 32, FF = 512, MOE_MAXROWS = 2 * T + NE * 256;

constexpr size_t MiB = 1u << 20;
constexpr size_t WS_CTL = 0, CTL_ZERO_BYTES = 1 * MiB;
constexpr size_t WS_W_GLA_IN = 1 * MiB;
constexpr size_t WS_W_GLA_OUT = 26 * MiB;
constexpr size_t WS_W_KVQ = 34 * MiB;
constexpr size_t WS_W_SWA_OUT = 44 * MiB;
constexpr size_t WS_W_ROUTER = 52 * MiB;
constexpr size_t WS_TOK = 54 * MiB;
constexpr size_t WS_RL = 56 * MiB;
constexpr size_t WS_W_GU = 64 * MiB;
constexpr size_t WS_W_DN = 192 * MiB;
constexpr size_t WS_HN = 256 * MiB;
constexpr size_t WS_BIG = 384 * MiB;
constexpr size_t WS_QK = WS_BIG;
constexpr size_t WS_V = WS_BIG + 128 * MiB;
constexpr size_t WS_R = WS_BIG + 256 * MiB;
constexpr size_t WS_GL = WS_BIG + 384 * MiB;
constexpr size_t WS_QEF = WS_BIG + 400 * MiB;
constexpr size_t WS_KLTF = WS_BIG + 464 * MiB;
constexpr size_t WS_ATTF = WS_BIG + 528 * MiB;
constexpr size_t WS_VTF = WS_BIG + 544 * MiB;
constexpr size_t WS_DEC = WS_BIG + 672 * MiB;
constexpr size_t WS_SEND = WS_V;
constexpr size_t WS_DTOT = WS_V + 32 * MiB;
constexpr size_t WS_GLA_END = WS_BIG + 674 * MiB;
constexpr size_t WS_SSP = WS_BIG;
constexpr size_t WS_TL = WS_BIG + 8 * MiB;
constexpr size_t WS_RS = WS_BIG + 9 * MiB;
constexpr size_t WS_HB = WS_BIG + 16 * MiB;
constexpr size_t WS_ACT = WS_BIG + 288 * MiB;
constexpr size_t WS_Y = WS_BIG + 360 * MiB;
constexpr size_t WS_KVQ = WS_BIG;
constexpr size_t WS_AO = WS_BIG + 160 * MiB;
constexpr size_t WS_END = WS_GLA_END;
static_assert(WS_Y + (size_t)MOE_MAXROWS * 2048 * 2 <= WS_END && WS_ACT + (size_t)MOE_MAXROWS * 512 * 2 <= WS_Y, "MoE map");
constexpr int CW_BAR = 4096;
constexpr int CW_CNT = 16384;

constexpr int RING_OFF = 0, RING_BYTES = 149504;
constexpr int LDSCTL_OFF = RING_BYTES;
constexpr int MISC_OFF = LDSCTL_OFF + 64;
constexpr int MOE_OFF_OFF = LDSCTL_OFF + 256;
constexpr int MOE_TEXP_OFF = LDSCTL_OFF + 512;
constexpr int LDS_BYTES = RING_BYTES + 2048;

#define GAS __attribute__((address_space(1)))
#define LAS __attribute__((address_space(3)))
typedef unsigned short bf16;
typedef unsigned v4u __attribute__((ext_vector_type(4)));
typedef unsigned v2u __attribute__((ext_vector_type(2)));
typedef float f32x4 __attribute__((ext_vector_type(4)));
typedef short bf16x8 __attribute__((ext_vector_type(8)));
typedef GAS unsigned gu32;
#define RLX_AGENT __ATOMIC_RELAXED, __HIP_MEMORY_SCOPE_AGENT
#define LDS_WAIT() asm volatile("s_waitcnt lgkmcnt(0)" ::: "memory")
#define VM_WAIT() asm volatile("s_waitcnt vmcnt(0)" ::: "memory")
__device__ __forceinline__ unsigned f2bf(float f) { unsigned u = __builtin_bit_cast(unsigned, f); return (u + 0x7fffu + ((u >> 16) & 1u)) >> 16; }
__device__ __forceinline__ unsigned pk2(float lo, float hi) { return pg8::cvt_pk_bf16(lo, hi); }
__device__ __forceinline__ float bf_lo(unsigned w) { return __builtin_bit_cast(float, w << 16); }
__device__ __forceinline__ float bf_hi(unsigned w) { return __builtin_bit_cast(float, w & 0xffff0000u); }
__device__ __forceinline__ float bf2f(bf16 b) { return __builtin_bit_cast(float, ((unsigned)b) << 16); }
__device__ __forceinline__ float wave_sum(float v) {
#pragma unroll
    for (int o = 1; o < 64; o <<= 1) v += __shfl_xor(v, o);
    return v;
}

#define XB_TMO      128
#define XB_XCNT(j)  (256  + 64 * (j))
#define XB_XSUB(j)  (1280 + 64 * (j))
#define XB_XGEN(j)  (2304 + 64 * (j))
#define XB_TOP      3328
#define XB_TOPGEN   3392
#define XCD_BAR_WORDS 3456
#define XB_SPIN_CAP (1u << 18)

__device__ __forceinline__ unsigned xb_ld(unsigned* p)              { return __hip_atomic_load(p, __ATOMIC_RELAXED, __HIP_MEMORY_SCOPE_AGENT); }
__device__ __forceinline__ unsigned xb_add(unsigned* p, unsigned v) { return __hip_atomic_fetch_add(p, v, __ATOMIC_RELAXED, __HIP_MEMORY_SCOPE_AGENT); }
__device__ __forceinline__ unsigned xb_xcc_id() { return (unsigned)__builtin_amdgcn_s_getreg((3 << 11) | 20) & 0xFu; }
#define XB_SPIN(cond, bar) do { unsigned _sp = 0; while (cond) { __builtin_amdgcn_s_sleep(1); \
    if ((++_sp & 255u) == 0u) { if (xb_ld(&(bar)[XB_TMO])) break; if (_sp > XB_SPIN_CAP) { atomicAdd(&(bar)[XB_TMO], 1u); break; } } } } while (0)

struct XcdBarrier {
    unsigned* bar; unsigned x;
    volatile LAS unsigned* st;
};

__device__ __forceinline__ XcdBarrier xcd_barrier_post(unsigned* bar, volatile LAS unsigned* st) {
    XcdBarrier b; b.bar = bar; b.x = xb_xcc_id(); b.st = st;
    if (threadIdx.x == 0) (void)xb_add(&bar[XB_XCNT(b.x)], 1u);
    return b;
}
__device__ __forceinline__ void xcd_barrier_complete(unsigned* bar, unsigned x, unsigned& nloc, unsigned& nx) {
    const unsigned G = gridDim.x * gridDim.y * gridDim.z;
    unsigned sum, cnt, mine, sp = 0u;
    for (;;) {
        sum = 0u; cnt = 0u; mine = 0u;
#pragma unroll
        for (unsigned j = 0; j < 16; ++j) { const unsigned c = xb_ld(&bar[XB_XCNT(j)]); sum += c; cnt += (c > 0u) ? 1u : 0u; mine = (j == x) ? c : mine; }
        if (sum == G) break;
        __builtin_amdgcn_s_sleep(1);
        if ((++sp & 255u) == 0u) { if (xb_ld(&bar[XB_TMO])) break; if (sp > XB_SPIN_CAP) { atomicAdd(&bar[XB_TMO], 1u); break; } }
    }
    nloc = mine > 0u ? mine : 1u; nx = cnt > 0u ? cnt : 1u;
}

__device__ __forceinline__ void xcd_barrier(const XcdBarrier& b) {
    asm volatile("s_waitcnt vmcnt(0)" ::: "memory");
    __syncthreads();
    if (threadIdx.x == 0) {
        unsigned* bar = b.bar;
        __builtin_amdgcn_s_waitcnt(0);
        unsigned nloc = b.st[0], nx = b.st[1];
        if (nloc == 0u) { xcd_barrier_complete(bar, b.x, nloc, nx); b.st[0] = nloc; b.st[1] = nx; }
        const unsigned old = xb_add(&bar[XB_XSUB(b.x)], 1u);
        const unsigned gen = old / nloc;
        if (old + 1u == (gen + 1u) * nloc) {
            __builtin_amdgcn_fence(__ATOMIC_RELEASE, "agent");
            asm volatile("s_waitcnt vmcnt(0)" ::: "memory");
            const unsigned og = xb_add(&bar[XB_TOP], 1u);
            const unsigned tg = og / nx;
            if (og + 1u == (tg + 1u) * nx) xb_add(&bar[XB_TOPGEN], 1u);
            else XB_SPIN(xb_ld(&bar[XB_TOPGEN]) == tg, bar);
            __builtin_amdgcn_fence(__ATOMIC_ACQUIRE, "agent");
            xb_add(&bar[XB_XGEN(b.x)], 1u);
            asm volatile("s_waitcnt vmcnt(0)" ::: "memory");
        } else {
            XB_SPIN(xb_ld(&bar[XB_XGEN(b.x)]) == gen, bar);
            __builtin_amdgcn_fence(__ATOMIC_ACQUIRE, "agent");
            asm volatile("s_waitcnt vmcnt(0)" ::: "memory");
        }
    }
    __syncthreads();
}


__device__ __forceinline__ void cvt_item(const float* W, int N, const float* gain, bf16* WT, int K, int k0, int n0, size_t dst_row0, int lane) {
    const int q = lane >> 4, c = lane & 15;
    const bool ok = (n0 + 4 * c) < N;
    const GAS f32x4* src = (const GAS f32x4*)(W + (size_t)(k0 + 16 * q) * N + n0 + 4 * c);
    f32x4 v[16];
#pragma unroll
    for (int i = 0; i < 16; ++i) v[i] = ok ? src[(size_t)i * (N / 4)] : (f32x4){0.f, 0.f, 0.f, 0.f};
    if (gain) { const GAS f32x4* gp = (const GAS f32x4*)(gain + k0 + 16 * q);
#pragma unroll
        for (int i4 = 0; i4 < 4; ++i4) { const f32x4 g = gp[i4]; v[4 * i4 + 0] = v[4 * i4 + 0] * g.x; v[4 * i4 + 1] = v[4 * i4 + 1] * g.y; v[4 * i4 + 2] = v[4 * i4 + 2] * g.z; v[4 * i4 + 3] = v[4 * i4 + 3] * g.w; } }
    if (ok) {
#pragma unroll
        for (int e = 0; e < 4; ++e) { bf16* dst = WT + (dst_row0 + 4 * c + e) * (size_t)K + k0 + 16 * q;
            v4u o0, o1;
            o0.x = pk2(v[0][e], v[1][e]); o0.y = pk2(v[2][e], v[3][e]); o0.z = pk2(v[4][e], v[5][e]); o0.w = pk2(v[6][e], v[7][e]);
            o1.x = pk2(v[8][e], v[9][e]); o1.y = pk2(v[10][e], v[11][e]); o1.z = pk2(v[12][e], v[13][e]); o1.w = pk2(v[14][e], v[15][e]);
            *(GAS v4u*)dst = o0; *(GAS v4u*)(dst + 8) = o1; } }
}
__device__ __forceinline__ void cvt_matrix(const float* W, int K, int N, const float* gain, bf16* WT, int rowbase, int gw, int NGW, int lane) {
    const int nblk = (N + 63) / 64, nitems = (K / 64) * nblk;
    for (int it = gw; it < nitems; it += NGW) { const int kb = it / nblk, nb = it - kb * nblk;
        cvt_item(W, N, gain, WT, K, kb * 64, nb * 64, (size_t)(rowbase + nb * 64), lane); }
}
__device__ __forceinline__ void cvt_moe(const float* wg, const float* wu, const float* wd, const float* gain, bf16* WGU, bf16* WDN, int gw, int NGW, int lane) {
    for (int it = gw; it < 2 * 8192; it += NGW) { const int which = it >> 13, r = it & 8191, e = r >> 8, q = r & 255, kb = q >> 3, nb = q & 7, n0 = nb * 64;
        const float* W = (which ? wu : wg) + (size_t)e * 2048 * 512;
        const size_t dst = (size_t)e * 1024 + 256 * (n0 >> 7) + (n0 & 127) + (which ? 128 : 0);
        cvt_item(W, 512, gain, WGU, 2048, kb * 64, n0, dst, lane); }
    for (int it = gw; it < 8192; it += NGW) { const int e = it >> 8, q = it & 255, kb = q >> 5, nb = q & 31;
        cvt_item(wd + (size_t)e * 512 * 2048, 2048, nullptr, WDN + (size_t)e * 2048 * 512, 512, kb * 64, nb * 64, (size_t)(nb * 64), lane); }
}
__device__ __forceinline__ void norm_rows(const float* src, bf16* dst, int gw, int NGW, int lane) {
    for (int m = gw; m < T; m += NGW) {
        const GAS f32x4* xr = (const GAS f32x4*)(src + (size_t)m * D) + lane;
        f32x4 v[8]; float s = 0.f;
#pragma unroll
        for (int j = 0; j < 8; ++j) { v[j] = xr[64 * j]; s += (v[j].x * v[j].x + v[j].y * v[j].y) + (v[j].z * v[j].z + v[j].w * v[j].w); }
        const float rstd = rsqrtf(wave_sum(s) * (1.f / D) + RMS_EPS);
        GAS v2u* o8 = (GAS v2u*)(dst + (size_t)m * D) + lane;
#pragma unroll
        for (int j = 0; j < 8; ++j) { v2u o; o.x = pk2(v[j].x * rstd, v[j].y * rstd); o.y = pk2(v[j].z * rstd, v[j].w * rstd); o8[64 * j] = o; }
    }
}

__device__ __forceinline__ float logsig(float z) { return fminf(z, 0.f) - __logf(1.f + __expf(-fabsf(z))); }
constexpr int GP_QE = 0, GP_KE = 33792, GP_ATT = 67584, GP_TOT = 76800;
__device__ __forceinline__ void gla_prepass(LAS unsigned char* lds, const bf16* QK, const bf16* V, const bf16* GL, const float* Wgu, const float* bgate,
                                            bf16* QEF, bf16* KLTF, bf16* ATTF, bf16* VTF, float* DEC) {
    const int tid = threadIdx.x, lane = tid & 63, wave = __builtin_amdgcn_readfirstlane(tid >> 6);
    LAS bf16* QEl = (LAS bf16*)(lds + GP_QE); LAS bf16* KEl = (LAS bf16*)(lds + GP_KE); LAS bf16* ATl = (LAS bf16*)(lds + GP_ATT);
    LAS float* tot = (LAS float*)(lds + GP_TOT);
    const int cg2 = tid & 127, rg2 = __builtin_amdgcn_readfirstlane(tid >> 7);
    for (int it = blockIdx.x; it < NITEM_GLA; it += gridDim.x) {
        const int bh = it >> 8, n = it & 255, h = bh & 3, b = bh >> 2; const int t0 = b * SEQ + n * GLA_C;
        v2u qv[8], kv[8], vv[16];
        { const bf16* qp = QK + (size_t)(t0 + 8 * wave) * 2048 + h * 256 + 4 * lane;
#pragma unroll
          for (int jj = 0; jj < 8; ++jj) { qv[jj] = *(const GAS v2u*)(qp + (size_t)jj * 2048); kv[jj] = *(const GAS v2u*)(qp + (size_t)jj * 2048 + 1024); }
          const bf16* vp = V + (size_t)(t0 + 16 * rg2) * 2048 + h * 512 + 4 * cg2;
#pragma unroll
          for (int r = 0; r < 16; ++r) vv[r] = *(const GAS v2u*)(vp + (size_t)r * 2048); }
        f32x4 cum[8];
        { f32x4 wg[16];
#pragma unroll
          for (int j = 0; j < 16; ++j) wg[j] = *(const GAS f32x4*)(Wgu + j * 1024 + h * 256 + 4 * lane);
          const f32x4 bg = *(const GAS f32x4*)(bgate + h * 256 + 4 * lane);
          f32x4 run = {0.f, 0.f, 0.f, 0.f};
#pragma unroll
          for (int jj = 0; jj < 8; ++jj) { const unsigned* gp = (const unsigned*)(GL + (size_t)(t0 + 8 * wave + jj) * 256);
              f32x4 z = bg;
#pragma unroll
              for (int j2 = 0; j2 < 8; ++j2) { const unsigned w = gp[j2]; z += wg[2 * j2] * bf_lo(w) + wg[2 * j2 + 1] * bf_hi(w); }
#pragma unroll
              for (int e = 0; e < 4; ++e) run[e] += fmaxf(logsig(z[e]) * 0.0625f, -1.0f);
              cum[jj] = run; }
          *(LAS f32x4*)(tot + wave * 256 + 4 * lane) = run; }
        __syncthreads();
        f32x4 offs = {0.f, 0.f, 0.f, 0.f}, blast = {0.f, 0.f, 0.f, 0.f};
#pragma unroll
        for (int w2 = 0; w2 < 8; ++w2) { const f32x4 tv = *(const LAS f32x4*)(tot + w2 * 256 + 4 * lane); blast += tv; if (w2 < wave) offs += tv; }
        f32x4 dec;
#pragma unroll
        for (int e = 0; e < 4; ++e) dec[e] = __expf(blast[e]);
        { float klv[4][8];
#pragma unroll
          for (int jj = 0; jj < 8; ++jj) { const int c = 8 * wave + jj; const f32x4 bb = cum[jj] + offs;
              const float q4[4] = {bf_lo(qv[jj].x), bf_hi(qv[jj].x), bf_lo(qv[jj].y), bf_hi(qv[jj].y)}, k4[4] = {bf_lo(kv[jj].x), bf_hi(kv[jj].x), bf_lo(kv[jj].y), bf_hi(kv[jj].y)};
              float qe[4], ke[4];
#pragma unroll
              for (int e = 0; e < 4; ++e) { qe[e] = q4[e] * 0.0625f * __expf(bb[e]); ke[e] = k4[e] * __expf(-bb[e]); klv[e][jj] = ke[e] * dec[e]; }
              v2u o; o.x = pk2(qe[0], qe[1]); o.y = pk2(qe[2], qe[3]); *(LAS v2u*)(QEl + c * 264 + 4 * lane) = o;
              o.x = pk2(ke[0], ke[1]); o.y = pk2(ke[2], ke[3]); *(LAS v2u*)(KEl + c * 264 + 4 * lane) = o; }
#pragma unroll
          for (int e = 0; e < 4; ++e) { const int d = 4 * lane + e;
              v4u o; o.x = pk2(klv[e][0], klv[e][1]); o.y = pk2(klv[e][2], klv[e][3]); o.z = pk2(klv[e][4], klv[e][5]); o.w = pk2(klv[e][6], klv[e][7]);
              const size_t fi = ((((size_t)it * 8 + (d >> 5)) * 2 + ((d >> 4) & 1)) * 2 + (wave >> 2)) * 64 + (wave & 3) * 16 + (d & 15);
              *(GAS v4u*)(KLTF + fi * 8) = o; } }
        if (wave == 0) *(GAS f32x4*)(DEC + (size_t)it * 256 + 4 * lane) = dec;
#pragma unroll
        for (int f = 0; f < 2; ++f)
#pragma unroll
            for (int e = 0; e < 4; ++e) { unsigned x[8];
#pragma unroll
                for (int jj = 0; jj < 8; ++jj) { const unsigned wd = (e >> 1) ? vv[8 * f + jj].y : vv[8 * f + jj].x; x[jj] = (e & 1) ? (wd >> 16) : (wd & 0xffffu); }
                v4u o; o.x = x[0] | (x[1] << 16); o.y = x[2] | (x[3] << 16); o.z = x[4] | (x[5] << 16); o.w = x[6] | (x[7] << 16);
                const int v = 4 * cg2 + e;
                const size_t fi = (((size_t)it * 32 + (v >> 4)) * 2 + (rg2 >> 1)) * 64 + (2 * (rg2 & 1) + f) * 16 + (v & 15);
                *(GAS v4u*)(VTF + fi * 8) = o; }
        __syncthreads();
        { const int mt = wave >> 1, i = lane & 15, q = lane >> 4;
#pragma unroll
          for (int nn = 0; nn < 2; ++nn) { const int nt = 2 * (wave & 1) + nn; f32x4 acc = {0.f, 0.f, 0.f, 0.f};
            if (nt <= mt) {
#pragma unroll
                for (int ks = 0; ks < 8; ++ks) { const bf16x8 a = *(const LAS bf16x8*)(QEl + (16 * mt + i) * 264 + 32 * ks + 8 * q); const bf16x8 bb = *(const LAS bf16x8*)(KEl + (16 * nt + i) * 264 + 32 * ks + 8 * q);
                    acc = __builtin_amdgcn_mfma_f32_16x16x32_bf16(a, bb, acc, 0, 0, 0); } }
#pragma unroll
            for (int r = 0; r < 4; ++r) { const int c = 16 * mt + 4 * q + r, cp = 16 * nt + i; ATl[c * 72 + cp] = (bf16)f2bf(cp <= c ? acc[r] : 0.f); } } }
        __syncthreads();
        { const int f = tid, mt = f >> 7, ks = (f >> 6) & 1, l2 = f & 63, i2 = l2 & 15, q2 = l2 >> 4;
          const v4u o = *(const LAS v4u*)(ATl + (16 * mt + i2) * 72 + 32 * ks + 8 * q2);
          *(GAS v4u*)(ATTF + ((size_t)it * 512 + f) * 8) = o; }
#pragma unroll
        for (int k = 0; k < 4; ++k) { const int f = tid + 512 * k, w = f >> 8, mt = (f >> 6) & 3, l2 = f & 63, i2 = l2 & 15, q2 = l2 >> 4;
            const v2u lo = *(const LAS v2u*)(QEl + (16 * mt + i2) * 264 + 32 * w + 4 * q2), hi = *(const LAS v2u*)(QEl + (16 * mt + i2) * 264 + 32 * w + 16 + 4 * q2);
            v4u o; o.x = lo.x; o.y = lo.y; o.z = hi.x; o.w = hi.y;
            *(GAS v4u*)(QEF + ((((size_t)it * 8 + w) * 4 + mt) * 64 + l2) * 8) = o; }
        __syncthreads();
    }
}
constexpr int GS_QE = 0, GS_KLT = 32768, GS_ATT = 65536, GS_DEC = 73728, GS_STAGE = 74752;
constexpr int GLA_NSEG = 8, GLA_SEGLEN = 32;
template <int PASS>
__device__ __forceinline__ void gla_scan(LAS unsigned char* lds, const bf16* QEF, const bf16* KLTF, const bf16* ATTF, const bf16* VTF, const float* DEC, float* SEND, float* DTOT, bf16* O) {
    const int tid = threadIdx.x, lane = tid & 63, w = __builtin_amdgcn_readfirstlane(tid >> 6), q = lane >> 4, li = lane & 15;
#define GS_ISSUE(itv, bufv) do { LAS unsigned char* _st = lds + (bufv) * GS_STAGE; const size_t _it = (size_t)(itv); \
        _Pragma("unroll") for (int _k = 0; _k < 4; ++_k) { const int _f = 4 * w + _k; \
            if (PASS == 1) __builtin_amdgcn_global_load_lds((const unsigned*)(QEF + (_it * 32 + _f) * 512 + lane * 8), (LAS unsigned*)(_st + GS_QE + _f * 1024), 16, 0, 0); \
            __builtin_amdgcn_global_load_lds((const unsigned*)(KLTF + (_it * 32 + _f) * 512 + lane * 8), (LAS unsigned*)(_st + GS_KLT + _f * 1024), 16, 0, 0); } \
        if (PASS == 1) __builtin_amdgcn_global_load_lds((const unsigned*)(ATTF + (_it * 8 + w) * 512 + lane * 8), (LAS unsigned*)(_st + GS_ATT + w * 1024), 16, 0, 0); \
        if (w == 0) __builtin_amdgcn_global_load_lds((const unsigned*)(DEC + _it * 256 + lane * 4), (LAS unsigned*)(_st + GS_DEC), 16, 0, 0); } while (0)
    for (int wi = blockIdx.x; wi < 256; wi += gridDim.x) {
        const int bh = wi & 7, rest = wi >> 3, seg = rest >> 2, vsl = rest & 3, h = bh & 3, b = bh >> 2;
        const int it0 = bh * 256 + seg * GLA_SEGLEN, vs16 = vsl * 8 + w;
        f32x4 S[16];
#pragma unroll
        for (int m = 0; m < 16; ++m) S[m] = (f32x4){0.f, 0.f, 0.f, 0.f};
        if (PASS == 1) {
            for (int s2 = 0; s2 < seg; ++s2) { const float* se = SEND + ((size_t)((bh * GLA_NSEG + s2) * 32 + vs16) * 16) * 256; const float* dt = DTOT + (size_t)(bh * GLA_NSEG + s2) * 256;
#pragma unroll
                for (int m = 0; m < 16; ++m) { const f32x4 dv = *(const GAS f32x4*)(dt + 16 * m + 4 * q), sv = *(const GAS f32x4*)(se + (m * 64 + lane) * 4); S[m] = S[m] * dv + sv; } }
        } else if (vsl == 0 && tid < 256) { float p = 1.f;
            for (int n = 0; n < GLA_SEGLEN; ++n) p *= DEC[(size_t)(it0 + n) * 256 + tid];
            DTOT[(size_t)(bh * GLA_NSEG + seg) * 256 + tid] = p; }
        __syncthreads();
        GS_ISSUE(it0, 0);
        const GAS bf16x8* v16 = (const GAS bf16x8*)VTF + (((size_t)it0 * 32 + vs16) * 2) * 64 + lane;
        bf16x8 vb0 = v16[0], vb1 = v16[64], nvb0 = vb0, nvb1 = vb1;
        for (int n = 0; n < GLA_SEGLEN; ++n) {
            VM_WAIT(); __syncthreads();
            if (n + 1 < GLA_SEGLEN) { GS_ISSUE(it0 + n + 1, (n + 1) & 1); nvb0 = v16[(size_t)(n + 1) * 4096]; nvb1 = v16[(size_t)(n + 1) * 4096 + 64]; }
            const LAS unsigned char* st = lds + (n & 1) * GS_STAGE;
            f32x4 po[4];
            if (PASS == 1) {
                bf16x8 sb[8];
#pragma unroll
                for (int ks = 0; ks < 8; ++ks) { v4u x; x.x = pk2(S[2 * ks][0], S[2 * ks][1]); x.y = pk2(S[2 * ks][2], S[2 * ks][3]); x.z = pk2(S[2 * ks + 1][0], S[2 * ks + 1][1]); x.w = pk2(S[2 * ks + 1][2], S[2 * ks + 1][3]); sb[ks] = __builtin_bit_cast(bf16x8, x); }
#pragma unroll
                for (int mt = 0; mt < 4; ++mt) { f32x4 a = {0.f, 0.f, 0.f, 0.f};
#pragma unroll
                    for (int ks = 0; ks < 8; ++ks) a = __builtin_amdgcn_mfma_f32_16x16x32_bf16(*(const LAS bf16x8*)(st + GS_QE + (ks * 4 + mt) * 1024 + lane * 16), sb[ks], a, 0, 0, 0);
                    a = __builtin_amdgcn_mfma_f32_16x16x32_bf16(*(const LAS bf16x8*)(st + GS_ATT + (mt * 2 + 0) * 1024 + lane * 16), vb0, a, 0, 0, 0);
                    a = __builtin_amdgcn_mfma_f32_16x16x32_bf16(*(const LAS bf16x8*)(st + GS_ATT + (mt * 2 + 1) * 1024 + lane * 16), vb1, a, 0, 0, 0);
                    po[mt] = a; }
            }
#pragma unroll
            for (int m = 0; m < 16; ++m) { const f32x4 dv = *(const LAS f32x4*)(st + GS_DEC + (16 * m + 4 * q) * 4);
                f32x4 s = S[m] * dv;
                s = __builtin_amdgcn_mfma_f32_16x16x32_bf16(*(const LAS bf16x8*)(st + GS_KLT + (m * 2 + 0) * 1024 + lane * 16), vb0, s, 0, 0, 0);
                s = __builtin_amdgcn_mfma_f32_16x16x32_bf16(*(const LAS bf16x8*)(st + GS_KLT + (m * 2 + 1) * 1024 + lane * 16), vb1, s, 0, 0, 0);
                S[m] = s; }
            if (PASS == 1) { bf16* op = O + (size_t)(b * SEQ + (seg * GLA_SEGLEN + n) * GLA_C + 4 * q) * 2048 + h * 512 + vsl * 128 + w * 16 + li;
#pragma unroll
                for (int mt = 0; mt < 4; ++mt)
#pragma unroll
                    for (int r = 0; r < 4; ++r) { const float x = po[mt][r], y = __shfl_xor(x, 1); if ((lane & 1) == 0) *(GAS unsigned*)(op + (size_t)(16 * mt + r) * 2048) = pk2(x, y); } }
            vb0 = nvb0; vb1 = nvb1;
        }
        if (PASS == 0) { float* se = SEND + ((size_t)((bh * GLA_NSEG + seg) * 32 + vs16) * 16) * 256;
#pragma unroll
            for (int m = 0; m < 16; ++m) *(GAS f32x4*)(se + (m * 64 + lane) * 4) = S[m]; }
        __syncthreads();
    }
#undef GS_ISSUE
}
__device__ __forceinline__ void gla_gate(const bf16* O, const bf16* R, const float* head_g, bf16* OG, int gw, int NGW, int lane) {
    float hg[8];
#pragma unroll
    for (int j = 0; j < 8; ++j) hg[j] = head_g[8 * lane + j];
    for (int m = gw; m < T; m += NGW) {
#pragma unroll
        for (int h = 0; h < 4; ++h) {
            const v4u ov = *(const GAS v4u*)(O + (size_t)m * 2048 + h * 512 + 8 * lane), rv = *(const GAS v4u*)(R + (size_t)m * 2048 + h * 512 + 8 * lane);
            float o[8] = {bf_lo(ov.x), bf_hi(ov.x), bf_lo(ov.y), bf_hi(ov.y), bf_lo(ov.z), bf_hi(ov.z), bf_lo(ov.w), bf_hi(ov.w)};
            float r[8] = {bf_lo(rv.x), bf_hi(rv.x), bf_lo(rv.y), bf_hi(rv.y), bf_lo(rv.z), bf_hi(rv.z), bf_lo(rv.w), bf_hi(rv.w)};
            float ss = 0.f;
#pragma unroll
            for (int j = 0; j < 8; ++j) ss += o[j] * o[j];
            const float rstd = rsqrtf(wave_sum(ss) * (1.f / 512.f) + RMS_EPS);
            float y[8];
#pragma unroll
            for (int j = 0; j < 8; ++j) y[j] = o[j] * rstd * hg[j] * pg8::silu_f(r[j]);
            v4u w; w.x = pk2(y[0], y[1]); w.y = pk2(y[2], y[3]); w.z = pk2(y[4], y[5]); w.w = pk2(y[6], y[7]);
            *(GAS v4u*)(OG + (size_t)m * 2048 + h * 512 + 8 * lane) = w;
        }
    }
}

__device__ __forceinline__ void moe_route(LAS unsigned char* lds, const float* RL, const float* SSP, const float* bgroup, const float* brouter, unsigned* gcnt, unsigned* EP0, unsigned* EP1, float* W0, float* W1, float* RSTD) {
    const int tid = threadIdx.x; LAS int* lcnt = (LAS int*)lds; LAS int* lbase = lcnt + 32;
    for (int base = blockIdx.x * 128; base < T; base += gridDim.x * 128) {
        if (tid < 32) lcnt[tid] = 0;
        __syncthreads();
        int e0 = 0, e1 = 0, r0 = 0, r1 = 0; float w0 = 0.f, w1 = 0.f;
        if (tid < 128) { const int t = base + tid; const float* rl = RL + (size_t)t * 64;
            float ssq = 0.f; { const GAS f32x4* sp = (const GAS f32x4*)(SSP + (size_t)t * 32);
#pragma unroll
                for (int k = 0; k < 8; ++k) { const f32x4 v = sp[k]; ssq += (v.x + v.y) + (v.z + v.w); } }
            const float rstd = rsqrtf(ssq * (1.f / D) + RMS_EPS); RSTD[t] = rstd;
            const f32x4 g4 = *(const GAS f32x4*)rl; float gl[4] = {g4.x * rstd + bgroup[0], g4.y * rstd + bgroup[1], g4.z * rstd + bgroup[2], g4.w * rstd + bgroup[3]};
            int g = 0; float best = gl[0];
#pragma unroll
            for (int j = 1; j < 4; ++j) if (gl[j] > best) { best = gl[j]; g = j; }
            float se = 0.f;
#pragma unroll
            for (int j = 0; j < 4; ++j) se += __expf(gl[j] - best);
            const float pg = 1.0f / se;
            const f32x4 a4 = *(const GAS f32x4*)(rl + 4 + 8 * g), b4 = *(const GAS f32x4*)(rl + 8 + 8 * g);
            float el[8] = {a4.x, a4.y, a4.z, a4.w, b4.x, b4.y, b4.z, b4.w};
#pragma unroll
            for (int j = 0; j < 8; ++j) el[j] = el[j] * rstd + brouter[8 * g + j];
            int i0 = 0; float v0 = el[0];
#pragma unroll
            for (int j = 1; j < 8; ++j) if (el[j] > v0) { v0 = el[j]; i0 = j; }
            int i1 = -1; float v1 = -3.0e38f;
#pragma unroll
            for (int j = 0; j < 8; ++j) if (j != i0 && el[j] > v1) { v1 = el[j]; i1 = j; }
            w0 = pg / (1.0f + __expf(v1 - v0)); w1 = pg - w0;
            e0 = 8 * g + i0; e1 = 8 * g + i1;
            r0 = __hip_atomic_fetch_add(&lcnt[e0], 1, __ATOMIC_RELAXED, __HIP_MEMORY_SCOPE_WORKGROUP); r1 = __hip_atomic_fetch_add(&lcnt[e1], 1, __ATOMIC_RELAXED, __HIP_MEMORY_SCOPE_WORKGROUP); }
        __syncthreads();
        if (tid < 32) lbase[tid] = (int)__hip_atomic_fetch_add(gcnt + tid, (unsigned)lcnt[tid], RLX_AGENT);
        __syncthreads();
        if (tid < 128) { const int t = base + tid;
            EP0[t] = ((unsigned)e0 << 24) | (unsigned)(lbase[e0] + r0); EP1[t] = ((unsigned)e1 << 24) | (unsigned)(lbase[e1] + r1); W0[t] = w0; W1[t] = w1; }
        __syncthreads();
    }
}
__device__ __forceinline__ void moe_build_table(LAS unsigned char* ldsbase, unsigned* gcnt) {
    LAS int* off = (LAS int*)(ldsbase + MOE_OFF_OFF); LAS unsigned char* texp = ldsbase + MOE_TEXP_OFF;
    __syncthreads();
    if (threadIdx.x == 0) { int acc = 0, ti = 0;
        for (int e = 0; e < NE; ++e) { const int c = (int)__hip_atomic_load(gcnt + e, RLX_AGENT); off[e] = acc; const int nt = (c + 255) >> 8;
            for (int k = 0; k < nt && ti < 288; ++k) texp[ti++] = (unsigned char)e;
            acc += nt * 256; }
        off[32] = acc; }
    __syncthreads();
}
__device__ __forceinline__ void moe_slots(LAS unsigned char* ldsbase, unsigned* gcnt, const unsigned* EP0, const unsigned* EP1, const float* RSTD, unsigned* SL0, unsigned* SL1, unsigned* TL, float* RS) {
    const LAS int* off = (const LAS int*)(ldsbase + MOE_OFF_OFF); const int tid = threadIdx.x;
    for (int t = blockIdx.x * 512 + tid; t < T; t += gridDim.x * 512) {
        const unsigned p0 = EP0[t], p1 = EP1[t]; const float rs = RSTD[t];
        const unsigned s0 = (unsigned)off[p0 >> 24] + (p0 & 0xffffffu), s1 = (unsigned)off[p1 >> 24] + (p1 & 0xffffffu);
        TL[s0] = (unsigned)t; RS[s0] = rs; TL[s1] = (unsigned)t; RS[s1] = rs; SL0[t] = s0; SL1[t] = s1; }
    for (int e = blockIdx.x; e < NE; e += gridDim.x) { const int c = (int)__hip_atomic_load(gcnt + e, RLX_AGENT);
        for (int i = off[e] + c + tid; i < off[e + 1]; i += 512) { TL[i] = 0u; RS[i] = 0.f; } }
}
template <bool FINAL>
__device__ __forceinline__ void moe_combine(const bf16* H, const bf16* Y, const unsigned* SL0, const unsigned* SL1, const float* W0, const float* W1, float* outf, bf16* H2, bf16* HN, int gw, int NGW, int lane) {
    for (int t = gw; t < T; t += NGW) {
        const unsigned s0 = SL0[t], s1 = SL1[t]; const float w0 = W0[t], w1 = W1[t];
        const GAS v2u* hr = (const GAS v2u*)(H + (size_t)t * D) + lane;
        const GAS v2u* y0 = (const GAS v2u*)(Y + (size_t)s0 * 2048) + lane; const GAS v2u* y1 = (const GAS v2u*)(Y + (size_t)s1 * 2048) + lane;
        f32x4 v[8]; float s = 0.f;
#pragma unroll
        for (int j = 0; j < 8; ++j) { const v2u a = y0[64 * j], b = y1[64 * j], hh = hr[64 * j]; f32x4 x;
            x.x = bf_lo(hh.x) + w0 * bf_lo(a.x) + w1 * bf_lo(b.x); x.y = bf_hi(hh.x) + w0 * bf_hi(a.x) + w1 * bf_hi(b.x); x.z = bf_lo(hh.y) + w0 * bf_lo(a.y) + w1 * bf_lo(b.y); x.w = bf_hi(hh.y) + w0 * bf_hi(a.y) + w1 * bf_hi(b.y);
            v[j] = x; s += (x.x * x.x + x.y * x.y) + (x.z * x.z + x.w * x.w); }
        if constexpr (FINAL) { GAS f32x4* xr = (GAS f32x4*)(outf + (size_t)t * D) + lane;
#pragma unroll
            for (int j = 0; j < 8; ++j) xr[64 * j] = v[j]; }
        else { const float rstd = rsqrtf(wave_sum(s) * (1.f / D) + RMS_EPS);
            GAS v2u* o8 = (GAS v2u*)(HN + (size_t)t * D) + lane; GAS v2u* h8 = (GAS v2u*)(H2 + (size_t)t * D) + lane;
#pragma unroll
            for (int j = 0; j < 8; ++j) { v2u o; o.x = pk2(v[j].x, v[j].y); o.y = pk2(v[j].z, v[j].w); h8[64 * j] = o;
                o.x = pk2(v[j].x * rstd, v[j].y * rstd); o.y = pk2(v[j].z * rstd, v[j].w * rstd); o8[64 * j] = o; } }
    }
}

__device__ const unsigned char T5_BUCKET[128] = {0,1,2,3,4,5,6,7,8,9,10,11,12,13,14,15,16,16,16,17,17,18,18,18,19,19,19,20,20,20,20,21,21,21,21,22,22,22,22,22,23,23,23,23,23,23,24,24,24,24,24,24,25,25,25,25,25,25,25,26,26,26,26,26,26,26,26,27,27,27,27,27,27,27,27,27,27,28,28,28,28,28,28,28,28,28,28,29,29,29,29,29,29,29,29,29,29,29,29,30,30,30,30,30,30,30,30,30,30,30,30,30,30,31,31,31,31,31,31,31,31,31,31,31,31,31,31,31};
constexpr int AT_K = 0, AT_VT = 36864, AT_BIAS = 70656;
__device__ __forceinline__ void swa_attention(LAS unsigned char* lds, const bf16* KVQ, const float* knorm, const float* qnorm, const float* relb, const float* sinks, bf16* AO) {
    const int tid = threadIdx.x, lane = tid & 63, g = __builtin_amdgcn_readfirstlane(tid >> 6), li = lane & 15, q = lane >> 4;
    LAS bf16* KL = (LAS bf16*)(lds + AT_K); LAS bf16* VTL = (LAS bf16*)(lds + AT_VT); LAS float* BL = (LAS float*)(lds + AT_BIAS);
    float qn[2][8];
#pragma unroll
    for (int ks = 0; ks < 2; ++ks)
#pragma unroll
        for (int j = 0; j < 8; ++j) qn[ks][j] = qnorm[32 * ks + 8 * q + j] * 0.125f;
    for (int wi = blockIdx.x; wi < 1024; wi += gridDim.x) {
        const int hk = wi & 3, n = (wi >> 2) & 127, b = wi >> 9;
        __syncthreads();
        { const int key = tid >> 1, hf = tid & 1; const bool live = (n > 0) || (key >= 128);
          const size_t tk = (size_t)b * SEQ + (size_t)(n - 1) * 128 + key;
          const bf16* kp = KVQ + tk * KVQ_N + hk * 64 + 32 * hf;
          v4u kw[4], vw[4];
#pragma unroll
          for (int j = 0; j < 4; ++j) { kw[j] = live ? *(const GAS v4u*)(kp + 8 * j) : (v4u){0u, 0u, 0u, 0u}; vw[j] = live ? *(const GAS v4u*)(kp + 256 + 8 * j) : (v4u){0u, 0u, 0u, 0u}; }
          float ss = 0.f;
#pragma unroll
          for (int j = 0; j < 4; ++j) { const float a0 = bf_lo(kw[j].x), a1 = bf_hi(kw[j].x), a2 = bf_lo(kw[j].y), a3 = bf_hi(kw[j].y), a4 = bf_lo(kw[j].z), a5 = bf_hi(kw[j].z), a6 = bf_lo(kw[j].w), a7 = bf_hi(kw[j].w);
              ss += (a0 * a0 + a1 * a1) + (a2 * a2 + a3 * a3) + (a4 * a4 + a5 * a5) + (a6 * a6 + a7 * a7); }
          ss += __shfl_xor(ss, 1);
          const float rstd = rsqrtf(ss * (1.f / 64.f) + RMS_EPS);
#pragma unroll
          for (int j = 0; j < 4; ++j) { const float* kn = knorm + 32 * hf + 8 * j; v4u o;
              o.x = pk2(bf_lo(kw[j].x) * rstd * kn[0], bf_hi(kw[j].x) * rstd * kn[1]); o.y = pk2(bf_lo(kw[j].y) * rstd * kn[2], bf_hi(kw[j].y) * rstd * kn[3]);
              o.z = pk2(bf_lo(kw[j].z) * rstd * kn[4], bf_hi(kw[j].z) * rstd * kn[5]); o.w = pk2(bf_lo(kw[j].w) * rstd * kn[6], bf_hi(kw[j].w) * rstd * kn[7]);
              *(LAS v4u*)(KL + key * 72 + 32 * hf + 8 * j) = o; }
#pragma unroll
          for (int j = 0; j < 4; ++j) { const int d0 = 32 * hf + 8 * j;
              VTL[(d0 + 0) * 264 + key] = (bf16)(vw[j].x & 0xffffu); VTL[(d0 + 1) * 264 + key] = (bf16)(vw[j].x >> 16); VTL[(d0 + 2) * 264 + key] = (bf16)(vw[j].y & 0xffffu); VTL[(d0 + 3) * 264 + key] = (bf16)(vw[j].y >> 16);
              VTL[(d0 + 4) * 264 + key] = (bf16)(vw[j].z & 0xffffu); VTL[(d0 + 5) * 264 + key] = (bf16)(vw[j].z >> 16); VTL[(d0 + 6) * 264 + key] = (bf16)(vw[j].w & 0xffffu); VTL[(d0 + 7) * 264 + key] = (bf16)(vw[j].w >> 16); }
#pragma unroll
          for (int k = 0; k < 2; ++k) { const int e = tid + 512 * k, gg = e >> 7, dist = e & 127; BL[e] = relb[(int)T5_BUCKET[dist] * 32 + hk * 8 + gg]; }
        }
        __syncthreads();
        const int head = hk * 8 + g; const float sink = sinks[head];
        for (int mt = 0; mt < 8; ++mt) {
            const size_t tq = (size_t)b * SEQ + (size_t)n * 128 + 16 * mt + li;
            bf16x8 qf[2];
            { const bf16* qp = KVQ + tq * KVQ_N + 512 + head * 64 + 8 * q; const v4u q0 = *(const GAS v4u*)qp, q1 = *(const GAS v4u*)(qp + 32);
              float a[16] = {bf_lo(q0.x), bf_hi(q0.x), bf_lo(q0.y), bf_hi(q0.y), bf_lo(q0.z), bf_hi(q0.z), bf_lo(q0.w), bf_hi(q0.w), bf_lo(q1.x), bf_hi(q1.x), bf_lo(q1.y), bf_hi(q1.y), bf_lo(q1.z), bf_hi(q1.z), bf_lo(q1.w), bf_hi(q1.w)};
              float ss = 0.f;
#pragma unroll
              for (int j = 0; j < 16; ++j) ss += a[j] * a[j];
              ss += __shfl_xor(ss, 16); ss += __shfl_xor(ss, 32);
              const float rstd = rsqrtf(ss * (1.f / 64.f) + RMS_EPS);
              v4u w0, w1;
              w0.x = pk2(a[0] * rstd * qn[0][0], a[1] * rstd * qn[0][1]); w0.y = pk2(a[2] * rstd * qn[0][2], a[3] * rstd * qn[0][3]); w0.z = pk2(a[4] * rstd * qn[0][4], a[5] * rstd * qn[0][5]); w0.w = pk2(a[6] * rstd * qn[0][6], a[7] * rstd * qn[0][7]);
              w1.x = pk2(a[8] * rstd * qn[1][0], a[9] * rstd * qn[1][1]); w1.y = pk2(a[10] * rstd * qn[1][2], a[11] * rstd * qn[1][3]); w1.z = pk2(a[12] * rstd * qn[1][4], a[13] * rstd * qn[1][5]); w1.w = pk2(a[14] * rstd * qn[1][6], a[15] * rstd * qn[1][7]);
              qf[0] = __builtin_bit_cast(bf16x8, w0); qf[1] = __builtin_bit_cast(bf16x8, w1); }
            f32x4 st[9]; float mx = sink;
#pragma unroll
            for (int tt = 0; tt < 9; ++tt) { const int nt = mt + tt; f32x4 acc = {0.f, 0.f, 0.f, 0.f};
#pragma unroll
                for (int ks = 0; ks < 2; ++ks) { const bf16x8 a = *(const LAS bf16x8*)(KL + (16 * nt + li) * 72 + 32 * ks + 8 * q); acc = __builtin_amdgcn_mfma_f32_16x16x32_bf16(a, qf[ks], acc, 0, 0, 0); }
#pragma unroll
                for (int r = 0; r < 4; ++r) { const int col = 16 * nt + 4 * q + r, row = 16 * mt + li, dist = 128 + row - col;
                    const bool valid = (dist >= 0) && (dist < 128) && ((col >= 128) || (n > 0));
                    const float s = valid ? acc[r] + BL[g * 128 + (dist & 127)] : -__builtin_inff();
                    acc[r] = s; mx = fmaxf(mx, s); }
                st[tt] = acc; }
            mx = fmaxf(mx, __shfl_xor(mx, 16)); mx = fmaxf(mx, __shfl_xor(mx, 32));
            float lsum = 0.f;
#pragma unroll
            for (int tt = 0; tt < 9; ++tt)
#pragma unroll
                for (int r = 0; r < 4; ++r) { const float p = __expf(st[tt][r] - mx); st[tt][r] = p; lsum += p; }
            lsum += __shfl_xor(lsum, 16); lsum += __shfl_xor(lsum, 32);
            const float inv = 1.0f / (lsum + __expf(sink - mx));
            f32x4 oacc[4];
#pragma unroll
            for (int dt = 0; dt < 4; ++dt) oacc[dt] = (f32x4){0.f, 0.f, 0.f, 0.f};
#pragma unroll
            for (int s = 0; s < 5; ++s) {
                v4u pw; pw.x = pk2(st[2 * s][0], st[2 * s][1]); pw.y = pk2(st[2 * s][2], st[2 * s][3]);
                if (s < 4) { pw.z = pk2(st[2 * s + 1][0], st[2 * s + 1][1]); pw.w = pk2(st[2 * s + 1][2], st[2 * s + 1][3]); } else { pw.z = 0u; pw.w = 0u; }
                const bf16x8 pb = __builtin_bit_cast(bf16x8, pw);
                const int k0 = 16 * (mt + 2 * s) + 4 * q; int k1 = 16 * (mt + 2 * s + 1) + 4 * q; if (k1 > 252) k1 = 240 + 4 * q;
#pragma unroll
                for (int dt = 0; dt < 4; ++dt) { const v2u lo = *(const LAS v2u*)(VTL + (16 * dt + li) * 264 + k0), hi = *(const LAS v2u*)(VTL + (16 * dt + li) * 264 + k1);
                    v4u aw; aw.x = lo.x; aw.y = lo.y; aw.z = hi.x; aw.w = hi.y;
                    oacc[dt] = __builtin_amdgcn_mfma_f32_16x16x32_bf16(__builtin_bit_cast(bf16x8, aw), pb, oacc[dt], 0, 0, 0); } }
#pragma unroll
            for (int dt = 0; dt < 4; ++dt) { v2u o; o.x = pk2(oacc[dt][0] * inv, oacc[dt][1] * inv); o.y = pk2(oacc[dt][2] * inv, oacc[dt][3] * inv);
                *(GAS v2u*)(AO + tq * 2048 + head * 64 + 16 * dt + 4 * q) = o; }
        }
    }
}

struct Args { const float* in[24]; float* out; unsigned char* ws; int ph_lo, ph_hi; };
constexpr int N_PHASES = 23;
#define CAS __attribute__((address_space(4)))
template <int WHICH> struct OrderCvt : pg8::StaticOrder {
    int tpm, tpn, gw, NGW, lane;
    __device__ __forceinline__ void set_trigger(int when) { pg8::Unit u; if (!next(when, u)) (void)next(0, u); tpm = u.pm; tpn = u.pn; }
    __device__ __forceinline__ void done(const pg8::Unit& u) const {
        if (u.pm != tpm || u.pn != tpn) return;
        const CAS Args* a = (const CAS Args*)__builtin_amdgcn_kernarg_segment_ptr();
        unsigned char* ws = a->ws;
        if (WHICH == 0) {
            cvt_matrix(a->in[6], 2048, 2048, nullptr, (bf16*)(ws + WS_W_GLA_OUT), 0, gw, NGW, lane);
            cvt_matrix(a->in[8], 2048, 512, a->in[7], (bf16*)(ws + WS_W_KVQ), 0, gw, NGW, lane);
            cvt_matrix(a->in[12], 2048, 2048, a->in[11], (bf16*)(ws + WS_W_KVQ), 512, gw, NGW, lane);
            cvt_matrix(a->in[15], 2048, 2048, nullptr, (bf16*)(ws + WS_W_SWA_OUT), 0, gw, NGW, lane);
            for (int l = 0; l < 2; ++l) {
                cvt_matrix(a->in[17] + (size_t)l * 2048 * 4, 2048, 4, a->in[16] + l * 2048, (bf16*)(ws + WS_W_ROUTER) + (size_t)l * 256 * 2048, 0, gw, NGW, lane);
                cvt_matrix(a->in[19] + (size_t)l * 2048 * 32, 2048, 32, a->in[16] + l * 2048, (bf16*)(ws + WS_W_ROUTER) + (size_t)l * 256 * 2048, 4, gw, NGW, lane);
            }
            cvt_moe(a->in[21], a->in[22], a->in[23], a->in[16], (bf16*)(ws + WS_W_GU), (bf16*)(ws + WS_W_DN), gw, NGW, lane);
        } else {
            cvt_moe(a->in[21] + (size_t)NE * 2048 * 512, a->in[22] + (size_t)NE * 2048 * 512, a->in[23] + (size_t)NE * 512 * 2048, a->in[16] + 2048, (bf16*)(ws + WS_W_GU), (bf16*)(ws + WS_W_DN), gw, NGW, lane);
        }
    }
};
__global__ void __launch_bounds__(NWAVES * 64, 2) fwd(Args args) {
    extern __shared__ __attribute__((aligned(16))) unsigned char lds_raw[];
    LAS unsigned char* lds = (LAS unsigned char*)lds_raw;
    const int tid = threadIdx.x, lane = tid & 63, wave = __builtin_amdgcn_readfirstlane(tid >> 6);
    const int G = gridDim.x, gw = blockIdx.x * NWAVES + wave, NGW = G * NWAVES;
    unsigned char* ws = args.ws;
    gu32* ctl = (gu32*)(ws + WS_CTL);
    for (int u = tid; u < (LDS_BYTES - LDSCTL_OFF) / 4; u += NWAVES * 64) ((LAS unsigned*)(lds + LDSCTL_OFF))[u] = 0u;
    __syncthreads();
    XcdBarrier bar = xcd_barrier_post((unsigned*)(ctl + CW_BAR), (volatile LAS unsigned*)(lds + MISC_OFF));
    const int lo = args.ph_lo, hi = args.ph_hi;
#define IN(k) ((((MK_PHASE_MASK) >> (k)) & 1) && lo <= (k) && (k) < hi)
#define PB(k) const unsigned long long _pt0 = (((MK_DELAY_MASK) >> (k)) & 1) ? __builtin_amdgcn_s_memrealtime() : 0ull
#define PE(k) do { if (((MK_DELAY_MASK) >> (k)) & 1) { const unsigned long long _pt1 = __builtin_amdgcn_s_memrealtime(), _dt = _pt1 - _pt0; while (__builtin_amdgcn_s_memrealtime() - _pt1 < _dt) __builtin_amdgcn_s_sleep(8); } } while (0)
#define SEAM(k) do { if (IN(k) && IN((k) + 1)) xcd_barrier(bar); } while (0)

    const float* x = args.in[0]; float* out = args.out;
    bf16* W_GLA_IN = (bf16*)(ws + WS_W_GLA_IN); bf16* W_GLA_OUT = (bf16*)(ws + WS_W_GLA_OUT); bf16* W_KVQ = (bf16*)(ws + WS_W_KVQ); bf16* W_SWA_OUT = (bf16*)(ws + WS_W_SWA_OUT);
    bf16* W_ROUTER = (bf16*)(ws + WS_W_ROUTER); bf16* W_GU = (bf16*)(ws + WS_W_GU); bf16* W_DN = (bf16*)(ws + WS_W_DN);
    bf16* HN = (bf16*)(ws + WS_HN);
    unsigned* EP0 = (unsigned*)(ws + WS_TOK); unsigned* EP1 = EP0 + T; unsigned* SL0 = EP1 + T; unsigned* SL1 = SL0 + T; float* TW0 = (float*)(SL1 + T); float* TW1 = TW0 + T; float* RSTD = TW1 + T;
    bf16* HB = (bf16*)(ws + WS_HB); float* SSP = (float*)(ws + WS_SSP); unsigned* TL = (unsigned*)(ws + WS_TL); float* RS = (float*)(ws + WS_RS);
    float* RL = (float*)(ws + WS_RL);

    if (IN(0)) { PB(0);
        cvt_matrix(args.in[2], 2048, GLA_PROJ_N, args.in[1], W_GLA_IN, 0, gw, NGW, lane);
        norm_rows(x, HN, gw, NGW, lane);
        PE(0);
    }
    SEAM(0);
    if (IN(1)) { PB(1);
        pg8::Gemm g{HN, W_GLA_IN, T, GLA_PROJ_NP, 2048}; OrderCvt<0> S; S.init(T, GLA_PROJ_NP, G, (int)blockIdx.x); S.gw = gw; S.NGW = NGW; S.lane = lane; S.set_trigger((int)(blockIdx.x % 12));
        pg8::EpiGlaProj E{(bf16*)(ws + WS_QK), (bf16*)(ws + WS_V), (bf16*)(ws + WS_R), (bf16*)(ws + WS_GL)};
        pg8::gemm_phase<pg8::EpiGlaProj, OrderCvt<0>, true, true>(lds + RING_OFF, g, S, E);
        PE(1);
    }
    SEAM(1);
    if (IN(2)) { PB(2); gla_prepass(lds + RING_OFF, (const bf16*)(ws + WS_QK), (const bf16*)(ws + WS_V), (const bf16*)(ws + WS_GL), args.in[3], args.in[4],
                           (bf16*)(ws + WS_QEF), (bf16*)(ws + WS_KLTF), (bf16*)(ws + WS_ATTF), (bf16*)(ws + WS_VTF), (float*)(ws + WS_DEC)); PE(2); }
    SEAM(2);
    if (IN(3)) { PB(3); gla_scan<0>(lds + RING_OFF, (const bf16*)(ws + WS_QEF), (const bf16*)(ws + WS_KLTF), (const bf16*)(ws + WS_ATTF), (const bf16*)(ws + WS_VTF), (const float*)(ws + WS_DEC), (float*)(ws + WS_SEND), (float*)(ws + WS_DTOT), (bf16*)(ws + WS_QK)); PE(3); }
    SEAM(3);
    if (IN(4)) { PB(4); gla_scan<1>(lds + RING_OFF, (const bf16*)(ws + WS_QEF), (const bf16*)(ws + WS_KLTF), (const bf16*)(ws + WS_ATTF), (const bf16*)(ws + WS_VTF), (const float*)(ws + WS_DEC), (float*)(ws + WS_SEND), (float*)(ws + WS_DTOT), (bf16*)(ws + WS_QK)); PE(4); }
    SEAM(4);
    if (IN(5)) { PB(5); gla_gate((const bf16*)(ws + WS_QK), (const bf16*)(ws + WS_R), args.in[5], HN, gw, NGW, lane); PE(5); }
    SEAM(5);
    if (IN(6)) { PB(6);
        pg8::Gemm g{HN, W_GLA_OUT, T, 2048, 2048}; pg8::StaticOrder S; S.init(T, 2048, G, (int)blockIdx.x);
        pg8::EpiResBf16<false> E{x, 2048, HB, SSP};
        pg8::gemm_phase<pg8::EpiResBf16<false>, pg8::StaticOrder, true, true>(lds + RING_OFF, g, S, E);
        PE(6);
    }
    SEAM(6);

    { constexpr int layer = 0; constexpr int pb = 6 + 10 * layer;
    unsigned* gcnt = (unsigned*)(ctl + CW_CNT + layer * 64);
    if (IN(pb + 1)) { PB(pb + 1);
        pg8::Gemm g{HB, W_ROUTER + (size_t)layer * 256 * 2048, T, 256, 2048}; pg8::StaticOrder S; S.init(T, 256, G, (int)blockIdx.x);
        pg8::EpiRouter E{RL};
        pg8::gemm_phase<pg8::EpiRouter, pg8::StaticOrder, true, true>(lds + RING_OFF, g, S, E);
        PE(pb + 1);
    }
    SEAM(pb + 1);
    if (IN(pb + 2)) { PB(pb + 2); moe_route(lds + RING_OFF, RL, SSP, args.in[18] + layer * 4, args.in[20] + layer * 32, gcnt, EP0, EP1, TW0, TW1, RSTD); PE(pb + 2); }
    SEAM(pb + 2);
    if (IN(pb + 3)) { PB(pb + 3); { moe_build_table(lds, gcnt); moe_slots(lds, gcnt, EP0, EP1, RSTD, SL0, SL1, TL, RS); } PE(pb + 3); }
    SEAM(pb + 3);
    if (IN(pb + 4)) { PB(pb + 4);
        moe_build_table(lds, gcnt);
        const int rows = __builtin_amdgcn_readfirstlane(((const LAS int*)(lds + MOE_OFF_OFF))[32]);
        pg8::Gemm g{HB, W_GU, rows, 1024, 2048, TL};
        pg8::GroupedOrder S{(const LAS unsigned char*)(lds + MOE_TEXP_OFF), rows >> 8, 4, G, (int)blockIdx.x};
        pg8::EpiSwiGLU E{(bf16*)(ws + WS_ACT), RS};
        pg8::gemm_phase<pg8::EpiSwiGLU, pg8::GroupedOrder, true, true, true>(lds + RING_OFF, g, S, E);
        PE(pb + 4);
    }
    SEAM(pb + 4);
    if (IN(pb + 5)) { PB(pb + 5);
        moe_build_table(lds, gcnt);
        const int rows = __builtin_amdgcn_readfirstlane(((const LAS int*)(lds + MOE_OFF_OFF))[32]);
        pg8::Gemm g{(const bf16*)(ws + WS_ACT), W_DN, rows, 2048, 512};
        pg8::GroupedOrder S{(const LAS unsigned char*)(lds + MOE_TEXP_OFF), rows >> 8, 8, G, (int)blockIdx.x};
        pg8::EpiBf16 E{(bf16*)(ws + WS_Y), 2048};
        pg8::gemm_phase<pg8::EpiBf16, pg8::GroupedOrder, true, true>(lds + RING_OFF, g, S, E);
        PE(pb + 5);
    }
    SEAM(pb + 5);
    if (IN(pb + 6)) { PB(pb + 6);
        moe_combine<false>(HB, (const bf16*)(ws + WS_Y), SL0, SL1, TW0, TW1, nullptr, (bf16*)out, HN, gw, NGW, lane);
        PE(pb + 6);
    }
    if (layer == 0) SEAM(pb + 6);
    }
    if (IN(13)) { PB(13);
        pg8::Gemm g{HN, W_KVQ, T, KVQ_N, 2048}; OrderCvt<1> S; S.init(T, KVQ_N, G, (int)blockIdx.x); S.gw = gw; S.NGW = NGW; S.lane = lane; S.set_trigger((int)(blockIdx.x % 5));
        pg8::EpiBf16 E{(bf16*)(ws + WS_KVQ), KVQ_N};
        pg8::gemm_phase<pg8::EpiBf16, OrderCvt<1>, true, true>(lds + RING_OFF, g, S, E);
        PE(13);
    }
    SEAM(13);
    if (IN(14)) { PB(14); swa_attention(lds + RING_OFF, (const bf16*)(ws + WS_KVQ), args.in[9], args.in[13], args.in[10], args.in[14], (bf16*)(ws + WS_AO)); PE(14); }
    SEAM(14);
    if (IN(15)) { PB(15);
        pg8::Gemm g{(const bf16*)(ws + WS_AO), W_SWA_OUT, T, 2048, 2048}; pg8::StaticOrder S; S.init(T, 2048, G, (int)blockIdx.x);
        pg8::EpiResBf16<true> E{(const bf16*)out, 2048, HB, SSP};
        pg8::gemm_phase<pg8::EpiResBf16<true>, pg8::StaticOrder, true, true>(lds + RING_OFF, g, S, E);
        PE(15);
    }
    SEAM(15);
    { constexpr int layer = 1; constexpr int pb = 6 + 10 * layer;
    unsigned* gcnt = (unsigned*)(ctl + CW_CNT + layer * 64);
    if (IN(pb + 1)) { PB(pb + 1);
        pg8::Gemm g{HB, W_ROUTER + (size_t)layer * 256 * 2048, T, 256, 2048}; pg8::StaticOrder S; S.init(T, 256, G, (int)blockIdx.x);
        pg8::EpiRouter E{RL};
        pg8::gemm_phase<pg8::EpiRouter, pg8::StaticOrder, true, true>(lds + RING_OFF, g, S, E);
        PE(pb + 1);
    }
    SEAM(pb + 1);
    if (IN(pb + 2)) { PB(pb + 2); moe_route(lds + RING_OFF, RL, SSP, args.in[18] + layer * 4, args.in[20] + layer * 32, gcnt, EP0, EP1, TW0, TW1, RSTD); PE(pb + 2); }
    SEAM(pb + 2);
    if (IN(pb + 3)) { PB(pb + 3); { moe_build_table(lds, gcnt); moe_slots(lds, gcnt, EP0, EP1, RSTD, SL0, SL1, TL, RS); } PE(pb + 3); }
    SEAM(pb + 3);
    if (IN(pb + 4)) { PB(pb + 4);
        moe_build_table(lds, gcnt);
        const int rows = __builtin_amdgcn_readfirstlane(((const LAS int*)(lds + MOE_OFF_OFF))[32]);
        pg8::Gemm g{HB, W_GU, rows, 1024, 2048, TL};
        pg8::GroupedOrder S{(const LAS unsigned char*)(lds + MOE_TEXP_OFF), rows >> 8, 4, G, (int)blockIdx.x};
        pg8::EpiSwiGLU E{(bf16*)(ws + WS_ACT), RS};
        pg8::gemm_phase<pg8::EpiSwiGLU, pg8::GroupedOrder, true, true, true>(lds + RING_OFF, g, S, E);
        PE(pb + 4);
    }
    SEAM(pb + 4);
    if (IN(pb + 5)) { PB(pb + 5);
        moe_build_table(lds, gcnt);
        const int rows = __builtin_amdgcn_readfirstlane(((const LAS int*)(lds + MOE_OFF_OFF))[32]);
        pg8::Gemm g{(const bf16*)(ws + WS_ACT), W_DN, rows, 2048, 512};
        pg8::GroupedOrder S{(const LAS unsigned char*)(lds + MOE_TEXP_OFF), rows >> 8, 8, G, (int)blockIdx.x};
        pg8::EpiBf16 E{(bf16*)(ws + WS_Y), 2048};
        pg8::gemm_phase<pg8::EpiBf16, pg8::GroupedOrder, true, true>(lds + RING_OFF, g, S, E);
        PE(pb + 5);
    }
    SEAM(pb + 5);
    if (IN(pb + 6)) { PB(pb + 6);
        moe_combine<true>(HB, (const bf16*)(ws + WS_Y), SL0, SL1, TW0, TW1, out, nullptr, nullptr, gw, NGW, lane);
        PE(pb + 6);
    }
    if (layer == 0) SEAM(pb + 6);
    }
#undef IN
#undef SEAM
}

extern "C" void kernel_launch(void* const* d_in, const int* in_sizes, int n_in, void* d_out, int out_size, void* d_ws, size_t ws_size, hipStream_t stream) {
    static int grid = 0;
    if (grid == 0) {
        if (n_in != 24 || in_sizes[0] != T * D || out_size != T * D || ws_size < WS_END) { fprintf(stderr, "kernel_launch: unexpected shapes / workspace (n_in %d, in0 %d, out %d, ws %zu < %zu)\n", n_in, n_in > 0 ? in_sizes[0] : -1, out_size, ws_size, (size_t)WS_END); grid = -1; return; }
        int dev = 0, cus = 0, per_cu = 0;
        if (hipGetDevice(&dev) != hipSuccess || hipDeviceGetAttribute(&cus, hipDeviceAttributeMultiprocessorCount, dev) != hipSuccess) { grid = -1; return; }
        if (hipFuncSetAttribute((const void*)fwd, hipFuncAttributeMaxDynamicSharedMemorySize, LDS_BYTES) != hipSuccess) { fprintf(stderr, "kernel_launch: hipFuncSetAttribute failed\n"); grid = -1; return; }
        if (hipOccupancyMaxActiveBlocksPerMultiprocessor(&per_cu, (const void*)fwd, NWAVES * 64, LDS_BYTES) != hipSuccess || per_cu < 1) { fprintf(stderr, "kernel_launch: occupancy query says %d\n", per_cu); }
        (void)hipGetLastError();
        grid = cus;
    }
    if (grid < 0) return;
    if (hipMemsetAsync((char*)d_ws + WS_CTL, 0, CTL_ZERO_BYTES, stream) != hipSuccess) return;
    Args a{};
    for (int i = 0; i < 24; ++i) a.in[i] = (const float*)d_in[i];
    a.out = (float*)d_out; a.ws = (unsigned char*)d_ws;
#if MK_PER_PHASE
    for (int p = 0; p < MK_LAST_PHASE; ++p) { a.ph_lo = p; a.ph_hi = p + 1; hipLaunchKernelGGL(fwd, dim3(grid), dim3(NWAVES * 64), LDS_BYTES, stream, a); }
#else
    a.ph_lo = 0; a.ph_hi = MK_LAST_PHASE;
    hipLaunchKernelGGL(fwd, dim3(grid), dim3(NWAVES * 64), LDS_BYTES, stream, a);
#endif
    const hipError_t le = hipPeekAtLastError();
    if (le != hipSuccess) fprintf(stderr, "kernel_launch: launch failed: %s\n", hipGetErrorName(le));
}
```

```cpp
#include <hip/hip_runtime.h>
#include <cstdio>
#include <cstdint>

#ifndef MK_PER_PHASE
#define MK_PER_PHASE 0
#endif
#ifndef MK_LAST_PHASE
#define MK_LAST_PHASE 23
#endif

#ifndef MK_PHASE_MASK
#define MK_PHASE_MASK 0x7fffff
#endif

#ifndef MK_DELAY_MASK
#define MK_DELAY_MASK 0
#endif

#ifndef MK_STAG1
#define MK_STAG1 0
#endif

#ifndef MK_EPI2
#define MK_EPI2 0
#endif

namespace pg8 {
#define PG8_LAS __attribute__((address_space(3)))
typedef unsigned short bf16_t;
typedef short bf16x8 __attribute__((ext_vector_type(8)));
typedef float f32x4 __attribute__((ext_vector_type(4)));
typedef unsigned u32x4 __attribute__((ext_vector_type(4)));
constexpr int BM = 256, BK = 64, HALF = 128, HTB = HALF * BK * 2  , STAGE_BYTES = 8 * HTB, NXCD = 8, WGM = 8;

__host__ __device__ __forceinline__ int lds_byte(int r, int c) { const int st = (r >> 4) * 2 + (c >> 5), rr = r & 15, cc = c & 31, ob = rr * 64 + cc * 2; return st * 1024 + (ob ^ (((ob >> 9) & 1) << 5)); }
__host__ __device__ __forceinline__ void stage_rc(int b, int& R, int& C) { const int st = b / 1024, sb = b % 1024, swz = sb ^ (((sb >> 9) & 1) << 5); R = (st >> 1) * 16 + swz / 64; C = (st & 1) * 32 + (swz % 64) / 2; }
__host__ __device__ __forceinline__ int perm32(int rho) { const int n = rho >> 4, i = rho & 15; return 8 * (i >> 2) + 4 * n + (i & 3); }

struct Unit { int pm, pn, pc; };
struct Gemm { const bf16_t* A; const bf16_t* Bt; int M, N, K; const unsigned* rowidx; };


struct StaticOrder {
    int nM, nN, nwg, G, c;
    __host__ __device__ void init(int M, int N, int G_, int c_) { nM = M / BM; nN = N / BM; nwg = nM * nN; G = G_; c = c_; }
    __host__ __device__ bool next(int i, Unit& u) const {
        const long L = (long)i * G + c; if (L >= nwg) return false;
        int wgid = (int)L; { const int q = nwg / NXCD, r = nwg % NXCD, xcd = wgid % NXCD, off = wgid / NXCD; wgid = (xcd < r ? xcd * (q + 1) : r * (q + 1) + (xcd - r) * q) + off; }
        const int nig = WGM * nN, gid = wgid / nig, fm = gid * WGM, gsz = (nM - fm) < WGM ? (nM - fm) : WGM;
        u.pm = fm + ((wgid % nig) % gsz); u.pn = (wgid % nig) / gsz; u.pc = u.pn; return true;
    }
    __device__ __forceinline__ void a_ready(const Unit&) const {}
    __device__ __forceinline__ void done(const Unit&) const {}
};
struct GroupedOrder {
    const PG8_LAS unsigned char* texp; int MT, npn, G, c;
    __device__ __forceinline__ bool next(int i, Unit& u) const {
        const long L = (long)i * G + c; if (L >= (long)MT * npn) return false;
        const int pm = (int)(L / npn), pc = (int)(L % npn);
        const int e = __builtin_amdgcn_readfirstlane((int)texp[pm]);
        u.pm = pm; u.pn = e * npn + pc; u.pc = pc; return true;
    }
    __device__ __forceinline__ void a_ready(const Unit&) const {}
    __device__ __forceinline__ void done(const Unit&) const {}
};

__device__ __forceinline__ unsigned cvt_pk_bf16(float lo, float hi) { unsigned r; asm volatile("v_cvt_pk_bf16_f32 %0, %1, %2" : "=v"(r) : "v"(lo), "v"(hi)); return r; }

struct EpiBf16 {
    static constexpr bool PERM = true, AFTER_DRAIN = false;
    bf16_t* O; int ldc;
    __device__ __forceinline__ void operator()(const f32x4 (&acc)[2][2][4][2], const Unit& u, int wr, int wc, int fr, int fq) const {
        const int row0 = u.pm * BM + wr * 64 + fr, col0 = u.pc * BM + wc * 32 + 8 * fq;
#pragma unroll
        for (int ai = 0; ai < 2; ++ai)
#pragma unroll
            for (int m = 0; m < 4; ++m) { bf16_t* rowp = O + (size_t)(row0 + ai * HALF + m * 16) * ldc + col0;
#pragma unroll
                for (int bj = 0; bj < 2; ++bj) { const f32x4 v0 = acc[ai][bj][m][0], v1 = acc[ai][bj][m][1];
                    u32x4 w; w.x = cvt_pk_bf16(v0[0], v0[1]); w.y = cvt_pk_bf16(v0[2], v0[3]); w.z = cvt_pk_bf16(v1[0], v1[1]); w.w = cvt_pk_bf16(v1[2], v1[3]);
                    *(u32x4*)(rowp + bj * HALF) = w; } }
    }
};
struct EpiKVQ {
    static constexpr bool PERM = true, AFTER_DRAIN = false;
    bf16_t* O; bf16_t* VT;
    __device__ __forceinline__ void operator()(const f32x4 (&acc)[2][2][4][2], const Unit& u, int wr, int wc, int fr, int fq) const {
        const int row0 = u.pm * BM + wr * 64 + fr;
        if (u.pc == 1) {
#pragma unroll
            for (int ai = 0; ai < 2; ++ai)
#pragma unroll
                for (int m = 0; m < 4; ++m) { const int t = row0 + ai * HALF + m * 16, b = t >> 14, s = t & 16383;
#pragma unroll
                    for (int bj = 0; bj < 2; ++bj)
#pragma unroll
                        for (int n = 0; n < 2; ++n) { const int cv = bj * HALF + wc * 32 + 8 * fq + 4 * n; bf16_t* p = VT + ((size_t)(b * 4 + (cv >> 6)) * 64 + (cv & 63)) * 16384 + s;
                            const unsigned w0 = cvt_pk_bf16(acc[ai][bj][m][n][0], acc[ai][bj][m][n][1]), w1 = cvt_pk_bf16(acc[ai][bj][m][n][2], acc[ai][bj][m][n][3]);
                            p[0] = (bf16_t)(w0 & 0xffffu); p[16384] = (bf16_t)(w0 >> 16); p[2 * 16384] = (bf16_t)(w1 & 0xffffu); p[3 * 16384] = (bf16_t)(w1 >> 16); } }
            return; }
        const int col0 = u.pc * BM + wc * 32 + 8 * fq;
#pragma unroll
        for (int ai = 0; ai < 2; ++ai)
#pragma unroll
            for (int m = 0; m < 4; ++m) { bf16_t* rowp = O + (size_t)(row0 + ai * HALF + m * 16) * 2560 + col0;
#pragma unroll
                for (int bj = 0; bj < 2; ++bj) { const f32x4 v0 = acc[ai][bj][m][0], v1 = acc[ai][bj][m][1];
                    u32x4 w; w.x = cvt_pk_bf16(v0[0], v0[1]); w.y = cvt_pk_bf16(v0[2], v0[3]); w.z = cvt_pk_bf16(v1[0], v1[1]); w.w = cvt_pk_bf16(v1[2], v1[3]);
                    *(u32x4*)(rowp + bj * HALF) = w; } }
    }
};
struct EpiGlaProj {
    static constexpr bool PERM = true, AFTER_DRAIN = false;
    bf16_t *QK, *V, *R, *GL;
    __device__ __forceinline__ void operator()(const f32x4 (&acc)[2][2][4][2], const Unit& u, int wr, int wc, int fr, int fq) const {
        bf16_t* base; int ldc, ct;
        if (u.pc < 8) { base = QK; ldc = 2048; ct = u.pc; } else if (u.pc < 16) { base = V; ldc = 2048; ct = u.pc - 8; } else if (u.pc < 24) { base = R; ldc = 2048; ct = u.pc - 16; } else { base = GL; ldc = 256; ct = 0; }
        const int row0 = u.pm * BM + wr * 64 + fr, col0 = ct * BM + wc * 32 + 8 * fq;
#pragma unroll
        for (int ai = 0; ai < 2; ++ai)
#pragma unroll
            for (int m = 0; m < 4; ++m) { bf16_t* rowp = base + (size_t)(row0 + ai * HALF + m * 16) * ldc + col0;
#pragma unroll
                for (int bj = 0; bj < 2; ++bj) { const f32x4 v0 = acc[ai][bj][m][0], v1 = acc[ai][bj][m][1];
                    u32x4 w; w.x = cvt_pk_bf16(v0[0], v0[1]); w.y = cvt_pk_bf16(v0[2], v0[3]); w.z = cvt_pk_bf16(v1[0], v1[1]); w.w = cvt_pk_bf16(v1[2], v1[3]);
                    *(u32x4*)(rowp + bj * HALF) = w; } }
    }
};
template <bool RES_BF16> struct EpiResBf16 {
    static constexpr bool PERM = true, AFTER_DRAIN = false;
    const void* RES; int ldc; bf16_t* HB; float* SSP;
    __device__ __forceinline__ void operator()(const f32x4 (&acc)[2][2][4][2], const Unit& u, int wr, int wc, int fr, int fq) const {
        const int row0 = u.pm * BM + wr * 64 + fr, col0 = u.pc * BM + wc * 32 + 8 * fq;
#pragma unroll
        for (int ai = 0; ai < 2; ++ai)
#pragma unroll
            for (int m = 0; m < 4; ++m) { const int row = row0 + ai * HALF + m * 16; const size_t off = (size_t)row * ldc + col0;
                f32x4 rv[2][2];
#pragma unroll
                for (int bj = 0; bj < 2; ++bj) {
                    if constexpr (RES_BF16) { const u32x4 w = *(const u32x4*)((const bf16_t*)RES + off + bj * HALF);
                        rv[bj][0] = (f32x4){__builtin_bit_cast(float, w.x << 16), __builtin_bit_cast(float, w.x & 0xffff0000u), __builtin_bit_cast(float, w.y << 16), __builtin_bit_cast(float, w.y & 0xffff0000u)};
                        rv[bj][1] = (f32x4){__builtin_bit_cast(float, w.z << 16), __builtin_bit_cast(float, w.z & 0xffff0000u), __builtin_bit_cast(float, w.w << 16), __builtin_bit_cast(float, w.w & 0xffff0000u)}; }
                    else { rv[bj][0] = *(const f32x4*)((const float*)RES + off + bj * HALF); rv[bj][1] = *(const f32x4*)((const float*)RES + off + bj * HALF + 4); } }
                float ss = 0.f;
#pragma unroll
                for (int bj = 0; bj < 2; ++bj) { const f32x4 v0 = acc[ai][bj][m][0] + rv[bj][0], v1 = acc[ai][bj][m][1] + rv[bj][1];
                    u32x4 w; w.x = cvt_pk_bf16(v0[0], v0[1]); w.y = cvt_pk_bf16(v0[2], v0[3]); w.z = cvt_pk_bf16(v1[0], v1[1]); w.w = cvt_pk_bf16(v1[2], v1[3]);
                    *(u32x4*)(HB + off + bj * HALF) = w;
                    ss += (v0[0] * v0[0] + v0[1] * v0[1]) + (v0[2] * v0[2] + v0[3] * v0[3]) + (v1[0] * v1[0] + v1[1] * v1[1]) + (v1[2] * v1[2] + v1[3] * v1[3]); }
                ss += __shfl_xor(ss, 16); ss += __shfl_xor(ss, 32);
                if (fq == 0) SSP[(size_t)row * 32 + u.pc * 4 + wc] = ss; }
    }
};
struct EpiRouter {
    static constexpr bool PERM = false, AFTER_DRAIN = false;
    float* RL;
    __device__ __forceinline__ void operator()(const f32x4 (&acc)[2][2][4][2], const Unit& u, int wr, int wc, int fr, int fq) const {
        if (wc >= 2) return;
        const int row0 = u.pm * BM + wr * 64 + fr, col0 = wc * 32 + 4 * fq;
#pragma unroll
        for (int ai = 0; ai < 2; ++ai)
#pragma unroll
            for (int m = 0; m < 4; ++m) { float* rowp = RL + (size_t)(row0 + ai * HALF + m * 16) * 64 + col0;
#pragma unroll
                for (int n = 0; n < 2; ++n) *(f32x4*)(rowp + n * 16) = acc[ai][0][m][n]; }
    }
};
__device__ __forceinline__ float silu_f(float x) { return x * __builtin_amdgcn_rcpf(1.0f + __expf(-x)); }
struct EpiSwiGLU {
    static constexpr bool PERM = true, AFTER_DRAIN = false;
    bf16_t* ACT; const float* RS;
    __device__ __forceinline__ void operator()(const f32x4 (&acc)[2][2][4][2], const Unit& u, int wr, int wc, int fr, int fq) const {
        const int row0 = u.pm * BM + wr * 64 + fr, col0 = u.pc * HALF + wc * 32 + 8 * fq;
#pragma unroll
        for (int ai = 0; ai < 2; ++ai)
#pragma unroll
            for (int m = 0; m < 4; ++m) { const int row = row0 + ai * HALF + m * 16; bf16_t* rowp = ACT + (size_t)row * 512 + col0; const float rs = RS[row];
                const f32x4 g0 = acc[ai][0][m][0] * rs, g1 = acc[ai][0][m][1] * rs, u0 = acc[ai][1][m][0] * rs, u1 = acc[ai][1][m][1] * rs;
                u32x4 w;
                w.x = cvt_pk_bf16(silu_f(g0[0]) * u0[0], silu_f(g0[1]) * u0[1]); w.y = cvt_pk_bf16(silu_f(g0[2]) * u0[2], silu_f(g0[3]) * u0[3]);
                w.z = cvt_pk_bf16(silu_f(g1[0]) * u1[0], silu_f(g1[1]) * u1[1]); w.w = cvt_pk_bf16(silu_f(g1[2]) * u1[2], silu_f(g1[3]) * u1[3]);
                *(u32x4*)rowp = w; }
    }
};

template <class Epi, class Sched, bool ALIGN_EPI = false, bool SP2 = false, bool GATHER = false>
__device__ __forceinline__ void gemm_phase(PG8_LAS unsigned char* lds, const Gemm g, const Sched& S, const Epi& E) {
    const int tid = threadIdx.x, wid = __builtin_amdgcn_readfirstlane(tid >> 6), lane = tid & 63, wr = wid >> 2, wc = wid & 3, fr = lane & 15, fq = lane >> 4;
    const int K = g.K, nt = K / BK;
    unsigned voffA[2], voffB[2];
#pragma unroll
    for (int i = 0; i < 2; ++i) { int R, C; stage_rc(tid * 16 + i * 8192, R, C); const int Rb = Epi::PERM ? ((R & ~31) + perm32(R & 31)) : R;
        voffA[i] = (unsigned)(R * K + C) * 2u; voffB[i] = (unsigned)(Rb * K + C) * 2u; }
    unsigned vA[2][2] = {{0u, 0u}, {0u, 0u}}, vAn[2][2] = {{0u, 0u}, {0u, 0u}}; int rA[2] = {0, 0}; unsigned cbA[2] = {0u, 0u};
    if constexpr (GATHER) {
#pragma unroll
        for (int i = 0; i < 2; ++i) { int R, C; stage_rc(tid * 16 + i * 8192, R, C); rA[i] = R; cbA[i] = (unsigned)C * 2u; } }
#define PG8_GIDX(dst, pmv) do { _Pragma("unroll") for (int _h = 0; _h < 2; ++_h) _Pragma("unroll") for (int _i = 0; _i < 2; ++_i) \
        dst[_h][_i] = g.rowidx[(size_t)(pmv) * BM + _h * HALF + rA[_i]] * (unsigned)(K * 2) + cbA[_i]; } while (0)
    const size_t kstep = (size_t)(BK * 2);
    const size_t hstep = (size_t)HALF * K * 2;
    const size_t tstep = 2 * hstep;
    const unsigned ldsw = (unsigned)wid * 1024u;
    const int aoff = lds_byte(wr * 64 + fr, fq * 8), boff = lds_byte(wc * 32 + fr, fq * 8);
#define PG8_SA(b, h) (((b) * 2 + (h)) * HTB)
#define PG8_SB(b, h) ((4 + (b) * 2 + (h)) * HTB)
#define PG8_STAGE(bufoff, gbase, voff) do { _Pragma("unroll") for (int _i = 0; _i < 2; ++_i) \
        __builtin_amdgcn_global_load_lds((const unsigned*)((const char*)(gbase) + (voff)[_i]), (PG8_LAS unsigned*)(lds + (bufoff) + ldsw + _i * 8192), 16, 0, 0); } while (0)
#define PG8_STAGE_A(bufoff, nx, kb, h) do { if constexpr (GATHER) { const char* _b = (const char*)g.A + (kb); \
        _Pragma("unroll") for (int _i = 0; _i < 2; ++_i) { const unsigned _v = (nx) ? vAn[h][_i] : vA[h][_i]; \
            __builtin_amdgcn_global_load_lds((const unsigned*)(_b + _v), (PG8_LAS unsigned*)(lds + (bufoff) + ldsw + _i * 8192), 16, 0, 0); } } \
    else { const char* _b = ((nx) ? nA : cA) + (kb) + (size_t)(h) * hstep; PG8_STAGE(bufoff, _b, voffA); } } while (0)
#define PG8_LDA(dst, b, h) do { _Pragma("unroll") for (int m = 0; m < 4; ++m) _Pragma("unroll") for (int k = 0; k < 2; ++k) dst[m][k] = *(const PG8_LAS bf16x8*)(lds + PG8_SA(b, h) + aoff + m * 2048 + k * 1024); } while (0)
#define PG8_LDB(dst, b, h) do { _Pragma("unroll") for (int n = 0; n < 2; ++n) _Pragma("unroll") for (int k = 0; k < 2; ++k) dst[n][k] = *(const PG8_LAS bf16x8*)(lds + PG8_SB(b, h) + boff + n * 2048 + k * 1024); } while (0)
#define PG8_MMA(ai, bj, At, Bt) do { __builtin_amdgcn_s_setprio(1); _Pragma("unroll") for (int m = 0; m < 4; ++m) _Pragma("unroll") for (int n = 0; n < 2; ++n) _Pragma("unroll") for (int k = 0; k < 2; ++k) \
        acc[ai][bj][m][n] = __builtin_amdgcn_mfma_f32_16x16x32_bf16(Bt[n][k], At[m][k], acc[ai][bj][m][n], 0, 0, 0); __builtin_amdgcn_s_setprio(0); } while (0)
#define PG8_WAIT_V(n) asm volatile("s_waitcnt vmcnt(" #n ")" ::: "memory")
#define PG8_WAIT_L(n) asm volatile("s_waitcnt lgkmcnt(" #n ")" ::: "memory")
#define PG8_BAR __builtin_amdgcn_s_barrier()
#define PG8_SCHED __builtin_amdgcn_sched_barrier(0)
    Unit cur, nxt; int ui = 0;
    if (!S.next(0, cur)) return;
    f32x4 acc[2][2][4][2];
#pragma unroll
    for (int a = 0; a < 2; ++a)
#pragma unroll
        for (int b = 0; b < 2; ++b)
#pragma unroll
            for (int m = 0; m < 4; ++m)
#pragma unroll
                for (int n = 0; n < 2; ++n) acc[a][b][m][n] = (f32x4){0.f, 0.f, 0.f, 0.f};
    bf16x8 At[4][2], B0[2][2], B1[2][2];
    const char* cA = (const char*)g.A + (size_t)cur.pm * tstep; const char* cB = (const char*)g.Bt + (size_t)cur.pn * tstep;
    const char* nA = cA; const char* nB = cB;
    if constexpr (GATHER) { PG8_GIDX(vA, cur.pm); }
    S.a_ready(cur);
    if constexpr (SP2) {
        PG8_STAGE(PG8_SB(0, 0), cB, voffB); PG8_STAGE(PG8_SB(0, 1), cB + hstep, voffB); PG8_STAGE_A(PG8_SA(0, 0), false, 0, 0); PG8_STAGE_A(PG8_SA(0, 1), false, 0, 1);
        if (wr == 1) PG8_BAR;
        PG8_WAIT_V(2); PG8_BAR;
        PG8_STAGE(PG8_SB(1, 0), cB + kstep, voffB); PG8_STAGE_A(PG8_SA(1, 0), false, kstep, 0); PG8_STAGE(PG8_SB(1, 1), cB + hstep + kstep, voffB);
        PG8_WAIT_V(6); PG8_BAR;
    } else {
        PG8_STAGE(PG8_SB(0, 0), cB, voffB); PG8_STAGE(PG8_SA(0, 0), cA, voffA); PG8_STAGE(PG8_SB(0, 1), cB + hstep, voffB); PG8_STAGE(PG8_SA(0, 1), cA + hstep, voffA);
        if (wr == 1) PG8_BAR;
        PG8_WAIT_V(4); PG8_BAR;
        PG8_STAGE(PG8_SB(1, 0), cB + kstep, voffB); PG8_STAGE(PG8_SA(1, 0), cA + kstep, voffA); PG8_STAGE(PG8_SB(1, 1), cB + hstep + kstep, voffB);
        PG8_WAIT_V(6); PG8_BAR;
    }
    for (;;) {
        const bool has_next = S.next(ui + 1, nxt);
        nA = has_next ? (const char*)g.A + (size_t)nxt.pm * tstep : cA; nB = has_next ? (const char*)g.Bt + (size_t)nxt.pn * tstep : cB;
        if constexpr (GATHER) { if (has_next) { PG8_GIDX(vAn, nxt.pm); } else {
#pragma unroll
            for (int _h = 0; _h < 2; ++_h) { vAn[_h][0] = vA[_h][0]; vAn[_h][1] = vA[_h][1]; } } }
        for (int t = 0; t < nt; t += 2) {
            const bool last = (t == nt - 2);
            const char* a1 = cA + (size_t)(t + 1) * kstep;
            const char* a2 = last ? nA : cA + (size_t)(t + 2) * kstep; const char* b2 = last ? nB : cB + (size_t)(t + 2) * kstep;
            const char* a3 = a2 + kstep; const char* b3 = b2 + kstep;
            const size_t ka1 = (size_t)(t + 1) * kstep, ka2 = last ? (size_t)0 : (size_t)(t + 2) * kstep, ka3 = ka2 + kstep; (void)a1; (void)a3;
            if (last && has_next) S.a_ready(nxt);
            if constexpr (SP2) {
            PG8_LDB(B0, 0, 0); PG8_LDB(B1, 0, 1); PG8_SCHED; PG8_LDA(At, 0, 0); PG8_STAGE_A(PG8_SA(1, 1), false, ka1, 1);
            PG8_WAIT_V(8); PG8_WAIT_L(0); PG8_BAR; PG8_MMA(0, 0, At, B0); PG8_MMA(0, 1, At, B1); PG8_BAR; PG8_SCHED;
            PG8_LDA(At, 0, 1); PG8_STAGE(PG8_SB(0, 0), b2, voffB); PG8_STAGE(PG8_SB(0, 1), b2 + hstep, voffB); PG8_STAGE_A(PG8_SA(0, 0), last, ka2, 0);
            PG8_WAIT_V(8); PG8_WAIT_L(0); PG8_BAR; PG8_MMA(1, 0, At, B0); PG8_MMA(1, 1, At, B1); PG8_BAR; PG8_SCHED;
            PG8_LDB(B0, 1, 0); PG8_LDB(B1, 1, 1); PG8_SCHED; PG8_LDA(At, 1, 0); PG8_STAGE_A(PG8_SA(0, 1), last, ka2, 1);
            PG8_WAIT_V(8); PG8_WAIT_L(0); PG8_BAR; PG8_MMA(0, 0, At, B0); PG8_MMA(0, 1, At, B1); PG8_BAR; PG8_SCHED;
            PG8_LDA(At, 1, 1); PG8_STAGE(PG8_SB(1, 0), b3, voffB); PG8_STAGE(PG8_SB(1, 1), b3 + hstep, voffB); PG8_STAGE_A(PG8_SA(1, 0), last, ka3, 0);
            PG8_WAIT_V(8); PG8_WAIT_L(0); PG8_BAR; PG8_MMA(1, 0, At, B0); PG8_MMA(1, 1, At, B1); PG8_BAR; PG8_SCHED;
            } else {
            PG8_LDB(B0, 0, 0); PG8_SCHED; PG8_LDA(At, 0, 0); PG8_STAGE(PG8_SA(1, 1), a1 + hstep, voffA);
            PG8_WAIT_L(8); PG8_BAR; PG8_WAIT_L(0); PG8_MMA(0, 0, At, B0); PG8_BAR; PG8_SCHED;
            PG8_LDB(B1, 0, 1); PG8_STAGE(PG8_SB(0, 0), b2, voffB);
            PG8_BAR; PG8_WAIT_L(0); PG8_MMA(0, 1, At, B1); PG8_BAR;
            PG8_LDA(At, 0, 1); PG8_STAGE(PG8_SA(0, 0), a2, voffA);
            PG8_BAR; PG8_WAIT_L(0); PG8_MMA(1, 0, At, B0); PG8_BAR; PG8_SCHED;
            PG8_STAGE(PG8_SB(0, 1), b2 + hstep, voffB);
            PG8_WAIT_V(6); PG8_BAR; PG8_MMA(1, 1, At, B1); PG8_BAR;
            PG8_LDB(B0, 1, 0); PG8_SCHED; PG8_LDA(At, 1, 0); PG8_STAGE(PG8_SA(0, 1), a2 + hstep, voffA);
            PG8_WAIT_L(8); PG8_BAR; PG8_WAIT_L(0); PG8_MMA(0, 0, At, B0); PG8_BAR; PG8_SCHED;
            PG8_LDB(B1, 1, 1); PG8_STAGE(PG8_SB(1, 0), b3, voffB);
            PG8_BAR; PG8_WAIT_L(0); PG8_MMA(0, 1, At, B1); PG8_BAR;
            PG8_LDA(At, 1, 1); PG8_STAGE(PG8_SA(1, 0), a3, voffA);
            PG8_BAR; PG8_WAIT_L(0); PG8_MMA(1, 0, At, B0); PG8_BAR; PG8_SCHED;
            PG8_STAGE(PG8_SB(1, 1), b3 + hstep, voffB);
            PG8_WAIT_V(6); PG8_BAR; PG8_MMA(1, 1, At, B1); PG8_BAR;
            }
        }
        if constexpr (ALIGN_EPI) { if (wr == 0) PG8_BAR; }
        if constexpr (!Epi::AFTER_DRAIN) { E(acc, cur, wr, wc, fr, fq);
#if MK_EPI2
            asm volatile("" ::: "memory"); E(acc, cur, wr, wc, fr, fq);
#endif
            S.done(cur); }
        if (!has_next) break;
#pragma unroll
        for (int a = 0; a < 2; ++a)
#pragma unroll
            for (int b = 0; b < 2; ++b)
#pragma unroll
                for (int m = 0; m < 4; ++m)
#pragma unroll
                    for (int n = 0; n < 2; ++n) acc[a][b][m][n] = (f32x4){0.f, 0.f, 0.f, 0.f};
        cur = nxt; cA = nA; cB = nB; ++ui;
        if constexpr (GATHER) {
#pragma unroll
            for (int _h = 0; _h < 2; ++_h) { vA[_h][0] = vAn[_h][0]; vA[_h][1] = vAn[_h][1]; } }
        if constexpr (ALIGN_EPI) { if (wr == 1) PG8_BAR; }
    }
    PG8_WAIT_V(0);
    if constexpr (!ALIGN_EPI) { if (wr == 0) PG8_BAR; }
    PG8_BAR;
    if constexpr (Epi::AFTER_DRAIN) { E.fused(acc, cur, wr, wc, fr, fq, lds, wid, lane); S.done(cur); }
#undef PG8_SA
#undef PG8_STAGE_A
#undef PG8_GIDX
#undef PG8_SB
#undef PG8_STAGE
#undef PG8_LDA
#undef PG8_LDB
#undef PG8_MMA
#undef PG8_WAIT_V
#undef PG8_WAIT_L
#undef PG8_BAR
#undef PG8_SCHED
}
}

constexpr int NWAVES = 8;
constexpr int T = 32768, D = 2048, SEQ = 16384;
constexpr float RMS_EPS = 1e-6f;
constexpr int GLA_H = 4, GLA_DK = 256, GLA_DV = 512, GLA_C = 64, GLA_NCH = SEQ / GLA_C  , GLA_PROJ_N = 6160, GLA_PROJ_NP = 6400;
constexpr int NITEM_GLA = 2 * GLA_H * GLA_NCH;
constexpr int SWA_HQ = 32, SWA_HKV = 4, SWA_HD = 64, SWA_W = 128, KVQ_N = 2560;
constexpr int NE = 32, FF = 512, MOE_MAXROWS = 2 * T + NE * 256;

constexpr size_t MiB = 1u << 20;
constexpr size_t WS_CTL = 0, CTL_ZERO_BYTES = 1 * MiB;
constexpr size_t WS_W_GLA_IN = 1 * MiB;
constexpr size_t WS_W_GLA_OUT = 26 * MiB;
constexpr size_t WS_W_KVQ = 34 * MiB;
constexpr size_t WS_W_SWA_OUT = 44 * MiB;
constexpr size_t WS_W_ROUTER = 52 * MiB;
constexpr size_t WS_TOK = 54 * MiB;
constexpr size_t WS_RL = 56 * MiB;
constexpr size_t WS_W_GU = 64 * MiB;
constexpr size_t WS_W_DN = 192 * MiB;
constexpr size_t WS_HN = 256 * MiB;
constexpr size_t WS_BIG = 384 * MiB;
constexpr size_t WS_QK = WS_BIG;
constexpr size_t WS_V = WS_BIG + 128 * MiB;
constexpr size_t WS_R = WS_BIG + 256 * MiB;
constexpr size_t WS_GL = WS_BIG + 384 * MiB;
constexpr size_t WS_QEF = WS_BIG + 400 * MiB;
constexpr size_t WS_KLTF = WS_BIG + 464 * MiB;
constexpr size_t WS_ATTF = WS_BIG + 528 * MiB;
constexpr size_t WS_VTF = WS_BIG + 544 * MiB;
constexpr size_t WS_DEC = WS_BIG + 672 * MiB;
constexpr size_t WS_SEND = WS_V;
constexpr size_t WS_DTOT = WS_V + 32 * MiB;
constexpr size_t WS_GLA_END = WS_BIG + 674 * MiB;
constexpr size_t WS_SSP = WS_BIG;
constexpr size_t WS_TL = WS_BIG + 8 * MiB;
constexpr size_t WS_RS = WS_BIG + 9 * MiB;
constexpr size_t WS_HB = WS_BIG + 16 * MiB;
constexpr size_t WS_ACT = WS_BIG + 288 * MiB;
constexpr size_t WS_Y = WS_BIG + 360 * MiB;
constexpr size_t WS_KVQ = WS_BIG;
constexpr size_t WS_AO = WS_BIG + 160 * MiB;
constexpr size_t WS_VT = WS_BIG + 288 * MiB;
constexpr size_t WS_END = WS_GLA_END;
static_assert(WS_Y + (size_t)MOE_MAXROWS * 2048 * 2 <= WS_END && WS_ACT + (size_t)MOE_MAXROWS * 512 * 2 <= WS_Y, "MoE map");
constexpr int CW_BAR = 4096;
constexpr int CW_CNT = 16384;

constexpr int RING_OFF = 0, RING_BYTES = 149504;
constexpr int LDSCTL_OFF = RING_BYTES;
constexpr int MISC_OFF = LDSCTL_OFF + 64;
constexpr int MOE_OFF_OFF = LDSCTL_OFF + 256;
constexpr int MOE_TEXP_OFF = LDSCTL_OFF + 512;
constexpr int LDS_BYTES = RING_BYTES + 2048;

#define GAS __attribute__((address_space(1)))
#define LAS __attribute__((address_space(3)))
typedef unsigned short bf16;
typedef unsigned v4u __attribute__((ext_vector_type(4)));
typedef unsigned v2u __attribute__((ext_vector_type(2)));
typedef float f32x4 __attribute__((ext_vector_type(4)));
typedef short bf16x8 __attribute__((ext_vector_type(8)));
typedef GAS unsigned gu32;
#define RLX_AGENT __ATOMIC_RELAXED, __HIP_MEMORY_SCOPE_AGENT
#define LDS_WAIT() asm volatile("s_waitcnt lgkmcnt(0)" ::: "memory")
#define VM_WAIT() asm volatile("s_waitcnt vmcnt(0)" ::: "memory")
__device__ __forceinline__ unsigned f2bf(float f) { unsigned u = __builtin_bit_cast(unsigned, f); return (u + 0x7fffu + ((u >> 16) & 1u)) >> 16; }
__device__ __forceinline__ unsigned pk2(float lo, float hi) { return pg8::cvt_pk_bf16(lo, hi); }
__device__ __forceinline__ float bf_lo(unsigned w) { return __builtin_bit_cast(float, w << 16); }
__device__ __forceinline__ float bf_hi(unsigned w) { return __builtin_bit_cast(float, w & 0xffff0000u); }
__device__ __forceinline__ float bf2f(bf16 b) { return __builtin_bit_cast(float, ((unsigned)b) << 16); }
__device__ __forceinline__ float wave_sum(float v) {
#pragma unroll
    for (int o = 1; o < 64; o <<= 1) v += __shfl_xor(v, o);
    return v;
}

#define XB_TMO      128
#define XB_XCNT(j)  (256  + 64 * (j))
#define XB_XSUB(j)  (1280 + 64 * (j))
#define XB_XGEN(j)  (2304 + 64 * (j))
#define XB_TOP      3328
#define XB_TOPGEN   3392
#define XCD_BAR_WORDS 3456
#define XB_SPIN_CAP (1u << 18)

__device__ __forceinline__ unsigned xb_ld(unsigned* p)              { return __hip_atomic_load(p, __ATOMIC_RELAXED, __HIP_MEMORY_SCOPE_AGENT); }
__device__ __forceinline__ unsigned xb_add(unsigned* p, unsigned v) { return __hip_atomic_fetch_add(p, v, __ATOMIC_RELAXED, __HIP_MEMORY_SCOPE_AGENT); }
__device__ __forceinline__ unsigned xb_xcc_id() { return (unsigned)__builtin_amdgcn_s_getreg((3 << 11) | 20) & 0xFu; }
#define XB_SPIN(cond, bar) do { unsigned _sp = 0; while (cond) { __builtin_amdgcn_s_sleep(1); \
    if ((++_sp & 255u) == 0u) { if (xb_ld(&(bar)[XB_TMO])) break; if (_sp > XB_SPIN_CAP) { atomicAdd(&(bar)[XB_TMO], 1u); break; } } } } while (0)

struct XcdBarrier {
    unsigned* bar; unsigned x;
    volatile LAS unsigned* st;
};

__device__ __forceinline__ XcdBarrier xcd_barrier_post(unsigned* bar, volatile LAS unsigned* st) {
    XcdBarrier b; b.bar = bar; b.x = xb_xcc_id(); b.st = st;
    if (threadIdx.x == 0) (void)xb_add(&bar[XB_XCNT(b.x)], 1u);
    return b;
}
__device__ __forceinline__ void xcd_barrier_complete(unsigned* bar, unsigned x, unsigned& nloc, unsigned& nx) {
    const unsigned G = gridDim.x * gridDim.y * gridDim.z;
    unsigned sum, cnt, mine, sp = 0u;
    for (;;) {
        sum = 0u; cnt = 0u; mine = 0u;
#pragma unroll
        for (unsigned j = 0; j < 16; ++j) { const unsigned c = xb_ld(&bar[XB_XCNT(j)]); sum += c; cnt += (c > 0u) ? 1u : 0u; mine = (j == x) ? c : mine; }
        if (sum == G) break;
        __builtin_amdgcn_s_sleep(1);
        if ((++sp & 255u) == 0u) { if (xb_ld(&bar[XB_TMO])) break; if (sp > XB_SPIN_CAP) { atomicAdd(&bar[XB_TMO], 1u); break; } }
    }
    nloc = mine > 0u ? mine : 1u; nx = cnt > 0u ? cnt : 1u;
}

__device__ __forceinline__ void xcd_barrier(const XcdBarrier& b) {
    asm volatile("s_waitcnt vmcnt(0)" ::: "memory");
    __syncthreads();
    if (threadIdx.x == 0) {
        unsigned* bar = b.bar;
        __builtin_amdgcn_s_waitcnt(0);
        unsigned nloc = b.st[0], nx = b.st[1];
        if (nloc == 0u) { xcd_barrier_complete(bar, b.x, nloc, nx); b.st[0] = nloc; b.st[1] = nx; }
        const unsigned old = xb_add(&bar[XB_XSUB(b.x)], 1u);
        const unsigned gen = old / nloc;
        if (old + 1u == (gen + 1u) * nloc) {
            __builtin_amdgcn_fence(__ATOMIC_RELEASE, "agent");
            asm volatile("s_waitcnt vmcnt(0)" ::: "memory");
            const unsigned og = xb_add(&bar[XB_TOP], 1u);
            const unsigned tg = og / nx;
            if (og + 1u == (tg + 1u) * nx) xb_add(&bar[XB_TOPGEN], 1u);
            else XB_SPIN(xb_ld(&bar[XB_TOPGEN]) == tg, bar);
            __builtin_amdgcn_fence(__ATOMIC_ACQUIRE, "agent");
            xb_add(&bar[XB_XGEN(b.x)], 1u);
            asm volatile("s_waitcnt vmcnt(0)" ::: "memory");
        } else {
            XB_SPIN(xb_ld(&bar[XB_XGEN(b.x)]) == gen, bar);
            __builtin_amdgcn_fence(__ATOMIC_ACQUIRE, "agent");
            asm volatile("s_waitcnt vmcnt(0)" ::: "memory");
        }
    }
    __syncthreads();
}


__device__ __forceinline__ void cvt_item(const float* W, int N, const float* gain, bf16* WT, int K, int k0, int n0, size_t dst_row0, int lane) {
    const int q = lane >> 4, c = lane & 15;
    const bool ok = (n0 + 4 * c) < N;
    const GAS f32x4* src = (const GAS f32x4*)(W + (size_t)(k0 + 16 * q) * N + n0 + 4 * c);
    f32x4 v[16];
#pragma unroll
    for (int i = 0; i < 16; ++i) v[i] = ok ? src[(size_t)i * (N / 4)] : (f32x4){0.f, 0.f, 0.f, 0.f};
    if (gain) { const GAS f32x4* gp = (const GAS f32x4*)(gain + k0 + 16 * q);
#pragma unroll
        for (int i4 = 0; i4 < 4; ++i4) { const f32x4 g = gp[i4]; v[4 * i4 + 0] = v[4 * i4 + 0] * g.x; v[4 * i4 + 1] = v[4 * i4 + 1] * g.y; v[4 * i4 + 2] = v[4 * i4 + 2] * g.z; v[4 * i4 + 3] = v[4 * i4 + 3] * g.w; } }
    if (ok) {
#pragma unroll
        for (int e = 0; e < 4; ++e) { bf16* dst = WT + (dst_row0 + 4 * c + e) * (size_t)K + k0 + 16 * q;
            v4u o0, o1;
            o0.x = pk2(v[0][e], v[1][e]); o0.y = pk2(v[2][e], v[3][e]); o0.z = pk2(v[4][e], v[5][e]); o0.w = pk2(v[6][e], v[7][e]);
            o1.x = pk2(v[8][e], v[9][e]); o1.y = pk2(v[10][e], v[11][e]); o1.z = pk2(v[12][e], v[13][e]); o1.w = pk2(v[14][e], v[15][e]);
            *(GAS v4u*)dst = o0; *(GAS v4u*)(dst + 8) = o1; } }
}
__device__ __forceinline__ void cvt_matrix(const float* W, int K, int N, const float* gain, bf16* WT, int rowbase, int gw, int NGW, int lane) {
    const int nblk = (N + 63) / 64, nitems = (K / 64) * nblk;
    for (int it = gw; it < nitems; it += NGW) { const int kb = it / nblk, nb = it - kb * nblk;
        cvt_item(W, N, gain, WT, K, kb * 64, nb * 64, (size_t)(rowbase + nb * 64), lane); }
}
__device__ __forceinline__ void cvt_moe(const float* wg, const float* wu, const float* wd, const float* gain, bf16* WGU, bf16* WDN, int gw, int NGW, int lane) {
    for (int it = gw; it < 2 * 8192; it += NGW) { const int which = it >> 13, r = it & 8191, e = r >> 8, q = r & 255, kb = q >> 3, nb = q & 7, n0 = nb * 64;
        const float* W = (which ? wu : wg) + (size_t)e * 2048 * 512;
        const size_t dst = (size_t)e * 1024 + 256 * (n0 >> 7) + (n0 & 127) + (which ? 128 : 0);
        cvt_item(W, 512, gain, WGU, 2048, kb * 64, n0, dst, lane); }
    for (int it = gw; it < 8192; it += NGW) { const int e = it >> 8, q = it & 255, kb = q >> 5, nb = q & 31;
        cvt_item(wd + (size_t)e * 512 * 2048, 2048, nullptr, WDN + (size_t)e * 2048 * 512, 512, kb * 64, nb * 64, (size_t)(nb * 64), lane); }
}
__device__ __forceinline__ void norm_rows(const float* src, bf16* dst, int gw, int NGW, int lane) {
    for (int m = gw; m < T; m += NGW) {
        const GAS f32x4* xr = (const GAS f32x4*)(src + (size_t)m * D) + lane;
        f32x4 v[8]; float s = 0.f;
#pragma unroll
        for (int j = 0; j < 8; ++j) { v[j] = xr[64 * j]; s += (v[j].x * v[j].x + v[j].y * v[j].y) + (v[j].z * v[j].z + v[j].w * v[j].w); }
        const float rstd = rsqrtf(wave_sum(s) * (1.f / D) + RMS_EPS);
        GAS v2u* o8 = (GAS v2u*)(dst + (size_t)m * D) + lane;
#pragma unroll
        for (int j = 0; j < 8; ++j) { v2u o; o.x = pk2(v[j].x * rstd, v[j].y * rstd); o.y = pk2(v[j].z * rstd, v[j].w * rstd); o8[64 * j] = o; }
    }
}

__device__ __forceinline__ float logsig(float z) { return fminf(z, 0.f) - __logf(1.f + __expf(-fabsf(z))); }
constexpr int GP_QE = 0, GP_KE = 33792, GP_ATT = 67584, GP_TOT = 76800;
__device__ __forceinline__ void gla_prepass(LAS unsigned char* lds, const bf16* QK, const bf16* V, const bf16* GL, const float* Wgu, const float* bgate,
                                            bf16* QEF, bf16* KLTF, bf16* ATTF, bf16* VTF, float* DEC) {
    const int tid = threadIdx.x, lane = tid & 63, wave = __builtin_amdgcn_readfirstlane(tid >> 6);
    LAS bf16* QEl = (LAS bf16*)(lds + GP_QE); LAS bf16* KEl = (LAS bf16*)(lds + GP_KE); LAS bf16* ATl = (LAS bf16*)(lds + GP_ATT);
    LAS float* tot = (LAS float*)(lds + GP_TOT);
    const int cg2 = tid & 127, rg2 = __builtin_amdgcn_readfirstlane(tid >> 7);
    for (int it = blockIdx.x; it < NITEM_GLA; it += gridDim.x) {
        const int bh = it >> 8, n = it & 255, h = bh & 3, b = bh >> 2; const int t0 = b * SEQ + n * GLA_C;
        v2u qv[8], kv[8], vv[16];
        { const bf16* qp = QK + (size_t)(t0 + 8 * wave) * 2048 + h * 256 + 4 * lane;
#pragma unroll
          for (int jj = 0; jj < 8; ++jj) { qv[jj] = *(const GAS v2u*)(qp + (size_t)jj * 2048); kv[jj] = *(const GAS v2u*)(qp + (size_t)jj * 2048 + 1024); }
          const bf16* vp = V + (size_t)(t0 + 16 * rg2) * 2048 + h * 512 + 4 * cg2;
#pragma unroll
          for (int r = 0; r < 16; ++r) vv[r] = *(const GAS v2u*)(vp + (size_t)r * 2048); }
        f32x4 cum[8];
        { f32x4 wg[16];
#pragma unroll
          for (int j = 0; j < 16; ++j) wg[j] = *(const GAS f32x4*)(Wgu + j * 1024 + h * 256 + 4 * lane);
          const f32x4 bg = *(const GAS f32x4*)(bgate + h * 256 + 4 * lane);
          f32x4 run = {0.f, 0.f, 0.f, 0.f};
#pragma unroll
          for (int jj = 0; jj < 8; ++jj) { const unsigned* gp = (const unsigned*)(GL + (size_t)(t0 + 8 * wave + jj) * 256);
              f32x4 z = bg;
#pragma unroll
              for (int j2 = 0; j2 < 8; ++j2) { const unsigned w = gp[j2]; z += wg[2 * j2] * bf_lo(w) + wg[2 * j2 + 1] * bf_hi(w); }
#pragma unroll
              for (int e = 0; e < 4; ++e) run[e] += fmaxf(logsig(z[e]) * 0.0625f, -1.0f);
              cum[jj] = run; }
          *(LAS f32x4*)(tot + wave * 256 + 4 * lane) = run; }
        __syncthreads();
        f32x4 offs = {0.f, 0.f, 0.f, 0.f}, blast = {0.f, 0.f, 0.f, 0.f};
#pragma unroll
        for (int w2 = 0; w2 < 8; ++w2) { const f32x4 tv = *(const LAS f32x4*)(tot + w2 * 256 + 4 * lane); blast += tv; if (w2 < wave) offs += tv; }
        f32x4 dec;
#pragma unroll
        for (int e = 0; e < 4; ++e) dec[e] = __expf(blast[e]);
        { float klv[4][8];
#pragma unroll
          for (int jj = 0; jj < 8; ++jj) { const int c = 8 * wave + jj; const f32x4 bb = cum[jj] + offs;
              const float q4[4] = {bf_lo(qv[jj].x), bf_hi(qv[jj].x), bf_lo(qv[jj].y), bf_hi(qv[jj].y)}, k4[4] = {bf_lo(kv[jj].x), bf_hi(kv[jj].x), bf_lo(kv[jj].y), bf_hi(kv[jj].y)};
              float qe[4], ke[4];
#pragma unroll
              for (int e = 0; e < 4; ++e) { qe[e] = q4[e] * 0.0625f * __expf(bb[e]); ke[e] = k4[e] * __expf(-bb[e]); klv[e][jj] = ke[e] * dec[e]; }
              v2u o; o.x = pk2(qe[0], qe[1]); o.y = pk2(qe[2], qe[3]); *(LAS v2u*)(QEl + c * 264 + 4 * lane) = o;
              o.x = pk2(ke[0], ke[1]); o.y = pk2(ke[2], ke[3]); *(LAS v2u*)(KEl + c * 264 + 4 * lane) = o; }
#pragma unroll
          for (int e = 0; e < 4; ++e) { const int d = 4 * lane + e;
              v4u o; o.x = pk2(klv[e][0], klv[e][1]); o.y = pk2(klv[e][2], klv[e][3]); o.z = pk2(klv[e][4], klv[e][5]); o.w = pk2(klv[e][6], klv[e][7]);
              const size_t fi = ((((size_t)it * 8 + (d >> 5)) * 2 + ((d >> 4) & 1)) * 2 + (wave >> 2)) * 64 + (wave & 3) * 16 + (d & 15);
              *(GAS v4u*)(KLTF + fi * 8) = o; } }
        if (wave == 0) *(GAS f32x4*)(DEC + (size_t)it * 256 + 4 * lane) = dec;
#pragma unroll
        for (int f = 0; f < 2; ++f)
#pragma unroll
            for (int e = 0; e < 4; ++e) { unsigned x[8];
#pragma unroll
                for (int jj = 0; jj < 8; ++jj) { const unsigned wd = (e >> 1) ? vv[8 * f + jj].y : vv[8 * f + jj].x; x[jj] = (e & 1) ? (wd >> 16) : (wd & 0xffffu); }
                v4u o; o.x = x[0] | (x[1] << 16); o.y = x[2] | (x[3] << 16); o.z = x[4] | (x[5] << 16); o.w = x[6] | (x[7] << 16);
                const int v = 4 * cg2 + e;
                const size_t fi = (((size_t)it * 32 + (v >> 4)) * 2 + (rg2 >> 1)) * 64 + (2 * (rg2 & 1) + f) * 16 + (v & 15);
                *(GAS v4u*)(VTF + fi * 8) = o; }
        __syncthreads();
        { const int mt = wave >> 1, i = lane & 15, q = lane >> 4;
#pragma unroll
          for (int nn = 0; nn < 2; ++nn) { const int nt = 2 * (wave & 1) + nn; f32x4 acc = {0.f, 0.f, 0.f, 0.f};
            if (nt <= mt) {
#pragma unroll
                for (int ks = 0; ks < 8; ++ks) { const bf16x8 a = *(const LAS bf16x8*)(QEl + (16 * mt + i) * 264 + 32 * ks + 8 * q); const bf16x8 bb = *(const LAS bf16x8*)(KEl + (16 * nt + i) * 264 + 32 * ks + 8 * q);
                    acc = __builtin_amdgcn_mfma_f32_16x16x32_bf16(a, bb, acc, 0, 0, 0); } }
#pragma unroll
            for (int r = 0; r < 4; ++r) { const int c = 16 * mt + 4 * q + r, cp = 16 * nt + i; ATl[c * 72 + cp] = (bf16)f2bf(cp <= c ? acc[r] : 0.f); } } }
        __syncthreads();
        { const int f = tid, mt = f >> 7, ks = (f >> 6) & 1, l2 = f & 63, i2 = l2 & 15, q2 = l2 >> 4;
          const v4u o = *(const LAS v4u*)(ATl + (16 * mt + i2) * 72 + 32 * ks + 8 * q2);
          *(GAS v4u*)(ATTF + ((size_t)it * 512 + f) * 8) = o; }
#pragma unroll
        for (int k = 0; k < 4; ++k) { const int f = tid + 512 * k, w = f >> 8, mt = (f >> 6) & 3, l2 = f & 63, i2 = l2 & 15, q2 = l2 >> 4;
            const v2u lo = *(const LAS v2u*)(QEl + (16 * mt + i2) * 264 + 32 * w + 4 * q2), hi = *(const LAS v2u*)(QEl + (16 * mt + i2) * 264 + 32 * w + 16 + 4 * q2);
            v4u o; o.x = lo.x; o.y = lo.y; o.z = hi.x; o.w = hi.y;
            *(GAS v4u*)(QEF + ((((size_t)it * 8 + w) * 4 + mt) * 64 + l2) * 8) = o; }
        __syncthreads();
    }
}
constexpr int GS_QE = 0, GS_KLT = 32768, GS_ATT = 65536, GS_DEC = 73728, GS_STAGE = 74752;
constexpr int GLA_NSEG = 8, GLA_SEGLEN = 32;
template <int PASS>
__device__ __forceinline__ void gla_scan(LAS unsigned char* lds, const bf16* QEF, const bf16* KLTF, const bf16* ATTF, const bf16* VTF, const float* DEC, float* SEND, float* DTOT, bf16* O) {
    const int tid = threadIdx.x, lane = tid & 63, w = __builtin_amdgcn_readfirstlane(tid >> 6), q = lane >> 4, li = lane & 15;
#define GS_ISSUE(itv, bufv) do { LAS unsigned char* _st = lds + (bufv) * GS_STAGE; const size_t _it = (size_t)(itv); \
        _Pragma("unroll") for (int _k = 0; _k < 4; ++_k) { const int _f = 4 * w + _k; \
            if (PASS == 1) __builtin_amdgcn_global_load_lds((const unsigned*)(QEF + (_it * 32 + _f) * 512 + lane * 8), (LAS unsigned*)(_st + GS_QE + _f * 1024), 16, 0, 0); \
            __builtin_amdgcn_global_load_lds((const unsigned*)(KLTF + (_it * 32 + _f) * 512 + lane * 8), (LAS unsigned*)(_st + GS_KLT + _f * 1024), 16, 0, 0); } \
        if (PASS == 1) __builtin_amdgcn_global_load_lds((const unsigned*)(ATTF + (_it * 8 + w) * 512 + lane * 8), (LAS unsigned*)(_st + GS_ATT + w * 1024), 16, 0, 0); \
        if (w == 0) __builtin_amdgcn_global_load_lds((const unsigned*)(DEC + _it * 256 + lane * 4), (LAS unsigned*)(_st + GS_DEC), 16, 0, 0); } while (0)
    for (int wi = blockIdx.x; wi < 256; wi += gridDim.x) {
        const int bh = wi & 7, rest = wi >> 3, seg = rest >> 2, vsl = rest & 3, h = bh & 3, b = bh >> 2;
        const int it0 = bh * 256 + seg * GLA_SEGLEN, vs16 = vsl * 8 + w;
        f32x4 S[16];
#pragma unroll
        for (int m = 0; m < 16; ++m) S[m] = (f32x4){0.f, 0.f, 0.f, 0.f};
        if (PASS == 1) {
            for (int s2 = 0; s2 < seg; ++s2) { const float* se = SEND + ((size_t)((bh * GLA_NSEG + s2) * 32 + vs16) * 16) * 256; const float* dt = DTOT + (size_t)(bh * GLA_NSEG + s2) * 256;
#pragma unroll
                for (int m = 0; m < 16; ++m) { const f32x4 dv = *(const GAS f32x4*)(dt + 16 * m + 4 * q), sv = *(const GAS f32x4*)(se + (m * 64 + lane) * 4); S[m] = S[m] * dv + sv; } }
        } else if (vsl == 0 && tid < 256) { float p = 1.f;
            for (int n = 0; n < GLA_SEGLEN; ++n) p *= DEC[(size_t)(it0 + n) * 256 + tid];
            DTOT[(size_t)(bh * GLA_NSEG + seg) * 256 + tid] = p; }
        __syncthreads();
        GS_ISSUE(it0, 0);
        const GAS bf16x8* v16 = (const GAS bf16x8*)VTF + (((size_t)it0 * 32 + vs16) * 2) * 64 + lane;
        bf16x8 vb0 = v16[0], vb1 = v16[64], nvb0 = vb0, nvb1 = vb1;
        for (int n = 0; n < GLA_SEGLEN; ++n) {
            VM_WAIT(); __syncthreads();
            if (n + 1 < GLA_SEGLEN) { GS_ISSUE(it0 + n + 1, (n + 1) & 1); nvb0 = v16[(size_t)(n + 1) * 4096]; nvb1 = v16[(size_t)(n + 1) * 4096 + 64]; }
            const LAS unsigned char* st = lds + (n & 1) * GS_STAGE;
            f32x4 po[4];
            if (PASS == 1) {
                bf16x8 sb[8];
#pragma unroll
                for (int ks = 0; ks < 8; ++ks) { v4u x; x.x = pk2(S[2 * ks][0], S[2 * ks][1]); x.y = pk2(S[2 * ks][2], S[2 * ks][3]); x.z = pk2(S[2 * ks + 1][0], S[2 * ks + 1][1]); x.w = pk2(S[2 * ks + 1][2], S[2 * ks + 1][3]); sb[ks] = __builtin_bit_cast(bf16x8, x); }
#pragma unroll
                for (int mt = 0; mt < 4; ++mt) { f32x4 a = {0.f, 0.f, 0.f, 0.f};
#pragma unroll
                    for (int ks = 0; ks < 8; ++ks) a = __builtin_amdgcn_mfma_f32_16x16x32_bf16(*(const LAS bf16x8*)(st + GS_QE + (ks * 4 + mt) * 1024 + lane * 16), sb[ks], a, 0, 0, 0);
                    a = __builtin_amdgcn_mfma_f32_16x16x32_bf16(*(const LAS bf16x8*)(st + GS_ATT + (mt * 2 + 0) * 1024 + lane * 16), vb0, a, 0, 0, 0);
                    a = __builtin_amdgcn_mfma_f32_16x16x32_bf16(*(const LAS bf16x8*)(st + GS_ATT + (mt * 2 + 1) * 1024 + lane * 16), vb1, a, 0, 0, 0);
                    po[mt] = a; }
            }
#pragma unroll
            for (int m = 0; m < 16; ++m) { const f32x4 dv = *(const LAS f32x4*)(st + GS_DEC + (16 * m + 4 * q) * 4);
                f32x4 s = S[m] * dv;
                s = __builtin_amdgcn_mfma_f32_16x16x32_bf16(*(const LAS bf16x8*)(st + GS_KLT + (m * 2 + 0) * 1024 + lane * 16), vb0, s, 0, 0, 0);
                s = __builtin_amdgcn_mfma_f32_16x16x32_bf16(*(const LAS bf16x8*)(st + GS_KLT + (m * 2 + 1) * 1024 + lane * 16), vb1, s, 0, 0, 0);
                S[m] = s; }
            if (PASS == 1) { bf16* op = O + (size_t)(b * SEQ + (seg * GLA_SEGLEN + n) * GLA_C + 4 * q) * 2048 + h * 512 + vsl * 128 + w * 16 + li;
#pragma unroll
                for (int mt = 0; mt < 4; ++mt)
#pragma unroll
                    for (int r = 0; r < 4; ++r) { const float x = po[mt][r], y = __shfl_xor(x, 1); if ((lane & 1) == 0) *(GAS unsigned*)(op + (size_t)(16 * mt + r) * 2048) = pk2(x, y); } }
            vb0 = nvb0; vb1 = nvb1;
        }
        if (PASS == 0) { float* se = SEND + ((size_t)((bh * GLA_NSEG + seg) * 32 + vs16) * 16) * 256;
#pragma unroll
            for (int m = 0; m < 16; ++m) *(GAS f32x4*)(se + (m * 64 + lane) * 4) = S[m]; }
        __syncthreads();
    }
#undef GS_ISSUE
}
__device__ __forceinline__ void gla_gate(const bf16* O, const bf16* R, const float* head_g, bf16* OG, int gw, int NGW, int lane) {
    float hg[8];
#pragma unroll
    for (int j = 0; j < 8; ++j) hg[j] = head_g[8 * lane + j];
    for (int m = gw; m < T; m += NGW) {
#pragma unroll
        for (int h = 0; h < 4; ++h) {
            const v4u ov = *(const GAS v4u*)(O + (size_t)m * 2048 + h * 512 + 8 * lane), rv = *(const GAS v4u*)(R + (size_t)m * 2048 + h * 512 + 8 * lane);
            float o[8] = {bf_lo(ov.x), bf_hi(ov.x), bf_lo(ov.y), bf_hi(ov.y), bf_lo(ov.z), bf_hi(ov.z), bf_lo(ov.w), bf_hi(ov.w)};
            float r[8] = {bf_lo(rv.x), bf_hi(rv.x), bf_lo(rv.y), bf_hi(rv.y), bf_lo(rv.z), bf_hi(rv.z), bf_lo(rv.w), bf_hi(rv.w)};
            float ss = 0.f;
#pragma unroll
            for (int j = 0; j < 8; ++j) ss += o[j] * o[j];
            const float rstd = rsqrtf(wave_sum(ss) * (1.f / 512.f) + RMS_EPS);
            float y[8];
#pragma unroll
            for (int j = 0; j < 8; ++j) y[j] = o[j] * rstd * hg[j] * pg8::silu_f(r[j]);
            v4u w; w.x = pk2(y[0], y[1]); w.y = pk2(y[2], y[3]); w.z = pk2(y[4], y[5]); w.w = pk2(y[6], y[7]);
            *(GAS v4u*)(OG + (size_t)m * 2048 + h * 512 + 8 * lane) = w;
        }
    }
}

__device__ __forceinline__ void moe_route(LAS unsigned char* lds, const float* RL, const float* SSP, const float* bgroup, const float* brouter, unsigned* gcnt, unsigned* EP0, unsigned* EP1, float* W0, float* W1, float* RSTD) {
    const int tid = threadIdx.x; LAS int* lcnt = (LAS int*)lds; LAS int* lbase = lcnt + 32;
    for (int base = blockIdx.x * 128; base < T; base += gridDim.x * 128) {
        if (tid < 32) lcnt[tid] = 0;
        __syncthreads();
        int e0 = 0, e1 = 0, r0 = 0, r1 = 0; float w0 = 0.f, w1 = 0.f;
        if (tid < 128) { const int t = base + tid; const float* rl = RL + (size_t)t * 64;
            float ssq = 0.f; { const GAS f32x4* sp = (const GAS f32x4*)(SSP + (size_t)t * 32);
#pragma unroll
                for (int k = 0; k < 8; ++k) { const f32x4 v = sp[k]; ssq += (v.x + v.y) + (v.z + v.w); } }
            const float rstd = rsqrtf(ssq * (1.f / D) + RMS_EPS); RSTD[t] = rstd;
            const f32x4 g4 = *(const GAS f32x4*)rl; float gl[4] = {g4.x * rstd + bgroup[0], g4.y * rstd + bgroup[1], g4.z * rstd + bgroup[2], g4.w * rstd + bgroup[3]};
            int g = 0; float best = gl[0];
#pragma unroll
            for (int j = 1; j < 4; ++j) if (gl[j] > best) { best = gl[j]; g = j; }
            float se = 0.f;
#pragma unroll
            for (int j = 0; j < 4; ++j) se += __expf(gl[j] - best);
            const float pg = 1.0f / se;
            const f32x4 a4 = *(const GAS f32x4*)(rl + 4 + 8 * g), b4 = *(const GAS f32x4*)(rl + 8 + 8 * g);
            float el[8] = {a4.x, a4.y, a4.z, a4.w, b4.x, b4.y, b4.z, b4.w};
#pragma unroll
            for (int j = 0; j < 8; ++j) el[j] = el[j] * rstd + brouter[8 * g + j];
            int i0 = 0; float v0 = el[0];
#pragma unroll
            for (int j = 1; j < 8; ++j) if (el[j] > v0) { v0 = el[j]; i0 = j; }
            int i1 = -1; float v1 = -3.0e38f;
#pragma unroll
            for (int j = 0; j < 8; ++j) if (j != i0 && el[j] > v1) { v1 = el[j]; i1 = j; }
            w0 = pg / (1.0f + __expf(v1 - v0)); w1 = pg - w0;
            e0 = 8 * g + i0; e1 = 8 * g + i1;
            r0 = __hip_atomic_fetch_add(&lcnt[e0], 1, __ATOMIC_RELAXED, __HIP_MEMORY_SCOPE_WORKGROUP); r1 = __hip_atomic_fetch_add(&lcnt[e1], 1, __ATOMIC_RELAXED, __HIP_MEMORY_SCOPE_WORKGROUP); }
        __syncthreads();
        if (tid < 32) lbase[tid] = (int)__hip_atomic_fetch_add(gcnt + tid, (unsigned)lcnt[tid], RLX_AGENT);
        __syncthreads();
        if (tid < 128) { const int t = base + tid;
            EP0[t] = ((unsigned)e0 << 24) | (unsigned)(lbase[e0] + r0); EP1[t] = ((unsigned)e1 << 24) | (unsigned)(lbase[e1] + r1); W0[t] = w0; W1[t] = w1; }
        __syncthreads();
    }
}
__device__ __forceinline__ void moe_build_table(LAS unsigned char* ldsbase, unsigned* gcnt) {
    LAS int* off = (LAS int*)(ldsbase + MOE_OFF_OFF); LAS unsigned char* texp = ldsbase + MOE_TEXP_OFF;
    __syncthreads();
    if (threadIdx.x == 0) { int acc = 0, ti = 0;
        for (int e = 0; e < NE; ++e) { const int c = (int)__hip_atomic_load(gcnt + e, RLX_AGENT); off[e] = acc; const int nt = (c + 255) >> 8;
            for (int k = 0; k < nt && ti < 288; ++k) texp[ti++] = (unsigned char)e;
            acc += nt * 256; }
        off[32] = acc; }
    __syncthreads();
}
__device__ __forceinline__ void moe_slots(LAS unsigned char* ldsbase, unsigned* gcnt, const unsigned* EP0, const unsigned* EP1, const float* RSTD, unsigned* SL0, unsigned* SL1, unsigned* TL, float* RS) {
    const LAS int* off = (const LAS int*)(ldsbase + MOE_OFF_OFF); const int tid = threadIdx.x;
    for (int t = blockIdx.x * 512 + tid; t < T; t += gridDim.x * 512) {
        const unsigned p0 = EP0[t], p1 = EP1[t]; const float rs = RSTD[t];
        const unsigned s0 = (unsigned)off[p0 >> 24] + (p0 & 0xffffffu), s1 = (unsigned)off[p1 >> 24] + (p1 & 0xffffffu);
        TL[s0] = (unsigned)t; RS[s0] = rs; TL[s1] = (unsigned)t; RS[s1] = rs; SL0[t] = s0; SL1[t] = s1; }
    for (int e = blockIdx.x; e < NE; e += gridDim.x) { const int c = (int)__hip_atomic_load(gcnt + e, RLX_AGENT);
        for (int i = off[e] + c + tid; i < off[e + 1]; i += 512) { TL[i] = 0u; RS[i] = 0.f; } }
}
template <bool FINAL>
__device__ __forceinline__ void moe_combine(const bf16* H, const bf16* Y, const unsigned* SL0, const unsigned* SL1, const float* W0, const float* W1, float* outf, bf16* H2, bf16* HN, int gw, int NGW, int lane) {
    for (int t = gw; t < T; t += NGW) {
        const unsigned s0 = SL0[t], s1 = SL1[t]; const float w0 = W0[t], w1 = W1[t];
        const GAS v2u* hr = (const GAS v2u*)(H + (size_t)t * D) + lane;
        const GAS v2u* y0 = (const GAS v2u*)(Y + (size_t)s0 * 2048) + lane; const GAS v2u* y1 = (const GAS v2u*)(Y + (size_t)s1 * 2048) + lane;
        f32x4 v[8]; float s = 0.f;
#pragma unroll
        for (int j = 0; j < 8; ++j) { const v2u a = y0[64 * j], b = y1[64 * j], hh = hr[64 * j]; f32x4 x;
            x.x = bf_lo(hh.x) + w0 * bf_lo(a.x) + w1 * bf_lo(b.x); x.y = bf_hi(hh.x) + w0 * bf_hi(a.x) + w1 * bf_hi(b.x); x.z = bf_lo(hh.y) + w0 * bf_lo(a.y) + w1 * bf_lo(b.y); x.w = bf_hi(hh.y) + w0 * bf_hi(a.y) + w1 * bf_hi(b.y);
            v[j] = x; s += (x.x * x.x + x.y * x.y) + (x.z * x.z + x.w * x.w); }
        if constexpr (FINAL) { GAS f32x4* xr = (GAS f32x4*)(outf + (size_t)t * D) + lane;
#pragma unroll
            for (int j = 0; j < 8; ++j) xr[64 * j] = v[j]; }
        else { const float rstd = rsqrtf(wave_sum(s) * (1.f / D) + RMS_EPS);
            GAS v2u* o8 = (GAS v2u*)(HN + (size_t)t * D) + lane; GAS v2u* h8 = (GAS v2u*)(H2 + (size_t)t * D) + lane;
#pragma unroll
            for (int j = 0; j < 8; ++j) { v2u o; o.x = pk2(v[j].x, v[j].y); o.y = pk2(v[j].z, v[j].w); h8[64 * j] = o;
                o.x = pk2(v[j].x * rstd, v[j].y * rstd); o.y = pk2(v[j].z * rstd, v[j].w * rstd); o8[64 * j] = o; } }
    }
}

__device__ const unsigned char T5_BUCKET[128] = {0,1,2,3,4,5,6,7,8,9,10,11,12,13,14,15,16,16,16,17,17,18,18,18,19,19,19,20,20,20,20,21,21,21,21,22,22,22,22,22,23,23,23,23,23,23,24,24,24,24,24,24,25,25,25,25,25,25,25,26,26,26,26,26,26,26,26,27,27,27,27,27,27,27,27,27,27,28,28,28,28,28,28,28,28,28,28,29,29,29,29,29,29,29,29,29,29,29,29,30,30,30,30,30,30,30,30,30,30,30,30,30,30,31,31,31,31,31,31,31,31,31,31,31,31,31,31,31};
constexpr int AT_K = 0, AT_VT = 36864, AT_BIAS = 70656;
__device__ __forceinline__ void swa_attention(LAS unsigned char* lds, const bf16* KVQ, const bf16* VT, const float* knorm, const float* qnorm, const float* relb, const float* sinks, bf16* AO) {
    const int tid = threadIdx.x, lane = tid & 63, g = __builtin_amdgcn_readfirstlane(tid >> 6), li = lane & 15, q = lane >> 4;
    LAS bf16* KL = (LAS bf16*)(lds + AT_K); LAS bf16* VTL = (LAS bf16*)(lds + AT_VT); LAS float* BL = (LAS float*)(lds + AT_BIAS);
    constexpr float LOG2E = 1.4426950408889634f;
    float qn[2][8];
#pragma unroll
    for (int ks = 0; ks < 2; ++ks)
#pragma unroll
        for (int j = 0; j < 8; ++j) qn[ks][j] = qnorm[32 * ks + 8 * q + j] * (0.125f * LOG2E);
    const int key = tid >> 1, hf = tid & 1, vd = tid >> 3, vc = tid & 7;
    float kn[32];
#pragma unroll
    for (int j = 0; j < 32; ++j) kn[j] = knorm[32 * hf + j];
    v4u kw[4], vw[4];
#define AT_PREFETCH(wiv) do { const int _hk = (wiv) & 3, _n = ((wiv) >> 2) & 127, _b = (wiv) >> 9; \
        const bool _live = (_n > 0) || (key >= 128); const size_t _tk = (size_t)_b * SEQ + (size_t)(_n - 1) * 128 + key; \
        const bf16* _kp = KVQ + _tk * KVQ_N + _hk * 64 + 32 * hf; \
        _Pragma("unroll") for (int _j = 0; _j < 4; ++_j) kw[_j] = _live ? *(const GAS v4u*)(_kp + 8 * _j) : (v4u){0u, 0u, 0u, 0u}; \
        const bf16* _vp = VT + ((size_t)(_b * 4 + _hk) * 64 + vd) * SEQ + (size_t)(_n - 1) * 128; \
        _Pragma("unroll") for (int _j = 0; _j < 4; ++_j) { const int _c = vc + 8 * _j; vw[_j] = ((_n > 0) || (_c >= 16)) ? *(const GAS v4u*)(_vp + 8 * _c) : (v4u){0u, 0u, 0u, 0u}; } } while (0)
    if (blockIdx.x < 1024) AT_PREFETCH(blockIdx.x);
    for (int wi = blockIdx.x; wi < 1024; wi += gridDim.x) {
        const int hk = wi & 3, n = (wi >> 2) & 127, b = wi >> 9;
        __syncthreads();
        { float ss = 0.f;
#pragma unroll
          for (int j = 0; j < 4; ++j) { const float a0 = bf_lo(kw[j].x), a1 = bf_hi(kw[j].x), a2 = bf_lo(kw[j].y), a3 = bf_hi(kw[j].y), a4 = bf_lo(kw[j].z), a5 = bf_hi(kw[j].z), a6 = bf_lo(kw[j].w), a7 = bf_hi(kw[j].w);
              ss += (a0 * a0 + a1 * a1) + (a2 * a2 + a3 * a3) + (a4 * a4 + a5 * a5) + (a6 * a6 + a7 * a7); }
          ss += __shfl_xor(ss, 1);
          const float rstd = rsqrtf(ss * (1.f / 64.f) + RMS_EPS);
#pragma unroll
          for (int j = 0; j < 4; ++j) { v4u o;
              o.x = pk2(bf_lo(kw[j].x) * rstd * kn[8 * j + 0], bf_hi(kw[j].x) * rstd * kn[8 * j + 1]); o.y = pk2(bf_lo(kw[j].y) * rstd * kn[8 * j + 2], bf_hi(kw[j].y) * rstd * kn[8 * j + 3]);
              o.z = pk2(bf_lo(kw[j].z) * rstd * kn[8 * j + 4], bf_hi(kw[j].z) * rstd * kn[8 * j + 5]); o.w = pk2(bf_lo(kw[j].w) * rstd * kn[8 * j + 6], bf_hi(kw[j].w) * rstd * kn[8 * j + 7]);
              *(LAS v4u*)(KL + key * 72 + 32 * hf + 8 * j) = o; }
#pragma unroll
          for (int j = 0; j < 4; ++j) *(LAS v4u*)(VTL + vd * 264 + 8 * (vc + 8 * j)) = vw[j];
#pragma unroll
          for (int k = 0; k < 2; ++k) { const int e = tid + 512 * k, gg = e >> 7, dist = e & 127; BL[e] = relb[(int)T5_BUCKET[dist] * 32 + hk * 8 + gg] * LOG2E; }
        }
        __syncthreads();
        if (wi + (int)gridDim.x < 1024) AT_PREFETCH(wi + (int)gridDim.x);
        const int head = hk * 8 + g; const float sink = sinks[head] * LOG2E;
        float bz[9][4];
#pragma unroll
        for (int tt = 0; tt < 9; ++tt)
#pragma unroll
            for (int r = 0; r < 4; ++r) { const int dist = 128 - 16 * tt + li - (4 * q + r); const bool ok = (dist >= 0) && (dist < 128);
                bz[tt][r] = ok ? BL[g * 128 + (dist & 127)] : -__builtin_inff(); }
        v4u qr0, qr1;
        { const bf16* qp = KVQ + ((size_t)b * SEQ + (size_t)n * 128 + li) * KVQ_N + 512 + head * 64 + 8 * q; qr0 = *(const GAS v4u*)qp; qr1 = *(const GAS v4u*)(qp + 32); }
        for (int mt = 0; mt < 8; ++mt) {
            const size_t tq = (size_t)b * SEQ + (size_t)n * 128 + 16 * mt + li;
            bf16x8 qf[2];
            { const v4u q0 = qr0, q1 = qr1;
              if (mt < 7) { const bf16* qp = KVQ + (tq + 16) * KVQ_N + 512 + head * 64 + 8 * q; qr0 = *(const GAS v4u*)qp; qr1 = *(const GAS v4u*)(qp + 32); }
              float a[16] = {bf_lo(q0.x), bf_hi(q0.x), bf_lo(q0.y), bf_hi(q0.y), bf_lo(q0.z), bf_hi(q0.z), bf_lo(q0.w), bf_hi(q0.w), bf_lo(q1.x), bf_hi(q1.x), bf_lo(q1.y), bf_hi(q1.y), bf_lo(q1.z), bf_hi(q1.z), bf_lo(q1.w), bf_hi(q1.w)};
              float ss = 0.f;
#pragma unroll
              for (int j = 0; j < 16; ++j) ss += a[j] * a[j];
              ss += __shfl_xor(ss, 16); ss += __shfl_xor(ss, 32);
              const float rstd = rsqrtf(ss * (1.f / 64.f) + RMS_EPS);
              v4u w0, w1;
              w0.x = pk2(a[0] * rstd * qn[0][0], a[1] * rstd * qn[0][1]); w0.y = pk2(a[2] * rstd * qn[0][2], a[3] * rstd * qn[0][3]); w0.z = pk2(a[4] * rstd * qn[0][4], a[5] * rstd * qn[0][5]); w0.w = pk2(a[6] * rstd * qn[0][6], a[7] * rstd * qn[0][7]);
              w1.x = pk2(a[8] * rstd * qn[1][0], a[9] * rstd * qn[1][1]); w1.y = pk2(a[10] * rstd * qn[1][2], a[11] * rstd * qn[1][3]); w1.z = pk2(a[12] * rstd * qn[1][4], a[13] * rstd * qn[1][5]); w1.w = pk2(a[14] * rstd * qn[1][6], a[15] * rstd * qn[1][7]);
              qf[0] = __builtin_bit_cast(bf16x8, w0); qf[1] = __builtin_bit_cast(bf16x8, w1); }
            f32x4 st[9]; float mx = sink;
#pragma unroll
            for (int tt = 0; tt < 9; ++tt) { const int nt = mt + tt;
                if (n == 0 && nt < 8) { st[tt] = (f32x4){-__builtin_inff(), -__builtin_inff(), -__builtin_inff(), -__builtin_inff()}; }
                else { f32x4 acc = {0.f, 0.f, 0.f, 0.f};
#pragma unroll
                    for (int ks = 0; ks < 2; ++ks) { const bf16x8 a = *(const LAS bf16x8*)(KL + (16 * nt + li) * 72 + 32 * ks + 8 * q); acc = __builtin_amdgcn_mfma_f32_16x16x32_bf16(a, qf[ks], acc, 0, 0, 0); }
#pragma unroll
                    for (int r = 0; r < 4; ++r) { acc[r] += bz[tt][r]; mx = fmaxf(mx, acc[r]); }
                    st[tt] = acc; } }
            mx = fmaxf(mx, __shfl_xor(mx, 16)); mx = fmaxf(mx, __shfl_xor(mx, 32));
            float lsum = 0.f;
#pragma unroll
            for (int tt = 0; tt < 9; ++tt)
#pragma unroll
                for (int r = 0; r < 4; ++r) { const float p = __builtin_amdgcn_exp2f(st[tt][r] - mx); st[tt][r] = p; lsum += p; }
            lsum += __shfl_xor(lsum, 16); lsum += __shfl_xor(lsum, 32);
            const float inv = 1.0f / (lsum + __builtin_amdgcn_exp2f(sink - mx));
            f32x4 oacc[4];
#pragma unroll
            for (int dt = 0; dt < 4; ++dt) oacc[dt] = (f32x4){0.f, 0.f, 0.f, 0.f};
#pragma unroll
            for (int s = 0; s < 5; ++s) {
                v4u pw; pw.x = pk2(st[2 * s][0], st[2 * s][1]); pw.y = pk2(st[2 * s][2], st[2 * s][3]);
                if (s < 4) { pw.z = pk2(st[2 * s + 1][0], st[2 * s + 1][1]); pw.w = pk2(st[2 * s + 1][2], st[2 * s + 1][3]); } else { pw.z = 0u; pw.w = 0u; }
                const bf16x8 pb = __builtin_bit_cast(bf16x8, pw);
                const int k0 = 16 * (mt + 2 * s) + 4 * q; int k1 = 16 * (mt + 2 * s + 1) + 4 * q; if (k1 > 252) k1 = 240 + 4 * q;
#pragma unroll
                for (int dt = 0; dt < 4; ++dt) { const v2u lo = *(const LAS v2u*)(VTL + (16 * dt + li) * 264 + k0), hi = *(const LAS v2u*)(VTL + (16 * dt + li) * 264 + k1);
                    v4u aw; aw.x = lo.x; aw.y = lo.y; aw.z = hi.x; aw.w = hi.y;
                    oacc[dt] = __builtin_amdgcn_mfma_f32_16x16x32_bf16(__builtin_bit_cast(bf16x8, aw), pb, oacc[dt], 0, 0, 0); } }
#pragma unroll
            for (int dt = 0; dt < 4; ++dt) { v2u o; o.x = pk2(oacc[dt][0] * inv, oacc[dt][1] * inv); o.y = pk2(oacc[dt][2] * inv, oacc[dt][3] * inv);
                *(GAS v2u*)(AO + tq * 2048 + head * 64 + 16 * dt + 4 * q) = o; }
        }
    }
#undef AT_PREFETCH
}


struct Args { const float* in[24]; float* out; unsigned char* ws; int ph_lo, ph_hi; };
constexpr int N_PHASES = 23;
#define CAS __attribute__((address_space(4)))
template <int WHICH> struct OrderCvt : pg8::StaticOrder {
    int tpm, tpn, gw, NGW, lane;
    __device__ __forceinline__ void set_trigger(int when) { pg8::Unit u; if (!next(when, u)) (void)next(0, u); tpm = u.pm; tpn = u.pn; }
    __device__ __forceinline__ void done(const pg8::Unit& u) const {
        if (u.pm != tpm || u.pn != tpn) return;
        const CAS Args* a = (const CAS Args*)__builtin_amdgcn_kernarg_segment_ptr();
        unsigned char* ws = a->ws;
        if (WHICH == 0) {
            cvt_matrix(a->in[6], 2048, 2048, nullptr, (bf16*)(ws + WS_W_GLA_OUT), 0, gw, NGW, lane);
            cvt_matrix(a->in[8], 2048, 512, a->in[7], (bf16*)(ws + WS_W_KVQ), 0, gw, NGW, lane);
            cvt_matrix(a->in[12], 2048, 2048, a->in[11], (bf16*)(ws + WS_W_KVQ), 512, gw, NGW, lane);
            cvt_matrix(a->in[15], 2048, 2048, nullptr, (bf16*)(ws + WS_W_SWA_OUT), 0, gw, NGW, lane);
            for (int l = 0; l < 2; ++l) {
                cvt_matrix(a->in[17] + (size_t)l * 2048 * 4, 2048, 4, a->in[16] + l * 2048, (bf16*)(ws + WS_W_ROUTER) + (size_t)l * 256 * 2048, 0, gw, NGW, lane);
                cvt_matrix(a->in[19] + (size_t)l * 2048 * 32, 2048, 32, a->in[16] + l * 2048, (bf16*)(ws + WS_W_ROUTER) + (size_t)l * 256 * 2048, 4, gw, NGW, lane);
            }
            cvt_moe(a->in[21], a->in[22], a->in[23], a->in[16], (bf16*)(ws + WS_W_GU), (bf16*)(ws + WS_W_DN), gw, NGW, lane);
        } else {
            cvt_moe(a->in[21] + (size_t)NE * 2048 * 512, a->in[22] + (size_t)NE * 2048 * 512, a->in[23] + (size_t)NE * 512 * 2048, a->in[16] + 2048, (bf16*)(ws + WS_W_GU), (bf16*)(ws + WS_W_DN), gw, NGW, lane);
        }
    }
};
__global__ void __launch_bounds__(NWAVES * 64, 2) fwd(Args args) {
    extern __shared__ __attribute__((aligned(16))) unsigned char lds_raw[];
    LAS unsigned char* lds = (LAS unsigned char*)lds_raw;
    const int tid = threadIdx.x, lane = tid & 63, wave = __builtin_amdgcn_readfirstlane(tid >> 6);
    const int G = gridDim.x, gw = blockIdx.x * NWAVES + wave, NGW = G * NWAVES;
    unsigned char* ws = args.ws;
    gu32* ctl = (gu32*)(ws + WS_CTL);
    for (int u = tid; u < (LDS_BYTES - LDSCTL_OFF) / 4; u += NWAVES * 64) ((LAS unsigned*)(lds + LDSCTL_OFF))[u] = 0u;
    __syncthreads();
    XcdBarrier bar = xcd_barrier_post((unsigned*)(ctl + CW_BAR), (volatile LAS unsigned*)(lds + MISC_OFF));
    const int lo = args.ph_lo, hi = args.ph_hi;
#define IN(k) ((((MK_PHASE_MASK) >> (k)) & 1) && lo <= (k) && (k) < hi)
#define PB(k) const unsigned long long _pt0 = (((MK_DELAY_MASK) >> (k)) & 1) ? __builtin_amdgcn_s_memrealtime() : 0ull
#define PE(k) do { if (((MK_DELAY_MASK) >> (k)) & 1) { const unsigned long long _pt1 = __builtin_amdgcn_s_memrealtime(), _dt = _pt1 - _pt0; while (__builtin_amdgcn_s_memrealtime() - _pt1 < _dt) __builtin_amdgcn_s_sleep(8); } } while (0)
#define SEAM(k) do { if (IN(k) && IN((k) + 1)) xcd_barrier(bar); } while (0)

    const float* x = args.in[0]; float* out = args.out;
    bf16* W_GLA_IN = (bf16*)(ws + WS_W_GLA_IN); bf16* W_GLA_OUT = (bf16*)(ws + WS_W_GLA_OUT); bf16* W_KVQ = (bf16*)(ws + WS_W_KVQ); bf16* W_SWA_OUT = (bf16*)(ws + WS_W_SWA_OUT);
    bf16* W_ROUTER = (bf16*)(ws + WS_W_ROUTER); bf16* W_GU = (bf16*)(ws + WS_W_GU); bf16* W_DN = (bf16*)(ws + WS_W_DN);
    bf16* HN = (bf16*)(ws + WS_HN);
    unsigned* EP0 = (unsigned*)(ws + WS_TOK); unsigned* EP1 = EP0 + T; unsigned* SL0 = EP1 + T; unsigned* SL1 = SL0 + T; float* TW0 = (float*)(SL1 + T); float* TW1 = TW0 + T; float* RSTD = TW1 + T;
    bf16* HB = (bf16*)(ws + WS_HB); float* SSP = (float*)(ws + WS_SSP); unsigned* TL = (unsigned*)(ws + WS_TL); float* RS = (float*)(ws + WS_RS);
    float* RL = (float*)(ws + WS_RL);

    if (IN(0)) { PB(0);
        cvt_matrix(args.in[2], 2048, GLA_PROJ_N, args.in[1], W_GLA_IN, 0, gw, NGW, lane);
        norm_rows(x, HN, gw, NGW, lane);
        PE(0);
    }
    SEAM(0);
#define STAGGER(groups, ticks) do { if ((ticks) > 0) { const unsigned long long _s0 = __builtin_amdgcn_s_memrealtime(), _sd = (unsigned long long)((blockIdx.x % (groups)) * (ticks)); \
        while (__builtin_amdgcn_s_memrealtime() - _s0 < _sd) __builtin_amdgcn_s_sleep(4); } } while (0)
    if (IN(1)) { PB(1);
        pg8::Gemm g{HN, W_GLA_IN, T, GLA_PROJ_NP, 2048}; OrderCvt<0> S; S.init(T, GLA_PROJ_NP, G, (int)blockIdx.x); S.gw = gw; S.NGW = NGW; S.lane = lane; S.set_trigger((int)(blockIdx.x % 12));
        pg8::EpiGlaProj E{(bf16*)(ws + WS_QK), (bf16*)(ws + WS_V), (bf16*)(ws + WS_R), (bf16*)(ws + WS_GL)};
        STAGGER(4, MK_STAG1);
        pg8::gemm_phase<pg8::EpiGlaProj, OrderCvt<0>, true, true>(lds + RING_OFF, g, S, E);
        PE(1);
    }
    SEAM(1);
    if (IN(2)) { PB(2); gla_prepass(lds + RING_OFF, (const bf16*)(ws + WS_QK), (const bf16*)(ws + WS_V), (const bf16*)(ws + WS_GL), args.in[3], args.in[4],
                           (bf16*)(ws + WS_QEF), (bf16*)(ws + WS_KLTF), (bf16*)(ws + WS_ATTF), (bf16*)(ws + WS_VTF), (float*)(ws + WS_DEC)); PE(2); }
    SEAM(2);
    if (IN(3)) { PB(3); gla_scan<0>(lds + RING_OFF, (const bf16*)(ws + WS_QEF), (const bf16*)(ws + WS_KLTF), (const bf16*)(ws + WS_ATTF), (const bf16*)(ws + WS_VTF), (const float*)(ws + WS_DEC), (float*)(ws + WS_SEND), (float*)(ws + WS_DTOT), (bf16*)(ws + WS_QK)); PE(3); }
    SEAM(3);
    if (IN(4)) { PB(4); gla_scan<1>(lds + RING_OFF, (const bf16*)(ws + WS_QEF), (const bf16*)(ws + WS_KLTF), (const bf16*)(ws + WS_ATTF), (const bf16*)(ws + WS_VTF), (const float*)(ws + WS_DEC), (float*)(ws + WS_SEND), (float*)(ws + WS_DTOT), (bf16*)(ws + WS_QK)); PE(4); }
    SEAM(4);
    if (IN(5)) { PB(5); gla_gate((const bf16*)(ws + WS_QK), (const bf16*)(ws + WS_R), args.in[5], HN, gw, NGW, lane); PE(5); }
    SEAM(5);
    if (IN(6)) { PB(6);
        pg8::Gemm g{HN, W_GLA_OUT, T, 2048, 2048}; pg8::StaticOrder S; S.init(T, 2048, G, (int)blockIdx.x);
        pg8::EpiResBf16<false> E{x, 2048, HB, SSP};
        pg8::gemm_phase<pg8::EpiResBf16<false>, pg8::StaticOrder, true, true>(lds + RING_OFF, g, S, E);
        PE(6);
    }
    SEAM(6);

    { constexpr int layer = 0; constexpr int pb = 6 + 10 * layer;
    unsigned* gcnt = (unsigned*)(ctl + CW_CNT + layer * 64);
    if (IN(pb + 1)) { PB(pb + 1);
        pg8::Gemm g{HB, W_ROUTER + (size_t)layer * 256 * 2048, T, 256, 2048}; pg8::StaticOrder S; S.init(T, 256, G, (int)blockIdx.x);
        pg8::EpiRouter E{RL};
        pg8::gemm_phase<pg8::EpiRouter, pg8::StaticOrder, true, true>(lds + RING_OFF, g, S, E);
        PE(pb + 1);
    }
    SEAM(pb + 1);
    if (IN(pb + 2)) { PB(pb + 2); moe_route(lds + RING_OFF, RL, SSP, args.in[18] + layer * 4, args.in[20] + layer * 32, gcnt, EP0, EP1, TW0, TW1, RSTD); PE(pb + 2); }
    SEAM(pb + 2);
    if (IN(pb + 3)) { PB(pb + 3); { moe_build_table(lds, gcnt); moe_slots(lds, gcnt, EP0, EP1, RSTD, SL0, SL1, TL, RS); } PE(pb + 3); }
    SEAM(pb + 3);
    if (IN(pb + 4)) { PB(pb + 4);
        moe_build_table(lds, gcnt);
        const int rows = __builtin_amdgcn_readfirstlane(((const LAS int*)(lds + MOE_OFF_OFF))[32]);
        pg8::Gemm g{HB, W_GU, rows, 1024, 2048, TL};
        pg8::GroupedOrder S{(const LAS unsigned char*)(lds + MOE_TEXP_OFF), rows >> 8, 4, G, (int)blockIdx.x};
        pg8::EpiSwiGLU E{(bf16*)(ws + WS_ACT), RS};
        pg8::gemm_phase<pg8::EpiSwiGLU, pg8::GroupedOrder, true, true, true>(lds + RING_OFF, g, S, E);
        PE(pb + 4);
    }
    SEAM(pb + 4);
    if (IN(pb + 5)) { PB(pb + 5);
        moe_build_table(lds, gcnt);
        const int rows = __builtin_amdgcn_readfirstlane(((const LAS int*)(lds + MOE_OFF_OFF))[32]);
        pg8::Gemm g{(const bf16*)(ws + WS_ACT), W_DN, rows, 2048, 512};
        pg8::GroupedOrder S{(const LAS unsigned char*)(lds + MOE_TEXP_OFF), rows >> 8, 8, G, (int)blockIdx.x};
        pg8::EpiBf16 E{(bf16*)(ws + WS_Y), 2048};
        pg8::gemm_phase<pg8::EpiBf16, pg8::GroupedOrder, true, true>(lds + RING_OFF, g, S, E);
        PE(pb + 5);
    }
    SEAM(pb + 5);
    if (IN(pb + 6)) { PB(pb + 6);
        moe_combine<false>(HB, (const bf16*)(ws + WS_Y), SL0, SL1, TW0, TW1, nullptr, (bf16*)out, HN, gw, NGW, lane);
        PE(pb + 6);
    }
    if (layer == 0) SEAM(pb + 6);
    }
    if (IN(13)) { PB(13);
        pg8::Gemm g{HN, W_KVQ, T, KVQ_N, 2048}; OrderCvt<1> S; S.init(T, KVQ_N, G, (int)blockIdx.x); S.gw = gw; S.NGW = NGW; S.lane = lane; S.set_trigger((int)(blockIdx.x % 5));
        pg8::EpiKVQ E{(bf16*)(ws + WS_KVQ), (bf16*)(ws + WS_VT)};
        pg8::gemm_phase<pg8::EpiKVQ, OrderCvt<1>, true, true>(lds + RING_OFF, g, S, E);
        PE(13);
    }
    SEAM(13);
    if (IN(14)) { PB(14); swa_attention(lds + RING_OFF, (const bf16*)(ws + WS_KVQ), (const bf16*)(ws + WS_VT), args.in[9], args.in[13], args.in[10], args.in[14], (bf16*)(ws + WS_AO)); PE(14); }
    SEAM(14);
    if (IN(15)) { PB(15);
        pg8::Gemm g{(const bf16*)(ws + WS_AO), W_SWA_OUT, T, 2048, 2048}; pg8::StaticOrder S; S.init(T, 2048, G, (int)blockIdx.x);
        pg8::EpiResBf16<true> E{(const bf16*)out, 2048, HB, SSP};
        pg8::gemm_phase<pg8::EpiResBf16<true>, pg8::StaticOrder, true, true>(lds + RING_OFF, g, S, E);
        PE(15);
    }
    SEAM(15);
    { constexpr int layer = 1; constexpr int pb = 6 + 10 * layer;
    unsigned* gcnt = (unsigned*)(ctl + CW_CNT + layer * 64);
    if (IN(pb + 1)) { PB(pb + 1);
        pg8::Gemm g{HB, W_ROUTER + (size_t)layer * 256 * 2048, T, 256, 2048}; pg8::StaticOrder S; S.init(T, 256, G, (int)blockIdx.x);
        pg8::EpiRouter E{RL};
        pg8::gemm_phase<pg8::EpiRouter, pg8::StaticOrder, true, true>(lds + RING_OFF, g, S, E);
        PE(pb + 1);
    }
    SEAM(pb + 1);
    if (IN(pb + 2)) { PB(pb + 2); moe_route(lds + RING_OFF, RL, SSP, args.in[18] + layer * 4, args.in[20] + layer * 32, gcnt, EP0, EP1, TW0, TW1, RSTD); PE(pb + 2); }
    SEAM(pb + 2);
    if (IN(pb + 3)) { PB(pb + 3); { moe_build_table(lds, gcnt); moe_slots(lds, gcnt, EP0, EP1, RSTD, SL0, SL1, TL, RS); } PE(pb + 3); }
    SEAM(pb + 3);
    if (IN(pb + 4)) { PB(pb + 4);
        moe_build_table(lds, gcnt);
        const int rows = __builtin_amdgcn_readfirstlane(((const LAS int*)(lds + MOE_OFF_OFF))[32]);
        pg8::Gemm g{HB, W_GU, rows, 1024, 2048, TL};
        pg8::GroupedOrder S{(const LAS unsigned char*)(lds + MOE_TEXP_OFF), rows >> 8, 4, G, (int)blockIdx.x};
        pg8::EpiSwiGLU E{(bf16*)(ws + WS_ACT), RS};
        pg8::gemm_phase<pg8::EpiSwiGLU, pg8::GroupedOrder, true, true, true>(lds + RING_OFF, g, S, E);
        PE(pb + 4);
    }
    SEAM(pb + 4);
    if (IN(pb + 5)) { PB(pb + 5);
        moe_build_table(lds, gcnt);
        const int rows = __builtin_amdgcn_readfirstlane(((const LAS int*)(lds + MOE_OFF_OFF))[32]);
        pg8::Gemm g{(const bf16*)(ws + WS_ACT), W_DN, rows, 2048, 512};
        pg8::GroupedOrder S{(const LAS unsigned char*)(lds + MOE_TEXP_OFF), rows >> 8, 8, G, (int)blockIdx.x};
        pg8::EpiBf16 E{(bf16*)(ws + WS_Y), 2048};
        pg8::gemm_phase<pg8::EpiBf16, pg8::GroupedOrder, true, true>(lds + RING_OFF, g, S, E);
        PE(pb + 5);
    }
    SEAM(pb + 5);
    if (IN(pb + 6)) { PB(pb + 6);
        moe_combine<true>(HB, (const bf16*)(ws + WS_Y), SL0, SL1, TW0, TW1, out, nullptr, nullptr, gw, NGW, lane);
        PE(pb + 6);
    }
    if (layer == 0) SEAM(pb + 6);
    }
#undef IN
#undef SEAM
}

extern "C" void kernel_launch(void* const* d_in, const int* in_sizes, int n_in, void* d_out, int out_size, void* d_ws, size_t ws_size, hipStream_t stream) {
    static int grid = 0;
    if (grid == 0) {
        if (n_in != 24 || in_sizes[0] != T * D || out_size != T * D || ws_size < WS_END) { fprintf(stderr, "kernel_launch: unexpected shapes / workspace (n_in %d, in0 %d, out %d, ws %zu < %zu)\n", n_in, n_in > 0 ? in_sizes[0] : -1, out_size, ws_size, (size_t)WS_END); grid = -1; return; }
        int dev = 0, cus = 0, per_cu = 0;
        if (hipGetDevice(&dev) != hipSuccess || hipDeviceGetAttribute(&cus, hipDeviceAttributeMultiprocessorCount, dev) != hipSuccess) { grid = -1; return; }
        if (hipFuncSetAttribute((const void*)fwd, hipFuncAttributeMaxDynamicSharedMemorySize, LDS_BYTES) != hipSuccess) { fprintf(stderr, "kernel_launch: hipFuncSetAttribute failed\n"); grid = -1; return; }
        if (hipOccupancyMaxActiveBlocksPerMultiprocessor(&per_cu, (const void*)fwd, NWAVES * 64, LDS_BYTES) != hipSuccess || per_cu < 1) { fprintf(stderr, "kernel_launch: occupancy query says %d\n", per_cu); }
        (void)hipGetLastError();
        grid = cus;
    }
    if (grid < 0) return;
    if (hipMemsetAsync((char*)d_ws + WS_CTL, 0, CTL_ZERO_BYTES, stream) != hipSuccess) return;
    Args a{};
    for (int i = 0; i < 24; ++i) a.in[i] = (const float*)d_in[i];
    a.out = (float*)d_out; a.ws = (unsigned char*)d_ws;
#if MK_PER_PHASE
    for (int p = 0; p < MK_LAST_PHASE; ++p) { a.ph_lo = p; a.ph_hi = p + 1; hipLaunchKernelGGL(fwd, dim3(grid), dim3(NWAVES * 64), LDS_BYTES, stream, a); }
#else
    a.ph_lo = 0; a.ph_hi = MK_LAST_PHASE;
    hipLaunchKernelGGL(fwd, dim3(grid), dim3(NWAVES * 64), LDS_BYTES, stream, a);
#endif
    const hipError_t le = hipPeekAtLastError();
    if (le != hipSuccess) fprintf(stderr, "kernel_launch: launch failed: %s\n", hipGetErrorName(le));
}
```

```cpp
#include <hip/hip_runtime.h>
#include <cstdio>
#include <cstdint>

#ifndef MK_PER_PHASE
#define MK_PER_PHASE 0
#endif
#ifndef MK_LAST_PHASE
#define MK_LAST_PHASE 23
#endif

#ifndef MK_PHASE_MASK
#define MK_PHASE_MASK 0x7fffff
#endif

#ifndef MK_DELAY_MASK
#define MK_DELAY_MASK 0
#endif

#ifndef MK_STAG1
#define MK_STAG1 0
#endif

#ifndef MK_EPI2
#define MK_EPI2 0
#endif

#ifndef MK_EARLY_EPI
#define MK_EARLY_EPI 1
#endif

namespace pg8 {
#define PG8_LAS __attribute__((address_space(3)))
typedef unsigned short bf16_t;
typedef short bf16x8 __attribute__((ext_vector_type(8)));
typedef float f32x4 __attribute__((ext_vector_type(4)));
typedef unsigned u32x4 __attribute__((ext_vector_type(4)));
constexpr int BM = 256, BK = 64, HALF = 128, HTB = HALF * BK * 2  , STAGE_BYTES = 8 * HTB, NXCD = 8, WGM = 8;

__host__ __device__ __forceinline__ int lds_byte(int r, int c) { const int st = (r >> 4) * 2 + (c >> 5), rr = r & 15, cc = c & 31, ob = rr * 64 + cc * 2; return st * 1024 + (ob ^ (((ob >> 9) & 1) << 5)); }
__host__ __device__ __forceinline__ void stage_rc(int b, int& R, int& C) { const int st = b / 1024, sb = b % 1024, swz = sb ^ (((sb >> 9) & 1) << 5); R = (st >> 1) * 16 + swz / 64; C = (st & 1) * 32 + (swz % 64) / 2; }
__host__ __device__ __forceinline__ int perm32(int rho) { const int n = rho >> 4, i = rho & 15; return 8 * (i >> 2) + 4 * n + (i & 3); }

struct Unit { int pm, pn, pc; };
struct Gemm { const bf16_t* A; const bf16_t* Bt; int M, N, K; const unsigned* rowidx; };


struct StaticOrder {
    int nM, nN, nwg, G, c;
    __host__ __device__ void init(int M, int N, int G_, int c_) { nM = M / BM; nN = N / BM; nwg = nM * nN; G = G_; c = c_; }
    __host__ __device__ bool next(int i, Unit& u) const {
        const long L = (long)i * G + c; if (L >= nwg) return false;
        int wgid = (int)L; { const int q = nwg / NXCD, r = nwg % NXCD, xcd = wgid % NXCD, off = wgid / NXCD; wgid = (xcd < r ? xcd * (q + 1) : r * (q + 1) + (xcd - r) * q) + off; }
        const int nig = WGM * nN, gid = wgid / nig, fm = gid * WGM, gsz = (nM - fm) < WGM ? (nM - fm) : WGM;
        u.pm = fm + ((wgid % nig) % gsz); u.pn = (wgid % nig) / gsz; u.pc = u.pn; return true;
    }
    __device__ __forceinline__ void a_ready(const Unit&) const {}
    __device__ __forceinline__ void done(const Unit&) const {}
};
struct GroupedOrder {
    const PG8_LAS unsigned char* texp; int MT, npn, G, c;
    __device__ __forceinline__ bool next(int i, Unit& u) const {
        const long L = (long)i * G + c; if (L >= (long)MT * npn) return false;
        const int pm = (int)(L / npn), pc = (int)(L % npn);
        const int e = __builtin_amdgcn_readfirstlane((int)texp[pm]);
        u.pm = pm; u.pn = e * npn + pc; u.pc = pc; return true;
    }
    __device__ __forceinline__ void a_ready(const Unit&) const {}
    __device__ __forceinline__ void done(const Unit&) const {}
};

__device__ __forceinline__ unsigned cvt_pk_bf16(float lo, float hi) { unsigned r; asm volatile("v_cvt_pk_bf16_f32 %0, %1, %2" : "=v"(r) : "v"(lo), "v"(hi)); return r; }

struct EpiBf16 {
    static constexpr bool PERM = true, AFTER_DRAIN = false;
    __device__ __forceinline__ void operator()(const f32x4 (&acc)[2][2][4][2], const Unit& u, int wr, int wc, int fr, int fq) const { part<0, 2>(acc, u, wr, wc, fr, fq); }
    bf16_t* O; int ldc;
    template <int AI0, int AI1> __device__ __forceinline__ void part(const f32x4 (&acc)[2][2][4][2], const Unit& u, int wr, int wc, int fr, int fq) const {
        const int row0 = u.pm * BM + wr * 64 + fr, col0 = u.pc * BM + wc * 32 + 8 * fq;
#pragma unroll
        for (int ai = AI0; ai < AI1; ++ai)
#pragma unroll
            for (int m = 0; m < 4; ++m) { bf16_t* rowp = O + (size_t)(row0 + ai * HALF + m * 16) * ldc + col0;
#pragma unroll
                for (int bj = 0; bj < 2; ++bj) { const f32x4 v0 = acc[ai][bj][m][0], v1 = acc[ai][bj][m][1];
                    u32x4 w; w.x = cvt_pk_bf16(v0[0], v0[1]); w.y = cvt_pk_bf16(v0[2], v0[3]); w.z = cvt_pk_bf16(v1[0], v1[1]); w.w = cvt_pk_bf16(v1[2], v1[3]);
                    *(u32x4*)(rowp + bj * HALF) = w; } }
    }
};
struct EpiKVQ {
    static constexpr bool PERM = true, AFTER_DRAIN = false;
    __device__ __forceinline__ void operator()(const f32x4 (&acc)[2][2][4][2], const Unit& u, int wr, int wc, int fr, int fq) const { part<0, 2>(acc, u, wr, wc, fr, fq); }
    bf16_t* O; bf16_t* VT;
    template <int AI0, int AI1> __device__ __forceinline__ void part(const f32x4 (&acc)[2][2][4][2], const Unit& u, int wr, int wc, int fr, int fq) const {
        const int row0 = u.pm * BM + wr * 64 + fr;
        if (u.pc == 1) {
#pragma unroll
            for (int ai = AI0; ai < AI1; ++ai)
#pragma unroll
                for (int m = 0; m < 4; ++m) { const int t = row0 + ai * HALF + m * 16, b = t >> 14, s = t & 16383;
#pragma unroll
                    for (int bj = 0; bj < 2; ++bj)
#pragma unroll
                        for (int n = 0; n < 2; ++n) { const int cv = bj * HALF + wc * 32 + 8 * fq + 4 * n; bf16_t* p = VT + ((size_t)(b * 4 + (cv >> 6)) * 64 + (cv & 63)) * 16384 + s;
                            const unsigned w0 = cvt_pk_bf16(acc[ai][bj][m][n][0], acc[ai][bj][m][n][1]), w1 = cvt_pk_bf16(acc[ai][bj][m][n][2], acc[ai][bj][m][n][3]);
                            p[0] = (bf16_t)(w0 & 0xffffu); p[16384] = (bf16_t)(w0 >> 16); p[2 * 16384] = (bf16_t)(w1 & 0xffffu); p[3 * 16384] = (bf16_t)(w1 >> 16); } }
            return; }
        const int col0 = u.pc * BM + wc * 32 + 8 * fq;
#pragma unroll
        for (int ai = AI0; ai < AI1; ++ai)
#pragma unroll
            for (int m = 0; m < 4; ++m) { bf16_t* rowp = O + (size_t)(row0 + ai * HALF + m * 16) * 2560 + col0;
#pragma unroll
                for (int bj = 0; bj < 2; ++bj) { const f32x4 v0 = acc[ai][bj][m][0], v1 = acc[ai][bj][m][1];
                    u32x4 w; w.x = cvt_pk_bf16(v0[0], v0[1]); w.y = cvt_pk_bf16(v0[2], v0[3]); w.z = cvt_pk_bf16(v1[0], v1[1]); w.w = cvt_pk_bf16(v1[2], v1[3]);
                    *(u32x4*)(rowp + bj * HALF) = w; } }
    }
};
struct EpiGlaProj {
    static constexpr bool PERM = true, AFTER_DRAIN = false;
    __device__ __forceinline__ void operator()(const f32x4 (&acc)[2][2][4][2], const Unit& u, int wr, int wc, int fr, int fq) const { part<0, 2>(acc, u, wr, wc, fr, fq); }
    bf16_t *QK, *V, *R, *GL;
    template <int AI0, int AI1> __device__ __forceinline__ void part(const f32x4 (&acc)[2][2][4][2], const Unit& u, int wr, int wc, int fr, int fq) const {
        bf16_t* base; int ldc, ct;
        if (u.pc < 8) { base = QK; ldc = 2048; ct = u.pc; } else if (u.pc < 16) { base = V; ldc = 2048; ct = u.pc - 8; } else if (u.pc < 24) { base = R; ldc = 2048; ct = u.pc - 16; } else { base = GL; ldc = 256; ct = 0; }
        const int row0 = u.pm * BM + wr * 64 + fr, col0 = ct * BM + wc * 32 + 8 * fq;
#pragma unroll
        for (int ai = AI0; ai < AI1; ++ai)
#pragma unroll
            for (int m = 0; m < 4; ++m) { bf16_t* rowp = base + (size_t)(row0 + ai * HALF + m * 16) * ldc + col0;
#pragma unroll
                for (int bj = 0; bj < 2; ++bj) { const f32x4 v0 = acc[ai][bj][m][0], v1 = acc[ai][bj][m][1];
                    u32x4 w; w.x = cvt_pk_bf16(v0[0], v0[1]); w.y = cvt_pk_bf16(v0[2], v0[3]); w.z = cvt_pk_bf16(v1[0], v1[1]); w.w = cvt_pk_bf16(v1[2], v1[3]);
                    *(u32x4*)(rowp + bj * HALF) = w; } }
    }
};
template <bool RES_BF16> struct EpiResBf16 {
    static constexpr bool PERM = true, AFTER_DRAIN = false;
    __device__ __forceinline__ void operator()(const f32x4 (&acc)[2][2][4][2], const Unit& u, int wr, int wc, int fr, int fq) const { part<0, 2>(acc, u, wr, wc, fr, fq); }
    const void* RES; int ldc; bf16_t* HB; float* SSP;
    template <int AI0, int AI1> __device__ __forceinline__ void part(const f32x4 (&acc)[2][2][4][2], const Unit& u, int wr, int wc, int fr, int fq) const {
        const int row0 = u.pm * BM + wr * 64 + fr, col0 = u.pc * BM + wc * 32 + 8 * fq;
#pragma unroll
        for (int ai = AI0; ai < AI1; ++ai)
#pragma unroll
            for (int m = 0; m < 4; ++m) { const int row = row0 + ai * HALF + m * 16; const size_t off = (size_t)row * ldc + col0;
                f32x4 rv[2][2];
#pragma unroll
                for (int bj = 0; bj < 2; ++bj) {
                    if constexpr (RES_BF16) { const u32x4 w = *(const u32x4*)((const bf16_t*)RES + off + bj * HALF);
                        rv[bj][0] = (f32x4){__builtin_bit_cast(float, w.x << 16), __builtin_bit_cast(float, w.x & 0xffff0000u), __builtin_bit_cast(float, w.y << 16), __builtin_bit_cast(float, w.y & 0xffff0000u)};
                        rv[bj][1] = (f32x4){__builtin_bit_cast(float, w.z << 16), __builtin_bit_cast(float, w.z & 0xffff0000u), __builtin_bit_cast(float, w.w << 16), __builtin_bit_cast(float, w.w & 0xffff0000u)}; }
                    else { rv[bj][0] = *(const f32x4*)((const float*)RES + off + bj * HALF); rv[bj][1] = *(const f32x4*)((const float*)RES + off + bj * HALF + 4); } }
                float ss = 0.f;
#pragma unroll
                for (int bj = 0; bj < 2; ++bj) { const f32x4 v0 = acc[ai][bj][m][0] + rv[bj][0], v1 = acc[ai][bj][m][1] + rv[bj][1];
                    u32x4 w; w.x = cvt_pk_bf16(v0[0], v0[1]); w.y = cvt_pk_bf16(v0[2], v0[3]); w.z = cvt_pk_bf16(v1[0], v1[1]); w.w = cvt_pk_bf16(v1[2], v1[3]);
                    *(u32x4*)(HB + off + bj * HALF) = w;
                    ss += (v0[0] * v0[0] + v0[1] * v0[1]) + (v0[2] * v0[2] + v0[3] * v0[3]) + (v1[0] * v1[0] + v1[1] * v1[1]) + (v1[2] * v1[2] + v1[3] * v1[3]); }
                ss += __shfl_xor(ss, 16); ss += __shfl_xor(ss, 32);
                if (fq == 0) SSP[(size_t)row * 32 + u.pc * 4 + wc] = ss; }
    }
};
struct EpiRouter {
    static constexpr bool PERM = false, AFTER_DRAIN = false;
    __device__ __forceinline__ void operator()(const f32x4 (&acc)[2][2][4][2], const Unit& u, int wr, int wc, int fr, int fq) const { part<0, 2>(acc, u, wr, wc, fr, fq); }
    float* RL;
    template <int AI0, int AI1> __device__ __forceinline__ void part(const f32x4 (&acc)[2][2][4][2], const Unit& u, int wr, int wc, int fr, int fq) const {
        if (wc >= 2) return;
        const int row0 = u.pm * BM + wr * 64 + fr, col0 = wc * 32 + 4 * fq;
#pragma unroll
        for (int ai = AI0; ai < AI1; ++ai)
#pragma unroll
            for (int m = 0; m < 4; ++m) { float* rowp = RL + (size_t)(row0 + ai * HALF + m * 16) * 64 + col0;
#pragma unroll
                for (int n = 0; n < 2; ++n) *(f32x4*)(rowp + n * 16) = acc[ai][0][m][n]; }
    }
};
__device__ __forceinline__ float silu_f(float x) { return x * __builtin_amdgcn_rcpf(1.0f + __expf(-x)); }
struct EpiSwiGLU {
    static constexpr bool PERM = true, AFTER_DRAIN = false;
    __device__ __forceinline__ void operator()(const f32x4 (&acc)[2][2][4][2], const Unit& u, int wr, int wc, int fr, int fq) const { part<0, 2>(acc, u, wr, wc, fr, fq); }
    bf16_t* ACT; const float* RS;
    template <int AI0, int AI1> __device__ __forceinline__ void part(const f32x4 (&acc)[2][2][4][2], const Unit& u, int wr, int wc, int fr, int fq) const {
        const int row0 = u.pm * BM + wr * 64 + fr, col0 = u.pc * HALF + wc * 32 + 8 * fq;
#pragma unroll
        for (int ai = AI0; ai < AI1; ++ai)
#pragma unroll
            for (int m = 0; m < 4; ++m) { const int row = row0 + ai * HALF + m * 16; bf16_t* rowp = ACT + (size_t)row * 512 + col0; const float rs = RS[row];
                const f32x4 g0 = acc[ai][0][m][0] * rs, g1 = acc[ai][0][m][1] * rs, u0 = acc[ai][1][m][0] * rs, u1 = acc[ai][1][m][1] * rs;
                u32x4 w;
                w.x = cvt_pk_bf16(silu_f(g0[0]) * u0[0], silu_f(g0[1]) * u0[1]); w.y = cvt_pk_bf16(silu_f(g0[2]) * u0[2], silu_f(g0[3]) * u0[3]);
                w.z = cvt_pk_bf16(silu_f(g1[0]) * u1[0], silu_f(g1[1]) * u1[1]); w.w = cvt_pk_bf16(silu_f(g1[2]) * u1[2], silu_f(g1[3]) * u1[3]);
                *(u32x4*)rowp = w; }
    }
};

template <class Epi, class Sched, bool ALIGN_EPI = false, bool SP2 = false, bool GATHER = false, bool EARLY_EPI = false>
__device__ __forceinline__ void gemm_phase(PG8_LAS unsigned char* lds, const Gemm g, const Sched& S, const Epi& E) {
    const int tid = threadIdx.x, wid = __builtin_amdgcn_readfirstlane(tid >> 6), lane = tid & 63, wr = wid >> 2, wc = wid & 3, fr = lane & 15, fq = lane >> 4;
    const int K = g.K, nt = K / BK;
    unsigned voffA[2], voffB[2];
#pragma unroll
    for (int i = 0; i < 2; ++i) { int R, C; stage_rc(tid * 16 + i * 8192, R, C); const int Rb = Epi::PERM ? ((R & ~31) + perm32(R & 31)) : R;
        voffA[i] = (unsigned)(R * K + C) * 2u; voffB[i] = (unsigned)(Rb * K + C) * 2u; }
    unsigned vA[2][2] = {{0u, 0u}, {0u, 0u}}, vAn[2][2] = {{0u, 0u}, {0u, 0u}}; int rA[2] = {0, 0}; unsigned cbA[2] = {0u, 0u};
    if constexpr (GATHER) {
#pragma unroll
        for (int i = 0; i < 2; ++i) { int R, C; stage_rc(tid * 16 + i * 8192, R, C); rA[i] = R; cbA[i] = (unsigned)C * 2u; } }
#define PG8_GIDX(dst, pmv) do { _Pragma("unroll") for (int _h = 0; _h < 2; ++_h) _Pragma("unroll") for (int _i = 0; _i < 2; ++_i) \
        dst[_h][_i] = g.rowidx[(size_t)(pmv) * BM + _h * HALF + rA[_i]] * (unsigned)(K * 2) + cbA[_i]; } while (0)
    const size_t kstep = (size_t)(BK * 2);
    const size_t hstep = (size_t)HALF * K * 2;
    const size_t tstep = 2 * hstep;
    const unsigned ldsw = (unsigned)wid * 1024u;
    const int aoff = lds_byte(wr * 64 + fr, fq * 8), boff = lds_byte(wc * 32 + fr, fq * 8);
#define PG8_SA(b, h) (((b) * 2 + (h)) * HTB)
#define PG8_SB(b, h) ((4 + (b) * 2 + (h)) * HTB)
#define PG8_STAGE(bufoff, gbase, voff) do { _Pragma("unroll") for (int _i = 0; _i < 2; ++_i) \
        __builtin_amdgcn_global_load_lds((const unsigned*)((const char*)(gbase) + (voff)[_i]), (PG8_LAS unsigned*)(lds + (bufoff) + ldsw + _i * 8192), 16, 0, 0); } while (0)
#define PG8_STAGE_A(bufoff, nx, kb, h) do { if constexpr (GATHER) { const char* _b = (const char*)g.A + (kb); \
        _Pragma("unroll") for (int _i = 0; _i < 2; ++_i) { const unsigned _v = (nx) ? vAn[h][_i] : vA[h][_i]; \
            __builtin_amdgcn_global_load_lds((const unsigned*)(_b + _v), (PG8_LAS unsigned*)(lds + (bufoff) + ldsw + _i * 8192), 16, 0, 0); } } \
    else { const char* _b = ((nx) ? nA : cA) + (kb) + (size_t)(h) * hstep; PG8_STAGE(bufoff, _b, voffA); } } while (0)
#define PG8_LDA(dst, b, h) do { _Pragma("unroll") for (int m = 0; m < 4; ++m) _Pragma("unroll") for (int k = 0; k < 2; ++k) dst[m][k] = *(const PG8_LAS bf16x8*)(lds + PG8_SA(b, h) + aoff + m * 2048 + k * 1024); } while (0)
#define PG8_LDB(dst, b, h) do { _Pragma("unroll") for (int n = 0; n < 2; ++n) _Pragma("unroll") for (int k = 0; k < 2; ++k) dst[n][k] = *(const PG8_LAS bf16x8*)(lds + PG8_SB(b, h) + boff + n * 2048 + k * 1024); } while (0)
#define PG8_MMA(ai, bj, At, Bt) do { __builtin_amdgcn_s_setprio(1); _Pragma("unroll") for (int m = 0; m < 4; ++m) _Pragma("unroll") for (int n = 0; n < 2; ++n) _Pragma("unroll") for (int k = 0; k < 2; ++k) \
        acc[ai][bj][m][n] = __builtin_amdgcn_mfma_f32_16x16x32_bf16(Bt[n][k], At[m][k], acc[ai][bj][m][n], 0, 0, 0); __builtin_amdgcn_s_setprio(0); } while (0)
#define PG8_WAIT_V(n) asm volatile("s_waitcnt vmcnt(" #n ")" ::: "memory")
#define PG8_WAIT_L(n) asm volatile("s_waitcnt lgkmcnt(" #n ")" ::: "memory")
#define PG8_BAR __builtin_amdgcn_s_barrier()
#define PG8_SCHED __builtin_amdgcn_sched_barrier(0)
    Unit cur, nxt; int ui = 0;
    if (!S.next(0, cur)) return;
    f32x4 acc[2][2][4][2];
#pragma unroll
    for (int a = 0; a < 2; ++a)
#pragma unroll
        for (int b = 0; b < 2; ++b)
#pragma unroll
            for (int m = 0; m < 4; ++m)
#pragma unroll
                for (int n = 0; n < 2; ++n) acc[a][b][m][n] = (f32x4){0.f, 0.f, 0.f, 0.f};
    bf16x8 At[4][2], B0[2][2], B1[2][2];
    const char* cA = (const char*)g.A + (size_t)cur.pm * tstep; const char* cB = (const char*)g.Bt + (size_t)cur.pn * tstep;
    const char* nA = cA; const char* nB = cB;
    if constexpr (GATHER) { PG8_GIDX(vA, cur.pm); }
    S.a_ready(cur);
    if constexpr (SP2) {
        PG8_STAGE(PG8_SB(0, 0), cB, voffB); PG8_STAGE(PG8_SB(0, 1), cB + hstep, voffB); PG8_STAGE_A(PG8_SA(0, 0), false, 0, 0); PG8_STAGE_A(PG8_SA(0, 1), false, 0, 1);
        if (wr == 1) PG8_BAR;
        PG8_WAIT_V(2); PG8_BAR;
        PG8_STAGE(PG8_SB(1, 0), cB + kstep, voffB); PG8_STAGE_A(PG8_SA(1, 0), false, kstep, 0); PG8_STAGE(PG8_SB(1, 1), cB + hstep + kstep, voffB);
        PG8_WAIT_V(6); PG8_BAR;
    } else {
        PG8_STAGE(PG8_SB(0, 0), cB, voffB); PG8_STAGE(PG8_SA(0, 0), cA, voffA); PG8_STAGE(PG8_SB(0, 1), cB + hstep, voffB); PG8_STAGE(PG8_SA(0, 1), cA + hstep, voffA);
        if (wr == 1) PG8_BAR;
        PG8_WAIT_V(4); PG8_BAR;
        PG8_STAGE(PG8_SB(1, 0), cB + kstep, voffB); PG8_STAGE(PG8_SA(1, 0), cA + kstep, voffA); PG8_STAGE(PG8_SB(1, 1), cB + hstep + kstep, voffB);
        PG8_WAIT_V(6); PG8_BAR;
    }
    for (;;) {
        const bool has_next = S.next(ui + 1, nxt);
        nA = has_next ? (const char*)g.A + (size_t)nxt.pm * tstep : cA; nB = has_next ? (const char*)g.Bt + (size_t)nxt.pn * tstep : cB;
        if constexpr (GATHER) { if (has_next) { PG8_GIDX(vAn, nxt.pm); } else {
#pragma unroll
            for (int _h = 0; _h < 2; ++_h) { vAn[_h][0] = vA[_h][0]; vAn[_h][1] = vA[_h][1]; } } }
        for (int t = 0; t < nt; t += 2) {
            const bool last = (t == nt - 2);
            const char* a1 = cA + (size_t)(t + 1) * kstep;
            const char* a2 = last ? nA : cA + (size_t)(t + 2) * kstep; const char* b2 = last ? nB : cB + (size_t)(t + 2) * kstep;
            const char* a3 = a2 + kstep; const char* b3 = b2 + kstep;
            const size_t ka1 = (size_t)(t + 1) * kstep, ka2 = last ? (size_t)0 : (size_t)(t + 2) * kstep, ka3 = ka2 + kstep; (void)a1; (void)a3;
            if (last && has_next) S.a_ready(nxt);
            if constexpr (SP2) {
            PG8_LDB(B0, 0, 0); PG8_LDB(B1, 0, 1); PG8_SCHED; PG8_LDA(At, 0, 0); PG8_STAGE_A(PG8_SA(1, 1), false, ka1, 1);
            PG8_WAIT_V(8); PG8_WAIT_L(0); PG8_BAR; PG8_MMA(0, 0, At, B0); PG8_MMA(0, 1, At, B1); PG8_BAR; PG8_SCHED;
            PG8_LDA(At, 0, 1); PG8_STAGE(PG8_SB(0, 0), b2, voffB); PG8_STAGE(PG8_SB(0, 1), b2 + hstep, voffB); PG8_STAGE_A(PG8_SA(0, 0), last, ka2, 0);
            PG8_WAIT_V(8); PG8_WAIT_L(0); PG8_BAR; PG8_MMA(1, 0, At, B0); PG8_MMA(1, 1, At, B1); PG8_BAR; PG8_SCHED;
            PG8_LDB(B0, 1, 0); PG8_LDB(B1, 1, 1); PG8_SCHED; PG8_LDA(At, 1, 0); PG8_STAGE_A(PG8_SA(0, 1), last, ka2, 1);
            PG8_WAIT_V(8); PG8_WAIT_L(0); PG8_BAR; PG8_MMA(0, 0, At, B0); PG8_MMA(0, 1, At, B1); PG8_BAR; PG8_SCHED;
            PG8_LDA(At, 1, 1); PG8_STAGE(PG8_SB(1, 0), b3, voffB); PG8_STAGE(PG8_SB(1, 1), b3 + hstep, voffB); PG8_STAGE_A(PG8_SA(1, 0), last, ka3, 0);
            PG8_WAIT_V(8); PG8_WAIT_L(0); PG8_BAR;
            if constexpr (EARLY_EPI) { if (last) { E.template part<0, 1>(acc, cur, wr, wc, fr, fq); PG8_SCHED; } }
            PG8_MMA(1, 0, At, B0); PG8_MMA(1, 1, At, B1); PG8_BAR; PG8_SCHED;
            } else {
            PG8_LDB(B0, 0, 0); PG8_SCHED; PG8_LDA(At, 0, 0); PG8_STAGE(PG8_SA(1, 1), a1 + hstep, voffA);
            PG8_WAIT_L(8); PG8_BAR; PG8_WAIT_L(0); PG8_MMA(0, 0, At, B0); PG8_BAR; PG8_SCHED;
            PG8_LDB(B1, 0, 1); PG8_STAGE(PG8_SB(0, 0), b2, voffB);
            PG8_BAR; PG8_WAIT_L(0); PG8_MMA(0, 1, At, B1); PG8_BAR;
            PG8_LDA(At, 0, 1); PG8_STAGE(PG8_SA(0, 0), a2, voffA);
            PG8_BAR; PG8_WAIT_L(0); PG8_MMA(1, 0, At, B0); PG8_BAR; PG8_SCHED;
            PG8_STAGE(PG8_SB(0, 1), b2 + hstep, voffB);
            PG8_WAIT_V(6); PG8_BAR; PG8_MMA(1, 1, At, B1); PG8_BAR;
            PG8_LDB(B0, 1, 0); PG8_SCHED; PG8_LDA(At, 1, 0); PG8_STAGE(PG8_SA(0, 1), a2 + hstep, voffA);
            PG8_WAIT_L(8); PG8_BAR; PG8_WAIT_L(0); PG8_MMA(0, 0, At, B0); PG8_BAR; PG8_SCHED;
            PG8_LDB(B1, 1, 1); PG8_STAGE(PG8_SB(1, 0), b3, voffB);
            PG8_BAR; PG8_WAIT_L(0); PG8_MMA(0, 1, At, B1); PG8_BAR;
            PG8_LDA(At, 1, 1); PG8_STAGE(PG8_SA(1, 0), a3, voffA);
            PG8_BAR; PG8_WAIT_L(0); PG8_MMA(1, 0, At, B0); PG8_BAR; PG8_SCHED;
            PG8_STAGE(PG8_SB(1, 1), b3 + hstep, voffB);
            PG8_WAIT_V(6); PG8_BAR; PG8_MMA(1, 1, At, B1); PG8_BAR;
            }
        }
        if constexpr (ALIGN_EPI) { if (wr == 0) PG8_BAR; }
        if constexpr (!Epi::AFTER_DRAIN) { if constexpr (EARLY_EPI) E.template part<1, 2>(acc, cur, wr, wc, fr, fq); else E(acc, cur, wr, wc, fr, fq);
#if MK_EPI2
            asm volatile("" ::: "memory"); E(acc, cur, wr, wc, fr, fq);
#endif
            S.done(cur); }
        if (!has_next) break;
#pragma unroll
        for (int a = 0; a < 2; ++a)
#pragma unroll
            for (int b = 0; b < 2; ++b)
#pragma unroll
                for (int m = 0; m < 4; ++m)
#pragma unroll
                    for (int n = 0; n < 2; ++n) acc[a][b][m][n] = (f32x4){0.f, 0.f, 0.f, 0.f};
        cur = nxt; cA = nA; cB = nB; ++ui;
        if constexpr (GATHER) {
#pragma unroll
            for (int _h = 0; _h < 2; ++_h) { vA[_h][0] = vAn[_h][0]; vA[_h][1] = vAn[_h][1]; } }
        if constexpr (ALIGN_EPI) { if (wr == 1) PG8_BAR; }
    }
    PG8_WAIT_V(0);
    if constexpr (!ALIGN_EPI) { if (wr == 0) PG8_BAR; }
    PG8_BAR;
    if constexpr (Epi::AFTER_DRAIN) { E.fused(acc, cur, wr, wc, fr, fq, lds, wid, lane); S.done(cur); }
#undef PG8_SA
#undef PG8_STAGE_A
#undef PG8_GIDX
#undef PG8_SB
#undef PG8_STAGE
#undef PG8_LDA
#undef PG8_LDB
#undef PG8_MMA
#undef PG8_WAIT_V
#undef PG8_WAIT_L
#undef PG8_BAR
#undef PG8_SCHED
}
}

constexpr int NWAVES = 8;
constexpr int T = 32768, D = 2048, SEQ = 16384;
constexpr float RMS_EPS = 1e-6f;
constexpr int GLA_H = 4, GLA_DK = 256, GLA_DV = 512, GLA_C = 64, GLA_NCH = SEQ / GLA_C  , GLA_PROJ_N = 6160, GLA_PROJ_NP = 6400;
constexpr int NITEM_GLA = 2 * GLA_H * GLA_NCH;
constexpr int SWA_HQ = 32, SWA_HKV = 4, SWA_HD = 64, SWA_W = 128, KVQ_N = 2560;
constexpr int NE = 32, FF = 512, MOE_MAXROWS = 2 * T + NE * 256;

constexpr size_t MiB = 1u << 20;
constexpr size_t WS_CTL = 0, CTL_ZERO_BYTES = 1 * MiB;
constexpr size_t WS_W_GLA_IN = 1 * MiB;
constexpr size_t WS_W_GLA_OUT = 26 * MiB;
constexpr size_t WS_W_KVQ = 34 * MiB;
constexpr size_t WS_W_SWA_OUT = 44 * MiB;
constexpr size_t WS_W_ROUTER = 52 * MiB;
constexpr size_t WS_TOK = 54 * MiB;
constexpr size_t WS_RL = 56 * MiB;
constexpr size_t WS_W_GU = 64 * MiB;
constexpr size_t WS_W_DN = 192 * MiB;
constexpr size_t WS_HN = 256 * MiB;
constexpr size_t WS_BIG = 384 * MiB;
constexpr size_t WS_QK = WS_BIG;
constexpr size_t WS_V = WS_BIG + 128 * MiB;
constexpr size_t WS_R = WS_BIG + 256 * MiB;
constexpr size_t WS_GL = WS_BIG + 384 * MiB;
constexpr size_t WS_QEF = WS_BIG + 400 * MiB;
constexpr size_t WS_KLTF = WS_BIG + 464 * MiB;
constexpr size_t WS_ATTF = WS_BIG + 528 * MiB;
constexpr size_t WS_VTF = WS_BIG + 544 * MiB;
constexpr size_t WS_DEC = WS_BIG + 672 * MiB;
constexpr size_t WS_SEND = WS_V;
constexpr size_t WS_DTOT = WS_V + 32 * MiB;
constexpr size_t WS_GLA_END = WS_BIG + 674 * MiB;
constexpr size_t WS_SSP = WS_BIG;
constexpr size_t WS_TL = WS_BIG + 8 * MiB;
constexpr size_t WS_RS = WS_BIG + 9 * MiB;
constexpr size_t WS_HB = WS_BIG + 16 * MiB;
constexpr size_t WS_ACT = WS_BIG + 288 * MiB;
constexpr size_t WS_Y = WS_BIG + 360 * MiB;
constexpr size_t WS_KVQ = WS_BIG;
constexpr size_t WS_AO = WS_BIG + 160 * MiB;
constexpr size_t WS_VT = WS_BIG + 288 * MiB;
constexpr size_t WS_END = WS_GLA_END;
static_assert(WS_Y + (size_t)MOE_MAXROWS * 2048 * 2 <= WS_END && WS_ACT + (size_t)MOE_MAXROWS * 512 * 2 <= WS_Y, "MoE map");
constexpr int CW_BAR = 4096;
constexpr int CW_CNT = 16384;

constexpr int RING_OFF = 0, RING_BYTES = 149504;
constexpr int LDSCTL_OFF = RING_BYTES;
constexpr int MISC_OFF = LDSCTL_OFF + 64;
constexpr int MOE_OFF_OFF = LDSCTL_OFF + 256;
constexpr int MOE_TEXP_OFF = LDSCTL_OFF + 512;
constexpr int LDS_BYTES = RING_BYTES + 2048;

#define GAS __attribute__((address_space(1)))
#define LAS __attribute__((address_space(3)))
typedef unsigned short bf16;
typedef unsigned v4u __attribute__((ext_vector_type(4)));
typedef unsigned v2u __attribute__((ext_vector_type(2)));
typedef float f32x4 __attribute__((ext_vector_type(4)));
typedef short bf16x8 __attribute__((ext_vector_type(8)));
typedef GAS unsigned gu32;
#define RLX_AGENT __ATOMIC_RELAXED, __HIP_MEMORY_SCOPE_AGENT
#define LDS_WAIT() asm volatile("s_waitcnt lgkmcnt(0)" ::: "memory")
#define VM_WAIT() asm volatile("s_waitcnt vmcnt(0)" ::: "memory")
__device__ __forceinline__ unsigned f2bf(float f) { unsigned u = __builtin_bit_cast(unsigned, f); return (u + 0x7fffu + ((u >> 16) & 1u)) >> 16; }
__device__ __forceinline__ unsigned pk2(float lo, float hi) { return pg8::cvt_pk_bf16(lo, hi); }
__device__ __forceinline__ float bf_lo(unsigned w) { return __builtin_bit_cast(float, w << 16); }
__device__ __forceinline__ float bf_hi(unsigned w) { return __builtin_bit_cast(float, w & 0xffff0000u); }
__device__ __forceinline__ float bf2f(bf16 b) { return __builtin_bit_cast(float, ((unsigned)b) << 16); }
__device__ __forceinline__ float wave_sum(float v) {
#pragma unroll
    for (int o = 1; o < 64; o <<= 1) v += __shfl_xor(v, o);
    return v;
}

#define XB_TMO      128
#define XB_XCNT(j)  (256  + 64 * (j))
#define XB_XSUB(j)  (1280 + 64 * (j))
#define XB_XGEN(j)  (2304 + 64 * (j))
#define XB_TOP      3328
#define XB_TOPGEN   3392
#define XCD_BAR_WORDS 3456
#define XB_SPIN_CAP (1u << 18)

__device__ __forceinline__ unsigned xb_ld(unsigned* p)              { return __hip_atomic_load(p, __ATOMIC_RELAXED, __HIP_MEMORY_SCOPE_AGENT); }
__device__ __forceinline__ unsigned xb_add(unsigned* p, unsigned v) { return __hip_atomic_fetch_add(p, v, __ATOMIC_RELAXED, __HIP_MEMORY_SCOPE_AGENT); }
__device__ __forceinline__ unsigned xb_xcc_id() { return (unsigned)__builtin_amdgcn_s_getreg((3 << 11) | 20) & 0xFu; }
#define XB_SPIN(cond, bar) do { unsigned _sp = 0; while (cond) { __builtin_amdgcn_s_sleep(1); \
    if ((++_sp & 255u) == 0u) { if (xb_ld(&(bar)[XB_TMO])) break; if (_sp > XB_SPIN_CAP) { atomicAdd(&(bar)[XB_TMO], 1u); break; } } } } while (0)

struct XcdBarrier {
    unsigned* bar; unsigned x;
    volatile LAS unsigned* st;
};

__device__ __forceinline__ XcdBarrier xcd_barrier_post(unsigned* bar, volatile LAS unsigned* st) {
    XcdBarrier b; b.bar = bar; b.x = xb_xcc_id(); b.st = st;
    if (threadIdx.x == 0) (void)xb_add(&bar[XB_XCNT(b.x)], 1u);
    return b;
}
__device__ __forceinline__ void xcd_barrier_complete(unsigned* bar, unsigned x, unsigned& nloc, unsigned& nx) {
    const unsigned G = gridDim.x * gridDim.y * gridDim.z;
    unsigned sum, cnt, mine, sp = 0u;
    for (;;) {
        sum = 0u; cnt = 0u; mine = 0u;
#pragma unroll
        for (unsigned j = 0; j < 16; ++j) { const unsigned c = xb_ld(&bar[XB_XCNT(j)]); sum += c; cnt += (c > 0u) ? 1u : 0u; mine = (j == x) ? c : mine; }
        if (sum == G) break;
        __builtin_amdgcn_s_sleep(1);
        if ((++sp & 255u) == 0u) { if (xb_ld(&bar[XB_TMO])) break; if (sp > XB_SPIN_CAP) { atomicAdd(&bar[XB_TMO], 1u); break; } }
    }
    nloc = mine > 0u ? mine : 1u; nx = cnt > 0u ? cnt : 1u;
}

__device__ __forceinline__ void xcd_barrier(const XcdBarrier& b) {
    asm volatile("s_waitcnt vmcnt(0)" ::: "memory");
    __syncthreads();
    if (threadIdx.x == 0) {
        unsigned* bar = b.bar;
        __builtin_amdgcn_s_waitcnt(0);
        unsigned nloc = b.st[0], nx = b.st[1];
        if (nloc == 0u) { xcd_barrier_complete(bar, b.x, nloc, nx); b.st[0] = nloc; b.st[1] = nx; }
        const unsigned old = xb_add(&bar[XB_XSUB(b.x)], 1u);
        const unsigned gen = old / nloc;
        if (old + 1u == (gen + 1u) * nloc) {
            __builtin_amdgcn_fence(__ATOMIC_RELEASE, "agent");
            asm volatile("s_waitcnt vmcnt(0)" ::: "memory");
            const unsigned og = xb_add(&bar[XB_TOP], 1u);
            const unsigned tg = og / nx;
            if (og + 1u == (tg + 1u) * nx) xb_add(&bar[XB_TOPGEN], 1u);
            else XB_SPIN(xb_ld(&bar[XB_TOPGEN]) == tg, bar);
            __builtin_amdgcn_fence(__ATOMIC_ACQUIRE, "agent");
            xb_add(&bar[XB_XGEN(b.x)], 1u);
            asm volatile("s_waitcnt vmcnt(0)" ::: "memory");
        } else {
            XB_SPIN(xb_ld(&bar[XB_XGEN(b.x)]) == gen, bar);
            __builtin_amdgcn_fence(__ATOMIC_ACQUIRE, "agent");
            asm volatile("s_waitcnt vmcnt(0)" ::: "memory");
        }
    }
    __syncthreads();
}


__device__ __forceinline__ void cvt_item(const float* W, int N, const float* gain, bf16* WT, int K, int k0, int n0, size_t dst_row0, int lane) {
    const int q = lane >> 4, c = lane & 15;
    const bool ok = (n0 + 4 * c) < N;
    const GAS f32x4* src = (const GAS f32x4*)(W + (size_t)(k0 + 16 * q) * N + n0 + 4 * c);
    f32x4 v[16];
#pragma unroll
    for (int i = 0; i < 16; ++i) v[i] = ok ? src[(size_t)i * (N / 4)] : (f32x4){0.f, 0.f, 0.f, 0.f};
    if (gain) { const GAS f32x4* gp = (const GAS f32x4*)(gain + k0 + 16 * q);
#pragma unroll
        for (int i4 = 0; i4 < 4; ++i4) { const f32x4 g = gp[i4]; v[4 * i4 + 0] = v[4 * i4 + 0] * g.x; v[4 * i4 + 1] = v[4 * i4 + 1] * g.y; v[4 * i4 + 2] = v[4 * i4 + 2] * g.z; v[4 * i4 + 3] = v[4 * i4 + 3] * g.w; } }
    if (ok) {
#pragma unroll
        for (int e = 0; e < 4; ++e) { bf16* dst = WT + (dst_row0 + 4 * c + e) * (size_t)K + k0 + 16 * q;
            v4u o0, o1;
            o0.x = pk2(v[0][e], v[1][e]); o0.y = pk2(v[2][e], v[3][e]); o0.z = pk2(v[4][e], v[5][e]); o0.w = pk2(v[6][e], v[7][e]);
            o1.x = pk2(v[8][e], v[9][e]); o1.y = pk2(v[10][e], v[11][e]); o1.z = pk2(v[12][e], v[13][e]); o1.w = pk2(v[14][e], v[15][e]);
            *(GAS v4u*)dst = o0; *(GAS v4u*)(dst + 8) = o1; } }
}
__device__ __forceinline__ void cvt_matrix(const float* W, int K, int N, const float* gain, bf16* WT, int rowbase, int gw, int NGW, int lane) {
    const int nblk = (N + 63) / 64, nitems = (K / 64) * nblk;
    for (int it = gw; it < nitems; it += NGW) { const int kb = it / nblk, nb = it - kb * nblk;
        cvt_item(W, N, gain, WT, K, kb * 64, nb * 64, (size_t)(rowbase + nb * 64), lane); }
}
__device__ __forceinline__ void cvt_moe(const float* wg, const float* wu, const float* wd, const float* gain, bf16* WGU, bf16* WDN, int gw, int NGW, int lane) {
    for (int it = gw; it < 2 * 8192; it += NGW) { const int which = it >> 13, r = it & 8191, e = r >> 8, q = r & 255, kb = q >> 3, nb = q & 7, n0 = nb * 64;
        const float* W = (which ? wu : wg) + (size_t)e * 2048 * 512;
        const size_t dst = (size_t)e * 1024 + 256 * (n0 >> 7) + (n0 & 127) + (which ? 128 : 0);
        cvt_item(W, 512, gain, WGU, 2048, kb * 64, n0, dst, lane); }
    for (int it = gw; it < 8192; it += NGW) { const int e = it >> 8, q = it & 255, kb = q >> 5, nb = q & 31;
        cvt_item(wd + (size_t)e * 512 * 2048, 2048, nullptr, WDN + (size_t)e * 2048 * 512, 512, kb * 64, nb * 64, (size_t)(nb * 64), lane); }
}
__device__ __forceinline__ void norm_rows(const float* src, bf16* dst, int gw, int NGW, int lane) {
    for (int m = gw; m < T; m += NGW) {
        const GAS f32x4* xr = (const GAS f32x4*)(src + (size_t)m * D) + lane;
        f32x4 v[8]; float s = 0.f;
#pragma unroll
        for (int j = 0; j < 8; ++j) { v[j] = xr[64 * j]; s += (v[j].x * v[j].x + v[j].y * v[j].y) + (v[j].z * v[j].z + v[j].w * v[j].w); }
        const float rstd = rsqrtf(wave_sum(s) * (1.f / D) + RMS_EPS);
        GAS v2u* o8 = (GAS v2u*)(dst + (size_t)m * D) + lane;
#pragma unroll
        for (int j = 0; j < 8; ++j) { v2u o; o.x = pk2(v[j].x * rstd, v[j].y * rstd); o.y = pk2(v[j].z * rstd, v[j].w * rstd); o8[64 * j] = o; }
    }
}

__device__ __forceinline__ float logsig(float z) { return fminf(z, 0.f) - __logf(1.f + __expf(-fabsf(z))); }
constexpr int GP_QE = 0, GP_KE = 33792, GP_ATT = 67584, GP_TOT = 76800;
__device__ __forceinline__ void gla_prepass(LAS unsigned char* lds, const bf16* QK, const bf16* V, const bf16* GL, const float* Wgu, const float* bgate,
                                            bf16* QEF, bf16* KLTF, bf16* ATTF, bf16* VTF, float* DEC) {
    const int tid = threadIdx.x, lane = tid & 63, wave = __builtin_amdgcn_readfirstlane(tid >> 6);
    LAS bf16* QEl = (LAS bf16*)(lds + GP_QE); LAS bf16* KEl = (LAS bf16*)(lds + GP_KE); LAS bf16* ATl = (LAS bf16*)(lds + GP_ATT);
    LAS float* tot = (LAS float*)(lds + GP_TOT);
    const int cg2 = tid & 127, rg2 = __builtin_amdgcn_readfirstlane(tid >> 7);
    for (int it = blockIdx.x; it < NITEM_GLA; it += gridDim.x) {
        const int bh = it >> 8, n = it & 255, h = bh & 3, b = bh >> 2; const int t0 = b * SEQ + n * GLA_C;
        v2u qv[8], kv[8], vv[16];
        { const bf16* qp = QK + (size_t)(t0 + 8 * wave) * 2048 + h * 256 + 4 * lane;
#pragma unroll
          for (int jj = 0; jj < 8; ++jj) { qv[jj] = *(const GAS v2u*)(qp + (size_t)jj * 2048); kv[jj] = *(const GAS v2u*)(qp + (size_t)jj * 2048 + 1024); }
          const bf16* vp = V + (size_t)(t0 + 16 * rg2) * 2048 + h * 512 + 4 * cg2;
#pragma unroll
          for (int r = 0; r < 16; ++r) vv[r] = *(const GAS v2u*)(vp + (size_t)r * 2048); }
        f32x4 cum[8];
        { f32x4 wg[16];
#pragma unroll
          for (int j = 0; j < 16; ++j) wg[j] = *(const GAS f32x4*)(Wgu + j * 1024 + h * 256 + 4 * lane);
          const f32x4 bg = *(const GAS f32x4*)(bgate + h * 256 + 4 * lane);
          f32x4 run = {0.f, 0.f, 0.f, 0.f};
#pragma unroll
          for (int jj = 0; jj < 8; ++jj) { const unsigned* gp = (const unsigned*)(GL + (size_t)(t0 + 8 * wave + jj) * 256);
              f32x4 z = bg;
#pragma unroll
              for (int j2 = 0; j2 < 8; ++j2) { const unsigned w = gp[j2]; z += wg[2 * j2] * bf_lo(w) + wg[2 * j2 + 1] * bf_hi(w); }
#pragma unroll
              for (int e = 0; e < 4; ++e) run[e] += fmaxf(logsig(z[e]) * 0.0625f, -1.0f);
              cum[jj] = run; }
          *(LAS f32x4*)(tot + wave * 256 + 4 * lane) = run; }
        __syncthreads();
        f32x4 offs = {0.f, 0.f, 0.f, 0.f}, blast = {0.f, 0.f, 0.f, 0.f};
#pragma unroll
        for (int w2 = 0; w2 < 8; ++w2) { const f32x4 tv = *(const LAS f32x4*)(tot + w2 * 256 + 4 * lane); blast += tv; if (w2 < wave) offs += tv; }
        f32x4 dec;
#pragma unroll
        for (int e = 0; e < 4; ++e) dec[e] = __expf(blast[e]);
        { float klv[4][8];
#pragma unroll
          for (int jj = 0; jj < 8; ++jj) { const int c = 8 * wave + jj; const f32x4 bb = cum[jj] + offs;
              const float q4[4] = {bf_lo(qv[jj].x), bf_hi(qv[jj].x), bf_lo(qv[jj].y), bf_hi(qv[jj].y)}, k4[4] = {bf_lo(kv[jj].x), bf_hi(kv[jj].x), bf_lo(kv[jj].y), bf_hi(kv[jj].y)};
              float qe[4], ke[4];
#pragma unroll
              for (int e = 0; e < 4; ++e) { qe[e] = q4[e] * 0.0625f * __expf(bb[e]); ke[e] = k4[e] * __expf(-bb[e]); klv[e][jj] = ke[e] * dec[e]; }
              v2u o; o.x = pk2(qe[0], qe[1]); o.y = pk2(qe[2], qe[3]); *(LAS v2u*)(QEl + c * 264 + 4 * lane) = o;
              o.x = pk2(ke[0], ke[1]); o.y = pk2(ke[2], ke[3]); *(LAS v2u*)(KEl + c * 264 + 4 * lane) = o; }
#pragma unroll
          for (int e = 0; e < 4; ++e) { const int d = 4 * lane + e;
              v4u o; o.x = pk2(klv[e][0], klv[e][1]); o.y = pk2(klv[e][2], klv[e][3]); o.z = pk2(klv[e][4], klv[e][5]); o.w = pk2(klv[e][6], klv[e][7]);
              const size_t fi = ((((size_t)it * 8 + (d >> 5)) * 2 + ((d >> 4) & 1)) * 2 + (wave >> 2)) * 64 + (wave & 3) * 16 + (d & 15);
              *(GAS v4u*)(KLTF + fi * 8) = o; } }
        if (wave == 0) *(GAS f32x4*)(DEC + (size_t)it * 256 + 4 * lane) = dec;
#pragma unroll
        for (int f = 0; f < 2; ++f)
#pragma unroll
            for (int e = 0; e < 4; ++e) { unsigned x[8];
#pragma unroll
                for (int jj = 0; jj < 8; ++jj) { const unsigned wd = (e >> 1) ? vv[8 * f + jj].y : vv[8 * f + jj].x; x[jj] = (e & 1) ? (wd >> 16) : (wd & 0xffffu); }
                v4u o; o.x = x[0] | (x[1] << 16); o.y = x[2] | (x[3] << 16); o.z = x[4] | (x[5] << 16); o.w = x[6] | (x[7] << 16);
                const int v = 4 * cg2 + e;
                const size_t fi = (((size_t)it * 32 + (v >> 4)) * 2 + (rg2 >> 1)) * 64 + (2 * (rg2 & 1) + f) * 16 + (v & 15);
                *(GAS v4u*)(VTF + fi * 8) = o; }
        __syncthreads();
        { const int mt = wave >> 1, i = lane & 15, q = lane >> 4;
#pragma unroll
          for (int nn = 0; nn < 2; ++nn) { const int nt = 2 * (wave & 1) + nn; f32x4 acc = {0.f, 0.f, 0.f, 0.f};
            if (nt <= mt) {
#pragma unroll
                for (int ks = 0; ks < 8; ++ks) { const bf16x8 a = *(const LAS bf16x8*)(QEl + (16 * mt + i) * 264 + 32 * ks + 8 * q); const bf16x8 bb = *(const LAS bf16x8*)(KEl + (16 * nt + i) * 264 + 32 * ks + 8 * q);
                    acc = __builtin_amdgcn_mfma_f32_16x16x32_bf16(a, bb, acc, 0, 0, 0); } }
#pragma unroll
            for (int r = 0; r < 4; ++r) { const int c = 16 * mt + 4 * q + r, cp = 16 * nt + i; ATl[c * 72 + cp] = (bf16)f2bf(cp <= c ? acc[r] : 0.f); } } }
        __syncthreads();
        { const int f = tid, mt = f >> 7, ks = (f >> 6) & 1, l2 = f & 63, i2 = l2 & 15, q2 = l2 >> 4;
          const v4u o = *(const LAS v4u*)(ATl + (16 * mt + i2) * 72 + 32 * ks + 8 * q2);
          *(GAS v4u*)(ATTF + ((size_t)it * 512 + f) * 8) = o; }
#pragma unroll
        for (int k = 0; k < 4; ++k) { const int f = tid + 512 * k, w = f >> 8, mt = (f >> 6) & 3, l2 = f & 63, i2 = l2 & 15, q2 = l2 >> 4;
            const v2u lo = *(const LAS v2u*)(QEl + (16 * mt + i2) * 264 + 32 * w + 4 * q2), hi = *(const LAS v2u*)(QEl + (16 * mt + i2) * 264 + 32 * w + 16 + 4 * q2);
            v4u o; o.x = lo.x; o.y = lo.y; o.z = hi.x; o.w = hi.y;
            *(GAS v4u*)(QEF + ((((size_t)it * 8 + w) * 4 + mt) * 64 + l2) * 8) = o; }
        __syncthreads();
    }
}
constexpr int GS_QE = 0, GS_KLT = 32768, GS_ATT = 65536, GS_DEC = 73728, GS_STAGE = 74752;
constexpr int GLA_NSEG = 8, GLA_SEGLEN = 32;
template <int PASS>
__device__ __forceinline__ void gla_scan(LAS unsigned char* lds, const bf16* QEF, const bf16* KLTF, const bf16* ATTF, const bf16* VTF, const float* DEC, float* SEND, float* DTOT, bf16* O) {
    const int tid = threadIdx.x, lane = tid & 63, w = __builtin_amdgcn_readfirstlane(tid >> 6), q = lane >> 4, li = lane & 15;
#define GS_ISSUE(itv, bufv) do { LAS unsigned char* _st = lds + (bufv) * GS_STAGE; const size_t _it = (size_t)(itv); \
        _Pragma("unroll") for (int _k = 0; _k < 4; ++_k) { const int _f = 4 * w + _k; \
            if (PASS == 1) __builtin_amdgcn_global_load_lds((const unsigned*)(QEF + (_it * 32 + _f) * 512 + lane * 8), (LAS unsigned*)(_st + GS_QE + _f * 1024), 16, 0, 0); \
            __builtin_amdgcn_global_load_lds((const unsigned*)(KLTF + (_it * 32 + _f) * 512 + lane * 8), (LAS unsigned*)(_st + GS_KLT + _f * 1024), 16, 0, 0); } \
        if (PASS == 1) __builtin_amdgcn_global_load_lds((const unsigned*)(ATTF + (_it * 8 + w) * 512 + lane * 8), (LAS unsigned*)(_st + GS_ATT + w * 1024), 16, 0, 0); \
        if (w == 0) __builtin_amdgcn_global_load_lds((const unsigned*)(DEC + _it * 256 + lane * 4), (LAS unsigned*)(_st + GS_DEC), 16, 0, 0); } while (0)
    for (int wi = blockIdx.x; wi < 256; wi += gridDim.x) {
        const int bh = wi & 7, rest = wi >> 3, seg = rest >> 2, vsl = rest & 3, h = bh & 3, b = bh >> 2;
        const int it0 = bh * 256 + seg * GLA_SEGLEN, vs16 = vsl * 8 + w;
        f32x4 S[16];
#pragma unroll
        for (int m = 0; m < 16; ++m) S[m] = (f32x4){0.f, 0.f, 0.f, 0.f};
        if (PASS == 1) {
            for (int s2 = 0; s2 < seg; ++s2) { const float* se = SEND + ((size_t)((bh * GLA_NSEG + s2) * 32 + vs16) * 16) * 256; const float* dt = DTOT + (size_t)(bh * GLA_NSEG + s2) * 256;
#pragma unroll
                for (int m = 0; m < 16; ++m) { const f32x4 dv = *(const GAS f32x4*)(dt + 16 * m + 4 * q), sv = *(const GAS f32x4*)(se + (m * 64 + lane) * 4); S[m] = S[m] * dv + sv; } }
        } else if (vsl == 0 && tid < 256) { float p = 1.f;
            for (int n = 0; n < GLA_SEGLEN; ++n) p *= DEC[(size_t)(it0 + n) * 256 + tid];
            DTOT[(size_t)(bh * GLA_NSEG + seg) * 256 + tid] = p; }
        __syncthreads();
        GS_ISSUE(it0, 0);
        const GAS bf16x8* v16 = (const GAS bf16x8*)VTF + (((size_t)it0 * 32 + vs16) * 2) * 64 + lane;
        bf16x8 vb0 = v16[0], vb1 = v16[64], nvb0 = vb0, nvb1 = vb1;
        for (int n = 0; n < GLA_SEGLEN; ++n) {
            VM_WAIT(); __syncthreads();
            if (n + 1 < GLA_SEGLEN) { GS_ISSUE(it0 + n + 1, (n + 1) & 1); nvb0 = v16[(size_t)(n + 1) * 4096]; nvb1 = v16[(size_t)(n + 1) * 4096 + 64]; }
            const LAS unsigned char* st = lds + (n & 1) * GS_STAGE;
            f32x4 po[4];
            if (PASS == 1) {
                bf16x8 sb[8];
#pragma unroll
                for (int ks = 0; ks < 8; ++ks) { v4u x; x.x = pk2(S[2 * ks][0], S[2 * ks][1]); x.y = pk2(S[2 * ks][2], S[2 * ks][3]); x.z = pk2(S[2 * ks + 1][0], S[2 * ks + 1][1]); x.w = pk2(S[2 * ks + 1][2], S[2 * ks + 1][3]); sb[ks] = __builtin_bit_cast(bf16x8, x); }
#pragma unroll
                for (int mt = 0; mt < 4; ++mt) { f32x4 a = {0.f, 0.f, 0.f, 0.f};
#pragma unroll
                    for (int ks = 0; ks < 8; ++ks) a = __builtin_amdgcn_mfma_f32_16x16x32_bf16(*(const LAS bf16x8*)(st + GS_QE + (ks * 4 + mt) * 1024 + lane * 16), sb[ks], a, 0, 0, 0);
                    a = __builtin_amdgcn_mfma_f32_16x16x32_bf16(*(const LAS bf16x8*)(st + GS_ATT + (mt * 2 + 0) * 1024 + lane * 16), vb0, a, 0, 0, 0);
                    a = __builtin_amdgcn_mfma_f32_16x16x32_bf16(*(const LAS bf16x8*)(st + GS_ATT + (mt * 2 + 1) * 1024 + lane * 16), vb1, a, 0, 0, 0);
                    po[mt] = a; }
            }
#pragma unroll
            for (int m = 0; m < 16; ++m) { const f32x4 dv = *(const LAS f32x4*)(st + GS_DEC + (16 * m + 4 * q) * 4);
                f32x4 s = S[m] * dv;
                s = __builtin_amdgcn_mfma_f32_16x16x32_bf16(*(const LAS bf16x8*)(st + GS_KLT + (m * 2 + 0) * 1024 + lane * 16), vb0, s, 0, 0, 0);
                s = __builtin_amdgcn_mfma_f32_16x16x32_bf16(*(const LAS bf16x8*)(st + GS_KLT + (m * 2 + 1) * 1024 + lane * 16), vb1, s, 0, 0, 0);
                S[m] = s; }
            if (PASS == 1) { bf16* op = O + (size_t)(b * SEQ + (seg * GLA_SEGLEN + n) * GLA_C + 4 * q) * 2048 + h * 512 + vsl * 128 + w * 16 + li;
#pragma unroll
                for (int mt = 0; mt < 4; ++mt)
#pragma unroll
                    for (int r = 0; r < 4; ++r) { const float x = po[mt][r], y = __shfl_xor(x, 1); if ((lane & 1) == 0) *(GAS unsigned*)(op + (size_t)(16 * mt + r) * 2048) = pk2(x, y); } }
            vb0 = nvb0; vb1 = nvb1;
        }
        if (PASS == 0) { float* se = SEND + ((size_t)((bh * GLA_NSEG + seg) * 32 + vs16) * 16) * 256;
#pragma unroll
            for (int m = 0; m < 16; ++m) *(GAS f32x4*)(se + (m * 64 + lane) * 4) = S[m]; }
        __syncthreads();
    }
#undef GS_ISSUE
}
__device__ __forceinline__ void gla_gate(const bf16* O, const bf16* R, const float* head_g, bf16* OG, int gw, int NGW, int lane) {
    float hg[8];
#pragma unroll
    for (int j = 0; j < 8; ++j) hg[j] = head_g[8 * lane + j];
    for (int m = gw; m < T; m += NGW) {
#pragma unroll
        for (int h = 0; h < 4; ++h) {
            const v4u ov = *(const GAS v4u*)(O + (size_t)m * 2048 + h * 512 + 8 * lane), rv = *(const GAS v4u*)(R + (size_t)m * 2048 + h * 512 + 8 * lane);
            float o[8] = {bf_lo(ov.x), bf_hi(ov.x), bf_lo(ov.y), bf_hi(ov.y), bf_lo(ov.z), bf_hi(ov.z), bf_lo(ov.w), bf_hi(ov.w)};
            float r[8] = {bf_lo(rv.x), bf_hi(rv.x), bf_lo(rv.y), bf_hi(rv.y), bf_lo(rv.z), bf_hi(rv.z), bf_lo(rv.w), bf_hi(rv.w)};
            float ss = 0.f;
#pragma unroll
            for (int j = 0; j < 8; ++j) ss += o[j] * o[j];
            const float rstd = rsqrtf(wave_sum(ss) * (1.f / 512.f) + RMS_EPS);
            float y[8];
#pragma unroll
            for (int j = 0; j < 8; ++j) y[j] = o[j] * rstd * hg[j] * pg8::silu_f(r[j]);
            v4u w; w.x = pk2(y[0], y[1]); w.y = pk2(y[2], y[3]); w.z = pk2(y[4], y[5]); w.w = pk2(y[6], y[7]);
            *(GAS v4u*)(OG + (size_t)m * 2048 + h * 512 + 8 * lane) = w;
        }
    }
}

__device__ __forceinline__ void moe_route(LAS unsigned char* lds, const float* RL, const float* SSP, const float* bgroup, const float* brouter, unsigned* gcnt, unsigned* EP0, unsigned* EP1, float* W0, float* W1, float* RSTD) {
    const int tid = threadIdx.x; LAS int* lcnt = (LAS int*)lds; LAS int* lbase = lcnt + 32;
    for (int base = blockIdx.x * 128; base < T; base += gridDim.x * 128) {
        if (tid < 32) lcnt[tid] = 0;
        __syncthreads();
        int e0 = 0, e1 = 0, r0 = 0, r1 = 0; float w0 = 0.f, w1 = 0.f;
        if (tid < 128) { const int t = base + tid; const float* rl = RL + (size_t)t * 64;
            float ssq = 0.f; { const GAS f32x4* sp = (const GAS f32x4*)(SSP + (size_t)t * 32);
#pragma unroll
                for (int k = 0; k < 8; ++k) { const f32x4 v = sp[k]; ssq += (v.x + v.y) + (v.z + v.w); } }
            const float rstd = rsqrtf(ssq * (1.f / D) + RMS_EPS); RSTD[t] = rstd;
            const f32x4 g4 = *(const GAS f32x4*)rl; float gl[4] = {g4.x * rstd + bgroup[0], g4.y * rstd + bgroup[1], g4.z * rstd + bgroup[2], g4.w * rstd + bgroup[3]};
            int g = 0; float best = gl[0];
#pragma unroll
            for (int j = 1; j < 4; ++j) if (gl[j] > best) { best = gl[j]; g = j; }
            float se = 0.f;
#pragma unroll
            for (int j = 0; j < 4; ++j) se += __expf(gl[j] - best);
            const float pg = 1.0f / se;
            const f32x4 a4 = *(const GAS f32x4*)(rl + 4 + 8 * g), b4 = *(const GAS f32x4*)(rl + 8 + 8 * g);
            float el[8] = {a4.x, a4.y, a4.z, a4.w, b4.x, b4.y, b4.z, b4.w};
#pragma unroll
            for (int j = 0; j < 8; ++j) el[j] = el[j] * rstd + brouter[8 * g + j];
            int i0 = 0; float v0 = el[0];
#pragma unroll
            for (int j = 1; j < 8; ++j) if (el[j] > v0) { v0 = el[j]; i0 = j; }
            int i1 = -1; float v1 = -3.0e38f;
#pragma unroll
            for (int j = 0; j < 8; ++j) if (j != i0 && el[j] > v1) { v1 = el[j]; i1 = j; }
            w0 = pg / (1.0f + __expf(v1 - v0)); w1 = pg - w0;
            e0 = 8 * g + i0; e1 = 8 * g + i1;
            r0 = __hip_atomic_fetch_add(&lcnt[e0], 1, __ATOMIC_RELAXED, __HIP_MEMORY_SCOPE_WORKGROUP); r1 = __hip_atomic_fetch_add(&lcnt[e1], 1, __ATOMIC_RELAXED, __HIP_MEMORY_SCOPE_WORKGROUP); }
        __syncthreads();
        if (tid < 32) lbase[tid] = (int)__hip_atomic_fetch_add(gcnt + tid, (unsigned)lcnt[tid], RLX_AGENT);
        __syncthreads();
        if (tid < 128) { const int t = base + tid;
            EP0[t] = ((unsigned)e0 << 24) | (unsigned)(lbase[e0] + r0); EP1[t] = ((unsigned)e1 << 24) | (unsigned)(lbase[e1] + r1); W0[t] = w0; W1[t] = w1; }
        __syncthreads();
    }
}
__device__ __forceinline__ void moe_build_table(LAS unsigned char* ldsbase, unsigned* gcnt) {
    LAS int* off = (LAS int*)(ldsbase + MOE_OFF_OFF); LAS unsigned char* texp = ldsbase + MOE_TEXP_OFF;
    __syncthreads();
    if (threadIdx.x == 0) { int acc = 0, ti = 0;
        for (int e = 0; e < NE; ++e) { const int c = (int)__hip_atomic_load(gcnt + e, RLX_AGENT); off[e] = acc; const int nt = (c + 255) >> 8;
            for (int k = 0; k < nt && ti < 288; ++k) texp[ti++] = (unsigned char)e;
            acc += nt * 256; }
        off[32] = acc; }
    __syncthreads();
}
__device__ __forceinline__ void moe_slots(LAS unsigned char* ldsbase, unsigned* gcnt, const unsigned* EP0, const unsigned* EP1, const float* RSTD, unsigned* SL0, unsigned* SL1, unsigned* TL, float* RS) {
    const LAS int* off = (const LAS int*)(ldsbase + MOE_OFF_OFF); const int tid = threadIdx.x;
    for (int t = blockIdx.x * 512 + tid; t < T; t += gridDim.x * 512) {
        const unsigned p0 = EP0[t], p1 = EP1[t]; const float rs = RSTD[t];
        const unsigned s0 = (unsigned)off[p0 >> 24] + (p0 & 0xffffffu), s1 = (unsigned)off[p1 >> 24] + (p1 & 0xffffffu);
        TL[s0] = (unsigned)t; RS[s0] = rs; TL[s1] = (unsigned)t; RS[s1] = rs; SL0[t] = s0; SL1[t] = s1; }
    for (int e = blockIdx.x; e < NE; e += gridDim.x) { const int c = (int)__hip_atomic_load(gcnt + e, RLX_AGENT);
        for (int i = off[e] + c + tid; i < off[e + 1]; i += 512) { TL[i] = 0u; RS[i] = 0.f; } }
}
template <bool FINAL>
__device__ __forceinline__ void moe_combine(const bf16* H, const bf16* Y, const unsigned* SL0, const unsigned* SL1, const float* W0, const float* W1, float* outf, bf16* H2, bf16* HN, int gw, int NGW, int lane) {
    for (int t = gw; t < T; t += NGW) {
        const unsigned s0 = SL0[t], s1 = SL1[t]; const float w0 = W0[t], w1 = W1[t];
        const GAS v2u* hr = (const GAS v2u*)(H + (size_t)t * D) + lane;
        const GAS v2u* y0 = (const GAS v2u*)(Y + (size_t)s0 * 2048) + lane; const GAS v2u* y1 = (const GAS v2u*)(Y + (size_t)s1 * 2048) + lane;
        f32x4 v[8]; float s = 0.f;
#pragma unroll
        for (int j = 0; j < 8; ++j) { const v2u a = y0[64 * j], b = y1[64 * j], hh = hr[64 * j]; f32x4 x;
            x.x = bf_lo(hh.x) + w0 * bf_lo(a.x) + w1 * bf_lo(b.x); x.y = bf_hi(hh.x) + w0 * bf_hi(a.x) + w1 * bf_hi(b.x); x.z = bf_lo(hh.y) + w0 * bf_lo(a.y) + w1 * bf_lo(b.y); x.w = bf_hi(hh.y) + w0 * bf_hi(a.y) + w1 * bf_hi(b.y);
            v[j] = x; s += (x.x * x.x + x.y * x.y) + (x.z * x.z + x.w * x.w); }
        if constexpr (FINAL) { GAS f32x4* xr = (GAS f32x4*)(outf + (size_t)t * D) + lane;
#pragma unroll
            for (int j = 0; j < 8; ++j) xr[64 * j] = v[j]; }
        else { const float rstd = rsqrtf(wave_sum(s) * (1.f / D) + RMS_EPS);
            GAS v2u* o8 = (GAS v2u*)(HN + (size_t)t * D) + lane; GAS v2u* h8 = (GAS v2u*)(H2 + (size_t)t * D) + lane;
#pragma unroll
            for (int j = 0; j < 8; ++j) { v2u o; o.x = pk2(v[j].x, v[j].y); o.y = pk2(v[j].z, v[j].w); h8[64 * j] = o;
                o.x = pk2(v[j].x * rstd, v[j].y * rstd); o.y = pk2(v[j].z * rstd, v[j].w * rstd); o8[64 * j] = o; } }
    }
}

__device__ const unsigned char T5_BUCKET[128] = {0,1,2,3,4,5,6,7,8,9,10,11,12,13,14,15,16,16,16,17,17,18,18,18,19,19,19,20,20,20,20,21,21,21,21,22,22,22,22,22,23,23,23,23,23,23,24,24,24,24,24,24,25,25,25,25,25,25,25,26,26,26,26,26,26,26,26,27,27,27,27,27,27,27,27,27,27,28,28,28,28,28,28,28,28,28,28,29,29,29,29,29,29,29,29,29,29,29,29,30,30,30,30,30,30,30,30,30,30,30,30,30,30,31,31,31,31,31,31,31,31,31,31,31,31,31,31,31};
constexpr int AT_K = 0, AT_VT = 36864, AT_BIAS = 70656;
__device__ __forceinline__ void swa_attention(LAS unsigned char* lds, const bf16* KVQ, const bf16* VT, const float* knorm, const float* qnorm, const float* relb, const float* sinks, bf16* AO) {
    const int tid = threadIdx.x, lane = tid & 63, g = __builtin_amdgcn_readfirstlane(tid >> 6), li = lane & 15, q = lane >> 4;
    LAS bf16* KL = (LAS bf16*)(lds + AT_K); LAS bf16* VTL = (LAS bf16*)(lds + AT_VT); LAS float* BL = (LAS float*)(lds + AT_BIAS);
    constexpr float LOG2E = 1.4426950408889634f;
    float qn[2][8];
#pragma unroll
    for (int ks = 0; ks < 2; ++ks)
#pragma unroll
        for (int j = 0; j < 8; ++j) qn[ks][j] = qnorm[32 * ks + 8 * q + j] * (0.125f * LOG2E);
    const int key = tid >> 1, hf = tid & 1, vd = tid >> 3, vc = tid & 7;
    float kn[32];
#pragma unroll
    for (int j = 0; j < 32; ++j) kn[j] = knorm[32 * hf + j];
    v4u kw[4], vw[4];
#define AT_PREFETCH(wiv) do { const int _hk = (wiv) & 3, _n = ((wiv) >> 2) & 127, _b = (wiv) >> 9; \
        const bool _live = (_n > 0) || (key >= 128); const size_t _tk = (size_t)_b * SEQ + (size_t)(_n - 1) * 128 + key; \
        const bf16* _kp = KVQ + _tk * KVQ_N + _hk * 64 + 32 * hf; \
        _Pragma("unroll") for (int _j = 0; _j < 4; ++_j) kw[_j] = _live ? *(const GAS v4u*)(_kp + 8 * _j) : (v4u){0u, 0u, 0u, 0u}; \
        const bf16* _vp = VT + ((size_t)(_b * 4 + _hk) * 64 + vd) * SEQ + (size_t)(_n - 1) * 128; \
        _Pragma("unroll") for (int _j = 0; _j < 4; ++_j) { const int _c = vc + 8 * _j; vw[_j] = ((_n > 0) || (_c >= 16)) ? *(const GAS v4u*)(_vp + 8 * _c) : (v4u){0u, 0u, 0u, 0u}; } } while (0)
    if (blockIdx.x < 1024) AT_PREFETCH(blockIdx.x);
    for (int wi = blockIdx.x; wi < 1024; wi += gridDim.x) {
        const int hk = wi & 3, n = (wi >> 2) & 127, b = wi >> 9;
        __syncthreads();
        { float ss = 0.f;
#pragma unroll
          for (int j = 0; j < 4; ++j) { const float a0 = bf_lo(kw[j].x), a1 = bf_hi(kw[j].x), a2 = bf_lo(kw[j].y), a3 = bf_hi(kw[j].y), a4 = bf_lo(kw[j].z), a5 = bf_hi(kw[j].z), a6 = bf_lo(kw[j].w), a7 = bf_hi(kw[j].w);
              ss += (a0 * a0 + a1 * a1) + (a2 * a2 + a3 * a3) + (a4 * a4 + a5 * a5) + (a6 * a6 + a7 * a7); }
          ss += __shfl_xor(ss, 1);
          const float rstd = rsqrtf(ss * (1.f / 64.f) + RMS_EPS);
#pragma unroll
          for (int j = 0; j < 4; ++j) { v4u o;
              o.x = pk2(bf_lo(kw[j].x) * rstd * kn[8 * j + 0], bf_hi(kw[j].x) * rstd * kn[8 * j + 1]); o.y = pk2(bf_lo(kw[j].y) * rstd * kn[8 * j + 2], bf_hi(kw[j].y) * rstd * kn[8 * j + 3]);
              o.z = pk2(bf_lo(kw[j].z) * rstd * kn[8 * j + 4], bf_hi(kw[j].z) * rstd * kn[8 * j + 5]); o.w = pk2(bf_lo(kw[j].w) * rstd * kn[8 * j + 6], bf_hi(kw[j].w) * rstd * kn[8 * j + 7]);
              *(LAS v4u*)(KL + key * 72 + 32 * hf + 8 * j) = o; }
#pragma unroll
          for (int j = 0; j < 4; ++j) *(LAS v4u*)(VTL + vd * 264 + 8 * (vc + 8 * j)) = vw[j];
#pragma unroll
          for (int k = 0; k < 2; ++k) { const int e = tid + 512 * k, gg = e >> 7, dist = e & 127; BL[e] = relb[(int)T5_BUCKET[dist] * 32 + hk * 8 + gg] * LOG2E; }
        }
        __syncthreads();
        if (wi + (int)gridDim.x < 1024) AT_PREFETCH(wi + (int)gridDim.x);
        const int head = hk * 8 + g; const float sink = sinks[head] * LOG2E;
        float bz[9][4];
#pragma unroll
        for (int tt = 0; tt < 9; ++tt)
#pragma unroll
            for (int r = 0; r < 4; ++r) { const int dist = 128 - 16 * tt + li - (4 * q + r); const bool ok = (dist >= 0) && (dist < 128);
                bz[tt][r] = ok ? BL[g * 128 + (dist & 127)] : -__builtin_inff(); }
        v4u qr0, qr1;
        { const bf16* qp = KVQ + ((size_t)b * SEQ + (size_t)n * 128 + li) * KVQ_N + 512 + head * 64 + 8 * q; qr0 = *(const GAS v4u*)qp; qr1 = *(const GAS v4u*)(qp + 32); }
        for (int mt = 0; mt < 8; ++mt) {
            const size_t tq = (size_t)b * SEQ + (size_t)n * 128 + 16 * mt + li;
            bf16x8 qf[2];
            { const v4u q0 = qr0, q1 = qr1;
              if (mt < 7) { const bf16* qp = KVQ + (tq + 16) * KVQ_N + 512 + head * 64 + 8 * q; qr0 = *(const GAS v4u*)qp; qr1 = *(const GAS v4u*)(qp + 32); }
              float a[16] = {bf_lo(q0.x), bf_hi(q0.x), bf_lo(q0.y), bf_hi(q0.y), bf_lo(q0.z), bf_hi(q0.z), bf_lo(q0.w), bf_hi(q0.w), bf_lo(q1.x), bf_hi(q1.x), bf_lo(q1.y), bf_hi(q1.y), bf_lo(q1.z), bf_hi(q1.z), bf_lo(q1.w), bf_hi(q1.w)};
              float ss = 0.f;
#pragma unroll
              for (int j = 0; j < 16; ++j) ss += a[j] * a[j];
              ss += __shfl_xor(ss, 16); ss += __shfl_xor(ss, 32);
              const float rstd = rsqrtf(ss * (1.f / 64.f) + RMS_EPS);
              v4u w0, w1;
              w0.x = pk2(a[0] * rstd * qn[0][0], a[1] * rstd * qn[0][1]); w0.y = pk2(a[2] * rstd * qn[0][2], a[3] * rstd * qn[0][3]); w0.z = pk2(a[4] * rstd * qn[0][4], a[5] * rstd * qn[0][5]); w0.w = pk2(a[6] * rstd * qn[0][6], a[7] * rstd * qn[0][7]);
              w1.x = pk2(a[8] * rstd * qn[1][0], a[9] * rstd * qn[1][1]); w1.y = pk2(a[10] * rstd * qn[1][2], a[11] * rstd * qn[1][3]); w1.z = pk2(a[12] * rstd * qn[1][4], a[13] * rstd * qn[1][5]); w1.w = pk2(a[14] * rstd * qn[1][6], a[15] * rstd * qn[1][7]);
              qf[0] = __builtin_bit_cast(bf16x8, w0); qf[1] = __builtin_bit_cast(bf16x8, w1); }
            f32x4 st[9]; float mx = sink;
#pragma unroll
            for (int tt = 0; tt < 9; ++tt) { const int nt = mt + tt;
                if (n == 0 && nt < 8) { st[tt] = (f32x4){-__builtin_inff(), -__builtin_inff(), -__builtin_inff(), -__builtin_inff()}; }
                else { f32x4 acc = {0.f, 0.f, 0.f, 0.f};
#pragma unroll
                    for (int ks = 0; ks < 2; ++ks) { const bf16x8 a = *(const LAS bf16x8*)(KL + (16 * nt + li) * 72 + 32 * ks + 8 * q); acc = __builtin_amdgcn_mfma_f32_16x16x32_bf16(a, qf[ks], acc, 0, 0, 0); }
#pragma unroll
                    for (int r = 0; r < 4; ++r) { acc[r] += bz[tt][r]; mx = fmaxf(mx, acc[r]); }
                    st[tt] = acc; } }
            mx = fmaxf(mx, __shfl_xor(mx, 16)); mx = fmaxf(mx, __shfl_xor(mx, 32));
            float lsum = 0.f;
#pragma unroll
            for (int tt = 0; tt < 9; ++tt)
#pragma unroll
                for (int r = 0; r < 4; ++r) { const float p = __builtin_amdgcn_exp2f(st[tt][r] - mx); st[tt][r] = p; lsum += p; }
            lsum += __shfl_xor(lsum, 16); lsum += __shfl_xor(lsum, 32);
            const float inv = 1.0f / (lsum + __builtin_amdgcn_exp2f(sink - mx));
            f32x4 oacc[4];
#pragma unroll
            for (int dt = 0; dt < 4; ++dt) oacc[dt] = (f32x4){0.f, 0.f, 0.f, 0.f};
#pragma unroll
            for (int s = 0; s < 5; ++s) {
                v4u pw; pw.x = pk2(st[2 * s][0], st[2 * s][1]); pw.y = pk2(st[2 * s][2], st[2 * s][3]);
                if (s < 4) { pw.z = pk2(st[2 * s + 1][0], st[2 * s + 1][1]); pw.w = pk2(st[2 * s + 1][2], st[2 * s + 1][3]); } else { pw.z = 0u; pw.w = 0u; }
                const bf16x8 pb = __builtin_bit_cast(bf16x8, pw);
                const int k0 = 16 * (mt + 2 * s) + 4 * q; int k1 = 16 * (mt + 2 * s + 1) + 4 * q; if (k1 > 252) k1 = 240 + 4 * q;
#pragma unroll
                for (int dt = 0; dt < 4; ++dt) { const v2u lo = *(const LAS v2u*)(VTL + (16 * dt + li) * 264 + k0), hi = *(const LAS v2u*)(VTL + (16 * dt + li) * 264 + k1);
                    v4u aw; aw.x = lo.x; aw.y = lo.y; aw.z = hi.x; aw.w = hi.y;
                    oacc[dt] = __builtin_amdgcn_mfma_f32_16x16x32_bf16(__builtin_bit_cast(bf16x8, aw), pb, oacc[dt], 0, 0, 0); } }
#pragma unroll
            for (int dt = 0; dt < 4; ++dt) { v2u o; o.x = pk2(oacc[dt][0] * inv, oacc[dt][1] * inv); o.y = pk2(oacc[dt][2] * inv, oacc[dt][3] * inv);
                *(GAS v2u*)(AO + tq * 2048 + head * 64 + 16 * dt + 4 * q) = o; }
        }
    }
#undef AT_PREFETCH
}


struct Args { const float* in[24]; float* out; unsigned char* ws; int ph_lo, ph_hi; };
constexpr int N_PHASES = 23;
#define CAS __attribute__((address_space(4)))
template <int WHICH> struct OrderCvt : pg8::StaticOrder {
    int tpm, tpn, gw, NGW, lane;
    __device__ __forceinline__ void set_trigger(int when) { pg8::Unit u; if (!next(when, u)) (void)next(0, u); tpm = u.pm; tpn = u.pn; }
    __device__ __forceinline__ void done(const pg8::Unit& u) const {
        if (u.pm != tpm || u.pn != tpn) return;
        const CAS Args* a = (const CAS Args*)__builtin_amdgcn_kernarg_segment_ptr();
        unsigned char* ws = a->ws;
        if (WHICH == 0) {
            cvt_matrix(a->in[6], 2048, 2048, nullptr, (bf16*)(ws + WS_W_GLA_OUT), 0, gw, NGW, lane);
            cvt_matrix(a->in[8], 2048, 512, a->in[7], (bf16*)(ws + WS_W_KVQ), 0, gw, NGW, lane);
            cvt_matrix(a->in[12], 2048, 2048, a->in[11], (bf16*)(ws + WS_W_KVQ), 512, gw, NGW, lane);
            cvt_matrix(a->in[15], 2048, 2048, nullptr, (bf16*)(ws + WS_W_SWA_OUT), 0, gw, NGW, lane);
            for (int l = 0; l < 2; ++l) {
                cvt_matrix(a->in[17] + (size_t)l * 2048 * 4, 2048, 4, a->in[16] + l * 2048, (bf16*)(ws + WS_W_ROUTER) + (size_t)l * 256 * 2048, 0, gw, NGW, lane);
                cvt_matrix(a->in[19] + (size_t)l * 2048 * 32, 2048, 32, a->in[16] + l * 2048, (bf16*)(ws + WS_W_ROUTER) + (size_t)l * 256 * 2048, 4, gw, NGW, lane);
            }
            cvt_moe(a->in[21], a->in[22], a->in[23], a->in[16], (bf16*)(ws + WS_W_GU), (bf16*)(ws + WS_W_DN), gw, NGW, lane);
        } else {
            cvt_moe(a->in[21] + (size_t)NE * 2048 * 512, a->in[22] + (size_t)NE * 2048 * 512, a->in[23] + (size_t)NE * 512 * 2048, a->in[16] + 2048, (bf16*)(ws + WS_W_GU), (bf16*)(ws + WS_W_DN), gw, NGW, lane);
        }
    }
};
__global__ void __launch_bounds__(NWAVES * 64, 2) fwd(Args args) {
    extern __shared__ __attribute__((aligned(16))) unsigned char lds_raw[];
    LAS unsigned char* lds = (LAS unsigned char*)lds_raw;
    const int tid = threadIdx.x, lane = tid & 63, wave = __builtin_amdgcn_readfirstlane(tid >> 6);
    const int G = gridDim.x, gw = blockIdx.x * NWAVES + wave, NGW = G * NWAVES;
    unsigned char* ws = args.ws;
    gu32* ctl = (gu32*)(ws + WS_CTL);
    for (int u = tid; u < (LDS_BYTES - LDSCTL_OFF) / 4; u += NWAVES * 64) ((LAS unsigned*)(lds + LDSCTL_OFF))[u] = 0u;
    __syncthreads();
    XcdBarrier bar = xcd_barrier_post((unsigned*)(ctl + CW_BAR), (volatile LAS unsigned*)(lds + MISC_OFF));
    const int lo = args.ph_lo, hi = args.ph_hi;
#define IN(k) ((((MK_PHASE_MASK) >> (k)) & 1) && lo <= (k) && (k) < hi)
#define PB(k) const unsigned long long _pt0 = (((MK_DELAY_MASK) >> (k)) & 1) ? __builtin_amdgcn_s_memrealtime() : 0ull
#define PE(k) do { if (((MK_DELAY_MASK) >> (k)) & 1) { const unsigned long long _pt1 = __builtin_amdgcn_s_memrealtime(), _dt = _pt1 - _pt0; while (__builtin_amdgcn_s_memrealtime() - _pt1 < _dt) __builtin_amdgcn_s_sleep(8); } } while (0)
#define SEAM(k) do { if (IN(k) && IN((k) + 1)) xcd_barrier(bar); } while (0)

    const float* x = args.in[0]; float* out = args.out;
    bf16* W_GLA_IN = (bf16*)(ws + WS_W_GLA_IN); bf16* W_GLA_OUT = (bf16*)(ws + WS_W_GLA_OUT); bf16* W_KVQ = (bf16*)(ws + WS_W_KVQ); bf16* W_SWA_OUT = (bf16*)(ws + WS_W_SWA_OUT);
    bf16* W_ROUTER = (bf16*)(ws + WS_W_ROUTER); bf16* W_GU = (bf16*)(ws + WS_W_GU); bf16* W_DN = (bf16*)(ws + WS_W_DN);
    bf16* HN = (bf16*)(ws + WS_HN);
    unsigned* EP0 = (unsigned*)(ws + WS_TOK); unsigned* EP1 = EP0 + T; unsigned* SL0 = EP1 + T; unsigned* SL1 = SL0 + T; float* TW0 = (float*)(SL1 + T); float* TW1 = TW0 + T; float* RSTD = TW1 + T;
    bf16* HB = (bf16*)(ws + WS_HB); float* SSP = (float*)(ws + WS_SSP); unsigned* TL = (unsigned*)(ws + WS_TL); float* RS = (float*)(ws + WS_RS);
    float* RL = (float*)(ws + WS_RL);

    if (IN(0)) { PB(0);
        cvt_matrix(args.in[2], 2048, GLA_PROJ_N, args.in[1], W_GLA_IN, 0, gw, NGW, lane);
        norm_rows(x, HN, gw, NGW, lane);
        PE(0);
    }
    SEAM(0);
#define STAGGER(groups, ticks) do { if ((ticks) > 0) { const unsigned long long _s0 = __builtin_amdgcn_s_memrealtime(), _sd = (unsigned long long)((blockIdx.x % (groups)) * (ticks)); \
        while (__builtin_amdgcn_s_memrealtime() - _s0 < _sd) __builtin_amdgcn_s_sleep(4); } } while (0)
    if (IN(1)) { PB(1);
        pg8::Gemm g{HN, W_GLA_IN, T, GLA_PROJ_NP, 2048}; OrderCvt<0> S; S.init(T, GLA_PROJ_NP, G, (int)blockIdx.x); S.gw = gw; S.NGW = NGW; S.lane = lane; S.set_trigger((int)(blockIdx.x % 12));
        pg8::EpiGlaProj E{(bf16*)(ws + WS_QK), (bf16*)(ws + WS_V), (bf16*)(ws + WS_R), (bf16*)(ws + WS_GL)};
        STAGGER(4, MK_STAG1);
        pg8::gemm_phase<pg8::EpiGlaProj, OrderCvt<0>, true, true>(lds + RING_OFF, g, S, E);
        PE(1);
    }
    SEAM(1);
    if (IN(2)) { PB(2); gla_prepass(lds + RING_OFF, (const bf16*)(ws + WS_QK), (const bf16*)(ws + WS_V), (const bf16*)(ws + WS_GL), args.in[3], args.in[4],
                           (bf16*)(ws + WS_QEF), (bf16*)(ws + WS_KLTF), (bf16*)(ws + WS_ATTF), (bf16*)(ws + WS_VTF), (float*)(ws + WS_DEC)); PE(2); }
    SEAM(2);
    if (IN(3)) { PB(3); gla_scan<0>(lds + RING_OFF, (const bf16*)(ws + WS_QEF), (const bf16*)(ws + WS_KLTF), (const bf16*)(ws + WS_ATTF), (const bf16*)(ws + WS_VTF), (const float*)(ws + WS_DEC), (float*)(ws + WS_SEND), (float*)(ws + WS_DTOT), (bf16*)(ws + WS_QK)); PE(3); }
    SEAM(3);
    if (IN(4)) { PB(4); gla_scan<1>(lds + RING_OFF, (const bf16*)(ws + WS_QEF), (const bf16*)(ws + WS_KLTF), (const bf16*)(ws + WS_ATTF), (const bf16*)(ws + WS_VTF), (const float*)(ws + WS_DEC), (float*)(ws + WS_SEND), (float*)(ws + WS_DTOT), (bf16*)(ws + WS_QK)); PE(4); }
    SEAM(4);
    if (IN(5)) { PB(5); gla_gate((const bf16*)(ws + WS_QK), (const bf16*)(ws + WS_R), args.in[5], HN, gw, NGW, lane); PE(5); }
    SEAM(5);
    if (IN(6)) { PB(6);
        pg8::Gemm g{HN, W_GLA_OUT, T, 2048, 2048}; pg8::StaticOrder S; S.init(T, 2048, G, (int)blockIdx.x);
        pg8::EpiResBf16<false> E{x, 2048, HB, SSP};
        pg8::gemm_phase<pg8::EpiResBf16<false>, pg8::StaticOrder, true, true>(lds + RING_OFF, g, S, E);
        PE(6);
    }
    SEAM(6);

    { constexpr int layer = 0; constexpr int pb = 6 + 10 * layer;
    unsigned* gcnt = (unsigned*)(ctl + CW_CNT + layer * 64);
    if (IN(pb + 1)) { PB(pb + 1);
        pg8::Gemm g{HB, W_ROUTER + (size_t)layer * 256 * 2048, T, 256, 2048}; pg8::StaticOrder S; S.init(T, 256, G, (int)blockIdx.x);
        pg8::EpiRouter E{RL};
        pg8::gemm_phase<pg8::EpiRouter, pg8::StaticOrder, true, true>(lds + RING_OFF, g, S, E);
        PE(pb + 1);
    }
    SEAM(pb + 1);
    if (IN(pb + 2)) { PB(pb + 2); moe_route(lds + RING_OFF, RL, SSP, args.in[18] + layer * 4, args.in[20] + layer * 32, gcnt, EP0, EP1, TW0, TW1, RSTD); PE(pb + 2); }
    SEAM(pb + 2);
    if (IN(pb + 3)) { PB(pb + 3); { moe_build_table(lds, gcnt); moe_slots(lds, gcnt, EP0, EP1, RSTD, SL0, SL1, TL, RS); } PE(pb + 3); }
    SEAM(pb + 3);
    if (IN(pb + 4)) { PB(pb + 4);
        moe_build_table(lds, gcnt);
        const int rows = __builtin_amdgcn_readfirstlane(((const LAS int*)(lds + MOE_OFF_OFF))[32]);
        pg8::Gemm g{HB, W_GU, rows, 1024, 2048, TL};
        pg8::GroupedOrder S{(const LAS unsigned char*)(lds + MOE_TEXP_OFF), rows >> 8, 4, G, (int)blockIdx.x};
        pg8::EpiSwiGLU E{(bf16*)(ws + WS_ACT), RS};
        pg8::gemm_phase<pg8::EpiSwiGLU, pg8::GroupedOrder, true, true, true>(lds + RING_OFF, g, S, E);
        PE(pb + 4);
    }
    SEAM(pb + 4);
    if (IN(pb + 5)) { PB(pb + 5);
        moe_build_table(lds, gcnt);
        const int rows = __builtin_amdgcn_readfirstlane(((const LAS int*)(lds + MOE_OFF_OFF))[32]);
        pg8::Gemm g{(const bf16*)(ws + WS_ACT), W_DN, rows, 2048, 512};
        pg8::GroupedOrder S{(const LAS unsigned char*)(lds + MOE_TEXP_OFF), rows >> 8, 8, G, (int)blockIdx.x};
        pg8::EpiBf16 E{(bf16*)(ws + WS_Y), 2048};
        pg8::gemm_phase<pg8::EpiBf16, pg8::GroupedOrder, true, true, false, (MK_EARLY_EPI != 0)>(lds + RING_OFF, g, S, E);
        PE(pb + 5);
    }
    SEAM(pb + 5);
    if (IN(pb + 6)) { PB(pb + 6);
        moe_combine<false>(HB, (const bf16*)(ws + WS_Y), SL0, SL1, TW0, TW1, nullptr, (bf16*)out, HN, gw, NGW, lane);
        PE(pb + 6);
    }
    if (layer == 0) SEAM(pb + 6);
    }
    if (IN(13)) { PB(13);
        pg8::Gemm g{HN, W_KVQ, T, KVQ_N, 2048}; OrderCvt<1> S; S.init(T, KVQ_N, G, (int)blockIdx.x); S.gw = gw; S.NGW = NGW; S.lane = lane; S.set_trigger((int)(blockIdx.x % 5));
        pg8::EpiKVQ E{(bf16*)(ws + WS_KVQ), (bf16*)(ws + WS_VT)};
        pg8::gemm_phase<pg8::EpiKVQ, OrderCvt<1>, true, true>(lds + RING_OFF, g, S, E);
        PE(13);
    }
    SEAM(13);
    if (IN(14)) { PB(14); swa_attention(lds + RING_OFF, (const bf16*)(ws + WS_KVQ), (const bf16*)(ws + WS_VT), args.in[9], args.in[13], args.in[10], args.in[14], (bf16*)(ws + WS_AO)); PE(14); }
    SEAM(14);
    if (IN(15)) { PB(15);
        pg8::Gemm g{(const bf16*)(ws + WS_AO), W_SWA_OUT, T, 2048, 2048}; pg8::StaticOrder S; S.init(T, 2048, G, (int)blockIdx.x);
        pg8::EpiResBf16<true> E{(const bf16*)out, 2048, HB, SSP};
        pg8::gemm_phase<pg8::EpiResBf16<true>, pg8::StaticOrder, true, true>(lds + RING_OFF, g, S, E);
        PE(15);
    }
    SEAM(15);
    { constexpr int layer = 1; constexpr int pb = 6 + 10 * layer;
    unsigned* gcnt = (unsigned*)(ctl + CW_CNT + layer * 64);
    if (IN(pb + 1)) { PB(pb + 1);
        pg8::Gemm g{HB, W_ROUTER + (size_t)layer * 256 * 2048, T, 256, 2048}; pg8::StaticOrder S; S.init(T, 256, G, (int)blockIdx.x);
        pg8::EpiRouter E{RL};
        pg8::gemm_phase<pg8::EpiRouter, pg8::StaticOrder, true, true>(lds + RING_OFF, g, S, E);
        PE(pb + 1);
    }
    SEAM(pb + 1);
    if (IN(pb + 2)) { PB(pb + 2); moe_route(lds + RING_OFF, RL, SSP, args.in[18] + layer * 4, args.in[20] + layer * 32, gcnt, EP0, EP1, TW0, TW1, RSTD); PE(pb + 2); }
    SEAM(pb + 2);
    if (IN(pb + 3)) { PB(pb + 3); { moe_build_table(lds, gcnt); moe_slots(lds, gcnt, EP0, EP1, RSTD, SL0, SL1, TL, RS); } PE(pb + 3); }
    SEAM(pb + 3);
    if (IN(pb + 4)) { PB(pb + 4);
        moe_build_table(lds, gcnt);
        const int rows = __builtin_amdgcn_readfirstlane(((const LAS int*)(lds + MOE_OFF_OFF))[32]);
        pg8::Gemm g{HB, W_GU, rows, 1024, 2048, TL};
        pg8::GroupedOrder S{(const LAS unsigned char*)(lds + MOE_TEXP_OFF), rows >> 8, 4, G, (int)blockIdx.x};
        pg8::EpiSwiGLU E{(bf16*)(ws + WS_ACT), RS};
        pg8::gemm_phase<pg8::EpiSwiGLU, pg8::GroupedOrder, true, true, true>(lds + RING_OFF, g, S, E);
        PE(pb + 4);
    }
    SEAM(pb + 4);
    if (IN(pb + 5)) { PB(pb + 5);
        moe_build_table(lds, gcnt);
        const int rows = __builtin_amdgcn_readfirstlane(((const LAS int*)(lds + MOE_OFF_OFF))[32]);
        pg8::Gemm g{(const bf16*)(ws + WS_ACT), W_DN, rows, 2048, 512};
        pg8::GroupedOrder S{(const LAS unsigned char*)(lds + MOE_TEXP_OFF), rows >> 8, 8, G, (int)blockIdx.x};
        pg8::EpiBf16 E{(bf16*)(ws + WS_Y), 2048};
        pg8::gemm_phase<pg8::EpiBf16, pg8::GroupedOrder, true, true, false, (MK_EARLY_EPI != 0)>(lds + RING_OFF, g, S, E);
        PE(pb + 5);
    }
    SEAM(pb + 5);
    if (IN(pb + 6)) { PB(pb + 6);
        moe_combine<true>(HB, (const bf16*)(ws + WS_Y), SL0, SL1, TW0, TW1, out, nullptr, nullptr, gw, NGW, lane);
        PE(pb + 6);
    }
    if (layer == 0) SEAM(pb + 6);
    }
#undef IN
#undef SEAM
}

extern "C" void kernel_launch(void* const* d_in, const int* in_sizes, int n_in, void* d_out, int out_size, void* d_ws, size_t ws_size, hipStream_t stream) {
    static int grid = 0;
    if (grid == 0) {
        if (n_in != 24 || in_sizes[0] != T * D || out_size != T * D || ws_size < WS_END) { fprintf(stderr, "kernel_launch: unexpected shapes / workspace (n_in %d, in0 %d, out %d, ws %zu < %zu)\n", n_in, n_in > 0 ? in_sizes[0] : -1, out_size, ws_size, (size_t)WS_END); grid = -1; return; }
        int dev = 0, cus = 0, per_cu = 0;
        if (hipGetDevice(&dev) != hipSuccess || hipDeviceGetAttribute(&cus, hipDeviceAttributeMultiprocessorCount, dev) != hipSuccess) { grid = -1; return; }
        if (hipFuncSetAttribute((const void*)fwd, hipFuncAttributeMaxDynamicSharedMemorySize, LDS_BYTES) != hipSuccess) { fprintf(stderr, "kernel_launch: hipFuncSetAttribute failed\n"); grid = -1; return; }
        if (hipOccupancyMaxActiveBlocksPerMultiprocessor(&per_cu, (const void*)fwd, NWAVES * 64, LDS_BYTES) != hipSuccess || per_cu < 1) { fprintf(stderr, "kernel_launch: occupancy query says %d\n", per_cu); }
        (void)hipGetLastError();
        grid = cus;
    }
    if (grid < 0) return;
    if (hipMemsetAsync((char*)d_ws + WS_CTL, 0, CTL_ZERO_BYTES, stream) != hipSuccess) return;
    Args a{};
    for (int i = 0; i < 24; ++i) a.in[i] = (const float*)d_in[i];
    a.out = (float*)d_out; a.ws = (unsigned char*)d_ws;
#if MK_PER_PHASE
    for (int p = 0; p < MK_LAST_PHASE; ++p) { a.ph_lo = p; a.ph_hi = p + 1; hipLaunchKernelGGL(fwd, dim3(grid), dim3(NWAVES * 64), LDS_BYTES, stream, a); }
#else
    a.ph_lo = 0; a.ph_hi = MK_LAST_PHASE;
    hipLaunchKernelGGL(fwd, dim3(grid), dim3(NWAVES * 64), LDS_BYTES, stream, a);
#endif
    const hipError_t le = hipPeekAtLastError();
    if (le != hipSuccess) fprintf(stderr, "kernel_launch: launch failed: %s\n", hipGetErrorName(le));
}
```

```cpp
#include <hip/hip_runtime.h>
#include <cstdio>
#include <cstdint>

#ifndef MK_PER_PHASE
#define MK_PER_PHASE 0
#endif
#ifndef MK_LAST_PHASE
#define MK_LAST_PHASE 23
#endif

#ifndef MK_PHASE_MASK
#define MK_PHASE_MASK 0x7fffff
#endif

#ifndef MK_DELAY_MASK
#define MK_DELAY_MASK 0
#endif

#ifndef MK_STAG1
#define MK_STAG1 0
#endif

#ifndef MK_EPI2
#define MK_EPI2 0
#endif

#ifndef MK_EARLY_EPI
#define MK_EARLY_EPI 1
#endif

namespace pg8 {
#define PG8_LAS __attribute__((address_space(3)))
typedef unsigned short bf16_t;
typedef short bf16x8 __attribute__((ext_vector_type(8)));
typedef float f32x4 __attribute__((ext_vector_type(4)));
typedef unsigned u32x4 __attribute__((ext_vector_type(4)));
constexpr int BM = 256, BK = 64, HALF = 128, HTB = HALF * BK * 2  , STAGE_BYTES = 8 * HTB, NXCD = 8, WGM = 8;

__host__ __device__ __forceinline__ int lds_byte(int r, int c) { const int st = (r >> 4) * 2 + (c >> 5), rr = r & 15, cc = c & 31, ob = rr * 64 + cc * 2; return st * 1024 + (ob ^ (((ob >> 9) & 1) << 5)); }
__host__ __device__ __forceinline__ void stage_rc(int b, int& R, int& C) { const int st = b / 1024, sb = b % 1024, swz = sb ^ (((sb >> 9) & 1) << 5); R = (st >> 1) * 16 + swz / 64; C = (st & 1) * 32 + (swz % 64) / 2; }
__host__ __device__ __forceinline__ int perm32(int rho) { const int n = rho >> 4, i = rho & 15; return 8 * (i >> 2) + 4 * n + (i & 3); }

struct Unit { int pm, pn, pc; };
struct Gemm { const bf16_t* A; const bf16_t* Bt; int M, N, K; const unsigned* rowidx; };


struct StaticOrder {
    int nM, nN, nwg, G, c;
    __host__ __device__ void init(int M, int N, int G_, int c_) { nM = M / BM; nN = N / BM; nwg = nM * nN; G = G_; c = c_; }
    __host__ __device__ bool next(int i, Unit& u) const {
        const long L = (long)i * G + c; if (L >= nwg) return false;
        int wgid = (int)L; { const int q = nwg / NXCD, r = nwg % NXCD, xcd = wgid % NXCD, off = wgid / NXCD; wgid = (xcd < r ? xcd * (q + 1) : r * (q + 1) + (xcd - r) * q) + off; }
        const int nig = WGM * nN, gid = wgid / nig, fm = gid * WGM, gsz = (nM - fm) < WGM ? (nM - fm) : WGM;
        u.pm = fm + ((wgid % nig) % gsz); u.pn = (wgid % nig) / gsz; u.pc = u.pn; return true;
    }
    __device__ __forceinline__ void a_ready(const Unit&) const {}
    __device__ __forceinline__ void done(const Unit&) const {}
};
struct GroupedOrder {
    const PG8_LAS unsigned char* texp; int MT, npn, G, c;
    __device__ __forceinline__ bool next(int i, Unit& u) const {
        const long L = (long)i * G + c; if (L >= (long)MT * npn) return false;
        const int pm = (int)(L / npn), pc = (int)(L % npn);
        const int e = __builtin_amdgcn_readfirstlane((int)texp[pm]);
        u.pm = pm; u.pn = e * npn + pc; u.pc = pc; return true;
    }
    __device__ __forceinline__ void a_ready(const Unit&) const {}
    __device__ __forceinline__ void done(const Unit&) const {}
};

__device__ __forceinline__ unsigned cvt_pk_bf16(float lo, float hi) { unsigned r; asm volatile("v_cvt_pk_bf16_f32 %0, %1, %2" : "=v"(r) : "v"(lo), "v"(hi)); return r; }

struct EpiBf16 {
    static constexpr bool PERM = true, AFTER_DRAIN = false;
    __device__ __forceinline__ void operator()(const f32x4 (&acc)[2][2][4][2], const Unit& u, int wr, int wc, int fr, int fq) const { part<0, 2>(acc, u, wr, wc, fr, fq); }
    bf16_t* O; int ldc;
    template <int AI0, int AI1> __device__ __forceinline__ void part(const f32x4 (&acc)[2][2][4][2], const Unit& u, int wr, int wc, int fr, int fq) const {
        const int row0 = u.pm * BM + wr * 64 + fr, col0 = u.pc * BM + wc * 32 + 8 * fq;
#pragma unroll
        for (int ai = AI0; ai < AI1; ++ai)
#pragma unroll
            for (int m = 0; m < 4; ++m) { bf16_t* rowp = O + (size_t)(row0 + ai * HALF + m * 16) * ldc + col0;
#pragma unroll
                for (int bj = 0; bj < 2; ++bj) { const f32x4 v0 = acc[ai][bj][m][0], v1 = acc[ai][bj][m][1];
                    u32x4 w; w.x = cvt_pk_bf16(v0[0], v0[1]); w.y = cvt_pk_bf16(v0[2], v0[3]); w.z = cvt_pk_bf16(v1[0], v1[1]); w.w = cvt_pk_bf16(v1[2], v1[3]);
                    *(u32x4*)(rowp + bj * HALF) = w; } }
    }
};
struct EpiKVQ {
    static constexpr bool PERM = true, AFTER_DRAIN = false;
    __device__ __forceinline__ void operator()(const f32x4 (&acc)[2][2][4][2], const Unit& u, int wr, int wc, int fr, int fq) const { part<0, 2>(acc, u, wr, wc, fr, fq); }
    bf16_t* O; bf16_t* VT;
    template <int AI0, int AI1> __device__ __forceinline__ void part(const f32x4 (&acc)[2][2][4][2], const Unit& u, int wr, int wc, int fr, int fq) const {
        const int row0 = u.pm * BM + wr * 64 + fr;
        if (u.pc == 1) {
#pragma unroll
            for (int ai = AI0; ai < AI1; ++ai)
#pragma unroll
                for (int m = 0; m < 4; ++m) { const int t = row0 + ai * HALF + m * 16, b = t >> 14, s = t & 16383;
#pragma unroll
                    for (int bj = 0; bj < 2; ++bj)
#pragma unroll
                        for (int n = 0; n < 2; ++n) { const int cv = bj * HALF + wc * 32 + 8 * fq + 4 * n; bf16_t* p = VT + ((size_t)(b * 4 + (cv >> 6)) * 64 + (cv & 63)) * 16384 + s;
                            const unsigned w0 = cvt_pk_bf16(acc[ai][bj][m][n][0], acc[ai][bj][m][n][1]), w1 = cvt_pk_bf16(acc[ai][bj][m][n][2], acc[ai][bj][m][n][3]);
                            p[0] = (bf16_t)(w0 & 0xffffu); p[16384] = (bf16_t)(w0 >> 16); p[2 * 16384] = (bf16_t)(w1 & 0xffffu); p[3 * 16384] = (bf16_t)(w1 >> 16); } }
            return; }
        const int col0 = u.pc * BM + wc * 32 + 8 * fq;
#pragma unroll
        for (int ai = AI0; ai < AI1; ++ai)
#pragma unroll
            for (int m = 0; m < 4; ++m) { bf16_t* rowp = O + (size_t)(row0 + ai * HALF + m * 16) * 2560 + col0;
#pragma unroll
                for (int bj = 0; bj < 2; ++bj) { const f32x4 v0 = acc[ai][bj][m][0], v1 = acc[ai][bj][m][1];
                    u32x4 w; w.x = cvt_pk_bf16(v0[0], v0[1]); w.y = cvt_pk_bf16(v0[2], v0[3]); w.z = cvt_pk_bf16(v1[0], v1[1]); w.w = cvt_pk_bf16(v1[2], v1[3]);
                    *(u32x4*)(rowp + bj * HALF) = w; } }
    }
};
struct EpiGlaProj {
    static constexpr bool PERM = true, AFTER_DRAIN = false;
    __device__ __forceinline__ void operator()(const f32x4 (&acc)[2][2][4][2], const Unit& u, int wr, int wc, int fr, int fq) const { part<0, 2>(acc, u, wr, wc, fr, fq); }
    bf16_t *QK, *V, *R, *GL;
    template <int AI0, int AI1> __device__ __forceinline__ void part(const f32x4 (&acc)[2][2][4][2], const Unit& u, int wr, int wc, int fr, int fq) const {
        bf16_t* base; int ldc, ct;
        if (u.pc < 8) { base = QK; ldc = 2048; ct = u.pc; } else if (u.pc < 16) { base = V; ldc = 2048; ct = u.pc - 8; } else if (u.pc < 24) { base = R; ldc = 2048; ct = u.pc - 16; } else { base = GL; ldc = 256; ct = 0; }
        const int row0 = u.pm * BM + wr * 64 + fr, col0 = ct * BM + wc * 32 + 8 * fq;
#pragma unroll
        for (int ai = AI0; ai < AI1; ++ai)
#pragma unroll
            for (int m = 0; m < 4; ++m) { bf16_t* rowp = base + (size_t)(row0 + ai * HALF + m * 16) * ldc + col0;
#pragma unroll
                for (int bj = 0; bj < 2; ++bj) { const f32x4 v0 = acc[ai][bj][m][0], v1 = acc[ai][bj][m][1];
                    u32x4 w; w.x = cvt_pk_bf16(v0[0], v0[1]); w.y = cvt_pk_bf16(v0[2], v0[3]); w.z = cvt_pk_bf16(v1[0], v1[1]); w.w = cvt_pk_bf16(v1[2], v1[3]);
                    *(u32x4*)(rowp + bj * HALF) = w; } }
    }
};
template <bool RES_BF16> struct EpiResBf16 {
    static constexpr bool PERM = true, AFTER_DRAIN = false;
    __device__ __forceinline__ void operator()(const f32x4 (&acc)[2][2][4][2], const Unit& u, int wr, int wc, int fr, int fq) const { part<0, 2>(acc, u, wr, wc, fr, fq); }
    const void* RES; int ldc; bf16_t* HB; float* SSP;
    template <int AI0, int AI1> __device__ __forceinline__ void part(const f32x4 (&acc)[2][2][4][2], const Unit& u, int wr, int wc, int fr, int fq) const {
        const int row0 = u.pm * BM + wr * 64 + fr, col0 = u.pc * BM + wc * 32 + 8 * fq;
#pragma unroll
        for (int ai = AI0; ai < AI1; ++ai)
#pragma unroll
            for (int m = 0; m < 4; ++m) { const int row = row0 + ai * HALF + m * 16; const size_t off = (size_t)row * ldc + col0;
                f32x4 rv[2][2];
#pragma unroll
                for (int bj = 0; bj < 2; ++bj) {
                    if constexpr (RES_BF16) { const u32x4 w = *(const u32x4*)((const bf16_t*)RES + off + bj * HALF);
                        rv[bj][0] = (f32x4){__builtin_bit_cast(float, w.x << 16), __builtin_bit_cast(float, w.x & 0xffff0000u), __builtin_bit_cast(float, w.y << 16), __builtin_bit_cast(float, w.y & 0xffff0000u)};
                        rv[bj][1] = (f32x4){__builtin_bit_cast(float, w.z << 16), __builtin_bit_cast(float, w.z & 0xffff0000u), __builtin_bit_cast(float, w.w << 16), __builtin_bit_cast(float, w.w & 0xffff0000u)}; }
                    else { rv[bj][0] = *(const f32x4*)((const float*)RES + off + bj * HALF); rv[bj][1] = *(const f32x4*)((const float*)RES + off + bj * HALF + 4); } }
                float ss = 0.f;
#pragma unroll
                for (int bj = 0; bj < 2; ++bj) { const f32x4 v0 = acc[ai][bj][m][0] + rv[bj][0], v1 = acc[ai][bj][m][1] + rv[bj][1];
                    u32x4 w; w.x = cvt_pk_bf16(v0[0], v0[1]); w.y = cvt_pk_bf16(v0[2], v0[3]); w.z = cvt_pk_bf16(v1[0], v1[1]); w.w = cvt_pk_bf16(v1[2], v1[3]);
                    *(u32x4*)(HB + off + bj * HALF) = w;
                    ss += (v0[0] * v0[0] + v0[1] * v0[1]) + (v0[2] * v0[2] + v0[3] * v0[3]) + (v1[0] * v1[0] + v1[1] * v1[1]) + (v1[2] * v1[2] + v1[3] * v1[3]); }
                ss += __shfl_xor(ss, 16); ss += __shfl_xor(ss, 32);
                if (fq == 0) SSP[(size_t)row * 32 + u.pc * 4 + wc] = ss; }
    }
};
struct EpiRouter {
    static constexpr bool PERM = false, AFTER_DRAIN = false;
    __device__ __forceinline__ void operator()(const f32x4 (&acc)[2][2][4][2], const Unit& u, int wr, int wc, int fr, int fq) const { part<0, 2>(acc, u, wr, wc, fr, fq); }
    float* RL;
    template <int AI0, int AI1> __device__ __forceinline__ void part(const f32x4 (&acc)[2][2][4][2], const Unit& u, int wr, int wc, int fr, int fq) const {
        if (wc >= 2) return;
        const int row0 = u.pm * BM + wr * 64 + fr, col0 = wc * 32 + 4 * fq;
#pragma unroll
        for (int ai = AI0; ai < AI1; ++ai)
#pragma unroll
            for (int m = 0; m < 4; ++m) { float* rowp = RL + (size_t)(row0 + ai * HALF + m * 16) * 64 + col0;
#pragma unroll
                for (int n = 0; n < 2; ++n) *(f32x4*)(rowp + n * 16) = acc[ai][0][m][n]; }
    }
};
__device__ __forceinline__ float silu_f(float x) { return x * __builtin_amdgcn_rcpf(1.0f + __expf(-x)); }
struct EpiSwiGLU {
    static constexpr bool PERM = true, AFTER_DRAIN = false;
    __device__ __forceinline__ void operator()(const f32x4 (&acc)[2][2][4][2], const Unit& u, int wr, int wc, int fr, int fq) const { part<0, 2>(acc, u, wr, wc, fr, fq); }
    bf16_t* ACT; const float* RS;
    template <int AI0, int AI1> __device__ __forceinline__ void part(const f32x4 (&acc)[2][2][4][2], const Unit& u, int wr, int wc, int fr, int fq) const {
        const int row0 = u.pm * BM + wr * 64 + fr, col0 = u.pc * HALF + wc * 32 + 8 * fq;
#pragma unroll
        for (int ai = AI0; ai < AI1; ++ai)
#pragma unroll
            for (int m = 0; m < 4; ++m) { const int row = row0 + ai * HALF + m * 16; bf16_t* rowp = ACT + (size_t)row * 512 + col0; const float rs = RS[row];
                const f32x4 g0 = acc[ai][0][m][0] * rs, g1 = acc[ai][0][m][1] * rs, u0 = acc[ai][1][m][0] * rs, u1 = acc[ai][1][m][1] * rs;
                u32x4 w;
                w.x = cvt_pk_bf16(silu_f(g0[0]) * u0[0], silu_f(g0[1]) * u0[1]); w.y = cvt_pk_bf16(silu_f(g0[2]) * u0[2], silu_f(g0[3]) * u0[3]);
                w.z = cvt_pk_bf16(silu_f(g1[0]) * u1[0], silu_f(g1[1]) * u1[1]); w.w = cvt_pk_bf16(silu_f(g1[2]) * u1[2], silu_f(g1[3]) * u1[3]);
                *(u32x4*)rowp = w; }
    }
};

template <class Epi, class Sched, bool ALIGN_EPI = false, bool SP2 = false, bool GATHER = false, bool EARLY_EPI = (MK_EARLY_EPI != 0)>
__device__ __forceinline__ void gemm_phase(PG8_LAS unsigned char* lds, const Gemm g, const Sched& S, const Epi& E) {
    const int tid = threadIdx.x, wid = __builtin_amdgcn_readfirstlane(tid >> 6), lane = tid & 63, wr = wid >> 2, wc = wid & 3, fr = lane & 15, fq = lane >> 4;
    const int K = g.K, nt = K / BK;
    unsigned voffA[2], voffB[2];
#pragma unroll
    for (int i = 0; i < 2; ++i) { int R, C; stage_rc(tid * 16 + i * 8192, R, C); const int Rb = Epi::PERM ? ((R & ~31) + perm32(R & 31)) : R;
        voffA[i] = (unsigned)(R * K + C) * 2u; voffB[i] = (unsigned)(Rb * K + C) * 2u; }
    unsigned vA[2][2] = {{0u, 0u}, {0u, 0u}}, vAn[2][2] = {{0u, 0u}, {0u, 0u}}; int rA[2] = {0, 0}; unsigned cbA[2] = {0u, 0u};
    if constexpr (GATHER) {
#pragma unroll
        for (int i = 0; i < 2; ++i) { int R, C; stage_rc(tid * 16 + i * 8192, R, C); rA[i] = R; cbA[i] = (unsigned)C * 2u; } }
#define PG8_GIDX(dst, pmv) do { _Pragma("unroll") for (int _h = 0; _h < 2; ++_h) _Pragma("unroll") for (int _i = 0; _i < 2; ++_i) \
        dst[_h][_i] = g.rowidx[(size_t)(pmv) * BM + _h * HALF + rA[_i]] * (unsigned)(K * 2) + cbA[_i]; } while (0)
    const size_t kstep = (size_t)(BK * 2);
    const size_t hstep = (size_t)HALF * K * 2;
    const size_t tstep = 2 * hstep;
    const unsigned ldsw = (unsigned)wid * 1024u;
    const int aoff = lds_byte(wr * 64 + fr, fq * 8), boff = lds_byte(wc * 32 + fr, fq * 8);
#define PG8_SA(b, h) (((b) * 2 + (h)) * HTB)
#define PG8_SB(b, h) ((4 + (b) * 2 + (h)) * HTB)
#define PG8_STAGE(bufoff, gbase, voff) do { _Pragma("unroll") for (int _i = 0; _i < 2; ++_i) \
        __builtin_amdgcn_global_load_lds((const unsigned*)((const char*)(gbase) + (voff)[_i]), (PG8_LAS unsigned*)(lds + (bufoff) + ldsw + _i * 8192), 16, 0, 0); } while (0)
#define PG8_STAGE_A(bufoff, nx, kb, h) do { if constexpr (GATHER) { const char* _b = (const char*)g.A + (kb); \
        _Pragma("unroll") for (int _i = 0; _i < 2; ++_i) { const unsigned _v = (nx) ? vAn[h][_i] : vA[h][_i]; \
            __builtin_amdgcn_global_load_lds((const unsigned*)(_b + _v), (PG8_LAS unsigned*)(lds + (bufoff) + ldsw + _i * 8192), 16, 0, 0); } } \
    else { const char* _b = ((nx) ? nA : cA) + (kb) + (size_t)(h) * hstep; PG8_STAGE(bufoff, _b, voffA); } } while (0)
#define PG8_LDA(dst, b, h) do { _Pragma("unroll") for (int m = 0; m < 4; ++m) _Pragma("unroll") for (int k = 0; k < 2; ++k) dst[m][k] = *(const PG8_LAS bf16x8*)(lds + PG8_SA(b, h) + aoff + m * 2048 + k * 1024); } while (0)
#define PG8_LDB(dst, b, h) do { _Pragma("unroll") for (int n = 0; n < 2; ++n) _Pragma("unroll") for (int k = 0; k < 2; ++k) dst[n][k] = *(const PG8_LAS bf16x8*)(lds + PG8_SB(b, h) + boff + n * 2048 + k * 1024); } while (0)
#define PG8_MMA(ai, bj, At, Bt) do { __builtin_amdgcn_s_setprio(1); _Pragma("unroll") for (int m = 0; m < 4; ++m) _Pragma("unroll") for (int n = 0; n < 2; ++n) _Pragma("unroll") for (int k = 0; k < 2; ++k) \
        acc[ai][bj][m][n] = __builtin_amdgcn_mfma_f32_16x16x32_bf16(Bt[n][k], At[m][k], acc[ai][bj][m][n], 0, 0, 0); __builtin_amdgcn_s_setprio(0); } while (0)
#define PG8_WAIT_V(n) asm volatile("s_waitcnt vmcnt(" #n ")" ::: "memory")
#define PG8_WAIT_L(n) asm volatile("s_waitcnt lgkmcnt(" #n ")" ::: "memory")
#define PG8_BAR __builtin_amdgcn_s_barrier()
#define PG8_SCHED __builtin_amdgcn_sched_barrier(0)
    Unit cur, nxt; int ui = 0;
    if (!S.next(0, cur)) return;
    f32x4 acc[2][2][4][2];
#pragma unroll
    for (int a = 0; a < 2; ++a)
#pragma unroll
        for (int b = 0; b < 2; ++b)
#pragma unroll
            for (int m = 0; m < 4; ++m)
#pragma unroll
                for (int n = 0; n < 2; ++n) acc[a][b][m][n] = (f32x4){0.f, 0.f, 0.f, 0.f};
    bf16x8 At[4][2], B0[2][2], B1[2][2];
    const char* cA = (const char*)g.A + (size_t)cur.pm * tstep; const char* cB = (const char*)g.Bt + (size_t)cur.pn * tstep;
    const char* nA = cA; const char* nB = cB;
    if constexpr (GATHER) { PG8_GIDX(vA, cur.pm); }
    S.a_ready(cur);
    if constexpr (SP2) {
        PG8_STAGE(PG8_SB(0, 0), cB, voffB); PG8_STAGE(PG8_SB(0, 1), cB + hstep, voffB); PG8_STAGE_A(PG8_SA(0, 0), false, 0, 0); PG8_STAGE_A(PG8_SA(0, 1), false, 0, 1);
        if (wr == 1) PG8_BAR;
        PG8_WAIT_V(2); PG8_BAR;
        PG8_STAGE(PG8_SB(1, 0), cB + kstep, voffB); PG8_STAGE_A(PG8_SA(1, 0), false, kstep, 0); PG8_STAGE(PG8_SB(1, 1), cB + hstep + kstep, voffB);
        PG8_WAIT_V(6); PG8_BAR;
    } else {
        PG8_STAGE(PG8_SB(0, 0), cB, voffB); PG8_STAGE(PG8_SA(0, 0), cA, voffA); PG8_STAGE(PG8_SB(0, 1), cB + hstep, voffB); PG8_STAGE(PG8_SA(0, 1), cA + hstep, voffA);
        if (wr == 1) PG8_BAR;
        PG8_WAIT_V(4); PG8_BAR;
        PG8_STAGE(PG8_SB(1, 0), cB + kstep, voffB); PG8_STAGE(PG8_SA(1, 0), cA + kstep, voffA); PG8_STAGE(PG8_SB(1, 1), cB + hstep + kstep, voffB);
        PG8_WAIT_V(6); PG8_BAR;
    }
    for (;;) {
        const bool has_next = S.next(ui + 1, nxt);
        nA = has_next ? (const char*)g.A + (size_t)nxt.pm * tstep : cA; nB = has_next ? (const char*)g.Bt + (size_t)nxt.pn * tstep : cB;
        if constexpr (GATHER) { if (has_next) { PG8_GIDX(vAn, nxt.pm); } else {
#pragma unroll
            for (int _h = 0; _h < 2; ++_h) { vAn[_h][0] = vA[_h][0]; vAn[_h][1] = vA[_h][1]; } } }
        for (int t = 0; t < nt; t += 2) {
            const bool last = (t == nt - 2);
            const char* a1 = cA + (size_t)(t + 1) * kstep;
            const char* a2 = last ? nA : cA + (size_t)(t + 2) * kstep; const char* b2 = last ? nB : cB + (size_t)(t + 2) * kstep;
            const char* a3 = a2 + kstep; const char* b3 = b2 + kstep;
            const size_t ka1 = (size_t)(t + 1) * kstep, ka2 = last ? (size_t)0 : (size_t)(t + 2) * kstep, ka3 = ka2 + kstep; (void)a1; (void)a3;
            if (last && has_next) S.a_ready(nxt);
            if constexpr (SP2) {
            PG8_LDB(B0, 0, 0); PG8_LDB(B1, 0, 1); PG8_SCHED; PG8_LDA(At, 0, 0); PG8_STAGE_A(PG8_SA(1, 1), false, ka1, 1);
            PG8_WAIT_V(8); PG8_WAIT_L(0); PG8_BAR; PG8_MMA(0, 0, At, B0); PG8_MMA(0, 1, At, B1); PG8_BAR; PG8_SCHED;
            PG8_LDA(At, 0, 1); PG8_STAGE(PG8_SB(0, 0), b2, voffB); PG8_STAGE(PG8_SB(0, 1), b2 + hstep, voffB); PG8_STAGE_A(PG8_SA(0, 0), last, ka2, 0);
            PG8_WAIT_V(8); PG8_WAIT_L(0); PG8_BAR; PG8_MMA(1, 0, At, B0); PG8_MMA(1, 1, At, B1); PG8_BAR; PG8_SCHED;
            PG8_LDB(B0, 1, 0); PG8_LDB(B1, 1, 1); PG8_SCHED; PG8_LDA(At, 1, 0); PG8_STAGE_A(PG8_SA(0, 1), last, ka2, 1);
            PG8_WAIT_V(8); PG8_WAIT_L(0); PG8_BAR; PG8_MMA(0, 0, At, B0); PG8_MMA(0, 1, At, B1); PG8_BAR; PG8_SCHED;
            PG8_LDA(At, 1, 1); PG8_STAGE(PG8_SB(1, 0), b3, voffB); PG8_STAGE(PG8_SB(1, 1), b3 + hstep, voffB); PG8_STAGE_A(PG8_SA(1, 0), last, ka3, 0);
            PG8_WAIT_V(8); PG8_WAIT_L(0); PG8_BAR;
            if constexpr (EARLY_EPI) { if (last) { int fr2 = fr, fq2 = fq; asm volatile("" : "+v"(fr2), "+v"(fq2));
                E.template part<0, 1>(acc, cur, wr, wc, fr2, fq2); PG8_SCHED; } }
            PG8_MMA(1, 0, At, B0); PG8_MMA(1, 1, At, B1); PG8_BAR; PG8_SCHED;
            } else {
            PG8_LDB(B0, 0, 0); PG8_SCHED; PG8_LDA(At, 0, 0); PG8_STAGE(PG8_SA(1, 1), a1 + hstep, voffA);
            PG8_WAIT_L(8); PG8_BAR; PG8_WAIT_L(0); PG8_MMA(0, 0, At, B0); PG8_BAR; PG8_SCHED;
            PG8_LDB(B1, 0, 1); PG8_STAGE(PG8_SB(0, 0), b2, voffB);
            PG8_BAR; PG8_WAIT_L(0); PG8_MMA(0, 1, At, B1); PG8_BAR;
            PG8_LDA(At, 0, 1); PG8_STAGE(PG8_SA(0, 0), a2, voffA);
            PG8_BAR; PG8_WAIT_L(0); PG8_MMA(1, 0, At, B0); PG8_BAR; PG8_SCHED;
            PG8_STAGE(PG8_SB(0, 1), b2 + hstep, voffB);
            PG8_WAIT_V(6); PG8_BAR; PG8_MMA(1, 1, At, B1); PG8_BAR;
            PG8_LDB(B0, 1, 0); PG8_SCHED; PG8_LDA(At, 1, 0); PG8_STAGE(PG8_SA(0, 1), a2 + hstep, voffA);
            PG8_WAIT_L(8); PG8_BAR; PG8_WAIT_L(0); PG8_MMA(0, 0, At, B0); PG8_BAR; PG8_SCHED;
            PG8_LDB(B1, 1, 1); PG8_STAGE(PG8_SB(1, 0), b3, voffB);
            PG8_BAR; PG8_WAIT_L(0); PG8_MMA(0, 1, At, B1); PG8_BAR;
            PG8_LDA(At, 1, 1); PG8_STAGE(PG8_SA(1, 0), a3, voffA);
            PG8_BAR; PG8_WAIT_L(0); PG8_MMA(1, 0, At, B0); PG8_BAR; PG8_SCHED;
            PG8_STAGE(PG8_SB(1, 1), b3 + hstep, voffB);
            PG8_WAIT_V(6); PG8_BAR; PG8_MMA(1, 1, At, B1); PG8_BAR;
            }
        }
        if constexpr (ALIGN_EPI) { if (wr == 0) PG8_BAR; }
        if constexpr (!Epi::AFTER_DRAIN) { if constexpr (EARLY_EPI) E.template part<1, 2>(acc, cur, wr, wc, fr, fq); else E(acc, cur, wr, wc, fr, fq);
#if MK_EPI2
            asm volatile("" ::: "memory"); E(acc, cur, wr, wc, fr, fq);
#endif
            S.done(cur); }
        if (!has_next) break;
#pragma unroll
        for (int a = 0; a < 2; ++a)
#pragma unroll
            for (int b = 0; b < 2; ++b)
#pragma unroll
                for (int m = 0; m < 4; ++m)
#pragma unroll
                    for (int n = 0; n < 2; ++n) acc[a][b][m][n] = (f32x4){0.f, 0.f, 0.f, 0.f};
        cur = nxt; cA = nA; cB = nB; ++ui;
        if constexpr (GATHER) {
#pragma unroll
            for (int _h = 0; _h < 2; ++_h) { vA[_h][0] = vAn[_h][0]; vA[_h][1] = vAn[_h][1]; } }
        if constexpr (ALIGN_EPI) { if (wr == 1) PG8_BAR; }
    }
    PG8_WAIT_V(0);
    if constexpr (!ALIGN_EPI) { if (wr == 0) PG8_BAR; }
    PG8_BAR;
    if constexpr (Epi::AFTER_DRAIN) { E.fused(acc, cur, wr, wc, fr, fq, lds, wid, lane); S.done(cur); }
#undef PG8_SA
#undef PG8_STAGE_A
#undef PG8_GIDX
#undef PG8_SB
#undef PG8_STAGE
#undef PG8_LDA
#undef PG8_LDB
#undef PG8_MMA
#undef PG8_WAIT_V
#undef PG8_WAIT_L
#undef PG8_BAR
#undef PG8_SCHED
}
}

constexpr int NWAVES = 8;
constexpr int T = 32768, D = 2048, SEQ = 16384;
constexpr float RMS_EPS = 1e-6f;
constexpr int GLA_H = 4, GLA_DK = 256, GLA_DV = 512, GLA_C = 64, GLA_NCH = SEQ / GLA_C  , GLA_PROJ_N = 6160, GLA_PROJ_NP = 6400;
constexpr int NITEM_GLA = 2 * GLA_H * GLA_NCH;
constexpr int SWA_HQ = 32, SWA_HKV = 4, SWA_HD = 64, SWA_W = 128, KVQ_N = 2560;
constexpr int NE = 32, FF = 512, MOE_MAXROWS = 2 * T + NE * 256;

constexpr size_t MiB = 1u << 20;
constexpr size_t WS_CTL = 0, CTL_ZERO_BYTES = 1 * MiB;
constexpr size_t WS_W_GLA_IN = 1 * MiB;
constexpr size_t WS_W_GLA_OUT = 26 * MiB;
constexpr size_t WS_W_KVQ = 34 * MiB;
constexpr size_t WS_W_SWA_OUT = 44 * MiB;
constexpr size_t WS_W_ROUTER = 52 * MiB;
constexpr size_t WS_TOK = 54 * MiB;
constexpr size_t WS_RL = 56 * MiB;
constexpr size_t WS_W_GU = 64 * MiB;
constexpr size_t WS_W_DN = 192 * MiB;
constexpr size_t WS_HN = 256 * MiB;
constexpr size_t WS_BIG = 384 * MiB;
constexpr size_t WS_QK = WS_BIG;
constexpr size_t WS_V = WS_BIG + 128 * MiB;
constexpr size_t WS_R = WS_BIG + 256 * MiB;
constexpr size_t WS_GL = WS_BIG + 384 * MiB;
constexpr size_t WS_QEF = WS_BIG + 400 * MiB;
constexpr size_t WS_KLTF = WS_BIG + 464 * MiB;
constexpr size_t WS_ATTF = WS_BIG + 528 * MiB;
constexpr size_t WS_VTF = WS_BIG + 544 * MiB;
constexpr size_t WS_DEC = WS_BIG + 672 * MiB;
constexpr size_t WS_SEND = WS_V;
constexpr size_t WS_DTOT = WS_V + 32 * MiB;
constexpr size_t WS_GLA_END = WS_BIG + 674 * MiB;
constexpr size_t WS_SSP = WS_BIG;
constexpr size_t WS_TL = WS_BIG + 8 * MiB;
constexpr size_t WS_RS = WS_BIG + 9 * MiB;
constexpr size_t WS_HB = WS_BIG + 16 * MiB;
constexpr size_t WS_ACT = WS_BIG + 288 * MiB;
constexpr size_t WS_Y = WS_BIG + 360 * MiB;
constexpr size_t WS_KVQ = WS_BIG;
constexpr size_t WS_AO = WS_BIG + 160 * MiB;
constexpr size_t WS_VT = WS_BIG + 288 * MiB;
constexpr size_t WS_END = WS_GLA_END;
static_assert(WS_Y + (size_t)MOE_MAXROWS * 2048 * 2 <= WS_END && WS_ACT + (size_t)MOE_MAXROWS * 512 * 2 <= WS_Y, "MoE map");
constexpr int CW_BAR = 4096;
constexpr int CW_CNT = 16384;

constexpr int RING_OFF = 0, RING_BYTES = 149504;
constexpr int LDSCTL_OFF = RING_BYTES;
constexpr int MISC_OFF = LDSCTL_OFF + 64;
constexpr int MOE_OFF_OFF = LDSCTL_OFF + 256;
constexpr int MOE_TEXP_OFF = LDSCTL_OFF + 512;
constexpr int LDS_BYTES = RING_BYTES + 2048;

#define GAS __attribute__((address_space(1)))
#define LAS __attribute__((address_space(3)))
typedef unsigned short bf16;
typedef unsigned v4u __attribute__((ext_vector_type(4)));
typedef unsigned v2u __attribute__((ext_vector_type(2)));
typedef float f32x4 __attribute__((ext_vector_type(4)));
typedef short bf16x8 __attribute__((ext_vector_type(8)));
typedef GAS unsigned gu32;
#define RLX_AGENT __ATOMIC_RELAXED, __HIP_MEMORY_SCOPE_AGENT
#define LDS_WAIT() asm volatile("s_waitcnt lgkmcnt(0)" ::: "memory")
#define VM_WAIT() asm volatile("s_waitcnt vmcnt(0)" ::: "memory")
__device__ __forceinline__ unsigned f2bf(float f) { unsigned u = __builtin_bit_cast(unsigned, f); return (u + 0x7fffu + ((u >> 16) & 1u)) >> 16; }
__device__ __forceinline__ unsigned pk2(float lo, float hi) { return pg8::cvt_pk_bf16(lo, hi); }
__device__ __forceinline__ float bf_lo(unsigned w) { return __builtin_bit_cast(float, w << 16); }
__device__ __forceinline__ float bf_hi(unsigned w) { return __builtin_bit_cast(float, w & 0xffff0000u); }
__device__ __forceinline__ float bf2f(bf16 b) { return __builtin_bit_cast(float, ((unsigned)b) << 16); }
__device__ __forceinline__ float wave_sum(float v) {
#pragma unroll
    for (int o = 1; o < 64; o <<= 1) v += __shfl_xor(v, o);
    return v;
}

#define XB_TMO      128
#define XB_XCNT(j)  (256  + 64 * (j))
#define XB_XSUB(j)  (1280 + 64 * (j))
#define XB_XGEN(j)  (2304 + 64 * (j))
#define XB_TOP      3328
#define XB_TOPGEN   3392
#define XCD_BAR_WORDS 3456
#define XB_SPIN_CAP (1u << 18)

__device__ __forceinline__ unsigned xb_ld(unsigned* p)              { return __hip_atomic_load(p, __ATOMIC_RELAXED, __HIP_MEMORY_SCOPE_AGENT); }
__device__ __forceinline__ unsigned xb_add(unsigned* p, unsigned v) { return __hip_atomic_fetch_add(p, v, __ATOMIC_RELAXED, __HIP_MEMORY_SCOPE_AGENT); }
__device__ __forceinline__ unsigned xb_xcc_id() { return (unsigned)__builtin_amdgcn_s_getreg((3 << 11) | 20) & 0xFu; }
#define XB_SPIN(cond, bar) do { unsigned _sp = 0; while (cond) { __builtin_amdgcn_s_sleep(1); \
    if ((++_sp & 255u) == 0u) { if (xb_ld(&(bar)[XB_TMO])) break; if (_sp > XB_SPIN_CAP) { atomicAdd(&(bar)[XB_TMO], 1u); break; } } } } while (0)

struct XcdBarrier {
    unsigned* bar; unsigned x;
    volatile LAS unsigned* st;
};

__device__ __forceinline__ XcdBarrier xcd_barrier_post(unsigned* bar, volatile LAS unsigned* st) {
    XcdBarrier b; b.bar = bar; b.x = xb_xcc_id(); b.st = st;
    if (threadIdx.x == 0) (void)xb_add(&bar[XB_XCNT(b.x)], 1u);
    return b;
}
__device__ __forceinline__ void xcd_barrier_complete(unsigned* bar, unsigned x, unsigned& nloc, unsigned& nx) {
    const unsigned G = gridDim.x * gridDim.y * gridDim.z;
    unsigned sum, cnt, mine, sp = 0u;
    for (;;) {
        sum = 0u; cnt = 0u; mine = 0u;
#pragma unroll
        for (unsigned j = 0; j < 16; ++j) { const unsigned c = xb_ld(&bar[XB_XCNT(j)]); sum += c; cnt += (c > 0u) ? 1u : 0u; mine = (j == x) ? c : mine; }
        if (sum == G) break;
        __builtin_amdgcn_s_sleep(1);
        if ((++sp & 255u) == 0u) { if (xb_ld(&bar[XB_TMO])) break; if (sp > XB_SPIN_CAP) { atomicAdd(&bar[XB_TMO], 1u); break; } }
    }
    nloc = mine > 0u ? mine : 1u; nx = cnt > 0u ? cnt : 1u;
}

__device__ __forceinline__ void xcd_barrier(const XcdBarrier& b) {
    asm volatile("s_waitcnt vmcnt(0)" ::: "memory");
    __syncthreads();
    if (threadIdx.x == 0) {
        unsigned* bar = b.bar;
        __builtin_amdgcn_s_waitcnt(0);
        unsigned nloc = b.st[0], nx = b.st[1];
        if (nloc == 0u) { xcd_barrier_complete(bar, b.x, nloc, nx); b.st[0] = nloc; b.st[1] = nx; }
        const unsigned old = xb_add(&bar[XB_XSUB(b.x)], 1u);
        const unsigned gen = old / nloc;
        if (old + 1u == (gen + 1u) * nloc) {
            __builtin_amdgcn_fence(__ATOMIC_RELEASE, "agent");
            asm volatile("s_waitcnt vmcnt(0)" ::: "memory");
            const unsigned og = xb_add(&bar[XB_TOP], 1u);
            const unsigned tg = og / nx;
            if (og + 1u == (tg + 1u) * nx) xb_add(&bar[XB_TOPGEN], 1u);
            else XB_SPIN(xb_ld(&bar[XB_TOPGEN]) == tg, bar);
            __builtin_amdgcn_fence(__ATOMIC_ACQUIRE, "agent");
            xb_add(&bar[XB_XGEN(b.x)], 1u);
            asm volatile("s_waitcnt vmcnt(0)" ::: "memory");
        } else {
            XB_SPIN(xb_ld(&bar[XB_XGEN(b.x)]) == gen, bar);
            __builtin_amdgcn_fence(__ATOMIC_ACQUIRE, "agent");
            asm volatile("s_waitcnt vmcnt(0)" ::: "memory");
        }
    }
    __syncthreads();
}


__device__ __forceinline__ void cvt_item(const float* W, int N, const float* gain, bf16* WT, int K, int k0, int n0, size_t dst_row0, int lane) {
    const int q = lane >> 4, c = lane & 15;
    const bool ok = (n0 + 4 * c) < N;
    const GAS f32x4* src = (const GAS f32x4*)(W + (size_t)(k0 + 16 * q) * N + n0 + 4 * c);
    f32x4 v[16];
#pragma unroll
    for (int i = 0; i < 16; ++i) v[i] = ok ? src[(size_t)i * (N / 4)] : (f32x4){0.f, 0.f, 0.f, 0.f};
    if (gain) { const GAS f32x4* gp = (const GAS f32x4*)(gain + k0 + 16 * q);
#pragma unroll
        for (int i4 = 0; i4 < 4; ++i4) { const f32x4 g = gp[i4]; v[4 * i4 + 0] = v[4 * i4 + 0] * g.x; v[4 * i4 + 1] = v[4 * i4 + 1] * g.y; v[4 * i4 + 2] = v[4 * i4 + 2] * g.z; v[4 * i4 + 3] = v[4 * i4 + 3] * g.w; } }
    if (ok) {
#pragma unroll
        for (int e = 0; e < 4; ++e) { bf16* dst = WT + (dst_row0 + 4 * c + e) * (size_t)K + k0 + 16 * q;
            v4u o0, o1;
            o0.x = pk2(v[0][e], v[1][e]); o0.y = pk2(v[2][e], v[3][e]); o0.z = pk2(v[4][e], v[5][e]); o0.w = pk2(v[6][e], v[7][e]);
            o1.x = pk2(v[8][e], v[9][e]); o1.y = pk2(v[10][e], v[11][e]); o1.z = pk2(v[12][e], v[13][e]); o1.w = pk2(v[14][e], v[15][e]);
            *(GAS v4u*)dst = o0; *(GAS v4u*)(dst + 8) = o1; } }
}
__device__ __forceinline__ void cvt_matrix(const float* W, int K, int N, const float* gain, bf16* WT, int rowbase, int gw, int NGW, int lane) {
    const int nblk = (N + 63) / 64, nitems = (K / 64) * nblk;
    for (int it = gw; it < nitems; it += NGW) { const int kb = it / nblk, nb = it - kb * nblk;
        cvt_item(W, N, gain, WT, K, kb * 64, nb * 64, (size_t)(rowbase + nb * 64), lane); }
}
__device__ __forceinline__ void cvt_moe(const float* wg, const float* wu, const float* wd, const float* gain, bf16* WGU, bf16* WDN, int gw, int NGW, int lane) {
    for (int it = gw; it < 2 * 8192; it += NGW) { const int which = it >> 13, r = it & 8191, e = r >> 8, q = r & 255, kb = q >> 3, nb = q & 7, n0 = nb * 64;
        const float* W = (which ? wu : wg) + (size_t)e * 2048 * 512;
        const size_t dst = (size_t)e * 1024 + 256 * (n0 >> 7) + (n0 & 127) + (which ? 128 : 0);
        cvt_item(W, 512, gain, WGU, 2048, kb * 64, n0, dst, lane); }
    for (int it = gw; it < 8192; it += NGW) { const int e = it >> 8, q = it & 255, kb = q >> 5, nb = q & 31;
        cvt_item(wd + (size_t)e * 512 * 2048, 2048, nullptr, WDN + (size_t)e * 2048 * 512, 512, kb * 64, nb * 64, (size_t)(nb * 64), lane); }
}
__device__ __forceinline__ void norm_rows(const float* src, bf16* dst, int gw, int NGW, int lane) {
    for (int m = gw; m < T; m += NGW) {
        const GAS f32x4* xr = (const GAS f32x4*)(src + (size_t)m * D) + lane;
        f32x4 v[8]; float s = 0.f;
#pragma unroll
        for (int j = 0; j < 8; ++j) { v[j] = xr[64 * j]; s += (v[j].x * v[j].x + v[j].y * v[j].y) + (v[j].z * v[j].z + v[j].w * v[j].w); }
        const float rstd = rsqrtf(wave_sum(s) * (1.f / D) + RMS_EPS);
        GAS v2u* o8 = (GAS v2u*)(dst + (size_t)m * D) + lane;
#pragma unroll
        for (int j = 0; j < 8; ++j) { v2u o; o.x = pk2(v[j].x * rstd, v[j].y * rstd); o.y = pk2(v[j].z * rstd, v[j].w * rstd); o8[64 * j] = o; }
    }
}

__device__ __forceinline__ float logsig(float z) { return fminf(z, 0.f) - __logf(1.f + __expf(-fabsf(z))); }
constexpr int GP_QE = 0, GP_KE = 33792, GP_ATT = 67584, GP_TOT = 76800;
__device__ __forceinline__ void gla_prepass(LAS unsigned char* lds, const bf16* QK, const bf16* V, const bf16* GL, const float* Wgu, const float* bgate,
                                            bf16* QEF, bf16* KLTF, bf16* ATTF, bf16* VTF, float* DEC) {
    const int tid = threadIdx.x, lane = tid & 63, wave = __builtin_amdgcn_readfirstlane(tid >> 6);
    LAS bf16* QEl = (LAS bf16*)(lds + GP_QE); LAS bf16* KEl = (LAS bf16*)(lds + GP_KE); LAS bf16* ATl = (LAS bf16*)(lds + GP_ATT);
    LAS float* tot = (LAS float*)(lds + GP_TOT);
    const int cg2 = tid & 127, rg2 = __builtin_amdgcn_readfirstlane(tid >> 7);
    for (int it = blockIdx.x; it < NITEM_GLA; it += gridDim.x) {
        const int bh = it >> 8, n = it & 255, h = bh & 3, b = bh >> 2; const int t0 = b * SEQ + n * GLA_C;
        v2u qv[8], kv[8], vv[16];
        { const bf16* qp = QK + (size_t)(t0 + 8 * wave) * 2048 + h * 256 + 4 * lane;
#pragma unroll
          for (int jj = 0; jj < 8; ++jj) { qv[jj] = *(const GAS v2u*)(qp + (size_t)jj * 2048); kv[jj] = *(const GAS v2u*)(qp + (size_t)jj * 2048 + 1024); }
          const bf16* vp = V + (size_t)(t0 + 16 * rg2) * 2048 + h * 512 + 4 * cg2;
#pragma unroll
          for (int r = 0; r < 16; ++r) vv[r] = *(const GAS v2u*)(vp + (size_t)r * 2048); }
        f32x4 cum[8];
        { f32x4 wg[16];
#pragma unroll
          for (int j = 0; j < 16; ++j) wg[j] = *(const GAS f32x4*)(Wgu + j * 1024 + h * 256 + 4 * lane);
          const f32x4 bg = *(const GAS f32x4*)(bgate + h * 256 + 4 * lane);
          f32x4 run = {0.f, 0.f, 0.f, 0.f};
#pragma unroll
          for (int jj = 0; jj < 8; ++jj) { const unsigned* gp = (const unsigned*)(GL + (size_t)(t0 + 8 * wave + jj) * 256);
              f32x4 z = bg;
#pragma unroll
              for (int j2 = 0; j2 < 8; ++j2) { const unsigned w = gp[j2]; z += wg[2 * j2] * bf_lo(w) + wg[2 * j2 + 1] * bf_hi(w); }
#pragma unroll
              for (int e = 0; e < 4; ++e) run[e] += fmaxf(logsig(z[e]) * 0.0625f, -1.0f);
              cum[jj] = run; }
          *(LAS f32x4*)(tot + wave * 256 + 4 * lane) = run; }
        __syncthreads();
        f32x4 offs = {0.f, 0.f, 0.f, 0.f}, blast = {0.f, 0.f, 0.f, 0.f};
#pragma unroll
        for (int w2 = 0; w2 < 8; ++w2) { const f32x4 tv = *(const LAS f32x4*)(tot + w2 * 256 + 4 * lane); blast += tv; if (w2 < wave) offs += tv; }
        f32x4 dec;
#pragma unroll
        for (int e = 0; e < 4; ++e) dec[e] = __expf(blast[e]);
        { float klv[4][8];
#pragma unroll
          for (int jj = 0; jj < 8; ++jj) { const int c = 8 * wave + jj; const f32x4 bb = cum[jj] + offs;
              const float q4[4] = {bf_lo(qv[jj].x), bf_hi(qv[jj].x), bf_lo(qv[jj].y), bf_hi(qv[jj].y)}, k4[4] = {bf_lo(kv[jj].x), bf_hi(kv[jj].x), bf_lo(kv[jj].y), bf_hi(kv[jj].y)};
              float qe[4], ke[4];
#pragma unroll
              for (int e = 0; e < 4; ++e) { qe[e] = q4[e] * 0.0625f * __expf(bb[e]); ke[e] = k4[e] * __expf(-bb[e]); klv[e][jj] = ke[e] * dec[e]; }
              v2u o; o.x = pk2(qe[0], qe[1]); o.y = pk2(qe[2], qe[3]); *(LAS v2u*)(QEl + c * 264 + 4 * lane) = o;
              o.x = pk2(ke[0], ke[1]); o.y = pk2(ke[2], ke[3]); *(LAS v2u*)(KEl + c * 264 + 4 * lane) = o; }
#pragma unroll
          for (int e = 0; e < 4; ++e) { const int d = 4 * lane + e;
              v4u o; o.x = pk2(klv[e][0], klv[e][1]); o.y = pk2(klv[e][2], klv[e][3]); o.z = pk2(klv[e][4], klv[e][5]); o.w = pk2(klv[e][6], klv[e][7]);
              const size_t fi = ((((size_t)it * 8 + (d >> 5)) * 2 + ((d >> 4) & 1)) * 2 + (wave >> 2)) * 64 + (wave & 3) * 16 + (d & 15);
              *(GAS v4u*)(KLTF + fi * 8) = o; } }
        if (wave == 0) *(GAS f32x4*)(DEC + (size_t)it * 256 + 4 * lane) = dec;
#pragma unroll
        for (int f = 0; f < 2; ++f)
#pragma unroll
            for (int e = 0; e < 4; ++e) { unsigned x[8];
#pragma unroll
                for (int jj = 0; jj < 8; ++jj) { const unsigned wd = (e >> 1) ? vv[8 * f + jj].y : vv[8 * f + jj].x; x[jj] = (e & 1) ? (wd >> 16) : (wd & 0xffffu); }
                v4u o; o.x = x[0] | (x[1] << 16); o.y = x[2] | (x[3] << 16); o.z = x[4] | (x[5] << 16); o.w = x[6] | (x[7] << 16);
                const int v = 4 * cg2 + e;
                const size_t fi = (((size_t)it * 32 + (v >> 4)) * 2 + (rg2 >> 1)) * 64 + (2 * (rg2 & 1) + f) * 16 + (v & 15);
                *(GAS v4u*)(VTF + fi * 8) = o; }
        __syncthreads();
        { const int mt = wave >> 1, i = lane & 15, q = lane >> 4;
#pragma unroll
          for (int nn = 0; nn < 2; ++nn) { const int nt = 2 * (wave & 1) + nn; f32x4 acc = {0.f, 0.f, 0.f, 0.f};
            if (nt <= mt) {
#pragma unroll
                for (int ks = 0; ks < 8; ++ks) { const bf16x8 a = *(const LAS bf16x8*)(QEl + (16 * mt + i) * 264 + 32 * ks + 8 * q); const bf16x8 bb = *(const LAS bf16x8*)(KEl + (16 * nt + i) * 264 + 32 * ks + 8 * q);
                    acc = __builtin_amdgcn_mfma_f32_16x16x32_bf16(a, bb, acc, 0, 0, 0); } }
#pragma unroll
            for (int r = 0; r < 4; ++r) { const int c = 16 * mt + 4 * q + r, cp = 16 * nt + i; ATl[c * 72 + cp] = (bf16)f2bf(cp <= c ? acc[r] : 0.f); } } }
        __syncthreads();
        { const int f = tid, mt = f >> 7, ks = (f >> 6) & 1, l2 = f & 63, i2 = l2 & 15, q2 = l2 >> 4;
          const v4u o = *(const LAS v4u*)(ATl + (16 * mt + i2) * 72 + 32 * ks + 8 * q2);
          *(GAS v4u*)(ATTF + ((size_t)it * 512 + f) * 8) = o; }
#pragma unroll
        for (int k = 0; k < 4; ++k) { const int f = tid + 512 * k, w = f >> 8, mt = (f >> 6) & 3, l2 = f & 63, i2 = l2 & 15, q2 = l2 >> 4;
            const v2u lo = *(const LAS v2u*)(QEl + (16 * mt + i2) * 264 + 32 * w + 4 * q2), hi = *(const LAS v2u*)(QEl + (16 * mt + i2) * 264 + 32 * w + 16 + 4 * q2);
            v4u o; o.x = lo.x; o.y = lo.y; o.z = hi.x; o.w = hi.y;
            *(GAS v4u*)(QEF + ((((size_t)it * 8 + w) * 4 + mt) * 64 + l2) * 8) = o; }
        __syncthreads();
    }
}
constexpr int GS_QE = 0, GS_KLT = 32768, GS_ATT = 65536, GS_DEC = 73728, GS_STAGE = 74752;
constexpr int GLA_NSEG = 8, GLA_SEGLEN = 32;
template <int PASS>
__device__ __forceinline__ void gla_scan(LAS unsigned char* lds, const bf16* QEF, const bf16* KLTF, const bf16* ATTF, const bf16* VTF, const float* DEC, float* SEND, float* DTOT, bf16* O) {
    const int tid = threadIdx.x, lane = tid & 63, w = __builtin_amdgcn_readfirstlane(tid >> 6), q = lane >> 4, li = lane & 15;
#define GS_ISSUE(itv, bufv) do { LAS unsigned char* _st = lds + (bufv) * GS_STAGE; const size_t _it = (size_t)(itv); \
        _Pragma("unroll") for (int _k = 0; _k < 4; ++_k) { const int _f = 4 * w + _k; \
            if (PASS == 1) __builtin_amdgcn_global_load_lds((const unsigned*)(QEF + (_it * 32 + _f) * 512 + lane * 8), (LAS unsigned*)(_st + GS_QE + _f * 1024), 16, 0, 0); \
            __builtin_amdgcn_global_load_lds((const unsigned*)(KLTF + (_it * 32 + _f) * 512 + lane * 8), (LAS unsigned*)(_st + GS_KLT + _f * 1024), 16, 0, 0); } \
        if (PASS == 1) __builtin_amdgcn_global_load_lds((const unsigned*)(ATTF + (_it * 8 + w) * 512 + lane * 8), (LAS unsigned*)(_st + GS_ATT + w * 1024), 16, 0, 0); \
        if (w == 0) __builtin_amdgcn_global_load_lds((const unsigned*)(DEC + _it * 256 + lane * 4), (LAS unsigned*)(_st + GS_DEC), 16, 0, 0); } while (0)
    for (int wi = blockIdx.x; wi < 256; wi += gridDim.x) {
        const int bh = wi & 7, rest = wi >> 3, seg = rest >> 2, vsl = rest & 3, h = bh & 3, b = bh >> 2;
        const int it0 = bh * 256 + seg * GLA_SEGLEN, vs16 = vsl * 8 + w;
        f32x4 S[16];
#pragma unroll
        for (int m = 0; m < 16; ++m) S[m] = (f32x4){0.f, 0.f, 0.f, 0.f};
        if (PASS == 1) {
            for (int s2 = 0; s2 < seg; ++s2) { const float* se = SEND + ((size_t)((bh * GLA_NSEG + s2) * 32 + vs16) * 16) * 256; const float* dt = DTOT + (size_t)(bh * GLA_NSEG + s2) * 256;
#pragma unroll
                for (int m = 0; m < 16; ++m) { const f32x4 dv = *(const GAS f32x4*)(dt + 16 * m + 4 * q), sv = *(const GAS f32x4*)(se + (m * 64 + lane) * 4); S[m] = S[m] * dv + sv; } }
        } else if (vsl == 0 && tid < 256) { float p = 1.f;
            for (int n = 0; n < GLA_SEGLEN; ++n) p *= DEC[(size_t)(it0 + n) * 256 + tid];
            DTOT[(size_t)(bh * GLA_NSEG + seg) * 256 + tid] = p; }
        __syncthreads();
        GS_ISSUE(it0, 0);
        const GAS bf16x8* v16 = (const GAS bf16x8*)VTF + (((size_t)it0 * 32 + vs16) * 2) * 64 + lane;
        bf16x8 vb0 = v16[0], vb1 = v16[64], nvb0 = vb0, nvb1 = vb1;
        for (int n = 0; n < GLA_SEGLEN; ++n) {
            VM_WAIT(); __syncthreads();
            if (n + 1 < GLA_SEGLEN) { GS_ISSUE(it0 + n + 1, (n + 1) & 1); nvb0 = v16[(size_t)(n + 1) * 4096]; nvb1 = v16[(size_t)(n + 1) * 4096 + 64]; }
            const LAS unsigned char* st = lds + (n & 1) * GS_STAGE;
            f32x4 po[4];
            if (PASS == 1) {
                bf16x8 sb[8];
#pragma unroll
                for (int ks = 0; ks < 8; ++ks) { v4u x; x.x = pk2(S[2 * ks][0], S[2 * ks][1]); x.y = pk2(S[2 * ks][2], S[2 * ks][3]); x.z = pk2(S[2 * ks + 1][0], S[2 * ks + 1][1]); x.w = pk2(S[2 * ks + 1][2], S[2 * ks + 1][3]); sb[ks] = __builtin_bit_cast(bf16x8, x); }
#pragma unroll
                for (int mt = 0; mt < 4; ++mt) { f32x4 a = {0.f, 0.f, 0.f, 0.f};
#pragma unroll
                    for (int ks = 0; ks < 8; ++ks) a = __builtin_amdgcn_mfma_f32_16x16x32_bf16(*(const LAS bf16x8*)(st + GS_QE + (ks * 4 + mt) * 1024 + lane * 16), sb[ks], a, 0, 0, 0);
                    a = __builtin_amdgcn_mfma_f32_16x16x32_bf16(*(const LAS bf16x8*)(st + GS_ATT + (mt * 2 + 0) * 1024 + lane * 16), vb0, a, 0, 0, 0);
                    a = __builtin_amdgcn_mfma_f32_16x16x32_bf16(*(const LAS bf16x8*)(st + GS_ATT + (mt * 2 + 1) * 1024 + lane * 16), vb1, a, 0, 0, 0);
                    po[mt] = a; }
            }
#pragma unroll
            for (int m = 0; m < 16; ++m) { const f32x4 dv = *(const LAS f32x4*)(st + GS_DEC + (16 * m + 4 * q) * 4);
                f32x4 s = S[m] * dv;
                s = __builtin_amdgcn_mfma_f32_16x16x32_bf16(*(const LAS bf16x8*)(st + GS_KLT + (m * 2 + 0) * 1024 + lane * 16), vb0, s, 0, 0, 0);
                s = __builtin_amdgcn_mfma_f32_16x16x32_bf16(*(const LAS bf16x8*)(st + GS_KLT + (m * 2 + 1) * 1024 + lane * 16), vb1, s, 0, 0, 0);
                S[m] = s; }
            if (PASS == 1) { bf16* op = O + (size_t)(b * SEQ + (seg * GLA_SEGLEN + n) * GLA_C + 4 * q) * 2048 + h * 512 + vsl * 128 + w * 16 + li;
#pragma unroll
                for (int mt = 0; mt < 4; ++mt)
#pragma unroll
                    for (int r = 0; r < 4; ++r) { const float x = po[mt][r], y = __shfl_xor(x, 1); if ((lane & 1) == 0) *(GAS unsigned*)(op + (size_t)(16 * mt + r) * 2048) = pk2(x, y); } }
            vb0 = nvb0; vb1 = nvb1;
        }
        if (PASS == 0) { float* se = SEND + ((size_t)((bh * GLA_NSEG + seg) * 32 + vs16) * 16) * 256;
#pragma unroll
            for (int m = 0; m < 16; ++m) *(GAS f32x4*)(se + (m * 64 + lane) * 4) = S[m]; }
        __syncthreads();
    }
#undef GS_ISSUE
}
__device__ __forceinline__ void gla_gate(const bf16* O, const bf16* R, const float* head_g, bf16* OG, int gw, int NGW, int lane) {
    float hg[8];
#pragma unroll
    for (int j = 0; j < 8; ++j) hg[j] = head_g[8 * lane + j];
    for (int m = gw; m < T; m += NGW) {
#pragma unroll
        for (int h = 0; h < 4; ++h) {
            const v4u ov = *(const GAS v4u*)(O + (size_t)m * 2048 + h * 512 + 8 * lane), rv = *(const GAS v4u*)(R + (size_t)m * 2048 + h * 512 + 8 * lane);
            float o[8] = {bf_lo(ov.x), bf_hi(ov.x), bf_lo(ov.y), bf_hi(ov.y), bf_lo(ov.z), bf_hi(ov.z), bf_lo(ov.w), bf_hi(ov.w)};
            float r[8] = {bf_lo(rv.x), bf_hi(rv.x), bf_lo(rv.y), bf_hi(rv.y), bf_lo(rv.z), bf_hi(rv.z), bf_lo(rv.w), bf_hi(rv.w)};
            float ss = 0.f;
#pragma unroll
            for (int j = 0; j < 8; ++j) ss += o[j] * o[j];
            const float rstd = rsqrtf(wave_sum(ss) * (1.f / 512.f) + RMS_EPS);
            float y[8];
#pragma unroll
            for (int j = 0; j < 8; ++j) y[j] = o[j] * rstd * hg[j] * pg8::silu_f(r[j]);
            v4u w; w.x = pk2(y[0], y[1]); w.y = pk2(y[2], y[3]); w.z = pk2(y[4], y[5]); w.w = pk2(y[6], y[7]);
            *(GAS v4u*)(OG + (size_t)m * 2048 + h * 512 + 8 * lane) = w;
        }
    }
}

__device__ __forceinline__ void moe_route(LAS unsigned char* lds, const float* RL, const float* SSP, const float* bgroup, const float* brouter, unsigned* gcnt, unsigned* EP0, unsigned* EP1, float* W0, float* W1, float* RSTD) {
    const int tid = threadIdx.x; LAS int* lcnt = (LAS int*)lds; LAS int* lbase = lcnt + 32;
    for (int base = blockIdx.x * 128; base < T; base += gridDim.x * 128) {
        if (tid < 32) lcnt[tid] = 0;
        __syncthreads();
        int e0 = 0, e1 = 0, r0 = 0, r1 = 0; float w0 = 0.f, w1 = 0.f;
        if (tid < 128) { const int t = base + tid; const float* rl = RL + (size_t)t * 64;
            float ssq = 0.f; { const GAS f32x4* sp = (const GAS f32x4*)(SSP + (size_t)t * 32);
#pragma unroll
                for (int k = 0; k < 8; ++k) { const f32x4 v = sp[k]; ssq += (v.x + v.y) + (v.z + v.w); } }
            const float rstd = rsqrtf(ssq * (1.f / D) + RMS_EPS); RSTD[t] = rstd;
            const f32x4 g4 = *(const GAS f32x4*)rl; float gl[4] = {g4.x * rstd + bgroup[0], g4.y * rstd + bgroup[1], g4.z * rstd + bgroup[2], g4.w * rstd + bgroup[3]};
            int g = 0; float best = gl[0];
#pragma unroll
            for (int j = 1; j < 4; ++j) if (gl[j] > best) { best = gl[j]; g = j; }
            float se = 0.f;
#pragma unroll
            for (int j = 0; j < 4; ++j) se += __expf(gl[j] - best);
            const float pg = 1.0f / se;
            const f32x4 a4 = *(const GAS f32x4*)(rl + 4 + 8 * g), b4 = *(const GAS f32x4*)(rl + 8 + 8 * g);
            float el[8] = {a4.x, a4.y, a4.z, a4.w, b4.x, b4.y, b4.z, b4.w};
#pragma unroll
            for (int j = 0; j < 8; ++j) el[j] = el[j] * rstd + brouter[8 * g + j];
            int i0 = 0; float v0 = el[0];
#pragma unroll
            for (int j = 1; j < 8; ++j) if (el[j] > v0) { v0 = el[j]; i0 = j; }
            int i1 = -1; float v1 = -3.0e38f;
#pragma unroll
            for (int j = 0; j < 8; ++j) if (j != i0 && el[j] > v1) { v1 = el[j]; i1 = j; }
            w0 = pg / (1.0f + __expf(v1 - v0)); w1 = pg - w0;
            e0 = 8 * g + i0; e1 = 8 * g + i1;
            r0 = __hip_atomic_fetch_add(&lcnt[e0], 1, __ATOMIC_RELAXED, __HIP_MEMORY_SCOPE_WORKGROUP); r1 = __hip_atomic_fetch_add(&lcnt[e1], 1, __ATOMIC_RELAXED, __HIP_MEMORY_SCOPE_WORKGROUP); }
        __syncthreads();
        if (tid < 32) lbase[tid] = (int)__hip_atomic_fetch_add(gcnt + tid, (unsigned)lcnt[tid], RLX_AGENT);
        __syncthreads();
        if (tid < 128) { const int t = base + tid;
            EP0[t] = ((unsigned)e0 << 24) | (unsigned)(lbase[e0] + r0); EP1[t] = ((unsigned)e1 << 24) | (unsigned)(lbase[e1] + r1); W0[t] = w0; W1[t] = w1; }
        __syncthreads();
    }
}
__device__ __forceinline__ void moe_build_table(LAS unsigned char* ldsbase, unsigned* gcnt) {
    LAS int* off = (LAS int*)(ldsbase + MOE_OFF_OFF); LAS unsigned char* texp = ldsbase + MOE_TEXP_OFF;
    __syncthreads();
    if (threadIdx.x == 0) { int acc = 0, ti = 0;
        for (int e = 0; e < NE; ++e) { const int c = (int)__hip_atomic_load(gcnt + e, RLX_AGENT); off[e] = acc; const int nt = (c + 255) >> 8;
            for (int k = 0; k < nt && ti < 288; ++k) texp[ti++] = (unsigned char)e;
            acc += nt * 256; }
        off[32] = acc; }
    __syncthreads();
}
__device__ __forceinline__ void moe_slots(LAS unsigned char* ldsbase, unsigned* gcnt, const unsigned* EP0, const unsigned* EP1, const float* RSTD, unsigned* SL0, unsigned* SL1, unsigned* TL, float* RS) {
    const LAS int* off = (const LAS int*)(ldsbase + MOE_OFF_OFF); const int tid = threadIdx.x;
    for (int t = blockIdx.x * 512 + tid; t < T; t += gridDim.x * 512) {
        const unsigned p0 = EP0[t], p1 = EP1[t]; const float rs = RSTD[t];
        const unsigned s0 = (unsigned)off[p0 >> 24] + (p0 & 0xffffffu), s1 = (unsigned)off[p1 >> 24] + (p1 & 0xffffffu);
        TL[s0] = (unsigned)t; RS[s0] = rs; TL[s1] = (unsigned)t; RS[s1] = rs; SL0[t] = s0; SL1[t] = s1; }
    for (int e = blockIdx.x; e < NE; e += gridDim.x) { const int c = (int)__hip_atomic_load(gcnt + e, RLX_AGENT);
        for (int i = off[e] + c + tid; i < off[e + 1]; i += 512) { TL[i] = 0u; RS[i] = 0.f; } }
}
template <bool FINAL>
__device__ __forceinline__ void moe_combine(const bf16* H, const bf16* Y, const unsigned* SL0, const unsigned* SL1, const float* W0, const float* W1, float* outf, bf16* H2, bf16* HN, int gw, int NGW, int lane) {
    for (int t = gw; t < T; t += NGW) {
        const unsigned s0 = SL0[t], s1 = SL1[t]; const float w0 = W0[t], w1 = W1[t];
        const GAS v2u* hr = (const GAS v2u*)(H + (size_t)t * D) + lane;
        const GAS v2u* y0 = (const GAS v2u*)(Y + (size_t)s0 * 2048) + lane; const GAS v2u* y1 = (const GAS v2u*)(Y + (size_t)s1 * 2048) + lane;
        f32x4 v[8]; float s = 0.f;
#pragma unroll
        for (int j = 0; j < 8; ++j) { const v2u a = y0[64 * j], b = y1[64 * j], hh = hr[64 * j]; f32x4 x;
            x.x = bf_lo(hh.x) + w0 * bf_lo(a.x) + w1 * bf_lo(b.x); x.y = bf_hi(hh.x) + w0 * bf_hi(a.x) + w1 * bf_hi(b.x); x.z = bf_lo(hh.y) + w0 * bf_lo(a.y) + w1 * bf_lo(b.y); x.w = bf_hi(hh.y) + w0 * bf_hi(a.y) + w1 * bf_hi(b.y);
            v[j] = x; s += (x.x * x.x + x.y * x.y) + (x.z * x.z + x.w * x.w); }
        if constexpr (FINAL) { GAS f32x4* xr = (GAS f32x4*)(outf + (size_t)t * D) + lane;
#pragma unroll
            for (int j = 0; j < 8; ++j) xr[64 * j] = v[j]; }
        else { const float rstd = rsqrtf(wave_sum(s) * (1.f / D) + RMS_EPS);
            GAS v2u* o8 = (GAS v2u*)(HN + (size_t)t * D) + lane; GAS v2u* h8 = (GAS v2u*)(H2 + (size_t)t * D) + lane;
#pragma unroll
            for (int j = 0; j < 8; ++j) { v2u o; o.x = pk2(v[j].x, v[j].y); o.y = pk2(v[j].z, v[j].w); h8[64 * j] = o;
                o.x = pk2(v[j].x * rstd, v[j].y * rstd); o.y = pk2(v[j].z * rstd, v[j].w * rstd); o8[64 * j] = o; } }
    }
}

__device__ const unsigned char T5_BUCKET[128] = {0,1,2,3,4,5,6,7,8,9,10,11,12,13,14,15,16,16,16,17,17,18,18,18,19,19,19,20,20,20,20,21,21,21,21,22,22,22,22,22,23,23,23,23,23,23,24,24,24,24,24,24,25,25,25,25,25,25,25,26,26,26,26,26,26,26,26,27,27,27,27,27,27,27,27,27,27,28,28,28,28,28,28,28,28,28,28,29,29,29,29,29,29,29,29,29,29,29,29,30,30,30,30,30,30,30,30,30,30,30,30,30,30,31,31,31,31,31,31,31,31,31,31,31,31,31,31,31};
constexpr int AT_K = 0, AT_VT = 36864, AT_BIAS = 70656;
__device__ __forceinline__ void swa_attention(LAS unsigned char* lds, const bf16* KVQ, const bf16* VT, const float* knorm, const float* qnorm, const float* relb, const float* sinks, bf16* AO) {
    const int tid = threadIdx.x, lane = tid & 63, g = __builtin_amdgcn_readfirstlane(tid >> 6), li = lane & 15, q = lane >> 4;
    LAS bf16* KL = (LAS bf16*)(lds + AT_K); LAS bf16* VTL = (LAS bf16*)(lds + AT_VT); LAS float* BL = (LAS float*)(lds + AT_BIAS);
    constexpr float LOG2E = 1.4426950408889634f;
    float qn[2][8];
#pragma unroll
    for (int ks = 0; ks < 2; ++ks)
#pragma unroll
        for (int j = 0; j < 8; ++j) qn[ks][j] = qnorm[32 * ks + 8 * q + j] * (0.125f * LOG2E);
    const int key = tid >> 1, hf = tid & 1, vd = tid >> 3, vc = tid & 7;
    float kn[32];
#pragma unroll
    for (int j = 0; j < 32; ++j) kn[j] = knorm[32 * hf + j];
    v4u kw[4], vw[4];
#define AT_PREFETCH(wiv) do { const int _hk = (wiv) & 3, _n = ((wiv) >> 2) & 127, _b = (wiv) >> 9; \
        const bool _live = (_n > 0) || (key >= 128); const size_t _tk = (size_t)_b * SEQ + (size_t)(_n - 1) * 128 + key; \
        const bf16* _kp = KVQ + _tk * KVQ_N + _hk * 64 + 32 * hf; \
        _Pragma("unroll") for (int _j = 0; _j < 4; ++_j) kw[_j] = _live ? *(const GAS v4u*)(_kp + 8 * _j) : (v4u){0u, 0u, 0u, 0u}; \
        const bf16* _vp = VT + ((size_t)(_b * 4 + _hk) * 64 + vd) * SEQ + (size_t)(_n - 1) * 128; \
        _Pragma("unroll") for (int _j = 0; _j < 4; ++_j) { const int _c = vc + 8 * _j; vw[_j] = ((_n > 0) || (_c >= 16)) ? *(const GAS v4u*)(_vp + 8 * _c) : (v4u){0u, 0u, 0u, 0u}; } } while (0)
    if (blockIdx.x < 1024) AT_PREFETCH(blockIdx.x);
    for (int wi = blockIdx.x; wi < 1024; wi += gridDim.x) {
        const int hk = wi & 3, n = (wi >> 2) & 127, b = wi >> 9;
        __syncthreads();
        { float ss = 0.f;
#pragma unroll
          for (int j = 0; j < 4; ++j) { const float a0 = bf_lo(kw[j].x), a1 = bf_hi(kw[j].x), a2 = bf_lo(kw[j].y), a3 = bf_hi(kw[j].y), a4 = bf_lo(kw[j].z), a5 = bf_hi(kw[j].z), a6 = bf_lo(kw[j].w), a7 = bf_hi(kw[j].w);
              ss += (a0 * a0 + a1 * a1) + (a2 * a2 + a3 * a3) + (a4 * a4 + a5 * a5) + (a6 * a6 + a7 * a7); }
          ss += __shfl_xor(ss, 1);
          const float rstd = rsqrtf(ss * (1.f / 64.f) + RMS_EPS);
#pragma unroll
          for (int j = 0; j < 4; ++j) { v4u o;
              o.x = pk2(bf_lo(kw[j].x) * rstd * kn[8 * j + 0], bf_hi(kw[j].x) * rstd * kn[8 * j + 1]); o.y = pk2(bf_lo(kw[j].y) * rstd * kn[8 * j + 2], bf_hi(kw[j].y) * rstd * kn[8 * j + 3]);
              o.z = pk2(bf_lo(kw[j].z) * rstd * kn[8 * j + 4], bf_hi(kw[j].z) * rstd * kn[8 * j + 5]); o.w = pk2(bf_lo(kw[j].w) * rstd * kn[8 * j + 6], bf_hi(kw[j].w) * rstd * kn[8 * j + 7]);
              *(LAS v4u*)(KL + key * 72 + 32 * hf + 8 * j) = o; }
#pragma unroll
          for (int j = 0; j < 4; ++j) *(LAS v4u*)(VTL + vd * 264 + 8 * (vc + 8 * j)) = vw[j];
#pragma unroll
          for (int k = 0; k < 2; ++k) { const int e = tid + 512 * k, gg = e >> 7, dist = e & 127; BL[e] = relb[(int)T5_BUCKET[dist] * 32 + hk * 8 + gg] * LOG2E; }
        }
        __syncthreads();
        if (wi + (int)gridDim.x < 1024) AT_PREFETCH(wi + (int)gridDim.x);
        const int head = hk * 8 + g; const float sink = sinks[head] * LOG2E;
        float bz[9][4];
#pragma unroll
        for (int tt = 0; tt < 9; ++tt)
#pragma unroll
            for (int r = 0; r < 4; ++r) { const int dist = 128 - 16 * tt + li - (4 * q + r); const bool ok = (dist >= 0) && (dist < 128);
                bz[tt][r] = ok ? BL[g * 128 + (dist & 127)] : -__builtin_inff(); }
        v4u qr0, qr1;
        { const bf16* qp = KVQ + ((size_t)b * SEQ + (size_t)n * 128 + li) * KVQ_N + 512 + head * 64 + 8 * q; qr0 = *(const GAS v4u*)qp; qr1 = *(const GAS v4u*)(qp + 32); }
        for (int mt = 0; mt < 8; ++mt) {
            const size_t tq = (size_t)b * SEQ + (size_t)n * 128 + 16 * mt + li;
            bf16x8 qf[2];
            { const v4u q0 = qr0, q1 = qr1;
              if (mt < 7) { const bf16* qp = KVQ + (tq + 16) * KVQ_N + 512 + head * 64 + 8 * q; qr0 = *(const GAS v4u*)qp; qr1 = *(const GAS v4u*)(qp + 32); }
              float a[16] = {bf_lo(q0.x), bf_hi(q0.x), bf_lo(q0.y), bf_hi(q0.y), bf_lo(q0.z), bf_hi(q0.z), bf_lo(q0.w), bf_hi(q0.w), bf_lo(q1.x), bf_hi(q1.x), bf_lo(q1.y), bf_hi(q1.y), bf_lo(q1.z), bf_hi(q1.z), bf_lo(q1.w), bf_hi(q1.w)};
              float ss = 0.f;
#pragma unroll
              for (int j = 0; j < 16; ++j) ss += a[j] * a[j];
              ss += __shfl_xor(ss, 16); ss += __shfl_xor(ss, 32);
              const float rstd = rsqrtf(ss * (1.f / 64.f) + RMS_EPS);
              v4u w0, w1;
              w0.x = pk2(a[0] * rstd * qn[0][0], a[1] * rstd * qn[0][1]); w0.y = pk2(a[2] * rstd * qn[0][2], a[3] * rstd * qn[0][3]); w0.z = pk2(a[4] * rstd * qn[0][4], a[5] * rstd * qn[0][5]); w0.w = pk2(a[6] * rstd * qn[0][6], a[7] * rstd * qn[0][7]);
              w1.x = pk2(a[8] * rstd * qn[1][0], a[9] * rstd * qn[1][1]); w1.y = pk2(a[10] * rstd * qn[1][2], a[11] * rstd * qn[1][3]); w1.z = pk2(a[12] * rstd * qn[1][4], a[13] * rstd * qn[1][5]); w1.w = pk2(a[14] * rstd * qn[1][6], a[15] * rstd * qn[1][7]);
              qf[0] = __builtin_bit_cast(bf16x8, w0); qf[1] = __builtin_bit_cast(bf16x8, w1); }
            f32x4 st[9]; float mx = sink;
#pragma unroll
            for (int tt = 0; tt < 9; ++tt) { const int nt = mt + tt;
                if (n == 0 && nt < 8) { st[tt] = (f32x4){-__builtin_inff(), -__builtin_inff(), -__builtin_inff(), -__builtin_inff()}; }
                else { f32x4 acc = {0.f, 0.f, 0.f, 0.f};
#pragma unroll
                    for (int ks = 0; ks < 2; ++ks) { const bf16x8 a = *(const LAS bf16x8*)(KL + (16 * nt + li) * 72 + 32 * ks + 8 * q); acc = __builtin_amdgcn_mfma_f32_16x16x32_bf16(a, qf[ks], acc, 0, 0, 0); }
#pragma unroll
                    for (int r = 0; r < 4; ++r) { acc[r] += bz[tt][r]; mx = fmaxf(mx, acc[r]); }
                    st[tt] = acc; } }
            mx = fmaxf(mx, __shfl_xor(mx, 16)); mx = fmaxf(mx, __shfl_xor(mx, 32));
            float lsum = 0.f;
#pragma unroll
            for (int tt = 0; tt < 9; ++tt)
#pragma unroll
                for (int r = 0; r < 4; ++r) { const float p = __builtin_amdgcn_exp2f(st[tt][r] - mx); st[tt][r] = p; lsum += p; }
            lsum += __shfl_xor(lsum, 16); lsum += __shfl_xor(lsum, 32);
            const float inv = 1.0f / (lsum + __builtin_amdgcn_exp2f(sink - mx));
            f32x4 oacc[4];
#pragma unroll
            for (int dt = 0; dt < 4; ++dt) oacc[dt] = (f32x4){0.f, 0.f, 0.f, 0.f};
#pragma unroll
            for (int s = 0; s < 5; ++s) {
                v4u pw; pw.x = pk2(st[2 * s][0], st[2 * s][1]); pw.y = pk2(st[2 * s][2], st[2 * s][3]);
                if (s < 4) { pw.z = pk2(st[2 * s + 1][0], st[2 * s + 1][1]); pw.w = pk2(st[2 * s + 1][2], st[2 * s + 1][3]); } else { pw.z = 0u; pw.w = 0u; }
                const bf16x8 pb = __builtin_bit_cast(bf16x8, pw);
                const int k0 = 16 * (mt + 2 * s) + 4 * q; int k1 = 16 * (mt + 2 * s + 1) + 4 * q; if (k1 > 252) k1 = 240 + 4 * q;
#pragma unroll
                for (int dt = 0; dt < 4; ++dt) { const v2u lo = *(const LAS v2u*)(VTL + (16 * dt + li) * 264 + k0), hi = *(const LAS v2u*)(VTL + (16 * dt + li) * 264 + k1);
                    v4u aw; aw.x = lo.x; aw.y = lo.y; aw.z = hi.x; aw.w = hi.y;
                    oacc[dt] = __builtin_amdgcn_mfma_f32_16x16x32_bf16(__builtin_bit_cast(bf16x8, aw), pb, oacc[dt], 0, 0, 0); } }
#pragma unroll
            for (int dt = 0; dt < 4; ++dt) { v2u o; o.x = pk2(oacc[dt][0] * inv, oacc[dt][1] * inv); o.y = pk2(oacc[dt][2] * inv, oacc[dt][3] * inv);
                *(GAS v2u*)(AO + tq * 2048 + head * 64 + 16 * dt + 4 * q) = o; }
        }
    }
#undef AT_PREFETCH
}


struct Args { const float* in[24]; float* out; unsigned char* ws; int ph_lo, ph_hi; };
constexpr int N_PHASES = 23;
#define CAS __attribute__((address_space(4)))
template <int WHICH> struct OrderCvt : pg8::StaticOrder {
    int tpm, tpn, gw, NGW, lane;
    __device__ __forceinline__ void set_trigger(int when) { pg8::Unit u; if (!next(when, u)) (void)next(0, u); tpm = u.pm; tpn = u.pn; }
    __device__ __forceinline__ void done(const pg8::Unit& u) const {
        if (u.pm != tpm || u.pn != tpn) return;
        const CAS Args* a = (const CAS Args*)__builtin_amdgcn_kernarg_segment_ptr();
        unsigned char* ws = a->ws;
        if (WHICH == 0) {
            cvt_matrix(a->in[6], 2048, 2048, nullptr, (bf16*)(ws + WS_W_GLA_OUT), 0, gw, NGW, lane);
            cvt_matrix(a->in[8], 2048, 512, a->in[7], (bf16*)(ws + WS_W_KVQ), 0, gw, NGW, lane);
            cvt_matrix(a->in[12], 2048, 2048, a->in[11], (bf16*)(ws + WS_W_KVQ), 512, gw, NGW, lane);
            cvt_matrix(a->in[15], 2048, 2048, nullptr, (bf16*)(ws + WS_W_SWA_OUT), 0, gw, NGW, lane);
            for (int l = 0; l < 2; ++l) {
                cvt_matrix(a->in[17] + (size_t)l * 2048 * 4, 2048, 4, a->in[16] + l * 2048, (bf16*)(ws + WS_W_ROUTER) + (size_t)l * 256 * 2048, 0, gw, NGW, lane);
                cvt_matrix(a->in[19] + (size_t)l * 2048 * 32, 2048, 32, a->in[16] + l * 2048, (bf16*)(ws + WS_W_ROUTER) + (size_t)l * 256 * 2048, 4, gw, NGW, lane);
            }
            cvt_moe(a->in[21], a->in[22], a->in[23], a->in[16], (bf16*)(ws + WS_W_GU), (bf16*)(ws + WS_W_DN), gw, NGW, lane);
        } else {
            cvt_moe(a->in[21] + (size_t)NE * 2048 * 512, a->in[22] + (size_t)NE * 2048 * 512, a->in[23] + (size_t)NE * 512 * 2048, a->in[16] + 2048, (bf16*)(ws + WS_W_GU), (bf16*)(ws + WS_W_DN), gw, NGW, lane);
        }
    }
};
__global__ void __launch_bounds__(NWAVES * 64, 2) fwd(Args args) {
    extern __shared__ __attribute__((aligned(16))) unsigned char lds_raw[];
    LAS unsigned char* lds = (LAS unsigned char*)lds_raw;
    const int tid = threadIdx.x, lane = tid & 63, wave = __builtin_amdgcn_readfirstlane(tid >> 6);
    const int G = gridDim.x, gw = blockIdx.x * NWAVES + wave, NGW = G * NWAVES;
    unsigned char* ws = args.ws;
    gu32* ctl = (gu32*)(ws + WS_CTL);
    for (int u = tid; u < (LDS_BYTES - LDSCTL_OFF) / 4; u += NWAVES * 64) ((LAS unsigned*)(lds + LDSCTL_OFF))[u] = 0u;
    __syncthreads();
    XcdBarrier bar = xcd_barrier_post((unsigned*)(ctl + CW_BAR), (volatile LAS unsigned*)(lds + MISC_OFF));
    const int lo = args.ph_lo, hi = args.ph_hi;
#define IN(k) ((((MK_PHASE_MASK) >> (k)) & 1) && lo <= (k) && (k) < hi)
#define PB(k) const unsigned long long _pt0 = (((MK_DELAY_MASK) >> (k)) & 1) ? __builtin_amdgcn_s_memrealtime() : 0ull
#define PE(k) do { if (((MK_DELAY_MASK) >> (k)) & 1) { const unsigned long long _pt1 = __builtin_amdgcn_s_memrealtime(), _dt = _pt1 - _pt0; while (__builtin_amdgcn_s_memrealtime() - _pt1 < _dt) __builtin_amdgcn_s_sleep(8); } } while (0)
#define SEAM(k) do { if (IN(k) && IN((k) + 1)) xcd_barrier(bar); } while (0)

    const float* x = args.in[0]; float* out = args.out;
    bf16* W_GLA_IN = (bf16*)(ws + WS_W_GLA_IN); bf16* W_GLA_OUT = (bf16*)(ws + WS_W_GLA_OUT); bf16* W_KVQ = (bf16*)(ws + WS_W_KVQ); bf16* W_SWA_OUT = (bf16*)(ws + WS_W_SWA_OUT);
    bf16* W_ROUTER = (bf16*)(ws + WS_W_ROUTER); bf16* W_GU = (bf16*)(ws + WS_W_GU); bf16* W_DN = (bf16*)(ws + WS_W_DN);
    bf16* HN = (bf16*)(ws + WS_HN);
    unsigned* EP0 = (unsigned*)(ws + WS_TOK); unsigned* EP1 = EP0 + T; unsigned* SL0 = EP1 + T; unsigned* SL1 = SL0 + T; float* TW0 = (float*)(SL1 + T); float* TW1 = TW0 + T; float* RSTD = TW1 + T;
    bf16* HB = (bf16*)(ws + WS_HB); float* SSP = (float*)(ws + WS_SSP); unsigned* TL = (unsigned*)(ws + WS_TL); float* RS = (float*)(ws + WS_RS);
    float* RL = (float*)(ws + WS_RL);

    if (IN(0)) { PB(0);
        cvt_matrix(args.in[2], 2048, GLA_PROJ_N, args.in[1], W_GLA_IN, 0, gw, NGW, lane);
        norm_rows(x, HN, gw, NGW, lane);
        PE(0);
    }
    SEAM(0);
#define STAGGER(groups, ticks) do { if ((ticks) > 0) { const unsigned long long _s0 = __builtin_amdgcn_s_memrealtime(), _sd = (unsigned long long)((blockIdx.x % (groups)) * (ticks)); \
        while (__builtin_amdgcn_s_memrealtime() - _s0 < _sd) __builtin_amdgcn_s_sleep(4); } } while (0)
    if (IN(1)) { PB(1);
        pg8::Gemm g{HN, W_GLA_IN, T, GLA_PROJ_NP, 2048}; OrderCvt<0> S; S.init(T, GLA_PROJ_NP, G, (int)blockIdx.x); S.gw = gw; S.NGW = NGW; S.lane = lane; S.set_trigger((int)(blockIdx.x % 12));
        pg8::EpiGlaProj E{(bf16*)(ws + WS_QK), (bf16*)(ws + WS_V), (bf16*)(ws + WS_R), (bf16*)(ws + WS_GL)};
        STAGGER(4, MK_STAG1);
        pg8::gemm_phase<pg8::EpiGlaProj, OrderCvt<0>, true, true, false, false>(lds + RING_OFF, g, S, E);
        PE(1);
    }
    SEAM(1);
    if (IN(2)) { PB(2); gla_prepass(lds + RING_OFF, (const bf16*)(ws + WS_QK), (const bf16*)(ws + WS_V), (const bf16*)(ws + WS_GL), args.in[3], args.in[4],
                           (bf16*)(ws + WS_QEF), (bf16*)(ws + WS_KLTF), (bf16*)(ws + WS_ATTF), (bf16*)(ws + WS_VTF), (float*)(ws + WS_DEC)); PE(2); }
    SEAM(2);
    if (IN(3)) { PB(3); gla_scan<0>(lds + RING_OFF, (const bf16*)(ws + WS_QEF), (const bf16*)(ws + WS_KLTF), (const bf16*)(ws + WS_ATTF), (const bf16*)(ws + WS_VTF), (const float*)(ws + WS_DEC), (float*)(ws + WS_SEND), (float*)(ws + WS_DTOT), (bf16*)(ws + WS_QK)); PE(3); }
    SEAM(3);
    if (IN(4)) { PB(4); gla_scan<1>(lds + RING_OFF, (const bf16*)(ws + WS_QEF), (const bf16*)(ws + WS_KLTF), (const bf16*)(ws + WS_ATTF), (const bf16*)(ws + WS_VTF), (const float*)(ws + WS_DEC), (float*)(ws + WS_SEND), (float*)(ws + WS_DTOT), (bf16*)(ws + WS_QK)); PE(4); }
    SEAM(4);
    if (IN(5)) { PB(5); gla_gate((const bf16*)(ws + WS_QK), (const bf16*)(ws + WS_R), args.in[5], HN, gw, NGW, lane); PE(5); }
    SEAM(5);
    if (IN(6)) { PB(6);
        pg8::Gemm g{HN, W_GLA_OUT, T, 2048, 2048}; pg8::StaticOrder S; S.init(T, 2048, G, (int)blockIdx.x);
        pg8::EpiResBf16<false> E{x, 2048, HB, SSP};
        pg8::gemm_phase<pg8::EpiResBf16<false>, pg8::StaticOrder, true, true, false, false>(lds + RING_OFF, g, S, E);
        PE(6);
    }
    SEAM(6);

    { constexpr int layer = 0; constexpr int pb = 6 + 10 * layer;
    unsigned* gcnt = (unsigned*)(ctl + CW_CNT + layer * 64);
    if (IN(pb + 1)) { PB(pb + 1);
        pg8::Gemm g{HB, W_ROUTER + (size_t)layer * 256 * 2048, T, 256, 2048}; pg8::StaticOrder S; S.init(T, 256, G, (int)blockIdx.x);
        pg8::EpiRouter E{RL};
        pg8::gemm_phase<pg8::EpiRouter, pg8::StaticOrder, true, true>(lds + RING_OFF, g, S, E);
        PE(pb + 1);
    }
    SEAM(pb + 1);
    if (IN(pb + 2)) { PB(pb + 2); moe_route(lds + RING_OFF, RL, SSP, args.in[18] + layer * 4, args.in[20] + layer * 32, gcnt, EP0, EP1, TW0, TW1, RSTD); PE(pb + 2); }
    SEAM(pb + 2);
    if (IN(pb + 3)) { PB(pb + 3); { moe_build_table(lds, gcnt); moe_slots(lds, gcnt, EP0, EP1, RSTD, SL0, SL1, TL, RS); } PE(pb + 3); }
    SEAM(pb + 3);
    if (IN(pb + 4)) { PB(pb + 4);
        moe_build_table(lds, gcnt);
        const int rows = __builtin_amdgcn_readfirstlane(((const LAS int*)(lds + MOE_OFF_OFF))[32]);
        pg8::Gemm g{HB, W_GU, rows, 1024, 2048, TL};
        pg8::GroupedOrder S{(const LAS unsigned char*)(lds + MOE_TEXP_OFF), rows >> 8, 4, G, (int)blockIdx.x};
        pg8::EpiSwiGLU E{(bf16*)(ws + WS_ACT), RS};
        pg8::gemm_phase<pg8::EpiSwiGLU, pg8::GroupedOrder, true, true, true>(lds + RING_OFF, g, S, E);
        PE(pb + 4);
    }
    SEAM(pb + 4);
    if (IN(pb + 5)) { PB(pb + 5);
        moe_build_table(lds, gcnt);
        const int rows = __builtin_amdgcn_readfirstlane(((const LAS int*)(lds + MOE_OFF_OFF))[32]);
        pg8::Gemm g{(const bf16*)(ws + WS_ACT), W_DN, rows, 2048, 512};
        pg8::GroupedOrder S{(const LAS unsigned char*)(lds + MOE_TEXP_OFF), rows >> 8, 8, G, (int)blockIdx.x};
        pg8::EpiBf16 E{(bf16*)(ws + WS_Y), 2048};
        pg8::gemm_phase<pg8::EpiBf16, pg8::GroupedOrder, true, true, false, (MK_EARLY_EPI != 0)>(lds + RING_OFF, g, S, E);
        PE(pb + 5);
    }
    SEAM(pb + 5);
    if (IN(pb + 6)) { PB(pb + 6);
        moe_combine<false>(HB, (const bf16*)(ws + WS_Y), SL0, SL1, TW0, TW1, nullptr, (bf16*)out, HN, gw, NGW, lane);
        PE(pb + 6);
    }
    if (layer == 0) SEAM(pb + 6);
    }
    if (IN(13)) { PB(13);
        pg8::Gemm g{HN, W_KVQ, T, KVQ_N, 2048}; OrderCvt<1> S; S.init(T, KVQ_N, G, (int)blockIdx.x); S.gw = gw; S.NGW = NGW; S.lane = lane; S.set_trigger((int)(blockIdx.x % 5));
        pg8::EpiKVQ E{(bf16*)(ws + WS_KVQ), (bf16*)(ws + WS_VT)};
        pg8::gemm_phase<pg8::EpiKVQ, OrderCvt<1>, true, true>(lds + RING_OFF, g, S, E);
        PE(13);
    }
    SEAM(13);
    if (IN(14)) { PB(14); swa_attention(lds + RING_OFF, (const bf16*)(ws + WS_KVQ), (const bf16*)(ws + WS_VT), args.in[9], args.in[13], args.in[10], args.in[14], (bf16*)(ws + WS_AO)); PE(14); }
    SEAM(14);
    if (IN(15)) { PB(15);
        pg8::Gemm g{(const bf16*)(ws + WS_AO), W_SWA_OUT, T, 2048, 2048}; pg8::StaticOrder S; S.init(T, 2048, G, (int)blockIdx.x);
        pg8::EpiResBf16<true> E{(const bf16*)out, 2048, HB, SSP};
        pg8::gemm_phase<pg8::EpiResBf16<true>, pg8::StaticOrder, true, true, false, false>(lds + RING_OFF, g, S, E);
        PE(15);
    }
    SEAM(15);
    { constexpr int layer = 1; constexpr int pb = 6 + 10 * layer;
    unsigned* gcnt = (unsigned*)(ctl + CW_CNT + layer * 64);
    if (IN(pb + 1)) { PB(pb + 1);
        pg8::Gemm g{HB, W_ROUTER + (size_t)layer * 256 * 2048, T, 256, 2048}; pg8::StaticOrder S; S.init(T, 256, G, (int)blockIdx.x);
        pg8::EpiRouter E{RL};
        pg8::gemm_phase<pg8::EpiRouter, pg8::StaticOrder, true, true>(lds + RING_OFF, g, S, E);
        PE(pb + 1);
    }
    SEAM(pb + 1);
    if (IN(pb + 2)) { PB(pb + 2); moe_route(lds + RING_OFF, RL, SSP, args.in[18] + layer * 4, args.in[20] + layer * 32, gcnt, EP0, EP1, TW0, TW1, RSTD); PE(pb + 2); }
    SEAM(pb + 2);
    if (IN(pb + 3)) { PB(pb + 3); { moe_build_table(lds, gcnt); moe_slots(lds, gcnt, EP0, EP1, RSTD, SL0, SL1, TL, RS); } PE(pb + 3); }
    SEAM(pb + 3);
    if (IN(pb + 4)) { PB(pb + 4);
        moe_build_table(lds, gcnt);
        const int rows = __builtin_amdgcn_readfirstlane(((const LAS int*)(lds + MOE_OFF_OFF))[32]);
        pg8::Gemm g{HB, W_GU, rows, 1024, 2048, TL};
        pg8::GroupedOrder S{(const LAS unsigned char*)(lds + MOE_TEXP_OFF), rows >> 8, 4, G, (int)blockIdx.x};
        pg8::EpiSwiGLU E{(bf16*)(ws + WS_ACT), RS};
        pg8::gemm_phase<pg8::EpiSwiGLU, pg8::GroupedOrder, true, true, true>(lds + RING_OFF, g, S, E);
        PE(pb + 4);
    }
    SEAM(pb + 4);
    if (IN(pb + 5)) { PB(pb + 5);
        moe_build_table(lds, gcnt);
        const int rows = __builtin_amdgcn_readfirstlane(((const LAS int*)(lds + MOE_OFF_OFF))[32]);
        pg8::Gemm g{(const bf16*)(ws + WS_ACT), W_DN, rows, 2048, 512};
        pg8::GroupedOrder S{(const LAS unsigned char*)(lds + MOE_TEXP_OFF), rows >> 8, 8, G, (int)blockIdx.x};
        pg8::EpiBf16 E{(bf16*)(ws + WS_Y), 2048};
        pg8::gemm_phase<pg8::EpiBf16, pg8::GroupedOrder, true, true, false, (MK_EARLY_EPI != 0)>(lds + RING_OFF, g, S, E);
        PE(pb + 5);
    }
    SEAM(pb + 5);
    if (IN(pb + 6)) { PB(pb + 6);
        moe_combine<true>(HB, (const bf16*)(ws + WS_Y), SL0, SL1, TW0, TW1, out, nullptr, nullptr, gw, NGW, lane);
        PE(pb + 6);
    }
    if (layer == 0) SEAM(pb + 6);
    }
#undef IN
#undef SEAM
}

extern "C" void kernel_launch(void* const* d_in, const int* in_sizes, int n_in, void* d_out, int out_size, void* d_ws, size_t ws_size, hipStream_t stream) {
    static int grid = 0;
    if (grid == 0) {
        if (n_in != 24 || in_sizes[0] != T * D || out_size != T * D || ws_size < WS_END) { fprintf(stderr, "kernel_launch: unexpected shapes / workspace (n_in %d, in0 %d, out %d, ws %zu < %zu)\n", n_in, n_in > 0 ? in_sizes[0] : -1, out_size, ws_size, (size_t)WS_END); grid = -1; return; }
        int dev = 0, cus = 0, per_cu = 0;
        if (hipGetDevice(&dev) != hipSuccess || hipDeviceGetAttribute(&cus, hipDeviceAttributeMultiprocessorCount, dev) != hipSuccess) { grid = -1; return; }
        if (hipFuncSetAttribute((const void*)fwd, hipFuncAttributeMaxDynamicSharedMemorySize, LDS_BYTES) != hipSuccess) { fprintf(stderr, "kernel_launch: hipFuncSetAttribute failed\n"); grid = -1; return; }
        if (hipOccupancyMaxActiveBlocksPerMultiprocessor(&per_cu, (const void*)fwd, NWAVES * 64, LDS_BYTES) != hipSuccess || per_cu < 1) { fprintf(stderr, "kernel_launch: occupancy query says %d\n", per_cu); }
        (void)hipGetLastError();
        grid = cus;
    }
    if (grid < 0) return;
    if (hipMemsetAsync((char*)d_ws + WS_CTL, 0, CTL_ZERO_BYTES, stream) != hipSuccess) return;
    Args a{};
    for (int i = 0; i < 24; ++i) a.in[i] = (const float*)d_in[i];
    a.out = (float*)d_out; a.ws = (unsigned char*)d_ws;
#if MK_PER_PHASE
    for (int p = 0; p < MK_LAST_PHASE; ++p) { a.ph_lo = p; a.ph_hi = p + 1; hipLaunchKernelGGL(fwd, dim3(grid), dim3(NWAVES * 64), LDS_BYTES, stream, a); }
#else
    a.ph_lo = 0; a.ph_hi = MK_LAST_PHASE;
    hipLaunchKernelGGL(fwd, dim3(grid), dim3(NWAVES * 64), LDS_BYTES, stream, a);
#endif
    const hipError_t le = hipPeekAtLastError();
    if (le != hipSuccess) fprintf(stderr, "kernel_launch: launch failed: %s\n", hipGetErrorName(le));
}
```
